# Optimizing an MI355X kernel written in HIP

```python
import math
import jax, jax.numpy as jnp
from jax import lax
import numpy as np

D_MODEL = 1024
BATCH = 2
SEQ = 8192
DEPTH = 4

CHUNK = 64
QBLK = 128
A_HEADS = 4
A_DQK = 64
A_DV = 2 * A_DQK
B_HEADS = 4
B_DH = 128
C_HEADS = 4
C_DK = 128
C_DV = 256
ROPE_BASE = 10000.0
N_BRANCH = 3
D_FF = 2816
CONV_W = 3
LN_EPS = 1e-5
ALPHA = (2 * DEPTH) ** 0.25
BETA = (8 * DEPTH) ** -0.25

SPLITS = (A_HEADS * 2 * A_DQK, A_HEADS * 2 * A_DQK, A_HEADS * A_DV,
          B_HEADS * B_DH, B_HEADS * B_DH, B_HEADS * B_DH, B_HEADS,
          C_HEADS * C_DK, C_HEADS * C_DK, C_HEADS * C_DV, C_HEADS * C_DV,
          N_BRANCH * D_MODEL)
D_IN = int(sum(SPLITS))
SPLIT_IDX = tuple(int(v) for v in np.cumsum(SPLITS)[:-1])

kernel_name = "hybrid_diff_fox_retention_convffn_deepnorm_adaln"


def _layernorm(x, g, b):
    xf = x.astype(jnp.float32)
    mu = jnp.mean(xf, -1, keepdims=True)
    var = jnp.mean(jnp.square(xf - mu), -1, keepdims=True)
    return ((xf - mu) * lax.rsqrt(var + LN_EPS) * g + b).astype(x.dtype)


def _head_rmsnorm(o, g):
    of = o.astype(jnp.float32)
    of = of * lax.rsqrt(jnp.mean(jnp.square(of), -1, keepdims=True) + LN_EPS)
    return of * g.reshape(o.shape[2], o.shape[3])


def _head_groupnorm(o, g):
    of = o.astype(jnp.float32)
    mu = jnp.mean(of, -1, keepdims=True)
    var = jnp.mean(jnp.square(of - mu), -1, keepdims=True)
    return (of - mu) * lax.rsqrt(var + LN_EPS) * g.reshape(o.shape[2], o.shape[3])


def _query_blocks(t):
    t = t.reshape((t.shape[0], t.shape[1] // QBLK, QBLK) + t.shape[2:])
    return jnp.moveaxis(t, 1, 0)


def _merge_blocks(o):
    o = jnp.moveaxis(o, 0, 1)
    return o.reshape((o.shape[0], o.shape[1] * o.shape[2]) + o.shape[3:])


def _diff_attention(q, k, v, lam):
    S_ = q.shape[1]
    scale = A_DQK ** -0.5
    k_chunk = jnp.arange(S_) // CHUNK

    def block(args):
        qb, i = args
        s = jnp.einsum('bqhmd,bkhmd->bhmqk', qb, k).astype(jnp.float32) * scale
        q_chunk = (i * QBLK + jnp.arange(QBLK)) // CHUNK
        mask = k_chunk[None, :] <= q_chunk[:, None]
        p = jax.nn.softmax(jnp.where(mask, s, -jnp.inf), axis=-1)
        a = p[:, :, 0] - lam * p[:, :, 1]
        return jnp.einsum('bhqk,bkhe->bqhe', a.astype(v.dtype), v)

    o = lax.map(block, (_query_blocks(q), jnp.arange(S_ // QBLK)))
    return _merge_blocks(o)


def _forgetting_attention(q, k, v, log_f):
    S_ = q.shape[1]
    scale = B_DH ** -0.5
    F = jnp.cumsum(log_f, axis=1)
    Fk = jnp.transpose(F, (0, 2, 1))[:, :, None, :]
    pos = jnp.arange(S_)

    def block(args):
        qb, Fq, i = args
        s = jnp.einsum('bqhd,bkhd->bhqk', qb, k).astype(jnp.float32) * scale
        s = s + jnp.transpose(Fq, (0, 2, 1))[..., None] - Fk
        q_pos = i * QBLK + jnp.arange(QBLK)
        mask = pos[None, :] <= q_pos[:, None]
        p = jax.nn.softmax(jnp.where(mask, s, -jnp.inf), axis=-1)
        return jnp.einsum('bhqk,bkhd->bqhd', p.astype(v.dtype), v)

    o = lax.map(block, (_query_blocks(q), _query_blocks(F), jnp.arange(S_ // QBLK)))
    return _merge_blocks(o)


def _rotary(t, pos):
    half = t.shape[-1] // 2
    inv = 1.0 / (ROPE_BASE ** jnp.linspace(0.0, 1.0, half, dtype=jnp.float32))
    ang = pos.astype(jnp.float32)[:, None] * inv[None, :]
    cos, sin = jnp.cos(ang)[None, :, None, :], jnp.sin(ang)[None, :, None, :]
    tf = t.astype(jnp.float32)
    t1, t2 = tf[..., :half], tf[..., half:]
    return jnp.concatenate([t1 * cos - t2 * sin, t1 * sin + t2 * cos], axis=-1)


def _retention(q, k, v):
    B_, S_ = q.shape[0], q.shape[1]
    nc = S_ // CHUNK
    log_gamma = jnp.log(1.0 - 2.0 ** (-5.0 - jnp.arange(C_HEADS, dtype=jnp.float32)))
    pos = jnp.arange(S_)
    qc = _rotary(q, pos).reshape(B_, nc, CHUNK, C_HEADS, C_DK)
    kc = (_rotary(k, pos) * C_DK ** -0.5).reshape(B_, nc, CHUNK, C_HEADS, C_DK)
    vc = v.astype(jnp.float32).reshape(B_, nc, CHUNK, C_HEADS, C_DV)
    i = jnp.arange(CHUNK, dtype=jnp.float32)
    diff = i[:, None] - i[None, :]
    dmask = jnp.where(diff >= 0, jnp.exp(log_gamma[:, None, None] * jnp.maximum(diff, 0.0)), 0.0)
    s = jnp.einsum('bnihd,bnjhd->bnhij', qc, kc) * dmask
    inner = jnp.einsum('bnhij,bnjhe->bnihe', s, vc)
    q_dec = qc * jnp.exp(log_gamma[None, :] * (i[:, None] + 1.0))[:, :, None]
    k_dec = kc * jnp.exp(log_gamma[None, :] * (CHUNK - 1.0 - i[:, None]))[:, :, None]
    chunk_decay = jnp.exp(log_gamma * CHUNK)[None, :, None, None]

    def step(R, xs):
        qd, kd, vv = xs
        cross = jnp.einsum('bihd,bhde->bihe', qd, R)
        R = chunk_decay * R + jnp.einsum('bjhd,bjhe->bhde', kd, vv)
        return R, cross

    R0 = jnp.zeros((B_, C_HEADS, C_DK, C_DV), jnp.float32)
    _, cross = lax.scan(step, R0, (jnp.moveaxis(q_dec, 1, 0), jnp.moveaxis(k_dec, 1, 0),
                                   jnp.moveaxis(vc, 1, 0)))
    o = inner + jnp.moveaxis(cross, 0, 1)
    return o.reshape(B_, S_, C_HEADS, C_DV)


def _token_mixer(h, w_in, b_in, lam, lam_init, g_diff, g_ret, w_pa, w_pb, w_pc, w_out):
    B_, S_, _ = h.shape
    z = h @ w_in + b_in
    aq, ak, av, bq, bk, bv, bf, cq, ck, cv, cg, gates = jnp.split(z, SPLIT_IDX, axis=-1)
    ya = _diff_attention(aq.reshape(B_, S_, A_HEADS, 2, A_DQK), ak.reshape(B_, S_, A_HEADS, 2, A_DQK),
                         av.reshape(B_, S_, A_HEADS, A_DV), lam)
    ya = (_head_rmsnorm(ya, g_diff) * (1.0 - lam_init)).astype(h.dtype).reshape(B_, S_, -1)
    yb = _forgetting_attention(bq.reshape(B_, S_, B_HEADS, B_DH), bk.reshape(B_, S_, B_HEADS, B_DH),
                               bv.reshape(B_, S_, B_HEADS, B_DH),
                               jax.nn.log_sigmoid(bf.astype(jnp.float32)))
    yb = yb.reshape(B_, S_, -1)
    yc = _retention(cq.reshape(B_, S_, C_HEADS, C_DK), ck.reshape(B_, S_, C_HEADS, C_DK),
                    cv.reshape(B_, S_, C_HEADS, C_DV))
    yc = _head_groupnorm(yc, g_ret).astype(h.dtype).reshape(B_, S_, -1) * jax.nn.silu(cg)
    ga, gb, gc = jnp.split(jax.nn.sigmoid(gates), N_BRANCH, axis=-1)
    m = ga * (ya @ w_pa) + gb * (yb @ w_pb) + gc * (yc @ w_pc)
    return m @ w_out


def _conv_ffn(h, w_up, w_conv, b_conv, w_down):
    S_ = h.shape[1]
    u, g = jnp.split(h @ w_up, 2, axis=-1)
    up = jnp.pad(u, ((0, 0), (CONV_W - 1, 0), (0, 0)))
    conv = b_conv + up[:, 0:S_] * w_conv[0]
    for j in range(1, CONV_W):
        conv = conv + up[:, j:j + S_] * w_conv[j]
    return (jax.nn.gelu(conv, approximate=False) * g) @ w_down


def setup_inputs(seed: int = 0) -> dict:
    key = jax.random.key(seed)
    ks = jax.random.split(key, 24)
    nrm = lambda k, shape, s: jax.random.normal(k, shape, jnp.float32) * s
    D = D_MODEL
    return {
        "x": nrm(ks[0], (BATCH, SEQ, D), 1.0),
        "c": nrm(ks[1], (BATCH, D), 1.0),
        "w_ada": nrm(ks[2], (DEPTH, D, 6 * D), D ** -0.5),
        "b_ada": nrm(ks[3], (DEPTH, 6 * D), 0.02),
        "w_in": nrm(ks[4], (DEPTH, D, D_IN), D ** -0.5),
        "b_in": nrm(ks[5], (DEPTH, D_IN), 0.02),
        "lam_q1": nrm(ks[6], (DEPTH, A_DQK), 0.1),
        "lam_k1": nrm(ks[7], (DEPTH, A_DQK), 0.1),
        "lam_q2": nrm(ks[8], (DEPTH, A_DQK), 0.1),
        "lam_k2": nrm(ks[9], (DEPTH, A_DQK), 0.1),
        "g_diff": 1.0 + nrm(ks[10], (DEPTH, A_HEADS * A_DV), 0.02),
        "g_ret": 1.0 + nrm(ks[11], (DEPTH, C_HEADS * C_DV), 0.02),
        "w_pa": nrm(ks[12], (DEPTH, A_HEADS * A_DV, D), (A_HEADS * A_DV) ** -0.5),
        "w_pb": nrm(ks[13], (DEPTH, B_HEADS * B_DH, D), (B_HEADS * B_DH) ** -0.5),
        "w_pc": nrm(ks[14], (DEPTH, C_HEADS * C_DV, D), (C_HEADS * C_DV) ** -0.5),
        "w_out": nrm(ks[15], (DEPTH, D, D), BETA * D ** -0.5),
        "ln_g": 1.0 + nrm(ks[16], (DEPTH, 2, D), 0.02),
        "ln_b": nrm(ks[17], (DEPTH, 2, D), 0.02),
        "w_up": nrm(ks[18], (DEPTH, D, 2 * D_FF), D ** -0.5),
        "w_conv": nrm(ks[19], (DEPTH, CONV_W, D_FF), CONV_W ** -0.5),
        "b_conv": nrm(ks[20], (DEPTH, D_FF), 0.02),
        "w_down": nrm(ks[21], (DEPTH, D_FF, D), BETA * D_FF ** -0.5),
    }


def reference(x, c, w_ada, b_ada, w_in, b_in, lam_q1, lam_k1, lam_q2, lam_k2, g_diff, g_ret,
              w_pa, w_pb, w_pc, w_out, ln_g, ln_b, w_up, w_conv, b_conv, w_down):
    c_act = jax.nn.silu(c)
    for l in range(DEPTH):
        mod = c_act @ w_ada[l] + b_ada[l]
        sh1, sc1, gt1, sh2, sc2, gt2 = [m[:, None, :] for m in jnp.split(mod, 6, axis=-1)]
        lam_init = 0.8 - 0.6 * math.exp(-0.3 * l)
        lam = (jnp.exp(jnp.sum(lam_q1[l].astype(jnp.float32) * lam_k1[l].astype(jnp.float32)))
               - jnp.exp(jnp.sum(lam_q2[l].astype(jnp.float32) * lam_k2[l].astype(jnp.float32)))
               + lam_init)
        h = x * (1.0 + sc1) + sh1
        y = _token_mixer(h, w_in[l], b_in[l], lam, lam_init, g_diff[l], g_ret[l],
                         w_pa[l], w_pb[l], w_pc[l], w_out[l])
        x = _layernorm(ALPHA * x + gt1 * y, ln_g[l, 0], ln_b[l, 0])
        h = x * (1.0 + sc2) + sh2
        y = _conv_ffn(h, w_up[l], w_conv[l], b_conv[l], w_down[l])
        x = _layernorm(ALPHA * x + gt2 * y, ln_g[l, 1], ln_b[l, 1])
    return x
```

```cpp
#include <hip/hip_runtime.h>
#include <hip/hip_cooperative_groups.h>
#include <cstdio>
#include <cstdint>
namespace cg = cooperative_groups;

typedef unsigned short bf16_t;
typedef short bf16x8 __attribute__((ext_vector_type(8)));
typedef float f32x4 __attribute__((ext_vector_type(4)));

constexpr int Dm = 1024, NB = 2, S = 8192, T = NB * S, DEPTH = 4, DFF = 2816, DIN = 9220, NIN = 9216;
constexpr float LN_EPS = 1e-5f;
constexpr float LOG2E = 1.4426950408889634f;
#define ALPHA_F 1.681792830507429f

#define DI __device__ __forceinline__
DI int otid() { int t = threadIdx.x; asm volatile("" : "+v"(t)); return t; }
DI int obid() { int b = blockIdx.x; asm volatile("" : "+s"(b)); return b; }

DI bf16_t f2bf(float x) { unsigned u = __float_as_uint(x); u += 0x7fffu + ((u >> 16) & 1u); return (bf16_t)(u >> 16); }
DI float bf2f(bf16_t v) { return __uint_as_float(((unsigned)v) << 16); }
DI float bflo(unsigned w) { return __uint_as_float(w << 16); }
DI float bfhi(unsigned w) { return __uint_as_float(w & 0xffff0000u); }
DI unsigned pack2(float a, float b) { return (unsigned)f2bf(a) | ((unsigned)f2bf(b) << 16); }

struct Params {
    const float *x, *c, *w_ada, *b_ada, *w_in, *b_in, *lq1, *lk1, *lq2, *lk2, *g_diff, *g_ret, *w_pa, *w_pb, *w_pc, *w_out, *ln_g, *ln_b, *w_up, *w_conv, *b_conv, *w_down;
    float* out;
    unsigned* ctr;
    float *mod, *lamv, *wf, *binp, *cstab, *xbuf, *vbuf, *logf, *F, *oc;
    bf16_t *WinT, *WpaT, *WpbT, *WpcT, *WoutT, *WupT, *WdownT;
    bf16_t *h, *qa, *ka, *vta, *qb, *kb, *vtb, *cq, *ck, *cv, *cg, *gates, *oa, *yb, *ya, *yc, *ug, *act, *ckT, *kv;
};

constexpr int BM = 128, BN = 128, BK = 64, LDP = BK + 8;
constexpr int SMEM_BYTES = 2 * (BM + BN) * LDP * 2;

DI int win_map(int n) {
    if (n < 3072) return n;
    if (n < 4096) { int r = n - 3072; int seg = r >> 9; r &= 511; int head = r >> 7; int c = r & 127; return 3076 + seg * 512 + head * 128 + (c >> 1) + 64 * (c & 1); }
    return n + 4;
}

DI void convert_tile(const float* __restrict__ src, int ldsrc, bf16_t* __restrict__ dst, int K, int tiles_n, int tile, int kind, float* lds) {
    const int tn = tile % tiles_n, tk = tile / tiles_n;
    const int tx = otid() & 63, ty = otid() >> 6;
    const int n = tn * 64 + tx;
    const int sn = kind == 1 ? win_map(n) : n;
    __syncthreads();
#pragma unroll 4
    for (int r = 0; r < 16; ++r) {
        const int kk = ty * 16 + r;
        lds[kk * 65 + tx] = src[(size_t)(tk * 64 + kk) * ldsrc + sn];
    }
    __syncthreads();
#pragma unroll 4
    for (int r = 0; r < 16; ++r) {
        const int nn = ty * 16 + r;
        dst[(size_t)(tn * 64 + nn) * K + tk * 64 + tx] = f2bf(lds[tx * 65 + nn]);
    }
}

DI void convert_layer(const Params& p, int l, float* lds) {
    const int n_in = 16 * 144, n_pa = 8 * 16, n_pb = 8 * 16, n_pc = 16 * 16, n_out = 16 * 16, n_up = 16 * 88, n_dn = 44 * 16;
    const int total = n_in + n_pa + n_pb + n_pc + n_out + n_up + n_dn;
    for (int it = obid(); it < total; it += gridDim.x) {
        int t = it;
        if (t < n_in) { convert_tile(p.w_in + (size_t)l * Dm * DIN, DIN, p.WinT, 1024, 144, t, 1, lds); continue; } t -= n_in;
        if (t < n_pa) { convert_tile(p.w_pa + (size_t)l * 512 * Dm, Dm, p.WpaT, 512, 16, t, 0, lds); continue; } t -= n_pa;
        if (t < n_pb) { convert_tile(p.w_pb + (size_t)l * 512 * Dm, Dm, p.WpbT, 512, 16, t, 0, lds); continue; } t -= n_pb;
        if (t < n_pc) { convert_tile(p.w_pc + (size_t)l * 1024 * Dm, Dm, p.WpcT, 1024, 16, t, 0, lds); continue; } t -= n_pc;
        if (t < n_out) { convert_tile(p.w_out + (size_t)l * Dm * Dm, Dm, p.WoutT, 1024, 16, t, 0, lds); continue; } t -= n_out;
        if (t < n_up) { convert_tile(p.w_up + (size_t)l * Dm * 2 * DFF, 2 * DFF, p.WupT, 1024, 88, t, 0, lds); continue; } t -= n_up;
        convert_tile(p.w_down + (size_t)l * DFF * Dm, Dm, p.WdownT, DFF, 16, t, 0, lds);
    }
    const int gtid = obid() * blockDim.x + otid(), gsz = gridDim.x * blockDim.x;
    for (int i = gtid; i < NIN; i += gsz) p.binp[i] = p.b_in[(size_t)l * DIN + win_map(i)];
    for (int i = gtid; i < 4096; i += gsz) { const int k = i >> 2, hh = i & 3; p.wf[i] = p.w_in[(size_t)l * Dm * DIN + (size_t)k * DIN + 3072 + hh]; }
    for (int i = gtid; i < 4; i += gsz) p.wf[4096 + i] = p.b_in[(size_t)l * DIN + 3072 + i];
}

DI float ex2(float x) { return __builtin_amdgcn_exp2f(x); }
DI float silu_f(float v) { return v / (1.f + __expf(-v)); }
DI float sigmoid_f(float v) { return 1.f / (1.f + __expf(-v)); }

DI void phase0_misc(const Params& p, float* lds) {
    for (int it = obid(); it < DEPTH * 96; it += gridDim.x) {
        const int l = it / 96, jb = it % 96;
        const int tx = otid() & 63, ks = otid() >> 6;
        const int j = jb * 64 + tx;
        const float* w = p.w_ada + (size_t)l * Dm * 6144 + j;
        float a0 = 0.f, a1 = 0.f;
#pragma unroll 8
        for (int k = ks * 256; k < ks * 256 + 256; ++k) {
            const float wv = w[(size_t)k * 6144];
            a0 += silu_f(p.c[k]) * wv; a1 += silu_f(p.c[Dm + k]) * wv;
        }
        __syncthreads();
        lds[(ks * 64 + tx) * 2] = a0; lds[(ks * 64 + tx) * 2 + 1] = a1;
        __syncthreads();
        if (ks == 0) {
            float s0 = 0.f, s1 = 0.f;
            for (int q = 0; q < 4; ++q) { s0 += lds[(q * 64 + tx) * 2]; s1 += lds[(q * 64 + tx) * 2 + 1]; }
            const float bb = p.b_ada[(size_t)l * 6144 + j];
            p.mod[((size_t)l * 2 + 0) * 6144 + j] = s0 + bb;
            p.mod[((size_t)l * 2 + 1) * 6144 + j] = s1 + bb;
        }
    }
    const int gtid = obid() * blockDim.x + otid(), gsz = gridDim.x * blockDim.x;
    for (int i = gtid; i < S * 64; i += gsz) {
        const int pos = i >> 6, fi = i & 63;
        const float invf = 1.0f / powf(10000.0f, (float)fi * (1.0f / 63.0f));
        const float angf = (float)pos * invf;
        const double rev = (double)angf * 0.15915494309189535;
        const double fr = rev - floor(rev);
        const float a = (float)(fr * 6.283185307179586);
        p.cstab[2 * i] = cosf(a); p.cstab[2 * i + 1] = sinf(a);
    }
    if (gtid < 64) p.ctr[gtid] = 0u;
    if (obid() == 0 && otid() < 64 * DEPTH) {
        const int l = otid() >> 6, ln = otid() & 63;
        float a = p.lq1[l * 64 + ln] * p.lk1[l * 64 + ln], b = p.lq2[l * 64 + ln] * p.lk2[l * 64 + ln];
        for (int o = 32; o; o >>= 1) { a += __shfl_xor(a, o); b += __shfl_xor(b, o); }
        if (ln == 0) { const float li = 0.8f - 0.6f * expf(-0.3f * (float)l); p.lamv[2 * l] = expf(a) - expf(b) + li; p.lamv[2 * l + 1] = li; }
    }
}

DI void row_phase(const Params& p, const float* __restrict__ src, bool do_ln, const float* __restrict__ lng, const float* __restrict__ lnb,
                  float* __restrict__ xdst, const float* __restrict__ modl  , int sh_off, int sc_off, bool want_h, bool want_logf) {
    const int lane = otid() & 63, wv = otid() >> 6;
    for (int row = obid() * 4 + wv; row < T; row += gridDim.x * 4) {
        const int b = row / S;
        const float* sp = src + (size_t)row * Dm;
        f32x4 v[4];
#pragma unroll
        for (int i = 0; i < 4; ++i) v[i] = *(const f32x4*)(sp + i * 256 + lane * 4);
        if (do_ln) {
            float s = 0.f;
#pragma unroll
            for (int i = 0; i < 4; ++i) s += (v[i][0] + v[i][1]) + (v[i][2] + v[i][3]);
            for (int o = 32; o; o >>= 1) s += __shfl_xor(s, o);
            const float mu = s * (1.f / 1024.f);
            float q = 0.f;
#pragma unroll
            for (int i = 0; i < 4; ++i) { f32x4 d = v[i] - mu; q += (d[0] * d[0] + d[1] * d[1]) + (d[2] * d[2] + d[3] * d[3]); }
            for (int o = 32; o; o >>= 1) q += __shfl_xor(q, o);
            const float rstd = rsqrtf(q * (1.f / 1024.f) + LN_EPS);
#pragma unroll
            for (int i = 0; i < 4; ++i) {
                const f32x4 g = *(const f32x4*)(lng + i * 256 + lane * 4), bb = *(const f32x4*)(lnb + i * 256 + lane * 4);
                v[i] = (v[i] - mu) * rstd * g + bb;
            }
        }
        if (xdst) {
#pragma unroll
            for (int i = 0; i < 4; ++i) *(f32x4*)(xdst + (size_t)row * Dm + i * 256 + lane * 4) = v[i];
        }
        if (want_h) {
            const float* mb = modl + (size_t)b * 6144;
            float d0 = 0.f, d1 = 0.f, d2 = 0.f, d3 = 0.f;
#pragma unroll
            for (int i = 0; i < 4; ++i) {
                const int c0 = i * 256 + lane * 4;
                const f32x4 sc = *(const f32x4*)(mb + sc_off + c0), sh = *(const f32x4*)(mb + sh_off + c0);
                const f32x4 hv = v[i] * (1.f + sc) + sh;
                uint2 w; w.x = pack2(hv[0], hv[1]); w.y = pack2(hv[2], hv[3]);
                *(uint2*)(p.h + (size_t)row * Dm + c0) = w;
                if (want_logf) {
#pragma unroll
                    for (int j = 0; j < 4; ++j) {
                        const f32x4 wf = *(const f32x4*)(p.wf + (c0 + j) * 4);
                        d0 += hv[j] * wf[0]; d1 += hv[j] * wf[1]; d2 += hv[j] * wf[2]; d3 += hv[j] * wf[3];
                    }
                }
            }
            if (want_logf) {
                for (int o = 32; o; o >>= 1) { d0 += __shfl_xor(d0, o); d1 += __shfl_xor(d1, o); d2 += __shfl_xor(d2, o); d3 += __shfl_xor(d3, o); }
                if (lane < 4) {
                    float z = (lane == 0 ? d0 : lane == 1 ? d1 : lane == 2 ? d2 : d3) + p.wf[4096 + lane];
                    const float ls = fminf(z, 0.f) - log1pf(__expf(-fabsf(z)));
                    p.logf[(size_t)row * 4 + lane] = ls * LOG2E;
                }
            }
        }
    }
}

DI void scan_item(const Params& p, int item, float* lds) {
    const int b = item >> 2, hh = item & 3, tid = otid();
    const float* lp = p.logf + (size_t)b * S * 4 + hh;
    float loc[32]; float s = 0.f;
#pragma unroll
    for (int i = 0; i < 32; ++i) { s += lp[(size_t)(tid * 32 + i) * 4]; loc[i] = s; }
    __syncthreads();
    lds[tid] = s;
    __syncthreads();
    float pre = 0.f;
    for (int i = 0; i < tid; ++i) pre += lds[i];
    float* fp = p.F + (size_t)(b * 4 + hh) * S + tid * 32;
#pragma unroll
    for (int i = 0; i < 32; ++i) fp[i] = pre + loc[i];
    __syncthreads();
}

DI void gemm_kloop(const bf16_t* __restrict__ Ag, int lda, const bf16_t* __restrict__ Bg, int ldb, int K, f32x4 (&acc)[4][4], bf16_t* sm) {
    const int tid = otid(), lane = tid & 63, wid = tid >> 6, wr = wid >> 1, wc = wid & 1;
    bf16_t* sa = sm; bf16_t* sb = sm + 2 * BM * LDP;
    const int lrow = tid >> 3, lcc = tid & 7;
    const bf16_t* ap = Ag + (size_t)lrow * lda + lcc * 8;
    const bf16_t* bp = Bg + (size_t)lrow * ldb + lcc * 8;
    const size_t sA = (size_t)32 * lda, sB = (size_t)32 * ldb;
    uint4 ra0, ra1, ra2, ra3, rb0, rb1, rb2, rb3;
#define G_LOAD(koff) do { ra0 = *(const uint4*)(ap + (koff)); ra1 = *(const uint4*)(ap + sA + (koff)); ra2 = *(const uint4*)(ap + 2 * sA + (koff)); ra3 = *(const uint4*)(ap + 3 * sA + (koff)); \
                          rb0 = *(const uint4*)(bp + (koff)); rb1 = *(const uint4*)(bp + sB + (koff)); rb2 = *(const uint4*)(bp + 2 * sB + (koff)); rb3 = *(const uint4*)(bp + 3 * sB + (koff)); } while (0)
#define G_STORE(buf) do { bf16_t* da_ = sa + (buf) * BM * LDP + lrow * LDP + lcc * 8; bf16_t* db_ = sb + (buf) * BN * LDP + lrow * LDP + lcc * 8; \
        *(uint4*)(da_) = ra0; *(uint4*)(da_ + 32 * LDP) = ra1; *(uint4*)(da_ + 64 * LDP) = ra2; *(uint4*)(da_ + 96 * LDP) = ra3; \
        *(uint4*)(db_) = rb0; *(uint4*)(db_ + 32 * LDP) = rb1; *(uint4*)(db_ + 64 * LDP) = rb2; *(uint4*)(db_ + 96 * LDP) = rb3; } while (0)
    G_LOAD(0);
    G_STORE(0);
    __syncthreads();
    const int nk = K / BK;
    const int fr = lane & 15, fq = lane >> 4;
    for (int kt = 0; kt < nk; ++kt) {
        const int cur = kt & 1;
        const bool more = kt + 1 < nk;
        if (more) G_LOAD((kt + 1) * BK);
        const bf16_t* ca = sa + cur * BM * LDP + (wr * 64 + fr) * LDP + fq * 8;
        const bf16_t* cb = sb + cur * BN * LDP + (wc * 64 + fr) * LDP + fq * 8;
#pragma unroll
        for (int kk = 0; kk < 2; ++kk) {
            bf16x8 af[4], bfr[4];
#pragma unroll
            for (int m = 0; m < 4; ++m) af[m] = *(const bf16x8*)(ca + m * 16 * LDP + kk * 32);
#pragma unroll
            for (int n = 0; n < 4; ++n) bfr[n] = *(const bf16x8*)(cb + n * 16 * LDP + kk * 32);
#pragma unroll
            for (int m = 0; m < 4; ++m)
#pragma unroll
                for (int n = 0; n < 4; ++n) acc[m][n] = __builtin_amdgcn_mfma_f32_16x16x32_bf16(bfr[n], af[m], acc[m][n], 0, 0, 0);
        }
        if (more) G_STORE(cur ^ 1);
        __syncthreads();
    }
#undef G_LOAD
#undef G_STORE
}

DI void tile_coords(int tile, int nM, int nN, int& mt, int& nt) {
    const int band = tile / (16 * nN), r = tile % (16 * nN);
    mt = band * 16 + (r & 15); nt = r >> 4;
}

DI void zero_acc(f32x4 (&acc)[4][4]) {
#pragma unroll
    for (int m = 0; m < 4; ++m)
#pragma unroll
        for (int n = 0; n < 4; ++n) acc[m][n] = (f32x4){0.f, 0.f, 0.f, 0.f};
}

DI void st4_wt(bf16_t* dst, f32x4 v) { const unsigned long long w = (unsigned long long)pack2(v[0], v[1]) | ((unsigned long long)pack2(v[2], v[3]) << 32); __hip_atomic_store((unsigned long long*)dst, w, __ATOMIC_RELAXED, __HIP_MEMORY_SCOPE_AGENT); }
DI void st4(bf16_t* dst, f32x4 v) { uint2 w; w.x = pack2(v[0], v[1]); w.y = pack2(v[2], v[3]); *(uint2*)dst = w; }

DI void epi_inproj(const Params& p, int row, int col, f32x4 v) {
    v += *(const f32x4*)(p.binp + col);
    const int b = row / S, s = row % S;
    if (col < 512) { st4(p.qa + (size_t)row * 512 + col, v * (0.125f * LOG2E)); }
    else if (col < 1024) { st4(p.ka + (size_t)row * 512 + (col - 512), v); }
    else if (col < 1536) { const int c = col - 1024, hh = c >> 7, e = c & 127; bf16_t* d = p.vta + ((size_t)(b * 4 + hh) * 128 + e) * S + s;
#pragma unroll
        for (int j = 0; j < 4; ++j) d[(size_t)j * S] = f2bf(v[j]); }
    else if (col < 2048) { st4(p.qb + (size_t)row * 512 + (col - 1536), v * (0.08838834764831845f * LOG2E)); }
    else if (col < 2560) { st4(p.kb + (size_t)row * 512 + (col - 2048), v); }
    else if (col < 3072) { const int c = col - 2560, hh = c >> 7, e = c & 127; bf16_t* d = p.vtb + ((size_t)(b * 4 + hh) * 128 + e) * S + s;
#pragma unroll
        for (int j = 0; j < 4; ++j) d[(size_t)j * S] = f2bf(v[j]); }
    else if (col < 4096) {
        const int r = col - 3072, seg = r >> 9, c = r & 511, cc = c & 127, i0 = cc >> 1, hd = c >> 7;
        f32x4 cs;
        {
            const float a0 = (float)s * ex2(-(float)i0 * 0.21091607f), a1 = (float)s * ex2(-(float)(i0 + 1) * 0.21091607f);
            float r0 = a0 * 0.15915494309189535f, r1 = a1 * 0.15915494309189535f;
            r0 -= floorf(r0); r1 -= floorf(r1);
            cs[0] = __builtin_amdgcn_cosf(r0); cs[1] = __builtin_amdgcn_sinf(r0); cs[2] = __builtin_amdgcn_cosf(r1); cs[3] = __builtin_amdgcn_sinf(r1);
        }
        f32x4 o; o[0] = v[0] * cs[0] - v[1] * cs[1]; o[1] = v[0] * cs[1] + v[1] * cs[0]; o[2] = v[2] * cs[2] - v[3] * cs[3]; o[3] = v[2] * cs[3] + v[3] * cs[2];
        const float lg = __log2f(1.0f - ex2(-5.0f - (float)hd));
        const int ic = s & 63;
        if (seg == 0) st4(p.cq + (size_t)row * 512 + c, o * ex2(lg * (float)(ic + 1)));
        else {
            o = o * 0.08838834764831845f;
            st4(p.ck + (size_t)row * 512 + c, o * ex2(-lg * (float)(ic + 1)));
            const f32x4 od = o * ex2(lg * (float)(63 - ic));
            bf16_t* d = p.ckT + ((size_t)(b * 4 + hd) * 128 + cc) * S + s;
#pragma unroll
            for (int j = 0; j < 4; ++j) d[(size_t)j * S] = f2bf(od[j]);
        }
    }
    else if (col < 5120) { const int c = col - 4096; bf16_t* d = p.cv + ((size_t)b * 1024 + c) * S + s;
#pragma unroll
        for (int j = 0; j < 4; ++j) d[(size_t)j * S] = f2bf(v[j]); }
    else if (col < 6144) { f32x4 o; for (int j = 0; j < 4; ++j) o[j] = silu_f(v[j]); st4(p.cg + (size_t)row * 1024 + (col - 5120), o); }
    else { f32x4 o; for (int j = 0; j < 4; ++j) o[j] = sigmoid_f(v[j]); st4(p.gates + (size_t)row * 3072 + (col - 6144), o); }
}

DI void phase_inproj(const Params& p, bf16_t* sm) {
    const int nM = T / BM, nN = NIN / BN;
    const int lane = otid() & 63, wid = otid() >> 6, wr = wid >> 1, wc = wid & 1;
    for (int tile = obid(); tile < nM * nN; tile += gridDim.x) {
        int mt, nt; tile_coords(tile, nM, nN, mt, nt);
        f32x4 acc[4][4]; zero_acc(acc);
        gemm_kloop(p.h + (size_t)mt * BM * Dm, Dm, p.WinT + (size_t)nt * BN * Dm, Dm, Dm, acc, sm);
#pragma unroll
        for (int m = 0; m < 4; ++m)
#pragma unroll
            for (int n = 0; n < 4; ++n) epi_inproj(p, mt * BM + wr * 64 + m * 16 + (lane & 15), nt * BN + wc * 64 + n * 16 + (lane >> 4) * 4, acc[m][n]);
    }
}

DI void phase_branch(const Params& p, bf16_t* sm) {
    const int nM = T / BM, nN = Dm / BN;
    const int lane = otid() & 63, wid = otid() >> 6, wr = wid >> 1, wc = wid & 1;
    for (int tile = obid(); tile < nM * nN; tile += gridDim.x) {
        int mt, nt; tile_coords(tile, nM, nN, mt, nt);
        f32x4 tot[4][4]; zero_acc(tot);
#pragma unroll 1
        for (int br = 0; br < 3; ++br) {
            const bf16_t* A = br == 0 ? p.ya : br == 1 ? p.yb : p.yc;
            const bf16_t* W = br == 0 ? p.WpaT : br == 1 ? p.WpbT : p.WpcT;
            const int K = br == 2 ? 1024 : 512;
            f32x4 acc[4][4]; zero_acc(acc);
            gemm_kloop(A + (size_t)mt * BM * K, K, W + (size_t)nt * BN * K, K, K, acc, sm);
#pragma unroll
            for (int m = 0; m < 4; ++m)
#pragma unroll
                for (int n = 0; n < 4; ++n) {
                    const int row = mt * BM + wr * 64 + m * 16 + (lane & 15), col = nt * BN + wc * 64 + n * 16 + (lane >> 4) * 4;
                    const uint2 g = *(const uint2*)(p.gates + (size_t)row * 3072 + br * 1024 + col);
                    tot[m][n][0] += bflo(g.x) * acc[m][n][0]; tot[m][n][1] += bfhi(g.x) * acc[m][n][1];
                    tot[m][n][2] += bflo(g.y) * acc[m][n][2]; tot[m][n][3] += bfhi(g.y) * acc[m][n][3];
                }
        }
#pragma unroll
        for (int m = 0; m < 4; ++m)
#pragma unroll
            for (int n = 0; n < 4; ++n) {
                const int row = mt * BM + wr * 64 + m * 16 + (lane & 15), col = nt * BN + wc * 64 + n * 16 + (lane >> 4) * 4;
                st4(p.h + (size_t)row * Dm + col, tot[m][n]);
            }
    }
}

DI void phase_gemm_res(const Params& p, const bf16_t* A, int K, const bf16_t* Wt, const float* xres, const float* modl, int gt_off, bf16_t* sm) {
    const int nM = T / BM, nN = Dm / BN;
    const int lane = otid() & 63, wid = otid() >> 6, wr = wid >> 1, wc = wid & 1;
    for (int tile = obid(); tile < nM * nN; tile += gridDim.x) {
        int mt, nt; tile_coords(tile, nM, nN, mt, nt);
        f32x4 acc[4][4]; zero_acc(acc);
        gemm_kloop(A + (size_t)mt * BM * K, K, Wt + (size_t)nt * BN * K, K, K, acc, sm);
#pragma unroll
        for (int m = 0; m < 4; ++m)
#pragma unroll
            for (int n = 0; n < 4; ++n) {
                const int row = mt * BM + wr * 64 + m * 16 + (lane & 15), col = nt * BN + wc * 64 + n * 16 + (lane >> 4) * 4;
                const int b = row / S;
                const f32x4 xr = *(const f32x4*)(xres + (size_t)row * Dm + col);
                const f32x4 gt = *(const f32x4*)(modl + (size_t)b * 6144 + gt_off + col);
                *(f32x4*)(p.vbuf + (size_t)row * Dm + col) = xr * ALPHA_F + gt * acc[m][n];
            }
    }
}

DI void phase_up(const Params& p, bf16_t* sm) {
    const int nM = T / BM, nN = 2 * DFF / BN;
    const int lane = otid() & 63, wid = otid() >> 6, wr = wid >> 1, wc = wid & 1;
    for (int tile = obid(); tile < nM * nN; tile += gridDim.x) {
        int mt, nt; tile_coords(tile, nM, nN, mt, nt);
        f32x4 acc[4][4]; zero_acc(acc);
        gemm_kloop(p.h + (size_t)mt * BM * Dm, Dm, p.WupT + (size_t)nt * BN * Dm, Dm, Dm, acc, sm);
#pragma unroll
        for (int m = 0; m < 4; ++m)
#pragma unroll
            for (int n = 0; n < 4; ++n) {
                const int row = mt * BM + wr * 64 + m * 16 + (lane & 15), col = nt * BN + wc * 64 + n * 16 + (lane >> 4) * 4;
                st4(p.ug + (size_t)row * (2 * DFF) + col, acc[m][n]);
            }
    }
}

DI void phase_conv(const Params& p, int l) {
    const int gtid = obid() * blockDim.x + otid(), gsz = gridDim.x * blockDim.x;
    const float* wc = p.w_conv + (size_t)l * 3 * DFF; const float* bc = p.b_conv + (size_t)l * DFF;
    for (int i = gtid; i < T * (DFF / 8); i += gsz) {
        const int row = i / (DFF / 8), c8 = (i % (DFF / 8)) * 8, s = row % S;
        const bf16_t* up = p.ug + (size_t)row * (2 * DFF) + c8;
        const uint4 u0 = *(const uint4*)up;
        uint4 u1 = make_uint4(0, 0, 0, 0), u2 = make_uint4(0, 0, 0, 0);
        if (s >= 1) u1 = *(const uint4*)(up - 2 * DFF);
        if (s >= 2) u2 = *(const uint4*)(up - 4 * DFF);
        const uint4 gg = *(const uint4*)(up + DFF);
        const unsigned a0[4] = {u0.x, u0.y, u0.z, u0.w}, a1[4] = {u1.x, u1.y, u1.z, u1.w}, a2[4] = {u2.x, u2.y, u2.z, u2.w}, ag[4] = {gg.x, gg.y, gg.z, gg.w};
        unsigned o[4];
#pragma unroll
        for (int j = 0; j < 4; ++j) {
            float r[2];
#pragma unroll
            for (int hl = 0; hl < 2; ++hl) {
                const int cidx = c8 + 2 * j + hl;
                const float x0 = hl ? bfhi(a0[j]) : bflo(a0[j]), x1 = hl ? bfhi(a1[j]) : bflo(a1[j]), x2 = hl ? bfhi(a2[j]) : bflo(a2[j]), g = hl ? bfhi(ag[j]) : bflo(ag[j]);
                const float cv = bc[cidx] + wc[cidx] * x2 + wc[DFF + cidx] * x1 + wc[2 * DFF + cidx] * x0;
                r[hl] = 0.5f * cv * (1.f + erff(cv * 0.7071067811865476f)) * g;
            }
            o[j] = pack2(r[0], r[1]);
        }
        *(uint4*)(p.act + (size_t)row * DFF + c8) = make_uint4(o[0], o[1], o[2], o[3]);
    }
}

template <int MODE>
DI void naive_attn(const Params& p, int item) {
    constexpr int D = MODE == 0 ? 64 : 128;
    constexpr int DV = MODE == 2 ? 256 : 128;
    constexpr int SW = DV / 4;
    constexpr int NH = MODE == 0 ? 8 : 4;
    const int tid = otid(), lane = tid & 63;
    const int sl = __builtin_amdgcn_readfirstlane(tid >> 6);
    const int qblk = 127 - (item % 128), hh = (item / 128) % NH, b = item / (128 * NH);
    const int q = qblk * 64 + lane; const size_t tq = (size_t)b * S + q;
    const bf16_t *Q, *Kp;
    if (MODE == 0) { Q = p.qa + tq * 512 + hh * 64; Kp = p.ka + (size_t)b * S * 512 + hh * 64; }
    else if (MODE == 1) { Q = p.qb + tq * 512 + hh * 128; Kp = p.kb + (size_t)b * S * 512 + hh * 128; }
    else { Q = p.cq + tq * 512 + hh * 128; Kp = p.ck + (size_t)b * S * 512 + hh * 128; }
    unsigned qp[D / 2];
#pragma unroll
    for (int i = 0; i < D / 8; ++i) { const uint4 t = ((const uint4*)Q)[i]; qp[4 * i] = t.x; qp[4 * i + 1] = t.y; qp[4 * i + 2] = t.z; qp[4 * i + 3] = t.w; }
    float acc[SW];
#pragma unroll
    for (int i = 0; i < SW; ++i) acc[i] = 0.f;
    float mx = -INFINITY, lsum = 0.f;
    const int send = (qblk + 1) * 64;
    float Fq = 0.f; const float* Fk = nullptr;
    if (MODE == 1) { Fk = p.F + (size_t)(b * 4 + hh) * S; Fq = Fk[q]; }
    float lg = 0.f;
    if (MODE == 2) lg = log2f(1.0f - exp2f(-5.0f - (float)hh));
    for (int s = 0; s < send; ++s) {
        const uint4* kr = (const uint4*)(Kp + (size_t)s * 512);
        float sc = 0.f;
#pragma unroll
        for (int i = 0; i < D / 8; ++i) {
            const uint4 kv = kr[i];
            sc += bflo(qp[4 * i]) * bflo(kv.x) + bfhi(qp[4 * i]) * bfhi(kv.x);
            sc += bflo(qp[4 * i + 1]) * bflo(kv.y) + bfhi(qp[4 * i + 1]) * bfhi(kv.y);
            sc += bflo(qp[4 * i + 2]) * bflo(kv.z) + bfhi(qp[4 * i + 2]) * bfhi(kv.z);
            sc += bflo(qp[4 * i + 3]) * bflo(kv.w) + bfhi(qp[4 * i + 3]) * bfhi(kv.w);
            if ((i & 3) == 3) asm volatile("" ::: "memory");
        }
        float w, corr = 1.f;
        if (MODE == 2) {
            w = (s <= q) ? sc * exp2f((float)(q - s) * lg) : 0.f;
        } else {
            if (MODE == 1) sc += Fq - Fk[s];
            const bool valid = (MODE == 0) || (s <= q);
            if (valid) {
                const float mn = fmaxf(mx, sc);
                corr = exp2f(mx - mn); w = exp2f(sc - mn); mx = mn;
                lsum = lsum * corr + w;
            } else { w = 0.f; }
        }
        if (MODE == 2) {
            const uint4* vr = (const uint4*)(p.cv + ((size_t)b * S + s) * 1024 + hh * 256 + sl * SW);
#pragma unroll
            for (int i = 0; i < SW / 8; ++i) {
                const uint4 vv = vr[i];
                acc[8 * i] += w * bflo(vv.x); acc[8 * i + 1] += w * bfhi(vv.x); acc[8 * i + 2] += w * bflo(vv.y); acc[8 * i + 3] += w * bfhi(vv.y);
                acc[8 * i + 4] += w * bflo(vv.z); acc[8 * i + 5] += w * bfhi(vv.z); acc[8 * i + 6] += w * bflo(vv.w); acc[8 * i + 7] += w * bfhi(vv.w);
            }
        } else {
            const bf16_t* vt = (MODE == 0 ? p.vta + ((size_t)(b * 4 + (hh >> 1)) * 128 + sl * SW) * S : p.vtb + ((size_t)(b * 4 + hh) * 128 + sl * SW) * S) + s;
#pragma unroll
            for (int i = 0; i < SW; ++i) { acc[i] = acc[i] * corr + w * bf2f(*vt); vt += S; asm volatile("" : "+v"(vt)); }
        }
    }
    if (MODE == 2) {
        float* o = p.oc + tq * 1024 + hh * 256 + sl * SW;
#pragma unroll
        for (int i = 0; i < SW / 4; ++i) *(f32x4*)(o + 4 * i) = (f32x4){acc[4 * i], acc[4 * i + 1], acc[4 * i + 2], acc[4 * i + 3]};
    } else {
        const float inv = 1.f / lsum;
        bf16_t* o = (MODE == 0 ? p.oa + tq * 1024 + hh * 128 : p.yb + tq * 512 + hh * 128) + sl * SW;
#pragma unroll
        for (int i = 0; i < SW / 8; ++i) {
            uint4 w4; w4.x = pack2(acc[8 * i] * inv, acc[8 * i + 1] * inv); w4.y = pack2(acc[8 * i + 2] * inv, acc[8 * i + 3] * inv);
            w4.z = pack2(acc[8 * i + 4] * inv, acc[8 * i + 5] * inv); w4.w = pack2(acc[8 * i + 6] * inv, acc[8 * i + 7] * inv);
            ((uint4*)o)[i] = w4;
        }
    }
}


typedef float f32x16 __attribute__((ext_vector_type(16)));
DI bf16x8 pack8(float a0, float a1, float a2, float a3, float a4, float a5, float a6, float a7) {
    typedef unsigned u32x4 __attribute__((ext_vector_type(4)));
    u32x4 w; w[0] = pack2(a0, a1); w[1] = pack2(a2, a3); w[2] = pack2(a4, a5); w[3] = pack2(a6, a7);
    return __builtin_bit_cast(bf16x8, w);
}

template <int MODE>
DI void flash_item(const Params& p, int b, int hh, int qi, unsigned char* smem) {
    constexpr int D = MODE == 0 ? 64 : 128, KST = D + 8, VST = 68, KS = D / 16;
    constexpr int KBYTES = 64 * KST * 2, VBYTES = 128 * VST * 2, BUFB = KBYTES + VBYTES + 256;
    constexpr int NKC = D / 32, CPR = D / 8;
    const int tid = otid(), lane = tid & 63, w = tid >> 6, r = lane & 31, hf = lane >> 5;
    const int q0 = qi * 128 + w * 32;
    const size_t tq = (size_t)b * S + q0 + r;
    bf16x8 qf[KS];
    {
        const bf16_t* qptr = (MODE == 0 ? p.qa + tq * 512 + hh * 64 : p.qb + tq * 512 + hh * 128) + hf * 8;
#pragma unroll
        for (int ks = 0; ks < KS; ++ks) qf[ks] = *(const bf16x8*)(qptr + ks * 16);
    }
    const float* fbase = p.F + (size_t)(b * 4 + (MODE == 1 ? hh : 0)) * S;
    float Fq = 0.f; if (MODE == 1) Fq = fbase[q0 + r];
    const bf16_t* kbase = MODE == 0 ? p.ka + (size_t)b * S * 512 + hh * 64 : p.kb + (size_t)b * S * 512 + hh * 128;
    const bf16_t* vbase = MODE == 0 ? p.vta + (size_t)(b * 4 + (hh >> 1)) * 128 * S : p.vtb + (size_t)(b * 4 + hh) * 128 * S;
    const int ntiles = 2 * qi + 2, wlast = 2 * qi + (w >> 1);
    uint4 kr[NKC], vr[4]; f32x4 frg = {0.f, 0.f, 0.f, 0.f};
#define FL_GLOAD(j) do { \
        _Pragma("unroll") for (int i_ = 0; i_ < NKC; ++i_) { const int c_ = tid + 256 * i_; kr[i_] = *(const uint4*)(kbase + (size_t)(64 * (j) + c_ / CPR) * 512 + (c_ % CPR) * 8); } \
        _Pragma("unroll") for (int i_ = 0; i_ < 4; ++i_) { const int c_ = tid + 256 * i_; vr[i_] = *(const uint4*)(vbase + (size_t)(c_ >> 3) * S + 64 * (j) + (c_ & 7) * 8); } \
        if (MODE == 1 && tid < 16) frg = *(const f32x4*)(fbase + 64 * (j) + tid * 4); } while (0)
#define FL_SSTORE(buf) do { unsigned char* B_ = smem + (buf) * BUFB; \
        _Pragma("unroll") for (int i_ = 0; i_ < NKC; ++i_) { const int c_ = tid + 256 * i_; *(uint4*)(B_ + ((c_ / CPR) * KST + (c_ % CPR) * 8) * 2) = kr[i_]; } \
        _Pragma("unroll") for (int i_ = 0; i_ < 4; ++i_) { const int c_ = tid + 256 * i_; uint2* d_ = (uint2*)(B_ + KBYTES + ((c_ >> 3) * VST + (c_ & 7) * 8) * 2); d_[0] = make_uint2(vr[i_].x, vr[i_].y); d_[1] = make_uint2(vr[i_].z, vr[i_].w); } \
        if (MODE == 1 && tid < 16) *(f32x4*)(B_ + KBYTES + VBYTES + tid * 16) = frg; } while (0)
    FL_GLOAD(0);
    FL_SSTORE(0);
    __syncthreads();
    f32x16 acc[4];
#pragma unroll
    for (int eb = 0; eb < 4; ++eb)
#pragma unroll
        for (int i = 0; i < 16; ++i) acc[eb][i] = 0.f;
    float mrun = -INFINITY, lsum = 0.f;
    for (int j = 0; j < ntiles; ++j) {
        const bool more = j + 1 < ntiles;
        if (more) FL_GLOAD(j + 1);
        if (j <= wlast) {
            const unsigned char* B = smem + (j & 1) * BUFB;
            f32x16 st[2];
#pragma unroll
            for (int kb = 0; kb < 2; ++kb) {
#pragma unroll
                for (int i = 0; i < 16; ++i) st[kb][i] = 0.f;
#pragma unroll
                for (int ks = 0; ks < KS; ++ks) {
                    const bf16x8 a = *(const bf16x8*)(B + ((kb * 32 + r) * KST + ks * 16 + hf * 8) * 2);
                    st[kb] = __builtin_amdgcn_mfma_f32_32x32x16_bf16(a, qf[ks], st[kb], 0, 0, 0);
                }
            }
            if (MODE == 1) {
                const float* Fl = (const float*)(B + KBYTES + VBYTES);
#pragma unroll
                for (int kb = 0; kb < 2; ++kb)
#pragma unroll
                    for (int g = 0; g < 4; ++g) {
                        const f32x4 fk = *(const f32x4*)(Fl + kb * 32 + 8 * g + 4 * hf);
#pragma unroll
                        for (int jj = 0; jj < 4; ++jj) st[kb][4 * g + jj] += Fq - fk[jj];
                    }
                if (j >= 2 * qi) {
                    const int qabs = q0 + r;
#pragma unroll
                    for (int kb = 0; kb < 2; ++kb)
#pragma unroll
                        for (int g = 0; g < 4; ++g)
#pragma unroll
                            for (int jj = 0; jj < 4; ++jj) { const int key = 64 * j + kb * 32 + 8 * g + 4 * hf + jj; if (key > qabs) st[kb][4 * g + jj] = -INFINITY; }
                }
            }
            float mt = st[0][0];
#pragma unroll
            for (int i = 1; i < 16; ++i) mt = fmaxf(mt, st[0][i]);
#pragma unroll
            for (int i = 0; i < 16; ++i) mt = fmaxf(mt, st[1][i]);
            mt = fmaxf(mt, __shfl_xor(mt, 32));
            const float mn = fmaxf(mrun, mt);
            const float corr = ex2(mrun - mn);
            mrun = mn; lsum *= corr;
#pragma unroll
            for (int kb = 0; kb < 2; ++kb)
#pragma unroll
                for (int i = 0; i < 16; ++i) { const float pv = ex2(st[kb][i] - mn); st[kb][i] = pv; lsum += pv; }
#pragma unroll
            for (int eb = 0; eb < 4; ++eb) acc[eb] *= corr;
#pragma unroll
            for (int kb = 0; kb < 2; ++kb)
#pragma unroll
                for (int s2 = 0; s2 < 2; ++s2) {
                    const bf16x8 pf = pack8(st[kb][8 * s2], st[kb][8 * s2 + 1], st[kb][8 * s2 + 2], st[kb][8 * s2 + 3], st[kb][8 * s2 + 4], st[kb][8 * s2 + 5], st[kb][8 * s2 + 6], st[kb][8 * s2 + 7]);
#pragma unroll
                    for (int eb = 0; eb < 4; ++eb) {
                        const unsigned char* vp = B + KBYTES + ((eb * 32 + r) * VST + kb * 32 + 16 * s2 + 4 * hf) * 2;
                        const uint2 lo = *(const uint2*)vp, hi = *(const uint2*)(vp + 16);
                        typedef unsigned u32x4 __attribute__((ext_vector_type(4)));
                        u32x4 av; av[0] = lo.x; av[1] = lo.y; av[2] = hi.x; av[3] = hi.y;
                        acc[eb] = __builtin_amdgcn_mfma_f32_32x32x16_bf16(__builtin_bit_cast(bf16x8, av), pf, acc[eb], 0, 0, 0);
                    }
                }
        }
        if (more) FL_SSTORE((j + 1) & 1);
        __syncthreads();
    }
#undef FL_GLOAD
#undef FL_SSTORE
    const float inv = 1.f / (lsum + __shfl_xor(lsum, 32));
    bf16_t* o = MODE == 0 ? p.oa + tq * 1024 + hh * 128 : p.yb + tq * 512 + hh * 128;
#pragma unroll
    for (int eb = 0; eb < 4; ++eb)
#pragma unroll
        for (int g = 0; g < 4; ++g) {
            f32x4 v = {acc[eb][4 * g] * inv, acc[eb][4 * g + 1] * inv, acc[eb][4 * g + 2] * inv, acc[eb][4 * g + 3] * inv};
            st4(o + eb * 32 + 8 * g + 4 * hf, v);
        }
}


DI void ret_state_item(const Params& p, int item) {
    const int n = item & 127, bh = item >> 7;
    const int tid = otid(), lane = tid & 63, w = tid >> 6, r = lane & 31, hf = lane >> 5;
    const bf16_t* kt = p.ckT + (size_t)bh * 128 * S + n * 64 + hf * 8;
    const bf16_t* vt = p.cv + ((size_t)bh * 256 + w * 64) * S + n * 64 + hf * 8;
    f32x16 acc[4][2];
#pragma unroll
    for (int a = 0; a < 4; ++a)
#pragma unroll
        for (int c = 0; c < 2; ++c)
#pragma unroll
            for (int i = 0; i < 16; ++i) acc[a][c][i] = 0.f;
#pragma unroll
    for (int s4 = 0; s4 < 4; ++s4) {
        bf16x8 af[4], bfr[2];
#pragma unroll
        for (int a = 0; a < 4; ++a) af[a] = *(const bf16x8*)(kt + (size_t)(a * 32 + r) * S + s4 * 16);
#pragma unroll
        for (int c = 0; c < 2; ++c) bfr[c] = *(const bf16x8*)(vt + (size_t)(c * 32 + r) * S + s4 * 16);
#pragma unroll
        for (int a = 0; a < 4; ++a)
#pragma unroll
            for (int c = 0; c < 2; ++c) acc[a][c] = __builtin_amdgcn_mfma_f32_32x32x16_bf16(af[a], bfr[c], acc[a][c], 0, 0, 0);
    }
    bf16_t* o = p.kv + ((size_t)(bh * 128 + n) * 256 + w * 64) * 128;
#pragma unroll
    for (int a = 0; a < 4; ++a)
#pragma unroll
        for (int c = 0; c < 2; ++c)
#pragma unroll
            for (int g = 0; g < 4; ++g) {
                f32x4 v = {acc[a][c][4 * g], acc[a][c][4 * g + 1], acc[a][c][4 * g + 2], acc[a][c][4 * g + 3]};
                st4_wt(o + (size_t)(c * 32 + r) * 128 + a * 32 + 8 * g + 4 * hf, v);
            }
}

DI void ret_scan(const Params& p) {
    const int gtid = obid() * 256 + otid(), gsz = gridDim.x * 256;
    for (int e = gtid; e < 8 * 8192; e += gsz) {
        const int bh = e >> 13, pi = e & 8191, hd = bh & 3;
        const float dec = ex2(64.0f * __log2f(1.0f - ex2(-5.0f - (float)hd)));
        unsigned long long* ptr = (unsigned long long*)p.kv + (size_t)bh * 128 * 8192 + pi;
        float c0 = 0.f, c1 = 0.f, c2 = 0.f, c3 = 0.f;
#pragma unroll 8
        for (int n = 0; n < 128; ++n) {
            const unsigned long long v = ptr[(size_t)n * 8192];
            const unsigned long long o = (unsigned long long)pack2(c0, c1) | ((unsigned long long)pack2(c2, c3) << 32);
            __hip_atomic_store(ptr + (size_t)n * 8192, o, __ATOMIC_RELAXED, __HIP_MEMORY_SCOPE_AGENT);
            const unsigned lo = (unsigned)v, hi = (unsigned)(v >> 32);
            c0 = c0 * dec + bflo(lo); c1 = c1 * dec + bfhi(lo); c2 = c2 * dec + bflo(hi); c3 = c3 * dec + bfhi(hi);
        }
    }
}

DI void ret_out_item(const Params& p, int l, int item, unsigned char* smem) {
    const int n = item & 127, bh = item >> 7, b = bh >> 2, hd = bh & 3;
    const int tid = otid(), lane = tid & 63, w = tid >> 6, r = lane & 31, hf = lane >> 5;
    const size_t t0 = (size_t)b * S + n * 64;
    f32x16 acc[2][2];
#pragma unroll
    for (int a = 0; a < 2; ++a)
#pragma unroll
        for (int c = 0; c < 2; ++c)
#pragma unroll
            for (int i = 0; i < 16; ++i) acc[a][c][i] = 0.f;
    bf16x8 pf[2][2][2];
    {
        bf16x8 qf[2][8];
#pragma unroll
        for (int qb = 0; qb < 2; ++qb)
#pragma unroll
            for (int ks = 0; ks < 8; ++ks) qf[qb][ks] = *(const bf16x8*)(p.cq + (t0 + qb * 32 + r) * 512 + hd * 128 + ks * 16 + hf * 8);
        const bf16_t* rt = p.kv + ((size_t)(bh * 128 + n) * 256 + w * 64) * 128 + hf * 8;
#pragma unroll
        for (int dvb = 0; dvb < 2; ++dvb)
#pragma unroll
            for (int ks = 0; ks < 8; ++ks) {
                const bf16x8 a = *(const bf16x8*)(rt + (size_t)(dvb * 32 + r) * 128 + ks * 16);
#pragma unroll
                for (int qb = 0; qb < 2; ++qb) acc[dvb][qb] = __builtin_amdgcn_mfma_f32_32x32x16_bf16(a, qf[qb][ks], acc[dvb][qb], 0, 0, 0);
            }
#pragma unroll
        for (int kb = 0; kb < 2; ++kb) {
            f32x16 st[2];
#pragma unroll
            for (int qb = 0; qb < 2; ++qb)
#pragma unroll
                for (int i = 0; i < 16; ++i) st[qb][i] = 0.f;
#pragma unroll
            for (int ks = 0; ks < 8; ++ks) {
                const bf16x8 a = *(const bf16x8*)(p.ck + (t0 + kb * 32 + r) * 512 + hd * 128 + ks * 16 + hf * 8);
#pragma unroll
                for (int qb = 0; qb < 2; ++qb) st[qb] = __builtin_amdgcn_mfma_f32_32x32x16_bf16(a, qf[qb][ks], st[qb], 0, 0, 0);
            }
#pragma unroll
            for (int qb = 0; qb < 2; ++qb) {
#pragma unroll
                for (int i = 0; i < 16; ++i) { const int key = kb * 32 + (i & 3) + 8 * (i >> 2) + 4 * hf; if (key > qb * 32 + r) st[qb][i] = 0.f; }
#pragma unroll
                for (int s2 = 0; s2 < 2; ++s2)
                    pf[kb][s2][qb] = pack8(st[qb][8 * s2], st[qb][8 * s2 + 1], st[qb][8 * s2 + 2], st[qb][8 * s2 + 3], st[qb][8 * s2 + 4], st[qb][8 * s2 + 5], st[qb][8 * s2 + 6], st[qb][8 * s2 + 7]);
            }
        }
    }
    {
        const bf16_t* vt = p.cv + ((size_t)bh * 256 + w * 64) * S + n * 64 + 4 * hf;
#pragma unroll
        for (int dvb = 0; dvb < 2; ++dvb)
#pragma unroll
            for (int kb = 0; kb < 2; ++kb)
#pragma unroll
                for (int s2 = 0; s2 < 2; ++s2) {
                    const bf16_t* vp = vt + (size_t)(dvb * 32 + r) * S + kb * 32 + 16 * s2;
                    const uint2 lo = *(const uint2*)vp, hi = *(const uint2*)(vp + 8);
                    typedef unsigned u32x4 __attribute__((ext_vector_type(4)));
                    u32x4 av; av[0] = lo.x; av[1] = lo.y; av[2] = hi.x; av[3] = hi.y;
                    const bf16x8 a = __builtin_bit_cast(bf16x8, av);
#pragma unroll
                    for (int qb = 0; qb < 2; ++qb) acc[dvb][qb] = __builtin_amdgcn_mfma_f32_32x32x16_bf16(a, pf[kb][s2][qb], acc[dvb][qb], 0, 0, 0);
                }
    }
    float* red = (float*)smem;
    float mu[2], rstd[2];
    __syncthreads();
#pragma unroll
    for (int qb = 0; qb < 2; ++qb) {
        float s1 = 0.f, s2 = 0.f;
#pragma unroll
        for (int dvb = 0; dvb < 2; ++dvb)
#pragma unroll
            for (int i = 0; i < 16; ++i) { const float x = acc[dvb][qb][i]; s1 += x; s2 += x * x; }
        s1 += __shfl_xor(s1, 32); s2 += __shfl_xor(s2, 32);
        if (hf == 0) { red[(w * 64 + qb * 32 + r) * 2] = s1; red[(w * 64 + qb * 32 + r) * 2 + 1] = s2; }
    }
    __syncthreads();
#pragma unroll
    for (int qb = 0; qb < 2; ++qb) {
        float s1 = 0.f, s2 = 0.f;
#pragma unroll
        for (int ww = 0; ww < 4; ++ww) { s1 += red[(ww * 64 + qb * 32 + r) * 2]; s2 += red[(ww * 64 + qb * 32 + r) * 2 + 1]; }
        const float m_ = s1 * (1.f / 256.f);
        mu[qb] = m_; rstd[qb] = rsqrtf(fmaxf(s2 * (1.f / 256.f) - m_ * m_, 0.f) + LN_EPS);
    }
    const float* gr = p.g_ret + (size_t)l * 1024 + hd * 256 + w * 64;
#pragma unroll
    for (int dvb = 0; dvb < 2; ++dvb)
#pragma unroll
        for (int g = 0; g < 4; ++g) {
            const int dv = dvb * 32 + 8 * g + 4 * hf;
            const f32x4 gg = *(const f32x4*)(gr + dv);
#pragma unroll
            for (int qb = 0; qb < 2; ++qb) {
                const size_t off = (t0 + qb * 32 + r) * 1024 + hd * 256 + w * 64 + dv;
                const uint2 cgv = *(const uint2*)(p.cg + off);
                f32x4 y;
#pragma unroll
                for (int jj = 0; jj < 4; ++jj) y[jj] = (acc[dvb][qb][4 * g + jj] - mu[qb]) * rstd[qb] * gg[jj];
                y[0] *= bflo(cgv.x); y[1] *= bfhi(cgv.x); y[2] *= bflo(cgv.y); y[3] *= bfhi(cgv.y);
                st4(p.yc + off, y);
            }
        }
}

DI void phase_mixers(const Params& p, int l, unsigned char* smem) {
    const int nF = 64 * 24, nC = 2 * 4 * 128;
    int* sitem = (int*)(smem + SMEM_BYTES - 16);
    for (;;) {
        __syncthreads();
        if (otid() == 0) *sitem = (int)atomicAdd(p.ctr + l, 1u);
        __syncthreads();
        const int it = *sitem;
        if (it >= nF + nC) break;
        if (it < nF) {
            const int qi = 63 - it / 24, r = it % 24;
            if (r < 8) flash_item<1>(p, r >> 2, r & 3, qi, smem);
            else flash_item<0>(p, (r - 8) >> 3, (r - 8) & 7, qi, smem);
        } else ret_state_item(p, it - nF);
    }
}

DI void phase_mixers_naive(const Params& p) {
    const int nA = 2 * 8 * 128, nB = 2 * 4 * 128, nC = 2 * 4 * 128;
    for (int it = obid(); it < nA + nB + nC; it += gridDim.x) {
        if (it < nB) naive_attn<1>(p, it);
        else if (it < nB + nC) naive_attn<2>(p, it - nB);
        else naive_attn<0>(p, it - nB - nC);
    }
}

DI void phase_post(const Params& p, int l) {
    const int lane = otid() & 63, wv = otid() >> 6;
    const float lam = p.lamv[2 * l], li = p.lamv[2 * l + 1];
    const float* gd = p.g_diff + (size_t)l * 512; const float* gr = p.g_ret + (size_t)l * 1024;
    for (int row = obid() * 4 + wv; row < T; row += gridDim.x * 4) {
#pragma unroll
        for (int hh = 0; hh < 4; ++hh) {
            const unsigned o0 = *(const unsigned*)(p.oa + (size_t)row * 1024 + (2 * hh) * 128 + lane * 2);
            const unsigned o1 = *(const unsigned*)(p.oa + (size_t)row * 1024 + (2 * hh + 1) * 128 + lane * 2);
            const float d0 = bflo(o0) - lam * bflo(o1), d1 = bfhi(o0) - lam * bfhi(o1);
            float ss = d0 * d0 + d1 * d1;
            for (int o = 32; o; o >>= 1) ss += __shfl_xor(ss, o);
            const float r = rsqrtf(ss * (1.f / 128.f) + LN_EPS) * (1.f - li);
            const int c = hh * 128 + lane * 2;
            *(unsigned*)(p.ya + (size_t)row * 512 + c) = pack2(d0 * r * gd[c], d1 * r * gd[c + 1]);
        }
    }
}

#define GSYNC() do { asm volatile("s_waitcnt vmcnt(0) lgkmcnt(0)" ::: "memory"); __builtin_amdgcn_fence(__ATOMIC_RELEASE, "agent"); grid.sync(); __builtin_amdgcn_fence(__ATOMIC_ACQUIRE, "agent"); } while (0)
__global__ void __launch_bounds__(256, 2) fwd_kernel(Params p) {
    __shared__ __attribute__((aligned(16))) unsigned char smem[SMEM_BYTES];
    cg::grid_group grid = cg::this_grid();
    bf16_t* sm = (bf16_t*)smem; float* smf = (float*)smem;

    convert_layer(p, 0, smf);
    phase0_misc(p, smf);
    GSYNC();
    row_phase(p, p.x, false, nullptr, nullptr, nullptr, p.mod, 0, 1024, true, true);
    GSYNC();
    for (int l = 0; l < DEPTH; ++l) {
        const float* modl = p.mod + (size_t)l * 2 * 6144;
        const float* xcur = l == 0 ? p.x : p.xbuf;
        if (obid() >= gridDim.x - 8) scan_item(p, obid() - (gridDim.x - 8), smf);
        phase_inproj(p, sm);
        GSYNC();
        phase_mixers(p, l, smem);
        GSYNC();
        phase_post(p, l);
        ret_scan(p);
        GSYNC();
        for (int it = obid(); it < 1024; it += gridDim.x) ret_out_item(p, l, it, smem);
        GSYNC();
        phase_branch(p, sm);
        GSYNC();
        phase_gemm_res(p, p.h, 1024, p.WoutT, xcur, modl, 2048, sm);
        GSYNC();
        row_phase(p, p.vbuf, true, p.ln_g + (size_t)(l * 2) * Dm, p.ln_b + (size_t)(l * 2) * Dm, p.xbuf, modl, 3072, 4096, true, false);
        GSYNC();
        phase_up(p, sm);
        GSYNC();
        phase_conv(p, l);
        GSYNC();
        phase_gemm_res(p, p.act, DFF, p.WdownT, p.xbuf, modl, 5120, sm);
        GSYNC();
        if (l + 1 < DEPTH) {
            convert_layer(p, l + 1, smf);
            GSYNC();
            row_phase(p, p.vbuf, true, p.ln_g + (size_t)(l * 2 + 1) * Dm, p.ln_b + (size_t)(l * 2 + 1) * Dm, p.xbuf, modl + 2 * 6144, 0, 1024, true, true);
            GSYNC();
        } else {
            row_phase(p, p.vbuf, true, p.ln_g + (size_t)(l * 2 + 1) * Dm, p.ln_b + (size_t)(l * 2 + 1) * Dm, p.out, modl, 0, 1024, false, false);
        }
    }
}

extern "C" void kernel_launch(void* const* d_in, const int* in_sizes, int n_in, void* d_out, int out_size, void* d_ws, size_t ws_size, hipStream_t stream) {
    static int grid_blocks = 0;
    if (!grid_blocks) {
        int dev = 0, cus = 0, per_cu = 0;
        hipGetDevice(&dev);
        hipDeviceGetAttribute(&cus, hipDeviceAttributeMultiprocessorCount, dev);
        hipOccupancyMaxActiveBlocksPerMultiprocessor(&per_cu, fwd_kernel, 256, 0);
        if (per_cu > 2) per_cu = 2;
        if (per_cu < 1) per_cu = 1;
        grid_blocks = cus * per_cu;
    }
    Params p{};
    const float** ins = (const float**)&p.x;
    for (int i = 0; i < 22; ++i) ins[i] = (const float*)d_in[i];
    p.out = (float*)d_out;
    char* w = (char*)d_ws; size_t off = 0;
    auto take = [&](size_t bytes) { char* r = w + off; off += (bytes + 255) & ~(size_t)255; return r; };
    const size_t MB = 1u << 20;
    p.mod = (float*)take((size_t)DEPTH * 2 * 6144 * 4);
    p.lamv = (float*)take(256);
    p.ctr = (unsigned*)take(256);
    p.wf = (float*)take(4100 * 4);
    p.binp = (float*)take(NIN * 4);
    p.cstab = (float*)take((size_t)S * 64 * 2 * 4);
    p.logf = (float*)take((size_t)T * 4 * 4);
    p.F = (float*)take((size_t)T * 4 * 4);
    p.WinT = (bf16_t*)take((size_t)NIN * 1024 * 2);
    p.WpaT = (bf16_t*)take((size_t)1024 * 512 * 2);
    p.WpbT = (bf16_t*)take((size_t)1024 * 512 * 2);
    p.WpcT = (bf16_t*)take((size_t)1024 * 1024 * 2);
    p.WoutT = (bf16_t*)take((size_t)1024 * 1024 * 2);
    p.WupT = (bf16_t*)take((size_t)2 * DFF * 1024 * 2);
    p.WdownT = (bf16_t*)take((size_t)1024 * DFF * 2);
    p.xbuf = (float*)take((size_t)T * Dm * 4);
    p.h = (bf16_t*)take((size_t)T * Dm * 2);
    const size_t offA = off;
    p.qa = (bf16_t*)take((size_t)T * 512 * 2); p.ka = (bf16_t*)take((size_t)T * 512 * 2); p.vta = (bf16_t*)take((size_t)T * 512 * 2);
    p.qb = (bf16_t*)take((size_t)T * 512 * 2); p.kb = (bf16_t*)take((size_t)T * 512 * 2); p.vtb = (bf16_t*)take((size_t)T * 512 * 2);
    p.cq = (bf16_t*)take((size_t)T * 512 * 2); p.ck = (bf16_t*)take((size_t)T * 512 * 2);
    p.cv = (bf16_t*)take((size_t)T * 1024 * 2); p.cg = (bf16_t*)take((size_t)T * 1024 * 2);
    p.gates = (bf16_t*)take((size_t)T * 3072 * 2);
    const size_t endA = off;
    p.ug = (bf16_t*)(w + offA);
    p.act = (bf16_t*)(w + offA + (size_t)T * 2 * DFF * 2);
    const size_t offB = endA;
    off = offB;
    p.vbuf = (float*)(w + offB);
    p.oa = p.h;
    p.yb = (bf16_t*)take((size_t)T * 512 * 2);
    p.kv = (bf16_t*)take((size_t)8 * 128 * 256 * 128 * 2);
    p.ckT = (bf16_t*)take((size_t)T * 512 * 2);
    p.ya = (bf16_t*)take((size_t)T * 512 * 2);
    p.yc = (bf16_t*)take((size_t)T * 1024 * 2);
    if (off > ws_size || (size_t)T * 2 * DFF * 2 + (size_t)T * DFF * 2 > endA - offA) {
        fprintf(stderr, "kernel_launch: workspace too small: need %zu MB have %zu MB\n", off / MB, ws_size / MB);
        return;
    }
    void* args[] = {&p};
    hipError_t e = hipLaunchCooperativeKernel((void*)fwd_kernel, dim3(grid_blocks), dim3(256), args, 0, stream);
    if (e != hipSuccess) fprintf(stderr, "cooperative launch failed: %s (grid %d)\n", hipGetErrorString(e), grid_blocks);
}
```

```cpp
#include <hip/hip_runtime.h>
#include <hip/hip_cooperative_groups.h>
#include <cstdio>
#include <cstdint>
namespace cg = cooperative_groups;

typedef unsigned short bf16_t;
typedef short bf16x8 __attribute__((ext_vector_type(8)));
typedef float f32x4 __attribute__((ext_vector_type(4)));

constexpr int Dm = 1024, NB = 2, S = 8192, T = NB * S, DEPTH = 4, DFF = 2816, DIN = 9220, NIN = 9216;
constexpr float LN_EPS = 1e-5f;
constexpr float LOG2E = 1.4426950408889634f;
#define ALPHA_F 1.681792830507429f

#define DI __device__ __forceinline__
DI int otid() { int t = threadIdx.x; asm volatile("" : "+v"(t)); return t; }
DI int obid() { int b = blockIdx.x; asm volatile("" : "+s"(b)); return b; }

DI bf16_t f2bf(float x) { unsigned u = __float_as_uint(x); u += 0x7fffu + ((u >> 16) & 1u); return (bf16_t)(u >> 16); }
DI float bf2f(bf16_t v) { return __uint_as_float(((unsigned)v) << 16); }
DI float bflo(unsigned w) { return __uint_as_float(w << 16); }
DI float bfhi(unsigned w) { return __uint_as_float(w & 0xffff0000u); }
DI unsigned pack2(float a, float b) { return (unsigned)f2bf(a) | ((unsigned)f2bf(b) << 16); }

struct Params {
    const float *x, *c, *w_ada, *b_ada, *w_in, *b_in, *lq1, *lk1, *lq2, *lk2, *g_diff, *g_ret, *w_pa, *w_pb, *w_pc, *w_out, *ln_g, *ln_b, *w_up, *w_conv, *b_conv, *w_down;
    float* out;
    unsigned* ctr;
    float *mod, *lamv, *wf, *binp, *cstab, *xbuf, *vbuf, *logf, *F, *oc;
    bf16_t *WinT, *WpaT, *WpbT, *WpcT, *WoutT, *WupT, *WdownT;
    bf16_t *h, *qa, *ka, *vta, *qb, *kb, *vtb, *cq, *ck, *cv, *cg, *gates, *oa, *yb, *ya, *yc, *ug, *act, *ckT, *kv;
};

constexpr int BM = 128, BN = 128, BK = 64, LDP = BK + 8;
constexpr int SMEM_BYTES = 2 * (BM + BN) * LDP * 2;

DI int win_map(int n) {
    if (n < 3072) return n;
    if (n < 4096) { int r = n - 3072; int seg = r >> 9; r &= 511; int head = r >> 7; int c = r & 127; return 3076 + seg * 512 + head * 128 + (c >> 1) + 64 * (c & 1); }
    return n + 4;
}

DI void convert_tile(const float* __restrict__ src, int ldsrc, bf16_t* __restrict__ dst, int K, int tiles_n, int tile, int kind, float* lds) {
    const int tn = tile % tiles_n, tk = tile / tiles_n;
    const int tx = otid() & 63, ty = otid() >> 6;
    const int n = tn * 64 + tx;
    const int sn = kind == 1 ? win_map(n) : n;
    __syncthreads();
#pragma unroll 4
    for (int r = 0; r < 16; ++r) {
        const int kk = ty * 16 + r;
        lds[kk * 65 + tx] = src[(size_t)(tk * 64 + kk) * ldsrc + sn];
    }
    __syncthreads();
#pragma unroll 4
    for (int r = 0; r < 16; ++r) {
        const int nn = ty * 16 + r;
        dst[(size_t)(tn * 64 + nn) * K + tk * 64 + tx] = f2bf(lds[tx * 65 + nn]);
    }
}

DI void convert_layer(const Params& p, int l, float* lds) {
    const int n_in = 16 * 144, n_pa = 8 * 16, n_pb = 8 * 16, n_pc = 16 * 16, n_out = 16 * 16, n_up = 16 * 88, n_dn = 44 * 16;
    const int total = n_in + n_pa + n_pb + n_pc + n_out + n_up + n_dn;
    for (int it = obid(); it < total; it += gridDim.x) {
        int t = it;
        if (t < n_in) { convert_tile(p.w_in + (size_t)l * Dm * DIN, DIN, p.WinT, 1024, 144, t, 1, lds); continue; } t -= n_in;
        if (t < n_pa) { convert_tile(p.w_pa + (size_t)l * 512 * Dm, Dm, p.WpaT, 512, 16, t, 0, lds); continue; } t -= n_pa;
        if (t < n_pb) { convert_tile(p.w_pb + (size_t)l * 512 * Dm, Dm, p.WpbT, 512, 16, t, 0, lds); continue; } t -= n_pb;
        if (t < n_pc) { convert_tile(p.w_pc + (size_t)l * 1024 * Dm, Dm, p.WpcT, 1024, 16, t, 0, lds); continue; } t -= n_pc;
        if (t < n_out) { convert_tile(p.w_out + (size_t)l * Dm * Dm, Dm, p.WoutT, 1024, 16, t, 0, lds); continue; } t -= n_out;
        if (t < n_up) { convert_tile(p.w_up + (size_t)l * Dm * 2 * DFF, 2 * DFF, p.WupT, 1024, 88, t, 0, lds); continue; } t -= n_up;
        convert_tile(p.w_down + (size_t)l * DFF * Dm, Dm, p.WdownT, DFF, 16, t, 0, lds);
    }
    const int gtid = obid() * blockDim.x + otid(), gsz = gridDim.x * blockDim.x;
    for (int i = gtid; i < NIN; i += gsz) p.binp[i] = p.b_in[(size_t)l * DIN + win_map(i)];
    for (int i = gtid; i < 4096; i += gsz) { const int k = i >> 2, hh = i & 3; p.wf[i] = p.w_in[(size_t)l * Dm * DIN + (size_t)k * DIN + 3072 + hh]; }
    for (int i = gtid; i < 4; i += gsz) p.wf[4096 + i] = p.b_in[(size_t)l * DIN + 3072 + i];
}

DI float ex2(float x) { return __builtin_amdgcn_exp2f(x); }
DI float lg2gamma(int hd) { return hd == 0 ? -0.04580368961312479f : hd == 1 ? -0.02272007650008353f : hd == 2 ? -0.011315313227834146f : -0.005646563141142063f; }
DI float silu_f(float v) { return v / (1.f + __expf(-v)); }
DI float sigmoid_f(float v) { return 1.f / (1.f + __expf(-v)); }

DI void phase0_misc(const Params& p, float* lds) {
    for (int it = obid(); it < DEPTH * 96; it += gridDim.x) {
        const int l = it / 96, jb = it % 96;
        const int tx = otid() & 63, ks = otid() >> 6;
        const int j = jb * 64 + tx;
        const float* w = p.w_ada + (size_t)l * Dm * 6144 + j;
        float a0 = 0.f, a1 = 0.f;
#pragma unroll 8
        for (int k = ks * 256; k < ks * 256 + 256; ++k) {
            const float wv = w[(size_t)k * 6144];
            a0 += silu_f(p.c[k]) * wv; a1 += silu_f(p.c[Dm + k]) * wv;
        }
        __syncthreads();
        lds[(ks * 64 + tx) * 2] = a0; lds[(ks * 64 + tx) * 2 + 1] = a1;
        __syncthreads();
        if (ks == 0) {
            float s0 = 0.f, s1 = 0.f;
            for (int q = 0; q < 4; ++q) { s0 += lds[(q * 64 + tx) * 2]; s1 += lds[(q * 64 + tx) * 2 + 1]; }
            const float bb = p.b_ada[(size_t)l * 6144 + j];
            p.mod[((size_t)l * 2 + 0) * 6144 + j] = s0 + bb;
            p.mod[((size_t)l * 2 + 1) * 6144 + j] = s1 + bb;
        }
    }
    const int gtid = obid() * blockDim.x + otid(), gsz = gridDim.x * blockDim.x;
    if (gtid < 64) p.ctr[gtid] = 0u;
    if (obid() == 0 && otid() < 64 * DEPTH) {
        const int l = otid() >> 6, ln = otid() & 63;
        float a = p.lq1[l * 64 + ln] * p.lk1[l * 64 + ln], b = p.lq2[l * 64 + ln] * p.lk2[l * 64 + ln];
        for (int o = 32; o; o >>= 1) { a += __shfl_xor(a, o); b += __shfl_xor(b, o); }
        if (ln == 0) { const float li = 0.8f - 0.6f * expf(-0.3f * (float)l); p.lamv[2 * l] = expf(a) - expf(b) + li; p.lamv[2 * l + 1] = li; }
    }
}

DI void row_phase(const Params& p, const float* __restrict__ src, bool do_ln, const float* __restrict__ lng, const float* __restrict__ lnb,
                  float* __restrict__ xdst, const float* __restrict__ modl  , int sh_off, int sc_off, bool want_h, bool want_logf) {
    const int lane = otid() & 63, wv = otid() >> 6;
    for (int row = obid() * 4 + wv; row < T; row += gridDim.x * 4) {
        const int b = row / S;
        const float* sp = src + (size_t)row * Dm;
        f32x4 v[4];
#pragma unroll
        for (int i = 0; i < 4; ++i) v[i] = *(const f32x4*)(sp + i * 256 + lane * 4);
        if (do_ln) {
            float s = 0.f;
#pragma unroll
            for (int i = 0; i < 4; ++i) s += (v[i][0] + v[i][1]) + (v[i][2] + v[i][3]);
            for (int o = 32; o; o >>= 1) s += __shfl_xor(s, o);
            const float mu = s * (1.f / 1024.f);
            float q = 0.f;
#pragma unroll
            for (int i = 0; i < 4; ++i) { f32x4 d = v[i] - mu; q += (d[0] * d[0] + d[1] * d[1]) + (d[2] * d[2] + d[3] * d[3]); }
            for (int o = 32; o; o >>= 1) q += __shfl_xor(q, o);
            const float rstd = rsqrtf(q * (1.f / 1024.f) + LN_EPS);
#pragma unroll
            for (int i = 0; i < 4; ++i) {
                const f32x4 g = *(const f32x4*)(lng + i * 256 + lane * 4), bb = *(const f32x4*)(lnb + i * 256 + lane * 4);
                v[i] = (v[i] - mu) * rstd * g + bb;
            }
        }
        if (xdst) {
#pragma unroll
            for (int i = 0; i < 4; ++i) *(f32x4*)(xdst + (size_t)row * Dm + i * 256 + lane * 4) = v[i];
        }
        if (want_h) {
            const float* mb = modl + (size_t)b * 6144;
            float d0 = 0.f, d1 = 0.f, d2 = 0.f, d3 = 0.f;
#pragma unroll
            for (int i = 0; i < 4; ++i) {
                const int c0 = i * 256 + lane * 4;
                const f32x4 sc = *(const f32x4*)(mb + sc_off + c0), sh = *(const f32x4*)(mb + sh_off + c0);
                const f32x4 hv = v[i] * (1.f + sc) + sh;
                uint2 w; w.x = pack2(hv[0], hv[1]); w.y = pack2(hv[2], hv[3]);
                *(uint2*)(p.h + (size_t)row * Dm + c0) = w;
                if (want_logf) {
#pragma unroll
                    for (int j = 0; j < 4; ++j) {
                        const f32x4 wf = *(const f32x4*)(p.wf + (c0 + j) * 4);
                        d0 += hv[j] * wf[0]; d1 += hv[j] * wf[1]; d2 += hv[j] * wf[2]; d3 += hv[j] * wf[3];
                    }
                }
            }
            if (want_logf) {
                for (int o = 32; o; o >>= 1) { d0 += __shfl_xor(d0, o); d1 += __shfl_xor(d1, o); d2 += __shfl_xor(d2, o); d3 += __shfl_xor(d3, o); }
                if (lane < 4) {
                    float z = (lane == 0 ? d0 : lane == 1 ? d1 : lane == 2 ? d2 : d3) + p.wf[4096 + lane];
                    const float ls = fminf(z, 0.f) - log1pf(__expf(-fabsf(z)));
                    p.logf[(size_t)row * 4 + lane] = ls * LOG2E;
                }
            }
        }
    }
}

DI void scan_item(const Params& p, int item, float* lds) {
    const int b = item >> 2, hh = item & 3, tid = otid();
    const float* lp = p.logf + (size_t)b * S * 4 + hh;
    float loc[32]; float s = 0.f;
#pragma unroll
    for (int i = 0; i < 32; ++i) { s += lp[(size_t)(tid * 32 + i) * 4]; loc[i] = s; }
    __syncthreads();
    lds[tid] = s;
    __syncthreads();
    float pre = 0.f;
    for (int i = 0; i < tid; ++i) pre += lds[i];
    float* fp = p.F + (size_t)(b * 4 + hh) * S + tid * 32;
#pragma unroll
    for (int i = 0; i < 32; ++i) fp[i] = pre + loc[i];
    __syncthreads();
}

DI void gemm_kloop(const bf16_t* __restrict__ Ag, int lda, const bf16_t* __restrict__ Bg, int ldb, int K, f32x4 (&acc)[4][4], bf16_t* sm) {
    const int tid = otid(), lane = tid & 63, wid = tid >> 6, wr = wid >> 1, wc = wid & 1;
    bf16_t* sa = sm; bf16_t* sb = sm + 2 * BM * LDP;
    const int lrow = tid >> 3, lcc = tid & 7;
    const bf16_t* ap = Ag + (size_t)lrow * lda + lcc * 8;
    const bf16_t* bp = Bg + (size_t)lrow * ldb + lcc * 8;
    const size_t sA = (size_t)32 * lda, sB = (size_t)32 * ldb;
    uint4 ra0, ra1, ra2, ra3, rb0, rb1, rb2, rb3;
#define G_LOAD(koff) do { ra0 = *(const uint4*)(ap + (koff)); ra1 = *(const uint4*)(ap + sA + (koff)); ra2 = *(const uint4*)(ap + 2 * sA + (koff)); ra3 = *(const uint4*)(ap + 3 * sA + (koff)); \
                          rb0 = *(const uint4*)(bp + (koff)); rb1 = *(const uint4*)(bp + sB + (koff)); rb2 = *(const uint4*)(bp + 2 * sB + (koff)); rb3 = *(const uint4*)(bp + 3 * sB + (koff)); } while (0)
#define G_STORE(buf) do { bf16_t* da_ = sa + (buf) * BM * LDP + lrow * LDP + lcc * 8; bf16_t* db_ = sb + (buf) * BN * LDP + lrow * LDP + lcc * 8; \
        *(uint4*)(da_) = ra0; *(uint4*)(da_ + 32 * LDP) = ra1; *(uint4*)(da_ + 64 * LDP) = ra2; *(uint4*)(da_ + 96 * LDP) = ra3; \
        *(uint4*)(db_) = rb0; *(uint4*)(db_ + 32 * LDP) = rb1; *(uint4*)(db_ + 64 * LDP) = rb2; *(uint4*)(db_ + 96 * LDP) = rb3; } while (0)
    G_LOAD(0);
    G_STORE(0);
    __syncthreads();
    const int nk = K / BK;
    const int fr = lane & 15, fq = lane >> 4;
    for (int kt = 0; kt < nk; ++kt) {
        const int cur = kt & 1;
        const bool more = kt + 1 < nk;
        if (more) G_LOAD((kt + 1) * BK);
        const bf16_t* ca = sa + cur * BM * LDP + (wr * 64 + fr) * LDP + fq * 8;
        const bf16_t* cb = sb + cur * BN * LDP + (wc * 64 + fr) * LDP + fq * 8;
#pragma unroll
        for (int kk = 0; kk < 2; ++kk) {
            bf16x8 af[4], bfr[4];
#pragma unroll
            for (int m = 0; m < 4; ++m) af[m] = *(const bf16x8*)(ca + m * 16 * LDP + kk * 32);
#pragma unroll
            for (int n = 0; n < 4; ++n) bfr[n] = *(const bf16x8*)(cb + n * 16 * LDP + kk * 32);
#pragma unroll
            for (int m = 0; m < 4; ++m)
#pragma unroll
                for (int n = 0; n < 4; ++n) acc[m][n] = __builtin_amdgcn_mfma_f32_16x16x32_bf16(bfr[n], af[m], acc[m][n], 0, 0, 0);
        }
        if (more) G_STORE(cur ^ 1);
        __syncthreads();
    }
#undef G_LOAD
#undef G_STORE
}

DI void tile_coords(int tile, int nM, int nN, int& mt, int& nt) {
    const int band = tile / (16 * nN), r = tile % (16 * nN);
    mt = band * 16 + (r & 15); nt = r >> 4;
}

DI void zero_acc(f32x4 (&acc)[4][4]) {
#pragma unroll
    for (int m = 0; m < 4; ++m)
#pragma unroll
        for (int n = 0; n < 4; ++n) acc[m][n] = (f32x4){0.f, 0.f, 0.f, 0.f};
}

DI void st4_wt(bf16_t* dst, f32x4 v) { const unsigned long long w = (unsigned long long)pack2(v[0], v[1]) | ((unsigned long long)pack2(v[2], v[3]) << 32); __hip_atomic_store((unsigned long long*)dst, w, __ATOMIC_RELAXED, __HIP_MEMORY_SCOPE_AGENT); }
DI void st4(bf16_t* dst, f32x4 v) { uint2 w; w.x = pack2(v[0], v[1]); w.y = pack2(v[2], v[3]); *(uint2*)dst = w; }

DI void epi_inproj(const Params& p, int row, int col, f32x4 v) {
    v += *(const f32x4*)(p.binp + col);
    const int b = row / S, s = row % S;
    if (col < 512) { st4(p.qa + (size_t)row * 512 + col, v * (0.125f * LOG2E)); }
    else if (col < 1024) { st4(p.ka + (size_t)row * 512 + (col - 512), v); }
    else if (col < 1536) { const int c = col - 1024, hh = c >> 7, e = c & 127; bf16_t* d = p.vta + ((size_t)(b * 4 + hh) * 128 + e) * S + s;
#pragma unroll
        for (int j = 0; j < 4; ++j) d[(size_t)j * S] = f2bf(v[j]); }
    else if (col < 2048) { st4(p.qb + (size_t)row * 512 + (col - 1536), v * (0.08838834764831845f * LOG2E)); }
    else if (col < 2560) { st4(p.kb + (size_t)row * 512 + (col - 2048), v); }
    else if (col < 3072) { const int c = col - 2560, hh = c >> 7, e = c & 127; bf16_t* d = p.vtb + ((size_t)(b * 4 + hh) * 128 + e) * S + s;
#pragma unroll
        for (int j = 0; j < 4; ++j) d[(size_t)j * S] = f2bf(v[j]); }
    else if (col < 4096) {
        const int r = col - 3072, seg = r >> 9, c = r & 511, cc = c & 127, i0 = cc >> 1, hd = c >> 7;
        f32x4 cs;
        {
            const float a0 = (float)s * ex2(-(float)i0 * 0.21091607f), a1 = (float)s * ex2(-(float)(i0 + 1) * 0.21091607f);
            float r0 = a0 * 0.15915494309189535f, r1 = a1 * 0.15915494309189535f;
            r0 -= floorf(r0); r1 -= floorf(r1);
            float c0_ = __builtin_amdgcn_cosf(r0), s0_ = __builtin_amdgcn_sinf(r0), c1_ = __builtin_amdgcn_cosf(r1), s1_ = __builtin_amdgcn_sinf(r1);
            asm volatile("s_nop 15\n\ts_nop 15" : "+v"(c0_), "+v"(s0_), "+v"(c1_), "+v"(s1_));
            cs[0] = c0_; cs[1] = s0_; cs[2] = c1_; cs[3] = s1_;
        }
        f32x4 o; o[0] = v[0] * cs[0] - v[1] * cs[1]; o[1] = v[0] * cs[1] + v[1] * cs[0]; o[2] = v[2] * cs[2] - v[3] * cs[3]; o[3] = v[2] * cs[3] + v[3] * cs[2];
        const float lg = lg2gamma(hd);
        const int ic = s & 63;
        float e1_ = ex2(lg * (float)(ic + 1)), e2_ = ex2(-lg * (float)(ic + 1)), e3_ = ex2(lg * (float)(63 - ic));
        asm volatile("s_nop 15\n\ts_nop 15" : "+v"(e1_), "+v"(e2_), "+v"(e3_));
        if (seg == 0) st4(p.cq + (size_t)row * 512 + c, o * e1_);
        else {
            o = o * 0.08838834764831845f;
            st4(p.ck + (size_t)row * 512 + c, o * e2_);
            const f32x4 od = o * e3_;
            bf16_t* d = p.ckT + ((size_t)(b * 4 + hd) * 128 + cc) * S + s;
#pragma unroll
            for (int j = 0; j < 4; ++j) d[(size_t)j * S] = f2bf(od[j]);
        }
    }
    else if (col < 5120) { const int c = col - 4096; bf16_t* d = p.cv + ((size_t)b * 1024 + c) * S + s;
#pragma unroll
        for (int j = 0; j < 4; ++j) d[(size_t)j * S] = f2bf(v[j]); }
    else if (col < 6144) { f32x4 o; for (int j = 0; j < 4; ++j) o[j] = silu_f(v[j]); st4(p.cg + (size_t)row * 1024 + (col - 5120), o); }
    else { f32x4 o; for (int j = 0; j < 4; ++j) o[j] = sigmoid_f(v[j]); st4(p.gates + (size_t)row * 3072 + (col - 6144), o); }
}

DI void phase_inproj(const Params& p, bf16_t* sm) {
    const int nM = T / BM, nN = NIN / BN;
    const int lane = otid() & 63, wid = otid() >> 6, wr = wid >> 1, wc = wid & 1;
    for (int tile = obid(); tile < nM * nN; tile += gridDim.x) {
        int mt, nt; tile_coords(tile, nM, nN, mt, nt);
        f32x4 acc[4][4]; zero_acc(acc);
        gemm_kloop(p.h + (size_t)mt * BM * Dm, Dm, p.WinT + (size_t)nt * BN * Dm, Dm, Dm, acc, sm);
#pragma unroll
        for (int m = 0; m < 4; ++m)
#pragma unroll
            for (int n = 0; n < 4; ++n) epi_inproj(p, mt * BM + wr * 64 + m * 16 + (lane & 15), nt * BN + wc * 64 + n * 16 + (lane >> 4) * 4, acc[m][n]);
    }
}

DI void phase_branch(const Params& p, bf16_t* sm) {
    const int nM = T / BM, nN = Dm / BN;
    const int lane = otid() & 63, wid = otid() >> 6, wr = wid >> 1, wc = wid & 1;
    for (int tile = obid(); tile < nM * nN; tile += gridDim.x) {
        int mt, nt; tile_coords(tile, nM, nN, mt, nt);
        f32x4 tot[4][4]; zero_acc(tot);
#pragma unroll 1
        for (int br = 0; br < 3; ++br) {
            const bf16_t* A = br == 0 ? p.ya : br == 1 ? p.yb : p.yc;
            const bf16_t* W = br == 0 ? p.WpaT : br == 1 ? p.WpbT : p.WpcT;
            const int K = br == 2 ? 1024 : 512;
            f32x4 acc[4][4]; zero_acc(acc);
            gemm_kloop(A + (size_t)mt * BM * K, K, W + (size_t)nt * BN * K, K, K, acc, sm);
#pragma unroll
            for (int m = 0; m < 4; ++m)
#pragma unroll
                for (int n = 0; n < 4; ++n) {
                    const int row = mt * BM + wr * 64 + m * 16 + (lane & 15), col = nt * BN + wc * 64 + n * 16 + (lane >> 4) * 4;
                    const uint2 g = *(const uint2*)(p.gates + (size_t)row * 3072 + br * 1024 + col);
                    tot[m][n][0] += bflo(g.x) * acc[m][n][0]; tot[m][n][1] += bfhi(g.x) * acc[m][n][1];
                    tot[m][n][2] += bflo(g.y) * acc[m][n][2]; tot[m][n][3] += bfhi(g.y) * acc[m][n][3];
                }
        }
#pragma unroll
        for (int m = 0; m < 4; ++m)
#pragma unroll
            for (int n = 0; n < 4; ++n) {
                const int row = mt * BM + wr * 64 + m * 16 + (lane & 15), col = nt * BN + wc * 64 + n * 16 + (lane >> 4) * 4;
                st4(p.h + (size_t)row * Dm + col, tot[m][n]);
            }
    }
}

DI void phase_gemm_res(const Params& p, const bf16_t* A, int K, const bf16_t* Wt, const float* xres, const float* modl, int gt_off, bf16_t* sm) {
    const int nM = T / BM, nN = Dm / BN;
    const int lane = otid() & 63, wid = otid() >> 6, wr = wid >> 1, wc = wid & 1;
    for (int tile = obid(); tile < nM * nN; tile += gridDim.x) {
        int mt, nt; tile_coords(tile, nM, nN, mt, nt);
        f32x4 acc[4][4]; zero_acc(acc);
        gemm_kloop(A + (size_t)mt * BM * K, K, Wt + (size_t)nt * BN * K, K, K, acc, sm);
#pragma unroll
        for (int m = 0; m < 4; ++m)
#pragma unroll
            for (int n = 0; n < 4; ++n) {
                const int row = mt * BM + wr * 64 + m * 16 + (lane & 15), col = nt * BN + wc * 64 + n * 16 + (lane >> 4) * 4;
                const int b = row / S;
                const f32x4 xr = *(const f32x4*)(xres + (size_t)row * Dm + col);
                const f32x4 gt = *(const f32x4*)(modl + (size_t)b * 6144 + gt_off + col);
                *(f32x4*)(p.vbuf + (size_t)row * Dm + col) = xr * ALPHA_F + gt * acc[m][n];
            }
    }
}

DI void phase_up(const Params& p, bf16_t* sm) {
    const int nM = T / BM, nN = 2 * DFF / BN;
    const int lane = otid() & 63, wid = otid() >> 6, wr = wid >> 1, wc = wid & 1;
    for (int tile = obid(); tile < nM * nN; tile += gridDim.x) {
        int mt, nt; tile_coords(tile, nM, nN, mt, nt);
        f32x4 acc[4][4]; zero_acc(acc);
        gemm_kloop(p.h + (size_t)mt * BM * Dm, Dm, p.WupT + (size_t)nt * BN * Dm, Dm, Dm, acc, sm);
#pragma unroll
        for (int m = 0; m < 4; ++m)
#pragma unroll
            for (int n = 0; n < 4; ++n) {
                const int row = mt * BM + wr * 64 + m * 16 + (lane & 15), col = nt * BN + wc * 64 + n * 16 + (lane >> 4) * 4;
                st4(p.ug + (size_t)row * (2 * DFF) + col, acc[m][n]);
            }
    }
}

DI void phase_conv(const Params& p, int l) {
    const int gtid = obid() * blockDim.x + otid(), gsz = gridDim.x * blockDim.x;
    const float* wc = p.w_conv + (size_t)l * 3 * DFF; const float* bc = p.b_conv + (size_t)l * DFF;
    for (int i = gtid; i < T * (DFF / 8); i += gsz) {
        const int row = i / (DFF / 8), c8 = (i % (DFF / 8)) * 8, s = row % S;
        const bf16_t* up = p.ug + (size_t)row * (2 * DFF) + c8;
        const uint4 u0 = *(const uint4*)up;
        uint4 u1 = make_uint4(0, 0, 0, 0), u2 = make_uint4(0, 0, 0, 0);
        if (s >= 1) u1 = *(const uint4*)(up - 2 * DFF);
        if (s >= 2) u2 = *(const uint4*)(up - 4 * DFF);
        const uint4 gg = *(const uint4*)(up + DFF);
        const unsigned a0[4] = {u0.x, u0.y, u0.z, u0.w}, a1[4] = {u1.x, u1.y, u1.z, u1.w}, a2[4] = {u2.x, u2.y, u2.z, u2.w}, ag[4] = {gg.x, gg.y, gg.z, gg.w};
        unsigned o[4];
#pragma unroll
        for (int j = 0; j < 4; ++j) {
            float r[2];
#pragma unroll
            for (int hl = 0; hl < 2; ++hl) {
                const int cidx = c8 + 2 * j + hl;
                const float x0 = hl ? bfhi(a0[j]) : bflo(a0[j]), x1 = hl ? bfhi(a1[j]) : bflo(a1[j]), x2 = hl ? bfhi(a2[j]) : bflo(a2[j]), g = hl ? bfhi(ag[j]) : bflo(ag[j]);
                const float cv = bc[cidx] + wc[cidx] * x2 + wc[DFF + cidx] * x1 + wc[2 * DFF + cidx] * x0;
                r[hl] = 0.5f * cv * (1.f + erff(cv * 0.7071067811865476f)) * g;
            }
            o[j] = pack2(r[0], r[1]);
        }
        *(uint4*)(p.act + (size_t)row * DFF + c8) = make_uint4(o[0], o[1], o[2], o[3]);
    }
}

template <int MODE>
DI void naive_attn(const Params& p, int item) {
    constexpr int D = MODE == 0 ? 64 : 128;
    constexpr int DV = MODE == 2 ? 256 : 128;
    constexpr int SW = DV / 4;
    constexpr int NH = MODE == 0 ? 8 : 4;
    const int tid = otid(), lane = tid & 63;
    const int sl = __builtin_amdgcn_readfirstlane(tid >> 6);
    const int qblk = 127 - (item % 128), hh = (item / 128) % NH, b = item / (128 * NH);
    const int q = qblk * 64 + lane; const size_t tq = (size_t)b * S + q;
    const bf16_t *Q, *Kp;
    if (MODE == 0) { Q = p.qa + tq * 512 + hh * 64; Kp = p.ka + (size_t)b * S * 512 + hh * 64; }
    else if (MODE == 1) { Q = p.qb + tq * 512 + hh * 128; Kp = p.kb + (size_t)b * S * 512 + hh * 128; }
    else { Q = p.cq + tq * 512 + hh * 128; Kp = p.ck + (size_t)b * S * 512 + hh * 128; }
    unsigned qp[D / 2];
#pragma unroll
    for (int i = 0; i < D / 8; ++i) { const uint4 t = ((const uint4*)Q)[i]; qp[4 * i] = t.x; qp[4 * i + 1] = t.y; qp[4 * i + 2] = t.z; qp[4 * i + 3] = t.w; }
    float acc[SW];
#pragma unroll
    for (int i = 0; i < SW; ++i) acc[i] = 0.f;
    float mx = -INFINITY, lsum = 0.f;
    const int send = (qblk + 1) * 64;
    float Fq = 0.f; const float* Fk = nullptr;
    if (MODE == 1) { Fk = p.F + (size_t)(b * 4 + hh) * S; Fq = Fk[q]; }
    float lg = 0.f;
    if (MODE == 2) lg = log2f(1.0f - exp2f(-5.0f - (float)hh));
    for (int s = 0; s < send; ++s) {
        const uint4* kr = (const uint4*)(Kp + (size_t)s * 512);
        float sc = 0.f;
#pragma unroll
        for (int i = 0; i < D / 8; ++i) {
            const uint4 kv = kr[i];
            sc += bflo(qp[4 * i]) * bflo(kv.x) + bfhi(qp[4 * i]) * bfhi(kv.x);
            sc += bflo(qp[4 * i + 1]) * bflo(kv.y) + bfhi(qp[4 * i + 1]) * bfhi(kv.y);
            sc += bflo(qp[4 * i + 2]) * bflo(kv.z) + bfhi(qp[4 * i + 2]) * bfhi(kv.z);
            sc += bflo(qp[4 * i + 3]) * bflo(kv.w) + bfhi(qp[4 * i + 3]) * bfhi(kv.w);
            if ((i & 3) == 3) asm volatile("" ::: "memory");
        }
        float w, corr = 1.f;
        if (MODE == 2) {
            w = (s <= q) ? sc * exp2f((float)(q - s) * lg) : 0.f;
        } else {
            if (MODE == 1) sc += Fq - Fk[s];
            const bool valid = (MODE == 0) || (s <= q);
            if (valid) {
                const float mn = fmaxf(mx, sc);
                corr = exp2f(mx - mn); w = exp2f(sc - mn); mx = mn;
                lsum = lsum * corr + w;
            } else { w = 0.f; }
        }
        if (MODE == 2) {
            const uint4* vr = (const uint4*)(p.cv + ((size_t)b * S + s) * 1024 + hh * 256 + sl * SW);
#pragma unroll
            for (int i = 0; i < SW / 8; ++i) {
                const uint4 vv = vr[i];
                acc[8 * i] += w * bflo(vv.x); acc[8 * i + 1] += w * bfhi(vv.x); acc[8 * i + 2] += w * bflo(vv.y); acc[8 * i + 3] += w * bfhi(vv.y);
                acc[8 * i + 4] += w * bflo(vv.z); acc[8 * i + 5] += w * bfhi(vv.z); acc[8 * i + 6] += w * bflo(vv.w); acc[8 * i + 7] += w * bfhi(vv.w);
            }
        } else {
            const bf16_t* vt = (MODE == 0 ? p.vta + ((size_t)(b * 4 + (hh >> 1)) * 128 + sl * SW) * S : p.vtb + ((size_t)(b * 4 + hh) * 128 + sl * SW) * S) + s;
#pragma unroll
            for (int i = 0; i < SW; ++i) { acc[i] = acc[i] * corr + w * bf2f(*vt); vt += S; asm volatile("" : "+v"(vt)); }
        }
    }
    if (MODE == 2) {
        float* o = p.oc + tq * 1024 + hh * 256 + sl * SW;
#pragma unroll
        for (int i = 0; i < SW / 4; ++i) *(f32x4*)(o + 4 * i) = (f32x4){acc[4 * i], acc[4 * i + 1], acc[4 * i + 2], acc[4 * i + 3]};
    } else {
        const float inv = 1.f / lsum;
        bf16_t* o = (MODE == 0 ? p.oa + tq * 1024 + hh * 128 : p.yb + tq * 512 + hh * 128) + sl * SW;
#pragma unroll
        for (int i = 0; i < SW / 8; ++i) {
            uint4 w4; w4.x = pack2(acc[8 * i] * inv, acc[8 * i + 1] * inv); w4.y = pack2(acc[8 * i + 2] * inv, acc[8 * i + 3] * inv);
            w4.z = pack2(acc[8 * i + 4] * inv, acc[8 * i + 5] * inv); w4.w = pack2(acc[8 * i + 6] * inv, acc[8 * i + 7] * inv);
            ((uint4*)o)[i] = w4;
        }
    }
}


typedef float f32x16 __attribute__((ext_vector_type(16)));
DI bf16x8 pack8(float a0, float a1, float a2, float a3, float a4, float a5, float a6, float a7) {
    typedef unsigned u32x4 __attribute__((ext_vector_type(4)));
    u32x4 w; w[0] = pack2(a0, a1); w[1] = pack2(a2, a3); w[2] = pack2(a4, a5); w[3] = pack2(a6, a7);
    return __builtin_bit_cast(bf16x8, w);
}

template <int MODE>
DI void flash_item(const Params& p, int b, int hh, int qi, unsigned char* smem) {
    constexpr int D = MODE == 0 ? 64 : 128, KST = D + 8, VST = 68, KS = D / 16;
    constexpr int KBYTES = 64 * KST * 2, VBYTES = 128 * VST * 2, BUFB = KBYTES + VBYTES + 256;
    constexpr int NKC = D / 32, CPR = D / 8;
    const int tid = otid(), lane = tid & 63, w = tid >> 6, r = lane & 31, hf = lane >> 5;
    const int q0 = qi * 128 + w * 32;
    const size_t tq = (size_t)b * S + q0 + r;
    bf16x8 qf[KS];
    {
        const bf16_t* qptr = (MODE == 0 ? p.qa + tq * 512 + hh * 64 : p.qb + tq * 512 + hh * 128) + hf * 8;
#pragma unroll
        for (int ks = 0; ks < KS; ++ks) qf[ks] = *(const bf16x8*)(qptr + ks * 16);
    }
    const float* fbase = p.F + (size_t)(b * 4 + (MODE == 1 ? hh : 0)) * S;
    float Fq = 0.f; if (MODE == 1) Fq = fbase[q0 + r];
    const bf16_t* kbase = MODE == 0 ? p.ka + (size_t)b * S * 512 + hh * 64 : p.kb + (size_t)b * S * 512 + hh * 128;
    const bf16_t* vbase = MODE == 0 ? p.vta + (size_t)(b * 4 + (hh >> 1)) * 128 * S : p.vtb + (size_t)(b * 4 + hh) * 128 * S;
    const int ntiles = 2 * qi + 2, wlast = 2 * qi + (w >> 1);
    uint4 kr[NKC], vr[4]; f32x4 frg = {0.f, 0.f, 0.f, 0.f};
#define FL_GLOAD(j) do { \
        _Pragma("unroll") for (int i_ = 0; i_ < NKC; ++i_) { const int c_ = tid + 256 * i_; kr[i_] = *(const uint4*)(kbase + (size_t)(64 * (j) + c_ / CPR) * 512 + (c_ % CPR) * 8); } \
        _Pragma("unroll") for (int i_ = 0; i_ < 4; ++i_) { const int c_ = tid + 256 * i_; vr[i_] = *(const uint4*)(vbase + (size_t)(c_ >> 3) * S + 64 * (j) + (c_ & 7) * 8); } \
        if (MODE == 1 && tid < 16) frg = *(const f32x4*)(fbase + 64 * (j) + tid * 4); } while (0)
#define FL_SSTORE(buf) do { unsigned char* B_ = smem + (buf) * BUFB; \
        _Pragma("unroll") for (int i_ = 0; i_ < NKC; ++i_) { const int c_ = tid + 256 * i_; *(uint4*)(B_ + ((c_ / CPR) * KST + (c_ % CPR) * 8) * 2) = kr[i_]; } \
        _Pragma("unroll") for (int i_ = 0; i_ < 4; ++i_) { const int c_ = tid + 256 * i_; uint2* d_ = (uint2*)(B_ + KBYTES + ((c_ >> 3) * VST + (c_ & 7) * 8) * 2); d_[0] = make_uint2(vr[i_].x, vr[i_].y); d_[1] = make_uint2(vr[i_].z, vr[i_].w); } \
        if (MODE == 1 && tid < 16) *(f32x4*)(B_ + KBYTES + VBYTES + tid * 16) = frg; } while (0)
    FL_GLOAD(0);
    FL_SSTORE(0);
    __syncthreads();
    f32x16 acc[4];
#pragma unroll
    for (int eb = 0; eb < 4; ++eb)
#pragma unroll
        for (int i = 0; i < 16; ++i) acc[eb][i] = 0.f;
    float mrun = -INFINITY, lsum = 0.f;
    for (int j = 0; j < ntiles; ++j) {
        const bool more = j + 1 < ntiles;
        if (more) FL_GLOAD(j + 1);
        if (j <= wlast) {
            const unsigned char* B = smem + (j & 1) * BUFB;
            f32x16 st[2];
#pragma unroll
            for (int kb = 0; kb < 2; ++kb) {
#pragma unroll
                for (int i = 0; i < 16; ++i) st[kb][i] = 0.f;
#pragma unroll
                for (int ks = 0; ks < KS; ++ks) {
                    const bf16x8 a = *(const bf16x8*)(B + ((kb * 32 + r) * KST + ks * 16 + hf * 8) * 2);
                    st[kb] = __builtin_amdgcn_mfma_f32_32x32x16_bf16(a, qf[ks], st[kb], 0, 0, 0);
                }
            }
            if (MODE == 1) {
                const float* Fl = (const float*)(B + KBYTES + VBYTES);
#pragma unroll
                for (int kb = 0; kb < 2; ++kb)
#pragma unroll
                    for (int g = 0; g < 4; ++g) {
                        const f32x4 fk = *(const f32x4*)(Fl + kb * 32 + 8 * g + 4 * hf);
#pragma unroll
                        for (int jj = 0; jj < 4; ++jj) st[kb][4 * g + jj] += Fq - fk[jj];
                    }
                if (j >= 2 * qi) {
                    const int qabs = q0 + r;
#pragma unroll
                    for (int kb = 0; kb < 2; ++kb)
#pragma unroll
                        for (int g = 0; g < 4; ++g)
#pragma unroll
                            for (int jj = 0; jj < 4; ++jj) { const int key = 64 * j + kb * 32 + 8 * g + 4 * hf + jj; if (key > qabs) st[kb][4 * g + jj] = -INFINITY; }
                }
            }
            float mt = st[0][0];
#pragma unroll
            for (int i = 1; i < 16; ++i) mt = fmaxf(mt, st[0][i]);
#pragma unroll
            for (int i = 0; i < 16; ++i) mt = fmaxf(mt, st[1][i]);
            mt = fmaxf(mt, __shfl_xor(mt, 32));
            const float mn = fmaxf(mrun, mt);
            const float corr = ex2(mrun - mn);
            mrun = mn; lsum *= corr;
#pragma unroll
            for (int kb = 0; kb < 2; ++kb)
#pragma unroll
                for (int i = 0; i < 16; ++i) { const float pv = ex2(st[kb][i] - mn); st[kb][i] = pv; lsum += pv; }
#pragma unroll
            for (int eb = 0; eb < 4; ++eb) acc[eb] *= corr;
#pragma unroll
            for (int kb = 0; kb < 2; ++kb)
#pragma unroll
                for (int s2 = 0; s2 < 2; ++s2) {
                    const bf16x8 pf = pack8(st[kb][8 * s2], st[kb][8 * s2 + 1], st[kb][8 * s2 + 2], st[kb][8 * s2 + 3], st[kb][8 * s2 + 4], st[kb][8 * s2 + 5], st[kb][8 * s2 + 6], st[kb][8 * s2 + 7]);
#pragma unroll
                    for (int eb = 0; eb < 4; ++eb) {
                        const unsigned char* vp = B + KBYTES + ((eb * 32 + r) * VST + kb * 32 + 16 * s2 + 4 * hf) * 2;
                        const uint2 lo = *(const uint2*)vp, hi = *(const uint2*)(vp + 16);
                        typedef unsigned u32x4 __attribute__((ext_vector_type(4)));
                        u32x4 av; av[0] = lo.x; av[1] = lo.y; av[2] = hi.x; av[3] = hi.y;
                        acc[eb] = __builtin_amdgcn_mfma_f32_32x32x16_bf16(__builtin_bit_cast(bf16x8, av), pf, acc[eb], 0, 0, 0);
                    }
                }
        }
        if (more) FL_SSTORE((j + 1) & 1);
        __syncthreads();
    }
#undef FL_GLOAD
#undef FL_SSTORE
    const float inv = 1.f / (lsum + __shfl_xor(lsum, 32));
    bf16_t* o = MODE == 0 ? p.oa + tq * 1024 + hh * 128 : p.yb + tq * 512 + hh * 128;
#pragma unroll
    for (int eb = 0; eb < 4; ++eb)
#pragma unroll
        for (int g = 0; g < 4; ++g) {
            f32x4 v = {acc[eb][4 * g] * inv, acc[eb][4 * g + 1] * inv, acc[eb][4 * g + 2] * inv, acc[eb][4 * g + 3] * inv};
            st4(o + eb * 32 + 8 * g + 4 * hf, v);
        }
}


DI void ret_state_item(const Params& p, int item) {
    const int n = item & 127, bh = item >> 7;
    const int tid = otid(), lane = tid & 63, w = tid >> 6, r = lane & 31, hf = lane >> 5;
    const bf16_t* kt = p.ckT + (size_t)bh * 128 * S + n * 64 + hf * 8;
    const bf16_t* vt = p.cv + ((size_t)bh * 256 + w * 64) * S + n * 64 + hf * 8;
    f32x16 acc[4][2];
#pragma unroll
    for (int a = 0; a < 4; ++a)
#pragma unroll
        for (int c = 0; c < 2; ++c)
#pragma unroll
            for (int i = 0; i < 16; ++i) acc[a][c][i] = 0.f;
#pragma unroll
    for (int s4 = 0; s4 < 4; ++s4) {
        bf16x8 af[4], bfr[2];
#pragma unroll
        for (int a = 0; a < 4; ++a) af[a] = *(const bf16x8*)(kt + (size_t)(a * 32 + r) * S + s4 * 16);
#pragma unroll
        for (int c = 0; c < 2; ++c) bfr[c] = *(const bf16x8*)(vt + (size_t)(c * 32 + r) * S + s4 * 16);
#pragma unroll
        for (int a = 0; a < 4; ++a)
#pragma unroll
            for (int c = 0; c < 2; ++c) acc[a][c] = __builtin_amdgcn_mfma_f32_32x32x16_bf16(af[a], bfr[c], acc[a][c], 0, 0, 0);
    }
    bf16_t* o = p.kv + ((size_t)(bh * 128 + n) * 256 + w * 64) * 128;
#pragma unroll
    for (int a = 0; a < 4; ++a)
#pragma unroll
        for (int c = 0; c < 2; ++c)
#pragma unroll
            for (int g = 0; g < 4; ++g) {
                f32x4 v = {acc[a][c][4 * g], acc[a][c][4 * g + 1], acc[a][c][4 * g + 2], acc[a][c][4 * g + 3]};
                st4_wt(o + (size_t)(c * 32 + r) * 128 + a * 32 + 8 * g + 4 * hf, v);
            }
}

DI void ret_scan(const Params& p) {
    const int gtid = obid() * 256 + otid(), gsz = gridDim.x * 256;
    for (int e = gtid; e < 8 * 8192; e += gsz) {
        const int bh = e >> 13, pi = e & 8191, hd = bh & 3;
        const float dec = ex2(64.0f * lg2gamma(hd));
        unsigned long long* ptr = (unsigned long long*)p.kv + (size_t)bh * 128 * 8192 + pi;
        float c0 = 0.f, c1 = 0.f, c2 = 0.f, c3 = 0.f;
        for (int n0 = 0; n0 < 128; n0 += 8) {
            unsigned long long v[8];
#pragma unroll
            for (int k = 0; k < 8; ++k) v[k] = ptr[(size_t)(n0 + k) * 8192];
            asm volatile("s_waitcnt vmcnt(0)" ::: "memory");
#pragma unroll
            for (int k = 0; k < 8; ++k) {
                const unsigned long long o = (unsigned long long)pack2(c0, c1) | ((unsigned long long)pack2(c2, c3) << 32);
                __hip_atomic_store(ptr + (size_t)(n0 + k) * 8192, o, __ATOMIC_RELAXED, __HIP_MEMORY_SCOPE_AGENT);
                const unsigned lo = (unsigned)v[k], hi = (unsigned)(v[k] >> 32);
                c0 = c0 * dec + bflo(lo); c1 = c1 * dec + bfhi(lo); c2 = c2 * dec + bflo(hi); c3 = c3 * dec + bfhi(hi);
            }
        }
    }
}

DI void ret_out_item(const Params& p, int l, int item, unsigned char* smem) {
    const int n = item & 127, bh = item >> 7, b = bh >> 2, hd = bh & 3;
    const int tid = otid(), lane = tid & 63, w = tid >> 6, r = lane & 31, hf = lane >> 5;
    const size_t t0 = (size_t)b * S + n * 64;
    f32x16 acc[2][2];
#pragma unroll
    for (int a = 0; a < 2; ++a)
#pragma unroll
        for (int c = 0; c < 2; ++c)
#pragma unroll
            for (int i = 0; i < 16; ++i) acc[a][c][i] = 0.f;
    bf16x8 pf[2][2][2];
    {
        bf16x8 qf[2][8];
#pragma unroll
        for (int qb = 0; qb < 2; ++qb)
#pragma unroll
            for (int ks = 0; ks < 8; ++ks) qf[qb][ks] = *(const bf16x8*)(p.cq + (t0 + qb * 32 + r) * 512 + hd * 128 + ks * 16 + hf * 8);
        const bf16_t* rt = p.kv + ((size_t)(bh * 128 + n) * 256 + w * 64) * 128 + hf * 8;
#pragma unroll
        for (int dvb = 0; dvb < 2; ++dvb)
#pragma unroll
            for (int ks = 0; ks < 8; ++ks) {
                const bf16x8 a = *(const bf16x8*)(rt + (size_t)(dvb * 32 + r) * 128 + ks * 16);
#pragma unroll
                for (int qb = 0; qb < 2; ++qb) acc[dvb][qb] = __builtin_amdgcn_mfma_f32_32x32x16_bf16(a, qf[qb][ks], acc[dvb][qb], 0, 0, 0);
            }
#pragma unroll
        for (int kb = 0; kb < 2; ++kb) {
            f32x16 st[2];
#pragma unroll
            for (int qb = 0; qb < 2; ++qb)
#pragma unroll
                for (int i = 0; i < 16; ++i) st[qb][i] = 0.f;
#pragma unroll
            for (int ks = 0; ks < 8; ++ks) {
                const bf16x8 a = *(const bf16x8*)(p.ck + (t0 + kb * 32 + r) * 512 + hd * 128 + ks * 16 + hf * 8);
#pragma unroll
                for (int qb = 0; qb < 2; ++qb) st[qb] = __builtin_amdgcn_mfma_f32_32x32x16_bf16(a, qf[qb][ks], st[qb], 0, 0, 0);
            }
#pragma unroll
            for (int qb = 0; qb < 2; ++qb) {
#pragma unroll
                for (int i = 0; i < 16; ++i) { const int key = kb * 32 + (i & 3) + 8 * (i >> 2) + 4 * hf; if (key > qb * 32 + r) st[qb][i] = 0.f; }
#pragma unroll
                for (int s2 = 0; s2 < 2; ++s2)
                    pf[kb][s2][qb] = pack8(st[qb][8 * s2], st[qb][8 * s2 + 1], st[qb][8 * s2 + 2], st[qb][8 * s2 + 3], st[qb][8 * s2 + 4], st[qb][8 * s2 + 5], st[qb][8 * s2 + 6], st[qb][8 * s2 + 7]);
            }
        }
    }
    {
        const bf16_t* vt = p.cv + ((size_t)bh * 256 + w * 64) * S + n * 64 + 4 * hf;
#pragma unroll
        for (int dvb = 0; dvb < 2; ++dvb)
#pragma unroll
            for (int kb = 0; kb < 2; ++kb)
#pragma unroll
                for (int s2 = 0; s2 < 2; ++s2) {
                    const bf16_t* vp = vt + (size_t)(dvb * 32 + r) * S + kb * 32 + 16 * s2;
                    const uint2 lo = *(const uint2*)vp, hi = *(const uint2*)(vp + 8);
                    typedef unsigned u32x4 __attribute__((ext_vector_type(4)));
                    u32x4 av; av[0] = lo.x; av[1] = lo.y; av[2] = hi.x; av[3] = hi.y;
                    const bf16x8 a = __builtin_bit_cast(bf16x8, av);
#pragma unroll
                    for (int qb = 0; qb < 2; ++qb) acc[dvb][qb] = __builtin_amdgcn_mfma_f32_32x32x16_bf16(a, pf[kb][s2][qb], acc[dvb][qb], 0, 0, 0);
                }
    }
    float* red = (float*)smem;
    float mu[2], rstd[2];
    __syncthreads();
#pragma unroll
    for (int qb = 0; qb < 2; ++qb) {
        float s1 = 0.f, s2 = 0.f;
#pragma unroll
        for (int dvb = 0; dvb < 2; ++dvb)
#pragma unroll
            for (int i = 0; i < 16; ++i) { const float x = acc[dvb][qb][i]; s1 += x; s2 += x * x; }
        s1 += __shfl_xor(s1, 32); s2 += __shfl_xor(s2, 32);
        if (hf == 0) { red[(w * 64 + qb * 32 + r) * 2] = s1; red[(w * 64 + qb * 32 + r) * 2 + 1] = s2; }
    }
    __syncthreads();
#pragma unroll
    for (int qb = 0; qb < 2; ++qb) {
        float s1 = 0.f, s2 = 0.f;
#pragma unroll
        for (int ww = 0; ww < 4; ++ww) { s1 += red[(ww * 64 + qb * 32 + r) * 2]; s2 += red[(ww * 64 + qb * 32 + r) * 2 + 1]; }
        const float m_ = s1 * (1.f / 256.f);
        mu[qb] = m_; rstd[qb] = rsqrtf(fmaxf(s2 * (1.f / 256.f) - m_ * m_, 0.f) + LN_EPS);
    }
    const float* gr = p.g_ret + (size_t)l * 1024 + hd * 256 + w * 64;
#pragma unroll
    for (int dvb = 0; dvb < 2; ++dvb)
#pragma unroll
        for (int g = 0; g < 4; ++g) {
            const int dv = dvb * 32 + 8 * g + 4 * hf;
            const f32x4 gg = *(const f32x4*)(gr + dv);
#pragma unroll
            for (int qb = 0; qb < 2; ++qb) {
                const size_t off = (t0 + qb * 32 + r) * 1024 + hd * 256 + w * 64 + dv;
                const uint2 cgv = *(const uint2*)(p.cg + off);
                f32x4 y;
#pragma unroll
                for (int jj = 0; jj < 4; ++jj) y[jj] = (acc[dvb][qb][4 * g + jj] - mu[qb]) * rstd[qb] * gg[jj];
                y[0] *= bflo(cgv.x); y[1] *= bfhi(cgv.x); y[2] *= bflo(cgv.y); y[3] *= bfhi(cgv.y);
                st4(p.yc + off, y);
            }
        }
}

DI void phase_mixers(const Params& p, int l, unsigned char* smem) {
    const int nF = 64 * 24, nC = 2 * 4 * 128;
    int* sitem = (int*)(smem + SMEM_BYTES - 16);
    for (;;) {
        __syncthreads();
        if (otid() == 0) *sitem = (int)atomicAdd(p.ctr + l, 1u);
        __syncthreads();
        const int it = *sitem;
        if (it >= nF + nC) break;
        if (it < nF) {
            const int qi = 63 - it / 24, r = it % 24;
            if (r < 8) flash_item<1>(p, r >> 2, r & 3, qi, smem);
            else flash_item<0>(p, (r - 8) >> 3, (r - 8) & 7, qi, smem);
        } else ret_state_item(p, it - nF);
    }
}

DI void phase_mixers_naive(const Params& p) {
    const int nA = 2 * 8 * 128, nB = 2 * 4 * 128, nC = 2 * 4 * 128;
    for (int it = obid(); it < nA + nB + nC; it += gridDim.x) {
        if (it < nB) naive_attn<1>(p, it);
        else if (it < nB + nC) naive_attn<2>(p, it - nB);
        else naive_attn<0>(p, it - nB - nC);
    }
}

DI void phase_post(const Params& p, int l) {
    const int lane = otid() & 63, wv = otid() >> 6;
    const float lam = p.lamv[2 * l], li = p.lamv[2 * l + 1];
    const float* gd = p.g_diff + (size_t)l * 512; const float* gr = p.g_ret + (size_t)l * 1024;
    for (int row = obid() * 4 + wv; row < T; row += gridDim.x * 4) {
#pragma unroll
        for (int hh = 0; hh < 4; ++hh) {
            const unsigned o0 = *(const unsigned*)(p.oa + (size_t)row * 1024 + (2 * hh) * 128 + lane * 2);
            const unsigned o1 = *(const unsigned*)(p.oa + (size_t)row * 1024 + (2 * hh + 1) * 128 + lane * 2);
            const float d0 = bflo(o0) - lam * bflo(o1), d1 = bfhi(o0) - lam * bfhi(o1);
            float ss = d0 * d0 + d1 * d1;
            for (int o = 32; o; o >>= 1) ss += __shfl_xor(ss, o);
            const float r = rsqrtf(ss * (1.f / 128.f) + LN_EPS) * (1.f - li);
            const int c = hh * 128 + lane * 2;
            *(unsigned*)(p.ya + (size_t)row * 512 + c) = pack2(d0 * r * gd[c], d1 * r * gd[c + 1]);
        }
    }
}

#define GSYNC() do { asm volatile("s_waitcnt vmcnt(0) lgkmcnt(0)" ::: "memory"); __builtin_amdgcn_fence(__ATOMIC_RELEASE, "agent"); grid.sync(); __builtin_amdgcn_fence(__ATOMIC_ACQUIRE, "agent"); } while (0)
__global__ void __launch_bounds__(256, 2) fwd_kernel(Params p) {
    __shared__ __attribute__((aligned(16))) unsigned char smem[SMEM_BYTES];
    cg::grid_group grid = cg::this_grid();
    bf16_t* sm = (bf16_t*)smem; float* smf = (float*)smem;

    GSYNC();
    convert_layer(p, 0, smf);
    phase0_misc(p, smf);
    GSYNC();
    row_phase(p, p.x, false, nullptr, nullptr, nullptr, p.mod, 0, 1024, true, true);
    GSYNC();
    for (int l = 0; l < DEPTH; ++l) {
        const float* modl = p.mod + (size_t)l * 2 * 6144;
        const float* xcur = l == 0 ? p.x : p.xbuf;
        if (obid() >= gridDim.x - 8) scan_item(p, obid() - (gridDim.x - 8), smf);
        phase_inproj(p, sm);
        GSYNC();
        phase_mixers(p, l, smem);
        GSYNC();
        phase_post(p, l);
        ret_scan(p);
        GSYNC();
        for (int it = obid(); it < 1024; it += gridDim.x) ret_out_item(p, l, it, smem);
        GSYNC();
        phase_branch(p, sm);
        GSYNC();
        phase_gemm_res(p, p.h, 1024, p.WoutT, xcur, modl, 2048, sm);
        GSYNC();
        row_phase(p, p.vbuf, true, p.ln_g + (size_t)(l * 2) * Dm, p.ln_b + (size_t)(l * 2) * Dm, p.xbuf, modl, 3072, 4096, true, false);
        GSYNC();
        phase_up(p, sm);
        GSYNC();
        phase_conv(p, l);
        GSYNC();
        phase_gemm_res(p, p.act, DFF, p.WdownT, p.xbuf, modl, 5120, sm);
        GSYNC();
        if (l + 1 < DEPTH) {
            convert_layer(p, l + 1, smf);
            GSYNC();
            row_phase(p, p.vbuf, true, p.ln_g + (size_t)(l * 2 + 1) * Dm, p.ln_b + (size_t)(l * 2 + 1) * Dm, p.xbuf, modl + 2 * 6144, 0, 1024, true, true);
            GSYNC();
        } else {
            row_phase(p, p.vbuf, true, p.ln_g + (size_t)(l * 2 + 1) * Dm, p.ln_b + (size_t)(l * 2 + 1) * Dm, p.out, modl, 0, 1024, false, false);
        }
    }
}

extern "C" void kernel_launch(void* const* d_in, const int* in_sizes, int n_in, void* d_out, int out_size, void* d_ws, size_t ws_size, hipStream_t stream) {
    static int grid_blocks = 0;
    if (!grid_blocks) {
        int dev = 0, cus = 0, per_cu = 0;
        hipGetDevice(&dev);
        hipDeviceGetAttribute(&cus, hipDeviceAttributeMultiprocessorCount, dev);
        hipOccupancyMaxActiveBlocksPerMultiprocessor(&per_cu, fwd_kernel, 256, 0);
        if (per_cu > 2) per_cu = 2;
        if (per_cu < 1) per_cu = 1;
        grid_blocks = cus * per_cu;
    }
    Params p{};
    const float** ins = (const float**)&p.x;
    for (int i = 0; i < 22; ++i) ins[i] = (const float*)d_in[i];
    p.out = (float*)d_out;
    char* w = (char*)d_ws; size_t off = 0;
    auto take = [&](size_t bytes) { char* r = w + off; off += (bytes + 255) & ~(size_t)255; return r; };
    const size_t MB = 1u << 20;
    p.mod = (float*)take((size_t)DEPTH * 2 * 6144 * 4);
    p.lamv = (float*)take(256);
    p.ctr = (unsigned*)take(256);
    p.wf = (float*)take(4100 * 4);
    p.binp = (float*)take(NIN * 4);
    p.cstab = (float*)take((size_t)S * 64 * 2 * 4);
    p.logf = (float*)take((size_t)T * 4 * 4);
    p.F = (float*)take((size_t)T * 4 * 4);
    p.WinT = (bf16_t*)take((size_t)NIN * 1024 * 2);
    p.WpaT = (bf16_t*)take((size_t)1024 * 512 * 2);
    p.WpbT = (bf16_t*)take((size_t)1024 * 512 * 2);
    p.WpcT = (bf16_t*)take((size_t)1024 * 1024 * 2);
    p.WoutT = (bf16_t*)take((size_t)1024 * 1024 * 2);
    p.WupT = (bf16_t*)take((size_t)2 * DFF * 1024 * 2);
    p.WdownT = (bf16_t*)take((size_t)1024 * DFF * 2);
    p.xbuf = (float*)take((size_t)T * Dm * 4);
    p.h = (bf16_t*)take((size_t)T * Dm * 2);
    const size_t offA = off;
    p.qa = (bf16_t*)take((size_t)T * 512 * 2); p.ka = (bf16_t*)take((size_t)T * 512 * 2); p.vta = (bf16_t*)take((size_t)T * 512 * 2);
    p.qb = (bf16_t*)take((size_t)T * 512 * 2); p.kb = (bf16_t*)take((size_t)T * 512 * 2); p.vtb = (bf16_t*)take((size_t)T * 512 * 2);
    p.cq = (bf16_t*)take((size_t)T * 512 * 2); p.ck = (bf16_t*)take((size_t)T * 512 * 2);
    p.cv = (bf16_t*)take((size_t)T * 1024 * 2); p.cg = (bf16_t*)take((size_t)T * 1024 * 2);
    p.gates = (bf16_t*)take((size_t)T * 3072 * 2);
    const size_t endA = off;
    p.ug = (bf16_t*)(w + offA);
    p.act = (bf16_t*)(w + offA + (size_t)T * 2 * DFF * 2);
    const size_t offB = endA;
    off = offB;
    p.vbuf = (float*)(w + offB);
    p.oa = p.h;
    p.yb = (bf16_t*)take((size_t)T * 512 * 2);
    p.kv = (bf16_t*)take((size_t)8 * 128 * 256 * 128 * 2);
    p.ckT = (bf16_t*)take((size_t)T * 512 * 2);
    p.ya = (bf16_t*)take((size_t)T * 512 * 2);
    p.yc = (bf16_t*)take((size_t)T * 1024 * 2);
    if (off > ws_size || (size_t)T * 2 * DFF * 2 + (size_t)T * DFF * 2 > endA - offA) {
        fprintf(stderr, "kernel_launch: workspace too small: need %zu MB have %zu MB\n", off / MB, ws_size / MB);
        return;
    }
    void* args[] = {&p};
    hipError_t e = hipLaunchCooperativeKernel((void*)fwd_kernel, dim3(grid_blocks), dim3(256), args, 0, stream);
    if (e != hipSuccess) fprintf(stderr, "cooperative launch failed: %s (grid %d)\n", hipGetErrorString(e), grid_blocks);
}
```

```cpp
#include <hip/hip_runtime.h>
#include <hip/hip_cooperative_groups.h>
#include <cstdio>
#include <cstdint>
namespace cg = cooperative_groups;

typedef unsigned short bf16_t;
typedef short bf16x8 __attribute__((ext_vector_type(8)));
typedef float f32x4 __attribute__((ext_vector_type(4)));

constexpr int Dm = 1024, NB = 2, S = 8192, T = NB * S, DEPTH = 4, DFF = 2816, DIN = 9220, NIN = 9216;
constexpr float LN_EPS = 1e-5f;
constexpr float LOG2E = 1.4426950408889634f;
#define ALPHA_F 1.681792830507429f

#define DI __device__ __forceinline__
DI int otid() { int t = threadIdx.x; asm volatile("" : "+v"(t)); return t; }
DI int obid() { int b = blockIdx.x; asm volatile("" : "+s"(b)); return b; }

DI bf16_t f2bf(float x) { unsigned u = __float_as_uint(x); u += 0x7fffu + ((u >> 16) & 1u); return (bf16_t)(u >> 16); }
DI float bf2f(bf16_t v) { return __uint_as_float(((unsigned)v) << 16); }
DI float bflo(unsigned w) { return __uint_as_float(w << 16); }
DI float bfhi(unsigned w) { return __uint_as_float(w & 0xffff0000u); }
DI unsigned pack2(float a, float b) { return (unsigned)f2bf(a) | ((unsigned)f2bf(b) << 16); }

struct Params {
    const float *x, *c, *w_ada, *b_ada, *w_in, *b_in, *lq1, *lk1, *lq2, *lk2, *g_diff, *g_ret, *w_pa, *w_pb, *w_pc, *w_out, *ln_g, *ln_b, *w_up, *w_conv, *b_conv, *w_down;
    float* out;
    unsigned* ctr;
    float *mod, *lamv, *wf, *binp, *cstab, *xbuf, *vbuf, *logf, *F, *oc;
    bf16_t *WinT, *WpaT, *WpbT, *WpcT, *WoutT, *WupT, *WdownT;
    bf16_t *h, *qa, *ka, *vta, *qb, *kb, *vtb, *cq, *ck, *cv, *cg, *gates, *oa, *yb, *ya, *yc, *ug, *act, *ckT, *kv;
};

constexpr int BM = 128, BN = 128, BK = 64, LDP = BK + 8;
constexpr int SMEM_BYTES = 2 * (BM + BN) * LDP * 2;

DI int win_map(int n) {
    if (n < 3072) return n;
    if (n < 4096) { int r = n - 3072; int seg = r >> 9; r &= 511; int head = r >> 7; int c = r & 127; return 3076 + seg * 512 + head * 128 + (c >> 1) + 64 * (c & 1); }
    return n + 4;
}

DI void convert_tile(const float* __restrict__ src, int ldsrc, bf16_t* __restrict__ dst, int K, int tiles_n, int tile, int kind, float* lds) {
    const int tn = tile % tiles_n, tk = tile / tiles_n;
    const int tx = otid() & 63, ty = otid() >> 6;
    const int n = tn * 64 + tx;
    const int sn = kind == 1 ? win_map(n) : n;
    __syncthreads();
#pragma unroll 4
    for (int r = 0; r < 16; ++r) {
        const int kk = ty * 16 + r;
        lds[kk * 65 + tx] = src[(size_t)(tk * 64 + kk) * ldsrc + sn];
    }
    __syncthreads();
#pragma unroll 4
    for (int r = 0; r < 16; ++r) {
        const int nn = ty * 16 + r;
        dst[(size_t)(tn * 64 + nn) * K + tk * 64 + tx] = f2bf(lds[tx * 65 + nn]);
    }
}

DI void convert_layer(const Params& p, int l, float* lds) {
    const int n_in = 16 * 144, n_pa = 8 * 16, n_pb = 8 * 16, n_pc = 16 * 16, n_out = 16 * 16, n_up = 16 * 88, n_dn = 44 * 16;
    const int total = n_in + n_pa + n_pb + n_pc + n_out + n_up + n_dn;
    for (int it = obid(); it < total; it += gridDim.x) {
        int t = it;
        if (t < n_in) { convert_tile(p.w_in + (size_t)l * Dm * DIN, DIN, p.WinT, 1024, 144, t, 1, lds); continue; } t -= n_in;
        if (t < n_pa) { convert_tile(p.w_pa + (size_t)l * 512 * Dm, Dm, p.WpaT, 512, 16, t, 0, lds); continue; } t -= n_pa;
        if (t < n_pb) { convert_tile(p.w_pb + (size_t)l * 512 * Dm, Dm, p.WpbT, 512, 16, t, 0, lds); continue; } t -= n_pb;
        if (t < n_pc) { convert_tile(p.w_pc + (size_t)l * 1024 * Dm, Dm, p.WpcT, 1024, 16, t, 0, lds); continue; } t -= n_pc;
        if (t < n_out) { convert_tile(p.w_out + (size_t)l * Dm * Dm, Dm, p.WoutT, 1024, 16, t, 0, lds); continue; } t -= n_out;
        if (t < n_up) { convert_tile(p.w_up + (size_t)l * Dm * 2 * DFF, 2 * DFF, p.WupT, 1024, 88, t, 0, lds); continue; } t -= n_up;
        convert_tile(p.w_down + (size_t)l * DFF * Dm, Dm, p.WdownT, DFF, 16, t, 0, lds);
    }
    const int gtid = obid() * blockDim.x + otid(), gsz = gridDim.x * blockDim.x;
    for (int i = gtid; i < NIN; i += gsz) p.binp[i] = p.b_in[(size_t)l * DIN + win_map(i)];
    for (int i = gtid; i < 4096; i += gsz) { const int k = i >> 2, hh = i & 3; p.wf[i] = p.w_in[(size_t)l * Dm * DIN + (size_t)k * DIN + 3072 + hh]; }
    for (int i = gtid; i < 4; i += gsz) p.wf[4096 + i] = p.b_in[(size_t)l * DIN + 3072 + i];
}

DI float ex2(float x) { return __builtin_amdgcn_exp2f(x); }
DI float lg2gamma(int hd) { return hd == 0 ? -0.04580368961312479f : hd == 1 ? -0.02272007650008353f : hd == 2 ? -0.011315313227834146f : -0.005646563141142063f; }
DI float silu_f(float v) { return v / (1.f + __expf(-v)); }
DI float sigmoid_f(float v) { return 1.f / (1.f + __expf(-v)); }

DI void phase0_misc(const Params& p, float* lds) {
    for (int it = obid(); it < DEPTH * 96; it += gridDim.x) {
        const int l = it / 96, jb = it % 96;
        const int tx = otid() & 63, ks = otid() >> 6;
        const int j = jb * 64 + tx;
        const float* w = p.w_ada + (size_t)l * Dm * 6144 + j;
        float a0 = 0.f, a1 = 0.f;
#pragma unroll 8
        for (int k = ks * 256; k < ks * 256 + 256; ++k) {
            const float wv = w[(size_t)k * 6144];
            a0 += silu_f(p.c[k]) * wv; a1 += silu_f(p.c[Dm + k]) * wv;
        }
        __syncthreads();
        lds[(ks * 64 + tx) * 2] = a0; lds[(ks * 64 + tx) * 2 + 1] = a1;
        __syncthreads();
        if (ks == 0) {
            float s0 = 0.f, s1 = 0.f;
            for (int q = 0; q < 4; ++q) { s0 += lds[(q * 64 + tx) * 2]; s1 += lds[(q * 64 + tx) * 2 + 1]; }
            const float bb = p.b_ada[(size_t)l * 6144 + j];
            p.mod[((size_t)l * 2 + 0) * 6144 + j] = s0 + bb;
            p.mod[((size_t)l * 2 + 1) * 6144 + j] = s1 + bb;
        }
    }
    const int gtid = obid() * blockDim.x + otid(), gsz = gridDim.x * blockDim.x;
    if (gtid < 64) p.ctr[gtid] = 0u;
    if (obid() == 0 && otid() < 64 * DEPTH) {
        const int l = otid() >> 6, ln = otid() & 63;
        float a = p.lq1[l * 64 + ln] * p.lk1[l * 64 + ln], b = p.lq2[l * 64 + ln] * p.lk2[l * 64 + ln];
        for (int o = 32; o; o >>= 1) { a += __shfl_xor(a, o); b += __shfl_xor(b, o); }
        if (ln == 0) { const float li = 0.8f - 0.6f * expf(-0.3f * (float)l); p.lamv[2 * l] = expf(a) - expf(b) + li; p.lamv[2 * l + 1] = li; }
    }
}

DI void row_phase(const Params& p, const float* __restrict__ src, bool do_ln, const float* __restrict__ lng, const float* __restrict__ lnb,
                  float* __restrict__ xdst, const float* __restrict__ modl  , int sh_off, int sc_off, bool want_h, bool want_logf) {
    const int lane = otid() & 63, wv = otid() >> 6;
    for (int row = obid() * 4 + wv; row < T; row += gridDim.x * 4) {
        const int b = row / S;
        const float* sp = src + (size_t)row * Dm;
        f32x4 v[4];
#pragma unroll
        for (int i = 0; i < 4; ++i) v[i] = *(const f32x4*)(sp + i * 256 + lane * 4);
        if (do_ln) {
            float s = 0.f;
#pragma unroll
            for (int i = 0; i < 4; ++i) s += (v[i][0] + v[i][1]) + (v[i][2] + v[i][3]);
            for (int o = 32; o; o >>= 1) s += __shfl_xor(s, o);
            const float mu = s * (1.f / 1024.f);
            float q = 0.f;
#pragma unroll
            for (int i = 0; i < 4; ++i) { f32x4 d = v[i] - mu; q += (d[0] * d[0] + d[1] * d[1]) + (d[2] * d[2] + d[3] * d[3]); }
            for (int o = 32; o; o >>= 1) q += __shfl_xor(q, o);
            const float rstd = rsqrtf(q * (1.f / 1024.f) + LN_EPS);
#pragma unroll
            for (int i = 0; i < 4; ++i) {
                const f32x4 g = *(const f32x4*)(lng + i * 256 + lane * 4), bb = *(const f32x4*)(lnb + i * 256 + lane * 4);
                v[i] = (v[i] - mu) * rstd * g + bb;
            }
        }
        if (xdst) {
#pragma unroll
            for (int i = 0; i < 4; ++i) *(f32x4*)(xdst + (size_t)row * Dm + i * 256 + lane * 4) = v[i];
        }
        if (want_h) {
            const float* mb = modl + (size_t)b * 6144;
            float d0 = 0.f, d1 = 0.f, d2 = 0.f, d3 = 0.f;
#pragma unroll
            for (int i = 0; i < 4; ++i) {
                const int c0 = i * 256 + lane * 4;
                const f32x4 sc = *(const f32x4*)(mb + sc_off + c0), sh = *(const f32x4*)(mb + sh_off + c0);
                const f32x4 hv = v[i] * (1.f + sc) + sh;
                uint2 w; w.x = pack2(hv[0], hv[1]); w.y = pack2(hv[2], hv[3]);
                *(uint2*)(p.h + (size_t)row * Dm + c0) = w;
                if (want_logf) {
#pragma unroll
                    for (int j = 0; j < 4; ++j) {
                        const f32x4 wf = *(const f32x4*)(p.wf + (c0 + j) * 4);
                        d0 += hv[j] * wf[0]; d1 += hv[j] * wf[1]; d2 += hv[j] * wf[2]; d3 += hv[j] * wf[3];
                    }
                }
            }
            if (want_logf) {
                for (int o = 32; o; o >>= 1) { d0 += __shfl_xor(d0, o); d1 += __shfl_xor(d1, o); d2 += __shfl_xor(d2, o); d3 += __shfl_xor(d3, o); }
                if (lane < 4) {
                    float z = (lane == 0 ? d0 : lane == 1 ? d1 : lane == 2 ? d2 : d3) + p.wf[4096 + lane];
                    const float ls = fminf(z, 0.f) - log1pf(__expf(-fabsf(z)));
                    p.logf[(size_t)row * 4 + lane] = ls * LOG2E;
                }
            }
        }
    }
}

DI void scan_item(const Params& p, int item, float* lds) {
    const int b = item >> 2, hh = item & 3, tid = otid();
    const float* lp = p.logf + (size_t)b * S * 4 + hh;
    float loc[32]; float s = 0.f;
#pragma unroll
    for (int i = 0; i < 32; ++i) { s += lp[(size_t)(tid * 32 + i) * 4]; loc[i] = s; }
    __syncthreads();
    lds[tid] = s;
    __syncthreads();
    float pre = 0.f;
    for (int i = 0; i < tid; ++i) pre += lds[i];
    float* fp = p.F + (size_t)(b * 4 + hh) * S + tid * 32;
#pragma unroll
    for (int i = 0; i < 32; ++i) fp[i] = pre + loc[i];
    __syncthreads();
}

DI void gemm_kloop(const bf16_t* __restrict__ Ag, int lda, const bf16_t* __restrict__ Bg, int ldb, int K, f32x4 (&acc)[4][4], bf16_t* sm) {
    const int tid = otid(), lane = tid & 63, wid = tid >> 6, wr = wid >> 1, wc = wid & 1;
    bf16_t* sa = sm; bf16_t* sb = sm + 2 * BM * LDP;
    const int lrow = tid >> 3, lcc = tid & 7;
    const bf16_t* ap = Ag + (size_t)lrow * lda + lcc * 8;
    const bf16_t* bp = Bg + (size_t)lrow * ldb + lcc * 8;
    const size_t sA = (size_t)32 * lda, sB = (size_t)32 * ldb;
    uint4 ra0, ra1, ra2, ra3, rb0, rb1, rb2, rb3;
#define G_LOAD(koff) do { ra0 = *(const uint4*)(ap + (koff)); ra1 = *(const uint4*)(ap + sA + (koff)); ra2 = *(const uint4*)(ap + 2 * sA + (koff)); ra3 = *(const uint4*)(ap + 3 * sA + (koff)); \
                          rb0 = *(const uint4*)(bp + (koff)); rb1 = *(const uint4*)(bp + sB + (koff)); rb2 = *(const uint4*)(bp + 2 * sB + (koff)); rb3 = *(const uint4*)(bp + 3 * sB + (koff)); } while (0)
#define G_STORE(buf) do { bf16_t* da_ = sa + (buf) * BM * LDP + lrow * LDP + lcc * 8; bf16_t* db_ = sb + (buf) * BN * LDP + lrow * LDP + lcc * 8; \
        *(uint4*)(da_) = ra0; *(uint4*)(da_ + 32 * LDP) = ra1; *(uint4*)(da_ + 64 * LDP) = ra2; *(uint4*)(da_ + 96 * LDP) = ra3; \
        *(uint4*)(db_) = rb0; *(uint4*)(db_ + 32 * LDP) = rb1; *(uint4*)(db_ + 64 * LDP) = rb2; *(uint4*)(db_ + 96 * LDP) = rb3; } while (0)
    G_LOAD(0);
    G_STORE(0);
    __syncthreads();
    const int nk = K / BK;
    const int fr = lane & 15, fq = lane >> 4;
    for (int kt = 0; kt < nk; ++kt) {
        const int cur = kt & 1;
        const bool more = kt + 1 < nk;
        if (more) G_LOAD((kt + 1) * BK);
        const bf16_t* ca = sa + cur * BM * LDP + (wr * 64 + fr) * LDP + fq * 8;
        const bf16_t* cb = sb + cur * BN * LDP + (wc * 64 + fr) * LDP + fq * 8;
#pragma unroll
        for (int kk = 0; kk < 2; ++kk) {
            bf16x8 af[4], bfr[4];
#pragma unroll
            for (int m = 0; m < 4; ++m) af[m] = *(const bf16x8*)(ca + m * 16 * LDP + kk * 32);
#pragma unroll
            for (int n = 0; n < 4; ++n) bfr[n] = *(const bf16x8*)(cb + n * 16 * LDP + kk * 32);
#pragma unroll
            for (int m = 0; m < 4; ++m)
#pragma unroll
                for (int n = 0; n < 4; ++n) acc[m][n] = __builtin_amdgcn_mfma_f32_16x16x32_bf16(bfr[n], af[m], acc[m][n], 0, 0, 0);
        }
        if (more) G_STORE(cur ^ 1);
        __syncthreads();
    }
#undef G_LOAD
#undef G_STORE
}

DI void gemm_kloop2(const bf16_t* __restrict__ Ag, int lda, const bf16_t* __restrict__ Bg, int ldb, int K, f32x4 (&acc)[4][4], bf16_t* sm) {
    const int tid = otid(), lane = tid & 63, wid = tid >> 6, wr = wid >> 1, wc = wid & 1;
    bf16_t* sa = sm; bf16_t* sb = sm + 2 * BM * LDP;
    const int lrow = tid >> 3, lcc = tid & 7;
    const bf16_t* ap = Ag + (size_t)lrow * lda + lcc * 8;
    const bf16_t* bp = Bg + (size_t)lrow * ldb + lcc * 8;
    const size_t sA = (size_t)32 * lda, sB = (size_t)32 * ldb;
    uint4 xa0, xa1, xa2, xa3, xb0, xb1, xb2, xb3;
    uint4 ya0, ya1, ya2, ya3, yb0, yb1, yb2, yb3;
#define G2_LOAD(P, koff) do { P##a0 = *(const uint4*)(ap + (koff)); P##a1 = *(const uint4*)(ap + sA + (koff)); P##a2 = *(const uint4*)(ap + 2 * sA + (koff)); P##a3 = *(const uint4*)(ap + 3 * sA + (koff)); \
                              P##b0 = *(const uint4*)(bp + (koff)); P##b1 = *(const uint4*)(bp + sB + (koff)); P##b2 = *(const uint4*)(bp + 2 * sB + (koff)); P##b3 = *(const uint4*)(bp + 3 * sB + (koff)); } while (0)
#define G2_STORE(P, buf) do { bf16_t* da_ = sa + (buf) * BM * LDP + lrow * LDP + lcc * 8; bf16_t* db_ = sb + (buf) * BN * LDP + lrow * LDP + lcc * 8; \
        *(uint4*)(da_) = P##a0; *(uint4*)(da_ + 32 * LDP) = P##a1; *(uint4*)(da_ + 64 * LDP) = P##a2; *(uint4*)(da_ + 96 * LDP) = P##a3; \
        *(uint4*)(db_) = P##b0; *(uint4*)(db_ + 32 * LDP) = P##b1; *(uint4*)(db_ + 64 * LDP) = P##b2; *(uint4*)(db_ + 96 * LDP) = P##b3; } while (0)
#define G2_COMPUTE(buf) do { \
        const bf16_t* ca = sa + (buf) * BM * LDP + (wr * 64 + fr) * LDP + fq * 8; \
        const bf16_t* cb = sb + (buf) * BN * LDP + (wc * 64 + fr) * LDP + fq * 8; \
        _Pragma("unroll") for (int kk = 0; kk < 2; ++kk) { \
            bf16x8 af[4], bfr[4]; \
            _Pragma("unroll") for (int m = 0; m < 4; ++m) af[m] = *(const bf16x8*)(ca + m * 16 * LDP + kk * 32); \
            _Pragma("unroll") for (int n = 0; n < 4; ++n) bfr[n] = *(const bf16x8*)(cb + n * 16 * LDP + kk * 32); \
            _Pragma("unroll") for (int m = 0; m < 4; ++m) _Pragma("unroll") for (int n = 0; n < 4; ++n) acc[m][n] = __builtin_amdgcn_mfma_f32_16x16x32_bf16(bfr[n], af[m], acc[m][n], 0, 0, 0); \
        } } while (0)
    const int nk = K / BK;
    const int fr = lane & 15, fq = lane >> 4;
    G2_LOAD(x, 0);
    G2_LOAD(y, BK);
    G2_STORE(x, 0);
    __syncthreads();
    for (int kt = 0; kt < nk; kt += 2) {
        const bool m2 = kt + 2 < nk;
        if (m2) G2_LOAD(x, (kt + 2) * BK);
        G2_COMPUTE(0);
        G2_STORE(y, 1);
        __syncthreads();
        if (kt + 3 < nk) G2_LOAD(y, (kt + 3) * BK);
        G2_COMPUTE(1);
        if (m2) G2_STORE(x, 0);
        __syncthreads();
    }
#undef G2_LOAD
#undef G2_STORE
#undef G2_COMPUTE
}

DI void tile_coords(int tile, int nM, int nN, int& mt, int& nt) {
    const int G = gridDim.x;
    if ((G & 7) == 0 && nM == 128 && (nM * nN) % G == 0) {
        const int b = tile % G, k = tile / G, per = G >> 3;
        const int xcd = b & 7, slot = b >> 3;
        const int li = k * per + slot;
        const int mh = li / (8 * nN), rem = li % (8 * nN);
        nt = rem >> 3; mt = (mh * 8 + (rem & 7)) * 8 + xcd;
        return;
    }
    const int band = tile / (16 * nN), r = tile % (16 * nN);
    mt = band * 16 + (r & 15); nt = r >> 4;
}

DI void zero_acc(f32x4 (&acc)[4][4]) {
#pragma unroll
    for (int m = 0; m < 4; ++m)
#pragma unroll
        for (int n = 0; n < 4; ++n) acc[m][n] = (f32x4){0.f, 0.f, 0.f, 0.f};
}

DI void st4_wt(bf16_t* dst, f32x4 v) { const unsigned long long w = (unsigned long long)pack2(v[0], v[1]) | ((unsigned long long)pack2(v[2], v[3]) << 32); __hip_atomic_store((unsigned long long*)dst, w, __ATOMIC_RELAXED, __HIP_MEMORY_SCOPE_AGENT); }
DI void st4(bf16_t* dst, f32x4 v) { uint2 w; w.x = pack2(v[0], v[1]); w.y = pack2(v[2], v[3]); *(uint2*)dst = w; }

DI void epi_inproj(const Params& p, int row, int col, f32x4 v) {
    v += *(const f32x4*)(p.binp + col);
    const int b = row / S, s = row % S;
    if (col < 512) { st4(p.qa + (size_t)row * 512 + col, v * (0.125f * LOG2E)); }
    else if (col < 1024) { st4(p.ka + (size_t)row * 512 + (col - 512), v); }
    else if (col < 1536) { const int c = col - 1024, hh = c >> 7, e = c & 127; bf16_t* d = p.vta + ((size_t)(b * 4 + hh) * 128 + e) * S + s;
#pragma unroll
        for (int j = 0; j < 4; ++j) d[(size_t)j * S] = f2bf(v[j]); }
    else if (col < 2048) { st4(p.qb + (size_t)row * 512 + (col - 1536), v * (0.08838834764831845f * LOG2E)); }
    else if (col < 2560) { st4(p.kb + (size_t)row * 512 + (col - 2048), v); }
    else if (col < 3072) { const int c = col - 2560, hh = c >> 7, e = c & 127; bf16_t* d = p.vtb + ((size_t)(b * 4 + hh) * 128 + e) * S + s;
#pragma unroll
        for (int j = 0; j < 4; ++j) d[(size_t)j * S] = f2bf(v[j]); }
    else if (col < 4096) {
        const int r = col - 3072, seg = r >> 9, c = r & 511, cc = c & 127, i0 = cc >> 1, hd = c >> 7;
        f32x4 cs;
        {
            const float a0 = (float)s * ex2(-(float)i0 * 0.21091607f), a1 = (float)s * ex2(-(float)(i0 + 1) * 0.21091607f);
            float r0 = a0 * 0.15915494309189535f, r1 = a1 * 0.15915494309189535f;
            r0 -= floorf(r0); r1 -= floorf(r1);
            float c0_ = __builtin_amdgcn_cosf(r0), s0_ = __builtin_amdgcn_sinf(r0), c1_ = __builtin_amdgcn_cosf(r1), s1_ = __builtin_amdgcn_sinf(r1);
            asm volatile("s_nop 15\n\ts_nop 15" : "+v"(c0_), "+v"(s0_), "+v"(c1_), "+v"(s1_));
            cs[0] = c0_; cs[1] = s0_; cs[2] = c1_; cs[3] = s1_;
        }
        f32x4 o; o[0] = v[0] * cs[0] - v[1] * cs[1]; o[1] = v[0] * cs[1] + v[1] * cs[0]; o[2] = v[2] * cs[2] - v[3] * cs[3]; o[3] = v[2] * cs[3] + v[3] * cs[2];
        const float lg = lg2gamma(hd);
        const int ic = s & 63;
        float e1_ = ex2(lg * (float)(ic + 1)), e2_ = ex2(-lg * (float)(ic + 1)), e3_ = ex2(lg * (float)(63 - ic));
        asm volatile("s_nop 15\n\ts_nop 15" : "+v"(e1_), "+v"(e2_), "+v"(e3_));
        if (seg == 0) st4(p.cq + (size_t)row * 512 + c, o * e1_);
        else {
            o = o * 0.08838834764831845f;
            st4(p.ck + (size_t)row * 512 + c, o * e2_);
            const f32x4 od = o * e3_;
            bf16_t* d = p.ckT + ((size_t)(b * 4 + hd) * 128 + cc) * S + s;
#pragma unroll
            for (int j = 0; j < 4; ++j) d[(size_t)j * S] = f2bf(od[j]);
        }
    }
    else if (col < 5120) { const int c = col - 4096; bf16_t* d = p.cv + ((size_t)b * 1024 + c) * S + s;
#pragma unroll
        for (int j = 0; j < 4; ++j) d[(size_t)j * S] = f2bf(v[j]); }
    else if (col < 6144) { f32x4 o; for (int j = 0; j < 4; ++j) o[j] = silu_f(v[j]); st4(p.cg + (size_t)row * 1024 + (col - 5120), o); }
    else { f32x4 o; for (int j = 0; j < 4; ++j) o[j] = sigmoid_f(v[j]); st4(p.gates + (size_t)row * 3072 + (col - 6144), o); }
}

DI void phase_inproj(const Params& p, bf16_t* sm) {
    const int nM = T / BM, nN = NIN / BN;
    const int lane = otid() & 63, wid = otid() >> 6, wr = wid >> 1, wc = wid & 1;
    for (int tile = obid(); tile < nM * nN; tile += gridDim.x) {
        int mt, nt; tile_coords(tile, nM, nN, mt, nt);
        f32x4 acc[4][4]; zero_acc(acc);
        gemm_kloop2(p.h + (size_t)mt * BM * Dm, Dm, p.WinT + (size_t)nt * BN * Dm, Dm, Dm, acc, sm);
#pragma unroll
        for (int m = 0; m < 4; ++m)
#pragma unroll
            for (int n = 0; n < 4; ++n) epi_inproj(p, mt * BM + wr * 64 + m * 16 + (lane & 15), nt * BN + wc * 64 + n * 16 + (lane >> 4) * 4, acc[m][n]);
    }
}

DI void phase_branch(const Params& p, bf16_t* sm) {
    const int nM = T / BM, nN = Dm / BN;
    const int lane = otid() & 63, wid = otid() >> 6, wr = wid >> 1, wc = wid & 1;
    for (int tile = obid(); tile < nM * nN; tile += gridDim.x) {
        int mt, nt; tile_coords(tile, nM, nN, mt, nt);
        f32x4 tot[4][4]; zero_acc(tot);
#pragma unroll 1
        for (int br = 0; br < 3; ++br) {
            const bf16_t* A = br == 0 ? p.ya : br == 1 ? p.yb : p.yc;
            const bf16_t* W = br == 0 ? p.WpaT : br == 1 ? p.WpbT : p.WpcT;
            const int K = br == 2 ? 1024 : 512;
            f32x4 acc[4][4]; zero_acc(acc);
            gemm_kloop(A + (size_t)mt * BM * K, K, W + (size_t)nt * BN * K, K, K, acc, sm);
#pragma unroll
            for (int m = 0; m < 4; ++m)
#pragma unroll
                for (int n = 0; n < 4; ++n) {
                    const int row = mt * BM + wr * 64 + m * 16 + (lane & 15), col = nt * BN + wc * 64 + n * 16 + (lane >> 4) * 4;
                    const uint2 g = *(const uint2*)(p.gates + (size_t)row * 3072 + br * 1024 + col);
                    tot[m][n][0] += bflo(g.x) * acc[m][n][0]; tot[m][n][1] += bfhi(g.x) * acc[m][n][1];
                    tot[m][n][2] += bflo(g.y) * acc[m][n][2]; tot[m][n][3] += bfhi(g.y) * acc[m][n][3];
                }
        }
#pragma unroll
        for (int m = 0; m < 4; ++m)
#pragma unroll
            for (int n = 0; n < 4; ++n) {
                const int row = mt * BM + wr * 64 + m * 16 + (lane & 15), col = nt * BN + wc * 64 + n * 16 + (lane >> 4) * 4;
                st4(p.h + (size_t)row * Dm + col, tot[m][n]);
            }
    }
}

DI void phase_gemm_res(const Params& p, const bf16_t* A, int K, const bf16_t* Wt, const float* xres, const float* modl, int gt_off, bf16_t* sm) {
    const int nM = T / BM, nN = Dm / BN;
    const int lane = otid() & 63, wid = otid() >> 6, wr = wid >> 1, wc = wid & 1;
    for (int tile = obid(); tile < nM * nN; tile += gridDim.x) {
        int mt, nt; tile_coords(tile, nM, nN, mt, nt);
        f32x4 acc[4][4]; zero_acc(acc);
        gemm_kloop2(A + (size_t)mt * BM * K, K, Wt + (size_t)nt * BN * K, K, K, acc, sm);
#pragma unroll
        for (int m = 0; m < 4; ++m)
#pragma unroll
            for (int n = 0; n < 4; ++n) {
                const int row = mt * BM + wr * 64 + m * 16 + (lane & 15), col = nt * BN + wc * 64 + n * 16 + (lane >> 4) * 4;
                const int b = row / S;
                const f32x4 xr = *(const f32x4*)(xres + (size_t)row * Dm + col);
                const f32x4 gt = *(const f32x4*)(modl + (size_t)b * 6144 + gt_off + col);
                *(f32x4*)(p.vbuf + (size_t)row * Dm + col) = xr * ALPHA_F + gt * acc[m][n];
            }
    }
}

DI void phase_up(const Params& p, bf16_t* sm) {
    const int nM = T / BM, nN = 2 * DFF / BN;
    const int lane = otid() & 63, wid = otid() >> 6, wr = wid >> 1, wc = wid & 1;
    for (int tile = obid(); tile < nM * nN; tile += gridDim.x) {
        int mt, nt; tile_coords(tile, nM, nN, mt, nt);
        f32x4 acc[4][4]; zero_acc(acc);
        gemm_kloop2(p.h + (size_t)mt * BM * Dm, Dm, p.WupT + (size_t)nt * BN * Dm, Dm, Dm, acc, sm);
#pragma unroll
        for (int m = 0; m < 4; ++m)
#pragma unroll
            for (int n = 0; n < 4; ++n) {
                const int row = mt * BM + wr * 64 + m * 16 + (lane & 15), col = nt * BN + wc * 64 + n * 16 + (lane >> 4) * 4;
                st4(p.ug + (size_t)row * (2 * DFF) + col, acc[m][n]);
            }
    }
}

DI void phase_conv(const Params& p, int l) {
    const int gtid = obid() * blockDim.x + otid(), gsz = gridDim.x * blockDim.x;
    const float* wc = p.w_conv + (size_t)l * 3 * DFF; const float* bc = p.b_conv + (size_t)l * DFF;
    for (int i = gtid; i < T * (DFF / 8); i += gsz) {
        const int row = i / (DFF / 8), c8 = (i % (DFF / 8)) * 8, s = row % S;
        const bf16_t* up = p.ug + (size_t)row * (2 * DFF) + c8;
        const uint4 u0 = *(const uint4*)up;
        uint4 u1 = make_uint4(0, 0, 0, 0), u2 = make_uint4(0, 0, 0, 0);
        if (s >= 1) u1 = *(const uint4*)(up - 2 * DFF);
        if (s >= 2) u2 = *(const uint4*)(up - 4 * DFF);
        const uint4 gg = *(const uint4*)(up + DFF);
        const unsigned a0[4] = {u0.x, u0.y, u0.z, u0.w}, a1[4] = {u1.x, u1.y, u1.z, u1.w}, a2[4] = {u2.x, u2.y, u2.z, u2.w}, ag[4] = {gg.x, gg.y, gg.z, gg.w};
        unsigned o[4];
#pragma unroll
        for (int j = 0; j < 4; ++j) {
            float r[2];
#pragma unroll
            for (int hl = 0; hl < 2; ++hl) {
                const int cidx = c8 + 2 * j + hl;
                const float x0 = hl ? bfhi(a0[j]) : bflo(a0[j]), x1 = hl ? bfhi(a1[j]) : bflo(a1[j]), x2 = hl ? bfhi(a2[j]) : bflo(a2[j]), g = hl ? bfhi(ag[j]) : bflo(ag[j]);
                const float cv = bc[cidx] + wc[cidx] * x2 + wc[DFF + cidx] * x1 + wc[2 * DFF + cidx] * x0;
                r[hl] = 0.5f * cv * (1.f + erff(cv * 0.7071067811865476f)) * g;
            }
            o[j] = pack2(r[0], r[1]);
        }
        *(uint4*)(p.act + (size_t)row * DFF + c8) = make_uint4(o[0], o[1], o[2], o[3]);
    }
}

template <int MODE>
DI void naive_attn(const Params& p, int item) {
    constexpr int D = MODE == 0 ? 64 : 128;
    constexpr int DV = MODE == 2 ? 256 : 128;
    constexpr int SW = DV / 4;
    constexpr int NH = MODE == 0 ? 8 : 4;
    const int tid = otid(), lane = tid & 63;
    const int sl = __builtin_amdgcn_readfirstlane(tid >> 6);
    const int qblk = 127 - (item % 128), hh = (item / 128) % NH, b = item / (128 * NH);
    const int q = qblk * 64 + lane; const size_t tq = (size_t)b * S + q;
    const bf16_t *Q, *Kp;
    if (MODE == 0) { Q = p.qa + tq * 512 + hh * 64; Kp = p.ka + (size_t)b * S * 512 + hh * 64; }
    else if (MODE == 1) { Q = p.qb + tq * 512 + hh * 128; Kp = p.kb + (size_t)b * S * 512 + hh * 128; }
    else { Q = p.cq + tq * 512 + hh * 128; Kp = p.ck + (size_t)b * S * 512 + hh * 128; }
    unsigned qp[D / 2];
#pragma unroll
    for (int i = 0; i < D / 8; ++i) { const uint4 t = ((const uint4*)Q)[i]; qp[4 * i] = t.x; qp[4 * i + 1] = t.y; qp[4 * i + 2] = t.z; qp[4 * i + 3] = t.w; }
    float acc[SW];
#pragma unroll
    for (int i = 0; i < SW; ++i) acc[i] = 0.f;
    float mx = -INFINITY, lsum = 0.f;
    const int send = (qblk + 1) * 64;
    float Fq = 0.f; const float* Fk = nullptr;
    if (MODE == 1) { Fk = p.F + (size_t)(b * 4 + hh) * S; Fq = Fk[q]; }
    float lg = 0.f;
    if (MODE == 2) lg = log2f(1.0f - exp2f(-5.0f - (float)hh));
    for (int s = 0; s < send; ++s) {
        const uint4* kr = (const uint4*)(Kp + (size_t)s * 512);
        float sc = 0.f;
#pragma unroll
        for (int i = 0; i < D / 8; ++i) {
            const uint4 kv = kr[i];
            sc += bflo(qp[4 * i]) * bflo(kv.x) + bfhi(qp[4 * i]) * bfhi(kv.x);
            sc += bflo(qp[4 * i + 1]) * bflo(kv.y) + bfhi(qp[4 * i + 1]) * bfhi(kv.y);
            sc += bflo(qp[4 * i + 2]) * bflo(kv.z) + bfhi(qp[4 * i + 2]) * bfhi(kv.z);
            sc += bflo(qp[4 * i + 3]) * bflo(kv.w) + bfhi(qp[4 * i + 3]) * bfhi(kv.w);
            if ((i & 3) == 3) asm volatile("" ::: "memory");
        }
        float w, corr = 1.f;
        if (MODE == 2) {
            w = (s <= q) ? sc * exp2f((float)(q - s) * lg) : 0.f;
        } else {
            if (MODE == 1) sc += Fq - Fk[s];
            const bool valid = (MODE == 0) || (s <= q);
            if (valid) {
                const float mn = fmaxf(mx, sc);
                corr = exp2f(mx - mn); w = exp2f(sc - mn); mx = mn;
                lsum = lsum * corr + w;
            } else { w = 0.f; }
        }
        if (MODE == 2) {
            const uint4* vr = (const uint4*)(p.cv + ((size_t)b * S + s) * 1024 + hh * 256 + sl * SW);
#pragma unroll
            for (int i = 0; i < SW / 8; ++i) {
                const uint4 vv = vr[i];
                acc[8 * i] += w * bflo(vv.x); acc[8 * i + 1] += w * bfhi(vv.x); acc[8 * i + 2] += w * bflo(vv.y); acc[8 * i + 3] += w * bfhi(vv.y);
                acc[8 * i + 4] += w * bflo(vv.z); acc[8 * i + 5] += w * bfhi(vv.z); acc[8 * i + 6] += w * bflo(vv.w); acc[8 * i + 7] += w * bfhi(vv.w);
            }
        } else {
            const bf16_t* vt = (MODE == 0 ? p.vta + ((size_t)(b * 4 + (hh >> 1)) * 128 + sl * SW) * S : p.vtb + ((size_t)(b * 4 + hh) * 128 + sl * SW) * S) + s;
#pragma unroll
            for (int i = 0; i < SW; ++i) { acc[i] = acc[i] * corr + w * bf2f(*vt); vt += S; asm volatile("" : "+v"(vt)); }
        }
    }
    if (MODE == 2) {
        float* o = p.oc + tq * 1024 + hh * 256 + sl * SW;
#pragma unroll
        for (int i = 0; i < SW / 4; ++i) *(f32x4*)(o + 4 * i) = (f32x4){acc[4 * i], acc[4 * i + 1], acc[4 * i + 2], acc[4 * i + 3]};
    } else {
        const float inv = 1.f / lsum;
        bf16_t* o = (MODE == 0 ? p.oa + tq * 1024 + hh * 128 : p.yb + tq * 512 + hh * 128) + sl * SW;
#pragma unroll
        for (int i = 0; i < SW / 8; ++i) {
            uint4 w4; w4.x = pack2(acc[8 * i] * inv, acc[8 * i + 1] * inv); w4.y = pack2(acc[8 * i + 2] * inv, acc[8 * i + 3] * inv);
            w4.z = pack2(acc[8 * i + 4] * inv, acc[8 * i + 5] * inv); w4.w = pack2(acc[8 * i + 6] * inv, acc[8 * i + 7] * inv);
            ((uint4*)o)[i] = w4;
        }
    }
}


typedef float f32x16 __attribute__((ext_vector_type(16)));
DI bf16x8 pack8(float a0, float a1, float a2, float a3, float a4, float a5, float a6, float a7) {
    typedef unsigned u32x4 __attribute__((ext_vector_type(4)));
    u32x4 w; w[0] = pack2(a0, a1); w[1] = pack2(a2, a3); w[2] = pack2(a4, a5); w[3] = pack2(a6, a7);
    return __builtin_bit_cast(bf16x8, w);
}

template <int MODE>
DI void flash_item(const Params& p, int b, int hh, int qi, unsigned char* smem) {
    constexpr int D = MODE == 0 ? 64 : 128, KST = D + 8, VST = 68, KS = D / 16;
    constexpr int KBYTES = 64 * KST * 2, VBYTES = 128 * VST * 2, BUFB = KBYTES + VBYTES + 256;
    constexpr int NKC = D / 32, CPR = D / 8;
    const int tid = otid(), lane = tid & 63, w = tid >> 6, r = lane & 31, hf = lane >> 5;
    const int q0 = qi * 128 + w * 32;
    const size_t tq = (size_t)b * S + q0 + r;
    bf16x8 qf[KS];
    {
        const bf16_t* qptr = (MODE == 0 ? p.qa + tq * 512 + hh * 64 : p.qb + tq * 512 + hh * 128) + hf * 8;
#pragma unroll
        for (int ks = 0; ks < KS; ++ks) qf[ks] = *(const bf16x8*)(qptr + ks * 16);
    }
    const float* fbase = p.F + (size_t)(b * 4 + (MODE == 1 ? hh : 0)) * S;
    float Fq = 0.f; if (MODE == 1) Fq = fbase[q0 + r];
    const bf16_t* kbase = MODE == 0 ? p.ka + (size_t)b * S * 512 + hh * 64 : p.kb + (size_t)b * S * 512 + hh * 128;
    const bf16_t* vbase = MODE == 0 ? p.vta + (size_t)(b * 4 + (hh >> 1)) * 128 * S : p.vtb + (size_t)(b * 4 + hh) * 128 * S;
    const int ntiles = 2 * qi + 2, wlast = 2 * qi + (w >> 1);
    uint4 kr[NKC], vr[4]; f32x4 frg = {0.f, 0.f, 0.f, 0.f};
#define FL_GLOAD(j) do { \
        _Pragma("unroll") for (int i_ = 0; i_ < NKC; ++i_) { const int c_ = tid + 256 * i_; kr[i_] = *(const uint4*)(kbase + (size_t)(64 * (j) + c_ / CPR) * 512 + (c_ % CPR) * 8); } \
        _Pragma("unroll") for (int i_ = 0; i_ < 4; ++i_) { const int c_ = tid + 256 * i_; vr[i_] = *(const uint4*)(vbase + (size_t)(c_ >> 3) * S + 64 * (j) + (c_ & 7) * 8); } \
        if (MODE == 1 && tid < 16) frg = *(const f32x4*)(fbase + 64 * (j) + tid * 4); } while (0)
#define FL_SSTORE(buf) do { unsigned char* B_ = smem + (buf) * BUFB; \
        _Pragma("unroll") for (int i_ = 0; i_ < NKC; ++i_) { const int c_ = tid + 256 * i_; *(uint4*)(B_ + ((c_ / CPR) * KST + (c_ % CPR) * 8) * 2) = kr[i_]; } \
        _Pragma("unroll") for (int i_ = 0; i_ < 4; ++i_) { const int c_ = tid + 256 * i_; uint2* d_ = (uint2*)(B_ + KBYTES + ((c_ >> 3) * VST + (c_ & 7) * 8) * 2); d_[0] = make_uint2(vr[i_].x, vr[i_].y); d_[1] = make_uint2(vr[i_].z, vr[i_].w); } \
        if (MODE == 1 && tid < 16) *(f32x4*)(B_ + KBYTES + VBYTES + tid * 16) = frg; } while (0)
    FL_GLOAD(0);
    FL_SSTORE(0);
    __syncthreads();
    f32x16 acc[4];
#pragma unroll
    for (int eb = 0; eb < 4; ++eb)
#pragma unroll
        for (int i = 0; i < 16; ++i) acc[eb][i] = 0.f;
    float mrun = -INFINITY, lsum = 0.f;
    for (int j = 0; j < ntiles; ++j) {
        const bool more = j + 1 < ntiles;
        if (more) FL_GLOAD(j + 1);
        if (j <= wlast) {
            const unsigned char* B = smem + (j & 1) * BUFB;
            f32x16 st[2];
#pragma unroll
            for (int kb = 0; kb < 2; ++kb) {
#pragma unroll
                for (int i = 0; i < 16; ++i) st[kb][i] = 0.f;
#pragma unroll
                for (int ks = 0; ks < KS; ++ks) {
                    const bf16x8 a = *(const bf16x8*)(B + ((kb * 32 + r) * KST + ks * 16 + hf * 8) * 2);
                    st[kb] = __builtin_amdgcn_mfma_f32_32x32x16_bf16(a, qf[ks], st[kb], 0, 0, 0);
                }
            }
            if (MODE == 1) {
                const float* Fl = (const float*)(B + KBYTES + VBYTES);
#pragma unroll
                for (int kb = 0; kb < 2; ++kb)
#pragma unroll
                    for (int g = 0; g < 4; ++g) {
                        const f32x4 fk = *(const f32x4*)(Fl + kb * 32 + 8 * g + 4 * hf);
#pragma unroll
                        for (int jj = 0; jj < 4; ++jj) st[kb][4 * g + jj] += Fq - fk[jj];
                    }
                if (j >= 2 * qi) {
                    const int qabs = q0 + r;
#pragma unroll
                    for (int kb = 0; kb < 2; ++kb)
#pragma unroll
                        for (int g = 0; g < 4; ++g)
#pragma unroll
                            for (int jj = 0; jj < 4; ++jj) { const int key = 64 * j + kb * 32 + 8 * g + 4 * hf + jj; if (key > qabs) st[kb][4 * g + jj] = -INFINITY; }
                }
            }
            float mt = st[0][0];
#pragma unroll
            for (int i = 1; i < 16; ++i) mt = fmaxf(mt, st[0][i]);
#pragma unroll
            for (int i = 0; i < 16; ++i) mt = fmaxf(mt, st[1][i]);
            mt = fmaxf(mt, __shfl_xor(mt, 32));
            const float mn = fmaxf(mrun, mt);
            const float corr = ex2(mrun - mn);
            mrun = mn; lsum *= corr;
#pragma unroll
            for (int kb = 0; kb < 2; ++kb)
#pragma unroll
                for (int i = 0; i < 16; ++i) { const float pv = ex2(st[kb][i] - mn); st[kb][i] = pv; lsum += pv; }
#pragma unroll
            for (int eb = 0; eb < 4; ++eb) acc[eb] *= corr;
#pragma unroll
            for (int kb = 0; kb < 2; ++kb)
#pragma unroll
                for (int s2 = 0; s2 < 2; ++s2) {
                    const bf16x8 pf = pack8(st[kb][8 * s2], st[kb][8 * s2 + 1], st[kb][8 * s2 + 2], st[kb][8 * s2 + 3], st[kb][8 * s2 + 4], st[kb][8 * s2 + 5], st[kb][8 * s2 + 6], st[kb][8 * s2 + 7]);
#pragma unroll
                    for (int eb = 0; eb < 4; ++eb) {
                        const unsigned char* vp = B + KBYTES + ((eb * 32 + r) * VST + kb * 32 + 16 * s2 + 4 * hf) * 2;
                        const uint2 lo = *(const uint2*)vp, hi = *(const uint2*)(vp + 16);
                        typedef unsigned u32x4 __attribute__((ext_vector_type(4)));
                        u32x4 av; av[0] = lo.x; av[1] = lo.y; av[2] = hi.x; av[3] = hi.y;
                        acc[eb] = __builtin_amdgcn_mfma_f32_32x32x16_bf16(__builtin_bit_cast(bf16x8, av), pf, acc[eb], 0, 0, 0);
                    }
                }
        }
        if (more) FL_SSTORE((j + 1) & 1);
        __syncthreads();
    }
#undef FL_GLOAD
#undef FL_SSTORE
    const float inv = 1.f / (lsum + __shfl_xor(lsum, 32));
    bf16_t* o = MODE == 0 ? p.oa + tq * 1024 + hh * 128 : p.yb + tq * 512 + hh * 128;
#pragma unroll
    for (int eb = 0; eb < 4; ++eb)
#pragma unroll
        for (int g = 0; g < 4; ++g) {
            f32x4 v = {acc[eb][4 * g] * inv, acc[eb][4 * g + 1] * inv, acc[eb][4 * g + 2] * inv, acc[eb][4 * g + 3] * inv};
            st4(o + eb * 32 + 8 * g + 4 * hf, v);
        }
}


DI void ret_state_item(const Params& p, int item) {
    const int n = item & 127, bh = item >> 7;
    const int tid = otid(), lane = tid & 63, w = tid >> 6, r = lane & 31, hf = lane >> 5;
    const bf16_t* kt = p.ckT + (size_t)bh * 128 * S + n * 64 + hf * 8;
    const bf16_t* vt = p.cv + ((size_t)bh * 256 + w * 64) * S + n * 64 + hf * 8;
    f32x16 acc[4][2];
#pragma unroll
    for (int a = 0; a < 4; ++a)
#pragma unroll
        for (int c = 0; c < 2; ++c)
#pragma unroll
            for (int i = 0; i < 16; ++i) acc[a][c][i] = 0.f;
#pragma unroll
    for (int s4 = 0; s4 < 4; ++s4) {
        bf16x8 af[4], bfr[2];
#pragma unroll
        for (int a = 0; a < 4; ++a) af[a] = *(const bf16x8*)(kt + (size_t)(a * 32 + r) * S + s4 * 16);
#pragma unroll
        for (int c = 0; c < 2; ++c) bfr[c] = *(const bf16x8*)(vt + (size_t)(c * 32 + r) * S + s4 * 16);
#pragma unroll
        for (int a = 0; a < 4; ++a)
#pragma unroll
            for (int c = 0; c < 2; ++c) acc[a][c] = __builtin_amdgcn_mfma_f32_32x32x16_bf16(af[a], bfr[c], acc[a][c], 0, 0, 0);
    }
    bf16_t* o = p.kv + ((size_t)(bh * 128 + n) * 256 + w * 64) * 128;
#pragma unroll
    for (int a = 0; a < 4; ++a)
#pragma unroll
        for (int c = 0; c < 2; ++c)
#pragma unroll
            for (int g = 0; g < 4; ++g) {
                f32x4 v = {acc[a][c][4 * g], acc[a][c][4 * g + 1], acc[a][c][4 * g + 2], acc[a][c][4 * g + 3]};
                st4_wt(o + (size_t)(c * 32 + r) * 128 + a * 32 + 8 * g + 4 * hf, v);
            }
}

DI void ret_scan(const Params& p) {
    const int gtid = obid() * 256 + otid(), gsz = gridDim.x * 256;
    for (int e = gtid; e < 8 * 8192; e += gsz) {
        const int bh = e >> 13, pi = e & 8191, hd = bh & 3;
        const float dec = ex2(64.0f * lg2gamma(hd));
        unsigned long long* ptr = (unsigned long long*)p.kv + (size_t)bh * 128 * 8192 + pi;
        float c0 = 0.f, c1 = 0.f, c2 = 0.f, c3 = 0.f;
        for (int n0 = 0; n0 < 128; n0 += 8) {
            unsigned long long v[8];
#pragma unroll
            for (int k = 0; k < 8; ++k) v[k] = ptr[(size_t)(n0 + k) * 8192];
            asm volatile("s_waitcnt vmcnt(0)" ::: "memory");
#pragma unroll
            for (int k = 0; k < 8; ++k) {
                const unsigned long long o = (unsigned long long)pack2(c0, c1) | ((unsigned long long)pack2(c2, c3) << 32);
                __hip_atomic_store(ptr + (size_t)(n0 + k) * 8192, o, __ATOMIC_RELAXED, __HIP_MEMORY_SCOPE_AGENT);
                const unsigned lo = (unsigned)v[k], hi = (unsigned)(v[k] >> 32);
                c0 = c0 * dec + bflo(lo); c1 = c1 * dec + bfhi(lo); c2 = c2 * dec + bflo(hi); c3 = c3 * dec + bfhi(hi);
            }
        }
    }
}

DI void ret_out_item(const Params& p, int l, int item, unsigned char* smem) {
    const int n = item & 127, bh = item >> 7, b = bh >> 2, hd = bh & 3;
    const int tid = otid(), lane = tid & 63, w = tid >> 6, r = lane & 31, hf = lane >> 5;
    const size_t t0 = (size_t)b * S + n * 64;
    f32x16 acc[2][2];
#pragma unroll
    for (int a = 0; a < 2; ++a)
#pragma unroll
        for (int c = 0; c < 2; ++c)
#pragma unroll
            for (int i = 0; i < 16; ++i) acc[a][c][i] = 0.f;
    bf16x8 pf[2][2][2];
    {
        bf16x8 qf[2][8];
#pragma unroll
        for (int qb = 0; qb < 2; ++qb)
#pragma unroll
            for (int ks = 0; ks < 8; ++ks) qf[qb][ks] = *(const bf16x8*)(p.cq + (t0 + qb * 32 + r) * 512 + hd * 128 + ks * 16 + hf * 8);
        const bf16_t* rt = p.kv + ((size_t)(bh * 128 + n) * 256 + w * 64) * 128 + hf * 8;
#pragma unroll
        for (int dvb = 0; dvb < 2; ++dvb)
#pragma unroll
            for (int ks = 0; ks < 8; ++ks) {
                const bf16x8 a = *(const bf16x8*)(rt + (size_t)(dvb * 32 + r) * 128 + ks * 16);
#pragma unroll
                for (int qb = 0; qb < 2; ++qb) acc[dvb][qb] = __builtin_amdgcn_mfma_f32_32x32x16_bf16(a, qf[qb][ks], acc[dvb][qb], 0, 0, 0);
            }
#pragma unroll
        for (int kb = 0; kb < 2; ++kb) {
            f32x16 st[2];
#pragma unroll
            for (int qb = 0; qb < 2; ++qb)
#pragma unroll
                for (int i = 0; i < 16; ++i) st[qb][i] = 0.f;
#pragma unroll
            for (int ks = 0; ks < 8; ++ks) {
                const bf16x8 a = *(const bf16x8*)(p.ck + (t0 + kb * 32 + r) * 512 + hd * 128 + ks * 16 + hf * 8);
#pragma unroll
                for (int qb = 0; qb < 2; ++qb) st[qb] = __builtin_amdgcn_mfma_f32_32x32x16_bf16(a, qf[qb][ks], st[qb], 0, 0, 0);
            }
#pragma unroll
            for (int qb = 0; qb < 2; ++qb) {
#pragma unroll
                for (int i = 0; i < 16; ++i) { const int key = kb * 32 + (i & 3) + 8 * (i >> 2) + 4 * hf; if (key > qb * 32 + r) st[qb][i] = 0.f; }
#pragma unroll
                for (int s2 = 0; s2 < 2; ++s2)
                    pf[kb][s2][qb] = pack8(st[qb][8 * s2], st[qb][8 * s2 + 1], st[qb][8 * s2 + 2], st[qb][8 * s2 + 3], st[qb][8 * s2 + 4], st[qb][8 * s2 + 5], st[qb][8 * s2 + 6], st[qb][8 * s2 + 7]);
            }
        }
    }
    {
        const bf16_t* vt = p.cv + ((size_t)bh * 256 + w * 64) * S + n * 64 + 4 * hf;
#pragma unroll
        for (int dvb = 0; dvb < 2; ++dvb)
#pragma unroll
            for (int kb = 0; kb < 2; ++kb)
#pragma unroll
                for (int s2 = 0; s2 < 2; ++s2) {
                    const bf16_t* vp = vt + (size_t)(dvb * 32 + r) * S + kb * 32 + 16 * s2;
                    const uint2 lo = *(const uint2*)vp, hi = *(const uint2*)(vp + 8);
                    typedef unsigned u32x4 __attribute__((ext_vector_type(4)));
                    u32x4 av; av[0] = lo.x; av[1] = lo.y; av[2] = hi.x; av[3] = hi.y;
                    const bf16x8 a = __builtin_bit_cast(bf16x8, av);
#pragma unroll
                    for (int qb = 0; qb < 2; ++qb) acc[dvb][qb] = __builtin_amdgcn_mfma_f32_32x32x16_bf16(a, pf[kb][s2][qb], acc[dvb][qb], 0, 0, 0);
                }
    }
    float* red = (float*)smem;
    float mu[2], rstd[2];
    __syncthreads();
#pragma unroll
    for (int qb = 0; qb < 2; ++qb) {
        float s1 = 0.f, s2 = 0.f;
#pragma unroll
        for (int dvb = 0; dvb < 2; ++dvb)
#pragma unroll
            for (int i = 0; i < 16; ++i) { const float x = acc[dvb][qb][i]; s1 += x; s2 += x * x; }
        s1 += __shfl_xor(s1, 32); s2 += __shfl_xor(s2, 32);
        if (hf == 0) { red[(w * 64 + qb * 32 + r) * 2] = s1; red[(w * 64 + qb * 32 + r) * 2 + 1] = s2; }
    }
    __syncthreads();
#pragma unroll
    for (int qb = 0; qb < 2; ++qb) {
        float s1 = 0.f, s2 = 0.f;
#pragma unroll
        for (int ww = 0; ww < 4; ++ww) { s1 += red[(ww * 64 + qb * 32 + r) * 2]; s2 += red[(ww * 64 + qb * 32 + r) * 2 + 1]; }
        const float m_ = s1 * (1.f / 256.f);
        mu[qb] = m_; rstd[qb] = rsqrtf(fmaxf(s2 * (1.f / 256.f) - m_ * m_, 0.f) + LN_EPS);
    }
    const float* gr = p.g_ret + (size_t)l * 1024 + hd * 256 + w * 64;
#pragma unroll
    for (int dvb = 0; dvb < 2; ++dvb)
#pragma unroll
        for (int g = 0; g < 4; ++g) {
            const int dv = dvb * 32 + 8 * g + 4 * hf;
            const f32x4 gg = *(const f32x4*)(gr + dv);
#pragma unroll
            for (int qb = 0; qb < 2; ++qb) {
                const size_t off = (t0 + qb * 32 + r) * 1024 + hd * 256 + w * 64 + dv;
                const uint2 cgv = *(const uint2*)(p.cg + off);
                f32x4 y;
#pragma unroll
                for (int jj = 0; jj < 4; ++jj) y[jj] = (acc[dvb][qb][4 * g + jj] - mu[qb]) * rstd[qb] * gg[jj];
                y[0] *= bflo(cgv.x); y[1] *= bfhi(cgv.x); y[2] *= bflo(cgv.y); y[3] *= bfhi(cgv.y);
                st4(p.yc + off, y);
            }
        }
}

DI void phase_mixers(const Params& p, int l, unsigned char* smem) {
    const int nF = 64 * 24, nC = 2 * 4 * 128;
    int* sitem = (int*)(smem + SMEM_BYTES - 16);
    for (;;) {
        __syncthreads();
        if (otid() == 0) *sitem = (int)atomicAdd(p.ctr + l, 1u);
        __syncthreads();
        const int it = *sitem;
        if (it >= nF + nC) break;
        if (it < nF) {
            const int qi = 63 - it / 24, r = it % 24;
            if (r < 8) flash_item<1>(p, r >> 2, r & 3, qi, smem);
            else flash_item<0>(p, (r - 8) >> 3, (r - 8) & 7, qi, smem);
        } else ret_state_item(p, it - nF);
    }
}

DI void phase_mixers_naive(const Params& p) {
    const int nA = 2 * 8 * 128, nB = 2 * 4 * 128, nC = 2 * 4 * 128;
    for (int it = obid(); it < nA + nB + nC; it += gridDim.x) {
        if (it < nB) naive_attn<1>(p, it);
        else if (it < nB + nC) naive_attn<2>(p, it - nB);
        else naive_attn<0>(p, it - nB - nC);
    }
}

DI void phase_post(const Params& p, int l) {
    const int lane = otid() & 63, wv = otid() >> 6;
    const float lam = p.lamv[2 * l], li = p.lamv[2 * l + 1];
    const float* gd = p.g_diff + (size_t)l * 512; const float* gr = p.g_ret + (size_t)l * 1024;
    for (int row = obid() * 4 + wv; row < T; row += gridDim.x * 4) {
#pragma unroll
        for (int hh = 0; hh < 4; ++hh) {
            const unsigned o0 = *(const unsigned*)(p.oa + (size_t)row * 1024 + (2 * hh) * 128 + lane * 2);
            const unsigned o1 = *(const unsigned*)(p.oa + (size_t)row * 1024 + (2 * hh + 1) * 128 + lane * 2);
            const float d0 = bflo(o0) - lam * bflo(o1), d1 = bfhi(o0) - lam * bfhi(o1);
            float ss = d0 * d0 + d1 * d1;
            for (int o = 32; o; o >>= 1) ss += __shfl_xor(ss, o);
            const float r = rsqrtf(ss * (1.f / 128.f) + LN_EPS) * (1.f - li);
            const int c = hh * 128 + lane * 2;
            *(unsigned*)(p.ya + (size_t)row * 512 + c) = pack2(d0 * r * gd[c], d1 * r * gd[c + 1]);
        }
    }
}

#define GSYNC() do { asm volatile("s_waitcnt vmcnt(0) lgkmcnt(0)" ::: "memory"); grid.sync(); } while (0)
__global__ void __launch_bounds__(256, 2) fwd_kernel(Params p) {
    __shared__ __attribute__((aligned(16))) unsigned char smem[SMEM_BYTES];
    cg::grid_group grid = cg::this_grid();
    bf16_t* sm = (bf16_t*)smem; float* smf = (float*)smem;

    GSYNC();
    convert_layer(p, 0, smf);
    phase0_misc(p, smf);
    GSYNC();
    row_phase(p, p.x, false, nullptr, nullptr, nullptr, p.mod, 0, 1024, true, true);
    GSYNC();
    for (int l = 0; l < DEPTH; ++l) {
        const float* modl = p.mod + (size_t)l * 2 * 6144;
        const float* xcur = l == 0 ? p.x : p.xbuf;
        if (obid() >= gridDim.x - 8) scan_item(p, obid() - (gridDim.x - 8), smf);
        phase_inproj(p, sm);
        GSYNC();
        phase_mixers(p, l, smem);
        GSYNC();
        phase_post(p, l);
        ret_scan(p);
        GSYNC();
        for (int it = obid(); it < 1024; it += gridDim.x) ret_out_item(p, l, it, smem);
        GSYNC();
        phase_branch(p, sm);
        GSYNC();
        phase_gemm_res(p, p.h, 1024, p.WoutT, xcur, modl, 2048, sm);
        GSYNC();
        row_phase(p, p.vbuf, true, p.ln_g + (size_t)(l * 2) * Dm, p.ln_b + (size_t)(l * 2) * Dm, p.xbuf, modl, 3072, 4096, true, false);
        GSYNC();
        phase_up(p, sm);
        GSYNC();
        phase_conv(p, l);
        GSYNC();
        phase_gemm_res(p, p.act, DFF, p.WdownT, p.xbuf, modl, 5120, sm);
        GSYNC();
        if (l + 1 < DEPTH) {
            convert_layer(p, l + 1, smf);
            GSYNC();
            row_phase(p, p.vbuf, true, p.ln_g + (size_t)(l * 2 + 1) * Dm, p.ln_b + (size_t)(l * 2 + 1) * Dm, p.xbuf, modl + 2 * 6144, 0, 1024, true, true);
            GSYNC();
        } else {
            row_phase(p, p.vbuf, true, p.ln_g + (size_t)(l * 2 + 1) * Dm, p.ln_b + (size_t)(l * 2 + 1) * Dm, p.out, modl, 0, 1024, false, false);
        }
    }
}

extern "C" void kernel_launch(void* const* d_in, const int* in_sizes, int n_in, void* d_out, int out_size, void* d_ws, size_t ws_size, hipStream_t stream) {
    static int grid_blocks = 0;
    if (!grid_blocks) {
        int dev = 0, cus = 0, per_cu = 0;
        hipGetDevice(&dev);
        hipDeviceGetAttribute(&cus, hipDeviceAttributeMultiprocessorCount, dev);
        hipOccupancyMaxActiveBlocksPerMultiprocessor(&per_cu, fwd_kernel, 256, 0);
        if (per_cu > 2) per_cu = 2;
        if (per_cu < 1) per_cu = 1;
        grid_blocks = cus * per_cu;
    }
    Params p{};
    const float** ins = (const float**)&p.x;
    for (int i = 0; i < 22; ++i) ins[i] = (const float*)d_in[i];
    p.out = (float*)d_out;
    char* w = (char*)d_ws; size_t off = 0;
    auto take = [&](size_t bytes) { char* r = w + off; off += (bytes + 255) & ~(size_t)255; return r; };
    const size_t MB = 1u << 20;
    p.mod = (float*)take((size_t)DEPTH * 2 * 6144 * 4);
    p.lamv = (float*)take(256);
    p.ctr = (unsigned*)take(256);
    p.wf = (float*)take(4100 * 4);
    p.binp = (float*)take(NIN * 4);
    p.cstab = (float*)take((size_t)S * 64 * 2 * 4);
    p.logf = (float*)take((size_t)T * 4 * 4);
    p.F = (float*)take((size_t)T * 4 * 4);
    p.WinT = (bf16_t*)take((size_t)NIN * 1024 * 2);
    p.WpaT = (bf16_t*)take((size_t)1024 * 512 * 2);
    p.WpbT = (bf16_t*)take((size_t)1024 * 512 * 2);
    p.WpcT = (bf16_t*)take((size_t)1024 * 1024 * 2);
    p.WoutT = (bf16_t*)take((size_t)1024 * 1024 * 2);
    p.WupT = (bf16_t*)take((size_t)2 * DFF * 1024 * 2);
    p.WdownT = (bf16_t*)take((size_t)1024 * DFF * 2);
    p.xbuf = (float*)take((size_t)T * Dm * 4);
    p.h = (bf16_t*)take((size_t)T * Dm * 2);
    const size_t offA = off;
    p.qa = (bf16_t*)take((size_t)T * 512 * 2); p.ka = (bf16_t*)take((size_t)T * 512 * 2); p.vta = (bf16_t*)take((size_t)T * 512 * 2);
    p.qb = (bf16_t*)take((size_t)T * 512 * 2); p.kb = (bf16_t*)take((size_t)T * 512 * 2); p.vtb = (bf16_t*)take((size_t)T * 512 * 2);
    p.cq = (bf16_t*)take((size_t)T * 512 * 2); p.ck = (bf16_t*)take((size_t)T * 512 * 2);
    p.cv = (bf16_t*)take((size_t)T * 1024 * 2); p.cg = (bf16_t*)take((size_t)T * 1024 * 2);
    p.gates = (bf16_t*)take((size_t)T * 3072 * 2);
    const size_t endA = off;
    p.ug = (bf16_t*)(w + offA);
    p.act = (bf16_t*)(w + offA + (size_t)T * 2 * DFF * 2);
    const size_t offB = endA;
    off = offB;
    p.vbuf = (float*)(w + offB);
    p.oa = p.h;
    p.yb = (bf16_t*)take((size_t)T * 512 * 2);
    p.kv = (bf16_t*)take((size_t)8 * 128 * 256 * 128 * 2);
    p.ckT = (bf16_t*)take((size_t)T * 512 * 2);
    p.ya = (bf16_t*)take((size_t)T * 512 * 2);
    p.yc = (bf16_t*)take((size_t)T * 1024 * 2);
    if (off > ws_size || (size_t)T * 2 * DFF * 2 + (size_t)T * DFF * 2 > endA - offA) {
        fprintf(stderr, "kernel_launch: workspace too small: need %zu MB have %zu MB\n", off / MB, ws_size / MB);
        return;
    }
    void* args[] = {&p};
    hipError_t e = hipLaunchCooperativeKernel((void*)fwd_kernel, dim3(grid_blocks), dim3(256), args, 0, stream);
    if (e != hipSuccess) fprintf(stderr, "cooperative launch failed: %s (grid %d)\n", hipGetErrorString(e), grid_blocks);
}
```

```cpp
#include <hip/hip_runtime.h>
#include <hip/hip_cooperative_groups.h>
#include <cstdio>
#include <cstdint>
namespace cg = cooperative_groups;

typedef unsigned short bf16_t;
typedef short bf16x8 __attribute__((ext_vector_type(8)));
typedef float f32x4 __attribute__((ext_vector_type(4)));

constexpr int Dm = 1024, NB = 2, S = 8192, T = NB * S, DEPTH = 4, DFF = 2816, DIN = 9220, NIN = 9216;
constexpr float LN_EPS = 1e-5f;
constexpr float LOG2E = 1.4426950408889634f;
#define ALPHA_F 1.681792830507429f

#define DI __device__ __forceinline__
DI int otid() { int t = threadIdx.x; asm volatile("" : "+v"(t)); return t; }
DI int obid() { int b = blockIdx.x; asm volatile("" : "+s"(b)); return b; }

DI bf16_t f2bf(float x) { unsigned u = __float_as_uint(x); u += 0x7fffu + ((u >> 16) & 1u); return (bf16_t)(u >> 16); }
DI float bf2f(bf16_t v) { return __uint_as_float(((unsigned)v) << 16); }
DI float bflo(unsigned w) { return __uint_as_float(w << 16); }
DI float bfhi(unsigned w) { return __uint_as_float(w & 0xffff0000u); }
DI unsigned pack2(float a, float b) { return (unsigned)f2bf(a) | ((unsigned)f2bf(b) << 16); }

struct Params {
    const float *x, *c, *w_ada, *b_ada, *w_in, *b_in, *lq1, *lk1, *lq2, *lk2, *g_diff, *g_ret, *w_pa, *w_pb, *w_pc, *w_out, *ln_g, *ln_b, *w_up, *w_conv, *b_conv, *w_down;
    float* out;
    unsigned* ctr; unsigned* bar;
    float *mod, *lamv, *wf, *binp, *cstab, *xbuf, *vbuf, *logf, *F, *oc;
    bf16_t *WinT, *WpaT, *WpbT, *WpcT, *WoutT, *WupT, *WdownT;
    bf16_t *h, *qa, *ka, *vta, *qb, *kb, *vtb, *cq, *ck, *cv, *cg, *gates, *oa, *yb, *ya, *yc, *ug, *act, *ckT, *kv;
};

constexpr int BM = 128, BN = 128, BK = 64, LDP = BK + 8;
constexpr int SMEM_BYTES = 2 * (BM + BN) * LDP * 2;

DI int win_map(int n) {
    if (n < 3072) return n;
    if (n < 4096) { int r = n - 3072; int seg = r >> 9; r &= 511; int head = r >> 7; int c = r & 127; return 3076 + seg * 512 + head * 128 + (c >> 1) + 64 * (c & 1); }
    return n + 4;
}

DI void convert_tile(const float* __restrict__ src, int ldsrc, bf16_t* __restrict__ dst, int K, int tiles_n, int tile, int kind, float* lds) {
    const int tn = tile % tiles_n, tk = tile / tiles_n;
    const int tx = otid() & 63, ty = otid() >> 6;
    const int n = tn * 64 + tx;
    const int sn = kind == 1 ? win_map(n) : n;
    __syncthreads();
#pragma unroll 4
    for (int r = 0; r < 16; ++r) {
        const int kk = ty * 16 + r;
        lds[kk * 65 + tx] = src[(size_t)(tk * 64 + kk) * ldsrc + sn];
    }
    __syncthreads();
#pragma unroll 4
    for (int r = 0; r < 16; ++r) {
        const int nn = ty * 16 + r;
        dst[(size_t)(tn * 64 + nn) * K + tk * 64 + tx] = f2bf(lds[tx * 65 + nn]);
    }
}

DI void convert_layer(const Params& p, int l, float* lds) {
    const int n_in = 16 * 144, n_pa = 8 * 16, n_pb = 8 * 16, n_pc = 16 * 16, n_out = 16 * 16, n_up = 16 * 88, n_dn = 44 * 16;
    const int total = n_in + n_pa + n_pb + n_pc + n_out + n_up + n_dn;
    for (int it = obid(); it < total; it += gridDim.x) {
        int t = it;
        if (t < n_in) { convert_tile(p.w_in + (size_t)l * Dm * DIN, DIN, p.WinT, 1024, 144, t, 1, lds); continue; } t -= n_in;
        if (t < n_pa) { convert_tile(p.w_pa + (size_t)l * 512 * Dm, Dm, p.WpaT, 512, 16, t, 0, lds); continue; } t -= n_pa;
        if (t < n_pb) { convert_tile(p.w_pb + (size_t)l * 512 * Dm, Dm, p.WpbT, 512, 16, t, 0, lds); continue; } t -= n_pb;
        if (t < n_pc) { convert_tile(p.w_pc + (size_t)l * 1024 * Dm, Dm, p.WpcT, 1024, 16, t, 0, lds); continue; } t -= n_pc;
        if (t < n_out) { convert_tile(p.w_out + (size_t)l * Dm * Dm, Dm, p.WoutT, 1024, 16, t, 0, lds); continue; } t -= n_out;
        if (t < n_up) { convert_tile(p.w_up + (size_t)l * Dm * 2 * DFF, 2 * DFF, p.WupT, 1024, 88, t, 0, lds); continue; } t -= n_up;
        convert_tile(p.w_down + (size_t)l * DFF * Dm, Dm, p.WdownT, DFF, 16, t, 0, lds);
    }
    const int gtid = obid() * blockDim.x + otid(), gsz = gridDim.x * blockDim.x;
    for (int i = gtid; i < NIN; i += gsz) p.binp[i] = p.b_in[(size_t)l * DIN + win_map(i)];
    for (int i = gtid; i < 4096; i += gsz) { const int k = i >> 2, hh = i & 3; p.wf[i] = p.w_in[(size_t)l * Dm * DIN + (size_t)k * DIN + 3072 + hh]; }
    for (int i = gtid; i < 4; i += gsz) p.wf[4096 + i] = p.b_in[(size_t)l * DIN + 3072 + i];
}

DI float ex2(float x) { return __builtin_amdgcn_exp2f(x); }
DI float lg2gamma(int hd) { return hd == 0 ? -0.04580368961312479f : hd == 1 ? -0.02272007650008353f : hd == 2 ? -0.011315313227834146f : -0.005646563141142063f; }
DI float silu_f(float v) { return v / (1.f + __expf(-v)); }
DI float sigmoid_f(float v) { return 1.f / (1.f + __expf(-v)); }

DI void phase0_misc(const Params& p, float* lds) {
    for (int it = obid(); it < DEPTH * 96; it += gridDim.x) {
        const int l = it / 96, jb = it % 96;
        const int tx = otid() & 63, ks = otid() >> 6;
        const int j = jb * 64 + tx;
        const float* w = p.w_ada + (size_t)l * Dm * 6144 + j;
        float a0 = 0.f, a1 = 0.f;
#pragma unroll 8
        for (int k = ks * 256; k < ks * 256 + 256; ++k) {
            const float wv = w[(size_t)k * 6144];
            a0 += silu_f(p.c[k]) * wv; a1 += silu_f(p.c[Dm + k]) * wv;
        }
        __syncthreads();
        lds[(ks * 64 + tx) * 2] = a0; lds[(ks * 64 + tx) * 2 + 1] = a1;
        __syncthreads();
        if (ks == 0) {
            float s0 = 0.f, s1 = 0.f;
            for (int q = 0; q < 4; ++q) { s0 += lds[(q * 64 + tx) * 2]; s1 += lds[(q * 64 + tx) * 2 + 1]; }
            const float bb = p.b_ada[(size_t)l * 6144 + j];
            p.mod[((size_t)l * 2 + 0) * 6144 + j] = s0 + bb;
            p.mod[((size_t)l * 2 + 1) * 6144 + j] = s1 + bb;
        }
    }
    const int gtid = obid() * blockDim.x + otid(), gsz = gridDim.x * blockDim.x;
    if (gtid < 64) p.ctr[gtid] = 0u;
    if (obid() == 0 && otid() < 64 * DEPTH) {
        const int l = otid() >> 6, ln = otid() & 63;
        float a = p.lq1[l * 64 + ln] * p.lk1[l * 64 + ln], b = p.lq2[l * 64 + ln] * p.lk2[l * 64 + ln];
        for (int o = 32; o; o >>= 1) { a += __shfl_xor(a, o); b += __shfl_xor(b, o); }
        if (ln == 0) { const float li = 0.8f - 0.6f * expf(-0.3f * (float)l); p.lamv[2 * l] = expf(a) - expf(b) + li; p.lamv[2 * l + 1] = li; }
    }
}

DI void row_phase(const Params& p, const float* __restrict__ src, bool do_ln, const float* __restrict__ lng, const float* __restrict__ lnb,
                  float* __restrict__ xdst, const float* __restrict__ modl  , int sh_off, int sc_off, bool want_h, bool want_logf) {
    const int lane = otid() & 63, wv = otid() >> 6;
    for (int row = obid() * 4 + wv; row < T; row += gridDim.x * 4) {
        const int b = row / S;
        const float* sp = src + (size_t)row * Dm;
        f32x4 v[4];
#pragma unroll
        for (int i = 0; i < 4; ++i) v[i] = *(const f32x4*)(sp + i * 256 + lane * 4);
        if (do_ln) {
            float s = 0.f;
#pragma unroll
            for (int i = 0; i < 4; ++i) s += (v[i][0] + v[i][1]) + (v[i][2] + v[i][3]);
            for (int o = 32; o; o >>= 1) s += __shfl_xor(s, o);
            const float mu = s * (1.f / 1024.f);
            float q = 0.f;
#pragma unroll
            for (int i = 0; i < 4; ++i) { f32x4 d = v[i] - mu; q += (d[0] * d[0] + d[1] * d[1]) + (d[2] * d[2] + d[3] * d[3]); }
            for (int o = 32; o; o >>= 1) q += __shfl_xor(q, o);
            const float rstd = rsqrtf(q * (1.f / 1024.f) + LN_EPS);
#pragma unroll
            for (int i = 0; i < 4; ++i) {
                const f32x4 g = *(const f32x4*)(lng + i * 256 + lane * 4), bb = *(const f32x4*)(lnb + i * 256 + lane * 4);
                v[i] = (v[i] - mu) * rstd * g + bb;
            }
        }
        if (xdst) {
#pragma unroll
            for (int i = 0; i < 4; ++i) *(f32x4*)(xdst + (size_t)row * Dm + i * 256 + lane * 4) = v[i];
        }
        if (want_h) {
            const float* mb = modl + (size_t)b * 6144;
            float d0 = 0.f, d1 = 0.f, d2 = 0.f, d3 = 0.f;
#pragma unroll
            for (int i = 0; i < 4; ++i) {
                const int c0 = i * 256 + lane * 4;
                const f32x4 sc = *(const f32x4*)(mb + sc_off + c0), sh = *(const f32x4*)(mb + sh_off + c0);
                const f32x4 hv = v[i] * (1.f + sc) + sh;
                uint2 w; w.x = pack2(hv[0], hv[1]); w.y = pack2(hv[2], hv[3]);
                *(uint2*)(p.h + (size_t)row * Dm + c0) = w;
                if (want_logf) {
#pragma unroll
                    for (int j = 0; j < 4; ++j) {
                        const f32x4 wf = *(const f32x4*)(p.wf + (c0 + j) * 4);
                        d0 += hv[j] * wf[0]; d1 += hv[j] * wf[1]; d2 += hv[j] * wf[2]; d3 += hv[j] * wf[3];
                    }
                }
            }
            if (want_logf) {
                for (int o = 32; o; o >>= 1) { d0 += __shfl_xor(d0, o); d1 += __shfl_xor(d1, o); d2 += __shfl_xor(d2, o); d3 += __shfl_xor(d3, o); }
                if (lane < 4) {
                    float z = (lane == 0 ? d0 : lane == 1 ? d1 : lane == 2 ? d2 : d3) + p.wf[4096 + lane];
                    const float ls = fminf(z, 0.f) - log1pf(__expf(-fabsf(z)));
                    p.logf[(size_t)row * 4 + lane] = ls * LOG2E;
                }
            }
        }
    }
}

DI void scan_item(const Params& p, int item, float* lds) {
    const int b = item >> 2, hh = item & 3, tid = otid();
    const float* lp = p.logf + (size_t)b * S * 4 + hh;
    float loc[32]; float s = 0.f;
#pragma unroll
    for (int i = 0; i < 32; ++i) { s += lp[(size_t)(tid * 32 + i) * 4]; loc[i] = s; }
    __syncthreads();
    lds[tid] = s;
    __syncthreads();
    float pre = 0.f;
    for (int i = 0; i < tid; ++i) pre += lds[i];
    float* fp = p.F + (size_t)(b * 4 + hh) * S + tid * 32;
#pragma unroll
    for (int i = 0; i < 32; ++i) fp[i] = pre + loc[i];
    __syncthreads();
}

DI void gemm_kloop(const bf16_t* __restrict__ Ag, int lda, const bf16_t* __restrict__ Bg, int ldb, int K, f32x4 (&acc)[4][4], bf16_t* sm) {
    const int tid = otid(), lane = tid & 63, wid = tid >> 6, wr = wid >> 1, wc = wid & 1;
    bf16_t* sa = sm; bf16_t* sb = sm + 2 * BM * LDP;
    const int lrow = tid >> 3, lcc = tid & 7;
    const bf16_t* ap = Ag + (size_t)lrow * lda + lcc * 8;
    const bf16_t* bp = Bg + (size_t)lrow * ldb + lcc * 8;
    const size_t sA = (size_t)32 * lda, sB = (size_t)32 * ldb;
    uint4 ra0, ra1, ra2, ra3, rb0, rb1, rb2, rb3;
#define G_LOAD(koff) do { ra0 = *(const uint4*)(ap + (koff)); ra1 = *(const uint4*)(ap + sA + (koff)); ra2 = *(const uint4*)(ap + 2 * sA + (koff)); ra3 = *(const uint4*)(ap + 3 * sA + (koff)); \
                          rb0 = *(const uint4*)(bp + (koff)); rb1 = *(const uint4*)(bp + sB + (koff)); rb2 = *(const uint4*)(bp + 2 * sB + (koff)); rb3 = *(const uint4*)(bp + 3 * sB + (koff)); } while (0)
#define G_STORE(buf) do { bf16_t* da_ = sa + (buf) * BM * LDP + lrow * LDP + lcc * 8; bf16_t* db_ = sb + (buf) * BN * LDP + lrow * LDP + lcc * 8; \
        *(uint4*)(da_) = ra0; *(uint4*)(da_ + 32 * LDP) = ra1; *(uint4*)(da_ + 64 * LDP) = ra2; *(uint4*)(da_ + 96 * LDP) = ra3; \
        *(uint4*)(db_) = rb0; *(uint4*)(db_ + 32 * LDP) = rb1; *(uint4*)(db_ + 64 * LDP) = rb2; *(uint4*)(db_ + 96 * LDP) = rb3; } while (0)
    G_LOAD(0);
    G_STORE(0);
    __syncthreads();
    const int nk = K / BK;
    const int fr = lane & 15, fq = lane >> 4;
    for (int kt = 0; kt < nk; ++kt) {
        const int cur = kt & 1;
        const bool more = kt + 1 < nk;
        if (more) G_LOAD((kt + 1) * BK);
        const bf16_t* ca = sa + cur * BM * LDP + (wr * 64 + fr) * LDP + fq * 8;
        const bf16_t* cb = sb + cur * BN * LDP + (wc * 64 + fr) * LDP + fq * 8;
#pragma unroll
        for (int kk = 0; kk < 2; ++kk) {
            bf16x8 af[4], bfr[4];
#pragma unroll
            for (int m = 0; m < 4; ++m) af[m] = *(const bf16x8*)(ca + m * 16 * LDP + kk * 32);
#pragma unroll
            for (int n = 0; n < 4; ++n) bfr[n] = *(const bf16x8*)(cb + n * 16 * LDP + kk * 32);
#pragma unroll
            for (int m = 0; m < 4; ++m)
#pragma unroll
                for (int n = 0; n < 4; ++n) acc[m][n] = __builtin_amdgcn_mfma_f32_16x16x32_bf16(bfr[n], af[m], acc[m][n], 0, 0, 0);
        }
        if (more) G_STORE(cur ^ 1);
        __syncthreads();
    }
#undef G_LOAD
#undef G_STORE
}

DI void gemm_kloop2(const bf16_t* __restrict__ Ag, int lda, const bf16_t* __restrict__ Bg, int ldb, int K, f32x4 (&acc)[4][4], bf16_t* sm) {
    const int tid = otid(), lane = tid & 63, wid = tid >> 6, wr = wid >> 1, wc = wid & 1;
    bf16_t* sa = sm; bf16_t* sb = sm + 2 * BM * LDP;
    const int lrow = tid >> 3, lcc = tid & 7;
    const bf16_t* ap = Ag + (size_t)lrow * lda + lcc * 8;
    const bf16_t* bp = Bg + (size_t)lrow * ldb + lcc * 8;
    const size_t sA = (size_t)32 * lda, sB = (size_t)32 * ldb;
    uint4 xa0, xa1, xa2, xa3, xb0, xb1, xb2, xb3;
    uint4 ya0, ya1, ya2, ya3, yb0, yb1, yb2, yb3;
#define G2_LOAD(P, koff) do { P##a0 = *(const uint4*)(ap + (koff)); P##a1 = *(const uint4*)(ap + sA + (koff)); P##a2 = *(const uint4*)(ap + 2 * sA + (koff)); P##a3 = *(const uint4*)(ap + 3 * sA + (koff)); \
                              P##b0 = *(const uint4*)(bp + (koff)); P##b1 = *(const uint4*)(bp + sB + (koff)); P##b2 = *(const uint4*)(bp + 2 * sB + (koff)); P##b3 = *(const uint4*)(bp + 3 * sB + (koff)); } while (0)
#define G2_STORE(P, buf) do { bf16_t* da_ = sa + (buf) * BM * LDP + lrow * LDP + lcc * 8; bf16_t* db_ = sb + (buf) * BN * LDP + lrow * LDP + lcc * 8; \
        *(uint4*)(da_) = P##a0; *(uint4*)(da_ + 32 * LDP) = P##a1; *(uint4*)(da_ + 64 * LDP) = P##a2; *(uint4*)(da_ + 96 * LDP) = P##a3; \
        *(uint4*)(db_) = P##b0; *(uint4*)(db_ + 32 * LDP) = P##b1; *(uint4*)(db_ + 64 * LDP) = P##b2; *(uint4*)(db_ + 96 * LDP) = P##b3; } while (0)
#define G2_COMPUTE(buf) do { \
        const bf16_t* ca = sa + (buf) * BM * LDP + (wr * 64 + fr) * LDP + fq * 8; \
        const bf16_t* cb = sb + (buf) * BN * LDP + (wc * 64 + fr) * LDP + fq * 8; \
        _Pragma("unroll") for (int kk = 0; kk < 2; ++kk) { \
            bf16x8 af[4], bfr[4]; \
            _Pragma("unroll") for (int m = 0; m < 4; ++m) af[m] = *(const bf16x8*)(ca + m * 16 * LDP + kk * 32); \
            _Pragma("unroll") for (int n = 0; n < 4; ++n) bfr[n] = *(const bf16x8*)(cb + n * 16 * LDP + kk * 32); \
            _Pragma("unroll") for (int m = 0; m < 4; ++m) _Pragma("unroll") for (int n = 0; n < 4; ++n) acc[m][n] = __builtin_amdgcn_mfma_f32_16x16x32_bf16(bfr[n], af[m], acc[m][n], 0, 0, 0); \
        } } while (0)
    const int nk = K / BK;
    const int fr = lane & 15, fq = lane >> 4;
    G2_LOAD(x, 0);
    G2_LOAD(y, BK);
    G2_STORE(x, 0);
    __syncthreads();
    for (int kt = 0; kt < nk; kt += 2) {
        const bool m2 = kt + 2 < nk;
        if (m2) G2_LOAD(x, (kt + 2) * BK);
        G2_COMPUTE(0);
        G2_STORE(y, 1);
        __syncthreads();
        if (kt + 3 < nk) G2_LOAD(y, (kt + 3) * BK);
        G2_COMPUTE(1);
        if (m2) G2_STORE(x, 0);
        __syncthreads();
    }
#undef G2_LOAD
#undef G2_STORE
#undef G2_COMPUTE
}

DI void tile_coords(int tile, int nM, int nN, int& mt, int& nt) {
    const int G = gridDim.x;
    if ((G & 7) == 0 && nM == 128 && (nM * nN) % G == 0) {
        const int b = tile % G, k = tile / G, per = G >> 3;
        const int xcd = b & 7, slot = b >> 3;
        const int li = k * per + slot;
        const int mh = li / (8 * nN), rem = li % (8 * nN);
        nt = rem >> 3; mt = (mh * 8 + (rem & 7)) * 8 + xcd;
        return;
    }
    const int band = tile / (16 * nN), r = tile % (16 * nN);
    mt = band * 16 + (r & 15); nt = r >> 4;
}

DI void zero_acc(f32x4 (&acc)[4][4]) {
#pragma unroll
    for (int m = 0; m < 4; ++m)
#pragma unroll
        for (int n = 0; n < 4; ++n) acc[m][n] = (f32x4){0.f, 0.f, 0.f, 0.f};
}

DI void st4_wt(bf16_t* dst, f32x4 v) { const unsigned long long w = (unsigned long long)pack2(v[0], v[1]) | ((unsigned long long)pack2(v[2], v[3]) << 32); __hip_atomic_store((unsigned long long*)dst, w, __ATOMIC_RELAXED, __HIP_MEMORY_SCOPE_AGENT); }
DI void st4(bf16_t* dst, f32x4 v) { uint2 w; w.x = pack2(v[0], v[1]); w.y = pack2(v[2], v[3]); *(uint2*)dst = w; }

DI void epi_inproj(const Params& p, int row, int col, f32x4 v) {
    v += *(const f32x4*)(p.binp + col);
    const int b = row / S, s = row % S;
    if (col < 512) { st4(p.qa + (size_t)row * 512 + col, v * (0.125f * LOG2E)); }
    else if (col < 1024) { st4(p.ka + (size_t)row * 512 + (col - 512), v); }
    else if (col < 1536) { const int c = col - 1024, hh = c >> 7, e = c & 127; bf16_t* d = p.vta + ((size_t)(b * 4 + hh) * 128 + e) * S + s;
#pragma unroll
        for (int j = 0; j < 4; ++j) d[(size_t)j * S] = f2bf(v[j]); }
    else if (col < 2048) { st4(p.qb + (size_t)row * 512 + (col - 1536), v * (0.08838834764831845f * LOG2E)); }
    else if (col < 2560) { st4(p.kb + (size_t)row * 512 + (col - 2048), v); }
    else if (col < 3072) { const int c = col - 2560, hh = c >> 7, e = c & 127; bf16_t* d = p.vtb + ((size_t)(b * 4 + hh) * 128 + e) * S + s;
#pragma unroll
        for (int j = 0; j < 4; ++j) d[(size_t)j * S] = f2bf(v[j]); }
    else if (col < 4096) {
        const int r = col - 3072, seg = r >> 9, c = r & 511, cc = c & 127, i0 = cc >> 1, hd = c >> 7;
        f32x4 cs;
        {
            const float a0 = (float)s * ex2(-(float)i0 * 0.21091607f), a1 = (float)s * ex2(-(float)(i0 + 1) * 0.21091607f);
            float r0 = a0 * 0.15915494309189535f, r1 = a1 * 0.15915494309189535f;
            r0 -= floorf(r0); r1 -= floorf(r1);
            float c0_ = __builtin_amdgcn_cosf(r0), s0_ = __builtin_amdgcn_sinf(r0), c1_ = __builtin_amdgcn_cosf(r1), s1_ = __builtin_amdgcn_sinf(r1);
            asm volatile("s_nop 15\n\ts_nop 15" : "+v"(c0_), "+v"(s0_), "+v"(c1_), "+v"(s1_));
            cs[0] = c0_; cs[1] = s0_; cs[2] = c1_; cs[3] = s1_;
        }
        f32x4 o; o[0] = v[0] * cs[0] - v[1] * cs[1]; o[1] = v[0] * cs[1] + v[1] * cs[0]; o[2] = v[2] * cs[2] - v[3] * cs[3]; o[3] = v[2] * cs[3] + v[3] * cs[2];
        const float lg = lg2gamma(hd);
        const int ic = s & 63;
        float e1_ = ex2(lg * (float)(ic + 1)), e2_ = ex2(-lg * (float)(ic + 1)), e3_ = ex2(lg * (float)(63 - ic));
        asm volatile("s_nop 15\n\ts_nop 15" : "+v"(e1_), "+v"(e2_), "+v"(e3_));
        if (seg == 0) st4(p.cq + (size_t)row * 512 + c, o * e1_);
        else {
            o = o * 0.08838834764831845f;
            st4(p.ck + (size_t)row * 512 + c, o * e2_);
            const f32x4 od = o * e3_;
            bf16_t* d = p.ckT + ((size_t)(b * 4 + hd) * 128 + cc) * S + s;
#pragma unroll
            for (int j = 0; j < 4; ++j) d[(size_t)j * S] = f2bf(od[j]);
        }
    }
    else if (col < 5120) { const int c = col - 4096; bf16_t* d = p.cv + ((size_t)b * 1024 + c) * S + s;
#pragma unroll
        for (int j = 0; j < 4; ++j) d[(size_t)j * S] = f2bf(v[j]); }
    else if (col < 6144) { f32x4 o; for (int j = 0; j < 4; ++j) o[j] = silu_f(v[j]); st4(p.cg + (size_t)row * 1024 + (col - 5120), o); }
    else { f32x4 o; for (int j = 0; j < 4; ++j) o[j] = sigmoid_f(v[j]); st4(p.gates + (size_t)row * 3072 + (col - 6144), o); }
}

DI void phase_inproj(const Params& p, bf16_t* sm) {
    const int nM = T / BM, nN = NIN / BN;
    const int lane = otid() & 63, wid = otid() >> 6, wr = wid >> 1, wc = wid & 1;
    for (int tile = obid(); tile < nM * nN; tile += gridDim.x) {
        int mt, nt; tile_coords(tile, nM, nN, mt, nt);
        f32x4 acc[4][4]; zero_acc(acc);
        gemm_kloop2(p.h + (size_t)mt * BM * Dm, Dm, p.WinT + (size_t)nt * BN * Dm, Dm, Dm, acc, sm);
#pragma unroll
        for (int m = 0; m < 4; ++m)
#pragma unroll
            for (int n = 0; n < 4; ++n) epi_inproj(p, mt * BM + wr * 64 + m * 16 + (lane & 15), nt * BN + wc * 64 + n * 16 + (lane >> 4) * 4, acc[m][n]);
    }
}

DI void phase_branch(const Params& p, bf16_t* sm) {
    const int nM = T / BM, nN = Dm / BN;
    const int lane = otid() & 63, wid = otid() >> 6, wr = wid >> 1, wc = wid & 1;
    for (int tile = obid(); tile < nM * nN; tile += gridDim.x) {
        int mt, nt; tile_coords(tile, nM, nN, mt, nt);
        f32x4 tot[4][4]; zero_acc(tot);
#pragma unroll 1
        for (int br = 0; br < 3; ++br) {
            const bf16_t* A = br == 0 ? p.ya : br == 1 ? p.yb : p.yc;
            const bf16_t* W = br == 0 ? p.WpaT : br == 1 ? p.WpbT : p.WpcT;
            const int K = br == 2 ? 1024 : 512;
            f32x4 acc[4][4]; zero_acc(acc);
            gemm_kloop(A + (size_t)mt * BM * K, K, W + (size_t)nt * BN * K, K, K, acc, sm);
#pragma unroll
            for (int m = 0; m < 4; ++m)
#pragma unroll
                for (int n = 0; n < 4; ++n) {
                    const int row = mt * BM + wr * 64 + m * 16 + (lane & 15), col = nt * BN + wc * 64 + n * 16 + (lane >> 4) * 4;
                    const uint2 g = *(const uint2*)(p.gates + (size_t)row * 3072 + br * 1024 + col);
                    tot[m][n][0] += bflo(g.x) * acc[m][n][0]; tot[m][n][1] += bfhi(g.x) * acc[m][n][1];
                    tot[m][n][2] += bflo(g.y) * acc[m][n][2]; tot[m][n][3] += bfhi(g.y) * acc[m][n][3];
                }
        }
#pragma unroll
        for (int m = 0; m < 4; ++m)
#pragma unroll
            for (int n = 0; n < 4; ++n) {
                const int row = mt * BM + wr * 64 + m * 16 + (lane & 15), col = nt * BN + wc * 64 + n * 16 + (lane >> 4) * 4;
                st4(p.h + (size_t)row * Dm + col, tot[m][n]);
            }
    }
}

DI void phase_gemm_res(const Params& p, const bf16_t* A, int K, const bf16_t* Wt, const float* xres, const float* modl, int gt_off, bf16_t* sm) {
    const int nM = T / BM, nN = Dm / BN;
    const int lane = otid() & 63, wid = otid() >> 6, wr = wid >> 1, wc = wid & 1;
    for (int tile = obid(); tile < nM * nN; tile += gridDim.x) {
        int mt, nt; tile_coords(tile, nM, nN, mt, nt);
        f32x4 acc[4][4]; zero_acc(acc);
        gemm_kloop2(A + (size_t)mt * BM * K, K, Wt + (size_t)nt * BN * K, K, K, acc, sm);
#pragma unroll
        for (int m = 0; m < 4; ++m)
#pragma unroll
            for (int n = 0; n < 4; ++n) {
                const int row = mt * BM + wr * 64 + m * 16 + (lane & 15), col = nt * BN + wc * 64 + n * 16 + (lane >> 4) * 4;
                const int b = row / S;
                const f32x4 xr = *(const f32x4*)(xres + (size_t)row * Dm + col);
                const f32x4 gt = *(const f32x4*)(modl + (size_t)b * 6144 + gt_off + col);
                *(f32x4*)(p.vbuf + (size_t)row * Dm + col) = xr * ALPHA_F + gt * acc[m][n];
            }
    }
}

DI void phase_up(const Params& p, bf16_t* sm) {
    const int nM = T / BM, nN = 2 * DFF / BN;
    const int lane = otid() & 63, wid = otid() >> 6, wr = wid >> 1, wc = wid & 1;
    for (int tile = obid(); tile < nM * nN; tile += gridDim.x) {
        int mt, nt; tile_coords(tile, nM, nN, mt, nt);
        f32x4 acc[4][4]; zero_acc(acc);
        gemm_kloop2(p.h + (size_t)mt * BM * Dm, Dm, p.WupT + (size_t)nt * BN * Dm, Dm, Dm, acc, sm);
#pragma unroll
        for (int m = 0; m < 4; ++m)
#pragma unroll
            for (int n = 0; n < 4; ++n) {
                const int row = mt * BM + wr * 64 + m * 16 + (lane & 15), col = nt * BN + wc * 64 + n * 16 + (lane >> 4) * 4;
                st4(p.ug + (size_t)row * (2 * DFF) + col, acc[m][n]);
            }
    }
}

DI void phase_conv(const Params& p, int l) {
    const int gtid = obid() * blockDim.x + otid(), gsz = gridDim.x * blockDim.x;
    const float* wc = p.w_conv + (size_t)l * 3 * DFF; const float* bc = p.b_conv + (size_t)l * DFF;
    for (int i = gtid; i < T * (DFF / 8); i += gsz) {
        const int row = i / (DFF / 8), c8 = (i % (DFF / 8)) * 8, s = row % S;
        const bf16_t* up = p.ug + (size_t)row * (2 * DFF) + c8;
        const uint4 u0 = *(const uint4*)up;
        uint4 u1 = make_uint4(0, 0, 0, 0), u2 = make_uint4(0, 0, 0, 0);
        if (s >= 1) u1 = *(const uint4*)(up - 2 * DFF);
        if (s >= 2) u2 = *(const uint4*)(up - 4 * DFF);
        const uint4 gg = *(const uint4*)(up + DFF);
        const unsigned a0[4] = {u0.x, u0.y, u0.z, u0.w}, a1[4] = {u1.x, u1.y, u1.z, u1.w}, a2[4] = {u2.x, u2.y, u2.z, u2.w}, ag[4] = {gg.x, gg.y, gg.z, gg.w};
        unsigned o[4];
#pragma unroll
        for (int j = 0; j < 4; ++j) {
            float r[2];
#pragma unroll
            for (int hl = 0; hl < 2; ++hl) {
                const int cidx = c8 + 2 * j + hl;
                const float x0 = hl ? bfhi(a0[j]) : bflo(a0[j]), x1 = hl ? bfhi(a1[j]) : bflo(a1[j]), x2 = hl ? bfhi(a2[j]) : bflo(a2[j]), g = hl ? bfhi(ag[j]) : bflo(ag[j]);
                const float cv = bc[cidx] + wc[cidx] * x2 + wc[DFF + cidx] * x1 + wc[2 * DFF + cidx] * x0;
                r[hl] = 0.5f * cv * (1.f + erff(cv * 0.7071067811865476f)) * g;
            }
            o[j] = pack2(r[0], r[1]);
        }
        *(uint4*)(p.act + (size_t)row * DFF + c8) = make_uint4(o[0], o[1], o[2], o[3]);
    }
}

template <int MODE>
DI void naive_attn(const Params& p, int item) {
    constexpr int D = MODE == 0 ? 64 : 128;
    constexpr int DV = MODE == 2 ? 256 : 128;
    constexpr int SW = DV / 4;
    constexpr int NH = MODE == 0 ? 8 : 4;
    const int tid = otid(), lane = tid & 63;
    const int sl = __builtin_amdgcn_readfirstlane(tid >> 6);
    const int qblk = 127 - (item % 128), hh = (item / 128) % NH, b = item / (128 * NH);
    const int q = qblk * 64 + lane; const size_t tq = (size_t)b * S + q;
    const bf16_t *Q, *Kp;
    if (MODE == 0) { Q = p.qa + tq * 512 + hh * 64; Kp = p.ka + (size_t)b * S * 512 + hh * 64; }
    else if (MODE == 1) { Q = p.qb + tq * 512 + hh * 128; Kp = p.kb + (size_t)b * S * 512 + hh * 128; }
    else { Q = p.cq + tq * 512 + hh * 128; Kp = p.ck + (size_t)b * S * 512 + hh * 128; }
    unsigned qp[D / 2];
#pragma unroll
    for (int i = 0; i < D / 8; ++i) { const uint4 t = ((const uint4*)Q)[i]; qp[4 * i] = t.x; qp[4 * i + 1] = t.y; qp[4 * i + 2] = t.z; qp[4 * i + 3] = t.w; }
    float acc[SW];
#pragma unroll
    for (int i = 0; i < SW; ++i) acc[i] = 0.f;
    float mx = -INFINITY, lsum = 0.f;
    const int send = (qblk + 1) * 64;
    float Fq = 0.f; const float* Fk = nullptr;
    if (MODE == 1) { Fk = p.F + (size_t)(b * 4 + hh) * S; Fq = Fk[q]; }
    float lg = 0.f;
    if (MODE == 2) lg = log2f(1.0f - exp2f(-5.0f - (float)hh));
    for (int s = 0; s < send; ++s) {
        const uint4* kr = (const uint4*)(Kp + (size_t)s * 512);
        float sc = 0.f;
#pragma unroll
        for (int i = 0; i < D / 8; ++i) {
            const uint4 kv = kr[i];
            sc += bflo(qp[4 * i]) * bflo(kv.x) + bfhi(qp[4 * i]) * bfhi(kv.x);
            sc += bflo(qp[4 * i + 1]) * bflo(kv.y) + bfhi(qp[4 * i + 1]) * bfhi(kv.y);
            sc += bflo(qp[4 * i + 2]) * bflo(kv.z) + bfhi(qp[4 * i + 2]) * bfhi(kv.z);
            sc += bflo(qp[4 * i + 3]) * bflo(kv.w) + bfhi(qp[4 * i + 3]) * bfhi(kv.w);
            if ((i & 3) == 3) asm volatile("" ::: "memory");
        }
        float w, corr = 1.f;
        if (MODE == 2) {
            w = (s <= q) ? sc * exp2f((float)(q - s) * lg) : 0.f;
        } else {
            if (MODE == 1) sc += Fq - Fk[s];
            const bool valid = (MODE == 0) || (s <= q);
            if (valid) {
                const float mn = fmaxf(mx, sc);
                corr = exp2f(mx - mn); w = exp2f(sc - mn); mx = mn;
                lsum = lsum * corr + w;
            } else { w = 0.f; }
        }
        if (MODE == 2) {
            const uint4* vr = (const uint4*)(p.cv + ((size_t)b * S + s) * 1024 + hh * 256 + sl * SW);
#pragma unroll
            for (int i = 0; i < SW / 8; ++i) {
                const uint4 vv = vr[i];
                acc[8 * i] += w * bflo(vv.x); acc[8 * i + 1] += w * bfhi(vv.x); acc[8 * i + 2] += w * bflo(vv.y); acc[8 * i + 3] += w * bfhi(vv.y);
                acc[8 * i + 4] += w * bflo(vv.z); acc[8 * i + 5] += w * bfhi(vv.z); acc[8 * i + 6] += w * bflo(vv.w); acc[8 * i + 7] += w * bfhi(vv.w);
            }
        } else {
            const bf16_t* vt = (MODE == 0 ? p.vta + ((size_t)(b * 4 + (hh >> 1)) * 128 + sl * SW) * S : p.vtb + ((size_t)(b * 4 + hh) * 128 + sl * SW) * S) + s;
#pragma unroll
            for (int i = 0; i < SW; ++i) { acc[i] = acc[i] * corr + w * bf2f(*vt); vt += S; asm volatile("" : "+v"(vt)); }
        }
    }
    if (MODE == 2) {
        float* o = p.oc + tq * 1024 + hh * 256 + sl * SW;
#pragma unroll
        for (int i = 0; i < SW / 4; ++i) *(f32x4*)(o + 4 * i) = (f32x4){acc[4 * i], acc[4 * i + 1], acc[4 * i + 2], acc[4 * i + 3]};
    } else {
        const float inv = 1.f / lsum;
        bf16_t* o = (MODE == 0 ? p.oa + tq * 1024 + hh * 128 : p.yb + tq * 512 + hh * 128) + sl * SW;
#pragma unroll
        for (int i = 0; i < SW / 8; ++i) {
            uint4 w4; w4.x = pack2(acc[8 * i] * inv, acc[8 * i + 1] * inv); w4.y = pack2(acc[8 * i + 2] * inv, acc[8 * i + 3] * inv);
            w4.z = pack2(acc[8 * i + 4] * inv, acc[8 * i + 5] * inv); w4.w = pack2(acc[8 * i + 6] * inv, acc[8 * i + 7] * inv);
            ((uint4*)o)[i] = w4;
        }
    }
}


typedef float f32x16 __attribute__((ext_vector_type(16)));
DI bf16x8 pack8(float a0, float a1, float a2, float a3, float a4, float a5, float a6, float a7) {
    typedef unsigned u32x4 __attribute__((ext_vector_type(4)));
    u32x4 w; w[0] = pack2(a0, a1); w[1] = pack2(a2, a3); w[2] = pack2(a4, a5); w[3] = pack2(a6, a7);
    return __builtin_bit_cast(bf16x8, w);
}

template <int MODE>
DI void flash_item(const Params& p, int b, int hh, int qi, unsigned char* smem) {
    constexpr int D = MODE == 0 ? 64 : 128, KST = D + 8, VST = 68, KS = D / 16;
    constexpr int KBYTES = 64 * KST * 2, VBYTES = 128 * VST * 2, BUFB = KBYTES + VBYTES + 256;
    constexpr int NKC = D / 32, CPR = D / 8;
    const int tid = otid(), lane = tid & 63, w = tid >> 6, r = lane & 31, hf = lane >> 5;
    const int q0 = qi * 128 + w * 32;
    const size_t tq = (size_t)b * S + q0 + r;
    bf16x8 qf[KS];
    {
        const bf16_t* qptr = (MODE == 0 ? p.qa + tq * 512 + hh * 64 : p.qb + tq * 512 + hh * 128) + hf * 8;
#pragma unroll
        for (int ks = 0; ks < KS; ++ks) qf[ks] = *(const bf16x8*)(qptr + ks * 16);
    }
    const float* fbase = p.F + (size_t)(b * 4 + (MODE == 1 ? hh : 0)) * S;
    float Fq = 0.f; if (MODE == 1) Fq = fbase[q0 + r];
    const bf16_t* kbase = MODE == 0 ? p.ka + (size_t)b * S * 512 + hh * 64 : p.kb + (size_t)b * S * 512 + hh * 128;
    const bf16_t* vbase = MODE == 0 ? p.vta + (size_t)(b * 4 + (hh >> 1)) * 128 * S : p.vtb + (size_t)(b * 4 + hh) * 128 * S;
    const int ntiles = 2 * qi + 2, wlast = 2 * qi + (w >> 1);
    uint4 kr[NKC], vr[4]; f32x4 frg = {0.f, 0.f, 0.f, 0.f};
#define FL_GLOAD(j) do { \
        _Pragma("unroll") for (int i_ = 0; i_ < NKC; ++i_) { const int c_ = tid + 256 * i_; kr[i_] = *(const uint4*)(kbase + (size_t)(64 * (j) + c_ / CPR) * 512 + (c_ % CPR) * 8); } \
        _Pragma("unroll") for (int i_ = 0; i_ < 4; ++i_) { const int c_ = tid + 256 * i_; vr[i_] = *(const uint4*)(vbase + (size_t)(c_ >> 3) * S + 64 * (j) + (c_ & 7) * 8); } \
        if (MODE == 1 && tid < 16) frg = *(const f32x4*)(fbase + 64 * (j) + tid * 4); } while (0)
#define FL_SSTORE(buf) do { unsigned char* B_ = smem + (buf) * BUFB; \
        _Pragma("unroll") for (int i_ = 0; i_ < NKC; ++i_) { const int c_ = tid + 256 * i_; *(uint4*)(B_ + ((c_ / CPR) * KST + (c_ % CPR) * 8) * 2) = kr[i_]; } \
        _Pragma("unroll") for (int i_ = 0; i_ < 4; ++i_) { const int c_ = tid + 256 * i_; uint2* d_ = (uint2*)(B_ + KBYTES + ((c_ >> 3) * VST + (c_ & 7) * 8) * 2); d_[0] = make_uint2(vr[i_].x, vr[i_].y); d_[1] = make_uint2(vr[i_].z, vr[i_].w); } \
        if (MODE == 1 && tid < 16) *(f32x4*)(B_ + KBYTES + VBYTES + tid * 16) = frg; } while (0)
    FL_GLOAD(0);
    FL_SSTORE(0);
    __syncthreads();
    f32x16 acc[4];
#pragma unroll
    for (int eb = 0; eb < 4; ++eb)
#pragma unroll
        for (int i = 0; i < 16; ++i) acc[eb][i] = 0.f;
    float mrun = -INFINITY, lsum = 0.f;
    for (int j = 0; j < ntiles; ++j) {
        const bool more = j + 1 < ntiles;
        if (more) FL_GLOAD(j + 1);
        if (j <= wlast) {
            const unsigned char* B = smem + (j & 1) * BUFB;
            f32x16 st[2];
#pragma unroll
            for (int kb = 0; kb < 2; ++kb) {
#pragma unroll
                for (int i = 0; i < 16; ++i) st[kb][i] = 0.f;
#pragma unroll
                for (int ks = 0; ks < KS; ++ks) {
                    const bf16x8 a = *(const bf16x8*)(B + ((kb * 32 + r) * KST + ks * 16 + hf * 8) * 2);
                    st[kb] = __builtin_amdgcn_mfma_f32_32x32x16_bf16(a, qf[ks], st[kb], 0, 0, 0);
                }
            }
            if (MODE == 1) {
                const float* Fl = (const float*)(B + KBYTES + VBYTES);
#pragma unroll
                for (int kb = 0; kb < 2; ++kb)
#pragma unroll
                    for (int g = 0; g < 4; ++g) {
                        const f32x4 fk = *(const f32x4*)(Fl + kb * 32 + 8 * g + 4 * hf);
#pragma unroll
                        for (int jj = 0; jj < 4; ++jj) st[kb][4 * g + jj] += Fq - fk[jj];
                    }
                if (j >= 2 * qi) {
                    const int qabs = q0 + r;
#pragma unroll
                    for (int kb = 0; kb < 2; ++kb)
#pragma unroll
                        for (int g = 0; g < 4; ++g)
#pragma unroll
                            for (int jj = 0; jj < 4; ++jj) { const int key = 64 * j + kb * 32 + 8 * g + 4 * hf + jj; if (key > qabs) st[kb][4 * g + jj] = -INFINITY; }
                }
            }
            float mt = st[0][0];
#pragma unroll
            for (int i = 1; i < 16; ++i) mt = fmaxf(mt, st[0][i]);
#pragma unroll
            for (int i = 0; i < 16; ++i) mt = fmaxf(mt, st[1][i]);
            mt = fmaxf(mt, __shfl_xor(mt, 32));
            const float mn = fmaxf(mrun, mt);
            const float corr = ex2(mrun - mn);
            mrun = mn; lsum *= corr;
#pragma unroll
            for (int kb = 0; kb < 2; ++kb)
#pragma unroll
                for (int i = 0; i < 16; ++i) { const float pv = ex2(st[kb][i] - mn); st[kb][i] = pv; lsum += pv; }
#pragma unroll
            for (int eb = 0; eb < 4; ++eb) acc[eb] *= corr;
#pragma unroll
            for (int kb = 0; kb < 2; ++kb)
#pragma unroll
                for (int s2 = 0; s2 < 2; ++s2) {
                    const bf16x8 pf = pack8(st[kb][8 * s2], st[kb][8 * s2 + 1], st[kb][8 * s2 + 2], st[kb][8 * s2 + 3], st[kb][8 * s2 + 4], st[kb][8 * s2 + 5], st[kb][8 * s2 + 6], st[kb][8 * s2 + 7]);
#pragma unroll
                    for (int eb = 0; eb < 4; ++eb) {
                        const unsigned char* vp = B + KBYTES + ((eb * 32 + r) * VST + kb * 32 + 16 * s2 + 4 * hf) * 2;
                        const uint2 lo = *(const uint2*)vp, hi = *(const uint2*)(vp + 16);
                        typedef unsigned u32x4 __attribute__((ext_vector_type(4)));
                        u32x4 av; av[0] = lo.x; av[1] = lo.y; av[2] = hi.x; av[3] = hi.y;
                        acc[eb] = __builtin_amdgcn_mfma_f32_32x32x16_bf16(__builtin_bit_cast(bf16x8, av), pf, acc[eb], 0, 0, 0);
                    }
                }
        }
        if (more) FL_SSTORE((j + 1) & 1);
        __syncthreads();
    }
#undef FL_GLOAD
#undef FL_SSTORE
    const float inv = 1.f / (lsum + __shfl_xor(lsum, 32));
    bf16_t* o = MODE == 0 ? p.oa + tq * 1024 + hh * 128 : p.yb + tq * 512 + hh * 128;
#pragma unroll
    for (int eb = 0; eb < 4; ++eb)
#pragma unroll
        for (int g = 0; g < 4; ++g) {
            f32x4 v = {acc[eb][4 * g] * inv, acc[eb][4 * g + 1] * inv, acc[eb][4 * g + 2] * inv, acc[eb][4 * g + 3] * inv};
            st4(o + eb * 32 + 8 * g + 4 * hf, v);
        }
}


DI void ret_state_item(const Params& p, int item) {
    const int n = item & 127, bh = item >> 7;
    const int tid = otid(), lane = tid & 63, w = tid >> 6, r = lane & 31, hf = lane >> 5;
    const bf16_t* kt = p.ckT + (size_t)bh * 128 * S + n * 64 + hf * 8;
    const bf16_t* vt = p.cv + ((size_t)bh * 256 + w * 64) * S + n * 64 + hf * 8;
    f32x16 acc[4][2];
#pragma unroll
    for (int a = 0; a < 4; ++a)
#pragma unroll
        for (int c = 0; c < 2; ++c)
#pragma unroll
            for (int i = 0; i < 16; ++i) acc[a][c][i] = 0.f;
#pragma unroll
    for (int s4 = 0; s4 < 4; ++s4) {
        bf16x8 af[4], bfr[2];
#pragma unroll
        for (int a = 0; a < 4; ++a) af[a] = *(const bf16x8*)(kt + (size_t)(a * 32 + r) * S + s4 * 16);
#pragma unroll
        for (int c = 0; c < 2; ++c) bfr[c] = *(const bf16x8*)(vt + (size_t)(c * 32 + r) * S + s4 * 16);
#pragma unroll
        for (int a = 0; a < 4; ++a)
#pragma unroll
            for (int c = 0; c < 2; ++c) acc[a][c] = __builtin_amdgcn_mfma_f32_32x32x16_bf16(af[a], bfr[c], acc[a][c], 0, 0, 0);
    }
    bf16_t* o = p.kv + ((size_t)(bh * 128 + n) * 256 + w * 64) * 128;
#pragma unroll
    for (int a = 0; a < 4; ++a)
#pragma unroll
        for (int c = 0; c < 2; ++c)
#pragma unroll
            for (int g = 0; g < 4; ++g) {
                f32x4 v = {acc[a][c][4 * g], acc[a][c][4 * g + 1], acc[a][c][4 * g + 2], acc[a][c][4 * g + 3]};
                st4_wt(o + (size_t)(c * 32 + r) * 128 + a * 32 + 8 * g + 4 * hf, v);
            }
}

DI void ret_scan(const Params& p) {
    const int gtid = obid() * 256 + otid(), gsz = gridDim.x * 256;
    for (int e = gtid; e < 8 * 8192; e += gsz) {
        const int bh = e >> 13, pi = e & 8191, hd = bh & 3;
        const float dec = ex2(64.0f * lg2gamma(hd));
        unsigned long long* ptr = (unsigned long long*)p.kv + (size_t)bh * 128 * 8192 + pi;
        float c0 = 0.f, c1 = 0.f, c2 = 0.f, c3 = 0.f;
        for (int n0 = 0; n0 < 128; n0 += 8) {
            unsigned long long v[8];
#pragma unroll
            for (int k = 0; k < 8; ++k) v[k] = ptr[(size_t)(n0 + k) * 8192];
            asm volatile("s_waitcnt vmcnt(0)" ::: "memory");
#pragma unroll
            for (int k = 0; k < 8; ++k) {
                const unsigned long long o = (unsigned long long)pack2(c0, c1) | ((unsigned long long)pack2(c2, c3) << 32);
                __hip_atomic_store(ptr + (size_t)(n0 + k) * 8192, o, __ATOMIC_RELAXED, __HIP_MEMORY_SCOPE_AGENT);
                const unsigned lo = (unsigned)v[k], hi = (unsigned)(v[k] >> 32);
                c0 = c0 * dec + bflo(lo); c1 = c1 * dec + bfhi(lo); c2 = c2 * dec + bflo(hi); c3 = c3 * dec + bfhi(hi);
            }
        }
    }
}

DI void ret_out_item(const Params& p, int l, int item, unsigned char* smem) {
    const int n = item & 127, bh = item >> 7, b = bh >> 2, hd = bh & 3;
    const int tid = otid(), lane = tid & 63, w = tid >> 6, r = lane & 31, hf = lane >> 5;
    const size_t t0 = (size_t)b * S + n * 64;
    f32x16 acc[2][2];
#pragma unroll
    for (int a = 0; a < 2; ++a)
#pragma unroll
        for (int c = 0; c < 2; ++c)
#pragma unroll
            for (int i = 0; i < 16; ++i) acc[a][c][i] = 0.f;
    bf16x8 pf[2][2][2];
    {
        bf16x8 qf[2][8];
#pragma unroll
        for (int qb = 0; qb < 2; ++qb)
#pragma unroll
            for (int ks = 0; ks < 8; ++ks) qf[qb][ks] = *(const bf16x8*)(p.cq + (t0 + qb * 32 + r) * 512 + hd * 128 + ks * 16 + hf * 8);
        const bf16_t* rt = p.kv + ((size_t)(bh * 128 + n) * 256 + w * 64) * 128 + hf * 8;
#pragma unroll
        for (int dvb = 0; dvb < 2; ++dvb)
#pragma unroll
            for (int ks = 0; ks < 8; ++ks) {
                const bf16x8 a = *(const bf16x8*)(rt + (size_t)(dvb * 32 + r) * 128 + ks * 16);
#pragma unroll
                for (int qb = 0; qb < 2; ++qb) acc[dvb][qb] = __builtin_amdgcn_mfma_f32_32x32x16_bf16(a, qf[qb][ks], acc[dvb][qb], 0, 0, 0);
            }
#pragma unroll
        for (int kb = 0; kb < 2; ++kb) {
            f32x16 st[2];
#pragma unroll
            for (int qb = 0; qb < 2; ++qb)
#pragma unroll
                for (int i = 0; i < 16; ++i) st[qb][i] = 0.f;
#pragma unroll
            for (int ks = 0; ks < 8; ++ks) {
                const bf16x8 a = *(const bf16x8*)(p.ck + (t0 + kb * 32 + r) * 512 + hd * 128 + ks * 16 + hf * 8);
#pragma unroll
                for (int qb = 0; qb < 2; ++qb) st[qb] = __builtin_amdgcn_mfma_f32_32x32x16_bf16(a, qf[qb][ks], st[qb], 0, 0, 0);
            }
#pragma unroll
            for (int qb = 0; qb < 2; ++qb) {
#pragma unroll
                for (int i = 0; i < 16; ++i) { const int key = kb * 32 + (i & 3) + 8 * (i >> 2) + 4 * hf; if (key > qb * 32 + r) st[qb][i] = 0.f; }
#pragma unroll
                for (int s2 = 0; s2 < 2; ++s2)
                    pf[kb][s2][qb] = pack8(st[qb][8 * s2], st[qb][8 * s2 + 1], st[qb][8 * s2 + 2], st[qb][8 * s2 + 3], st[qb][8 * s2 + 4], st[qb][8 * s2 + 5], st[qb][8 * s2 + 6], st[qb][8 * s2 + 7]);
            }
        }
    }
    {
        const bf16_t* vt = p.cv + ((size_t)bh * 256 + w * 64) * S + n * 64 + 4 * hf;
#pragma unroll
        for (int dvb = 0; dvb < 2; ++dvb)
#pragma unroll
            for (int kb = 0; kb < 2; ++kb)
#pragma unroll
                for (int s2 = 0; s2 < 2; ++s2) {
                    const bf16_t* vp = vt + (size_t)(dvb * 32 + r) * S + kb * 32 + 16 * s2;
                    const uint2 lo = *(const uint2*)vp, hi = *(const uint2*)(vp + 8);
                    typedef unsigned u32x4 __attribute__((ext_vector_type(4)));
                    u32x4 av; av[0] = lo.x; av[1] = lo.y; av[2] = hi.x; av[3] = hi.y;
                    const bf16x8 a = __builtin_bit_cast(bf16x8, av);
#pragma unroll
                    for (int qb = 0; qb < 2; ++qb) acc[dvb][qb] = __builtin_amdgcn_mfma_f32_32x32x16_bf16(a, pf[kb][s2][qb], acc[dvb][qb], 0, 0, 0);
                }
    }
    float* red = (float*)smem;
    float mu[2], rstd[2];
    __syncthreads();
#pragma unroll
    for (int qb = 0; qb < 2; ++qb) {
        float s1 = 0.f, s2 = 0.f;
#pragma unroll
        for (int dvb = 0; dvb < 2; ++dvb)
#pragma unroll
            for (int i = 0; i < 16; ++i) { const float x = acc[dvb][qb][i]; s1 += x; s2 += x * x; }
        s1 += __shfl_xor(s1, 32); s2 += __shfl_xor(s2, 32);
        if (hf == 0) { red[(w * 64 + qb * 32 + r) * 2] = s1; red[(w * 64 + qb * 32 + r) * 2 + 1] = s2; }
    }
    __syncthreads();
#pragma unroll
    for (int qb = 0; qb < 2; ++qb) {
        float s1 = 0.f, s2 = 0.f;
#pragma unroll
        for (int ww = 0; ww < 4; ++ww) { s1 += red[(ww * 64 + qb * 32 + r) * 2]; s2 += red[(ww * 64 + qb * 32 + r) * 2 + 1]; }
        const float m_ = s1 * (1.f / 256.f);
        mu[qb] = m_; rstd[qb] = rsqrtf(fmaxf(s2 * (1.f / 256.f) - m_ * m_, 0.f) + LN_EPS);
    }
    const float* gr = p.g_ret + (size_t)l * 1024 + hd * 256 + w * 64;
#pragma unroll
    for (int dvb = 0; dvb < 2; ++dvb)
#pragma unroll
        for (int g = 0; g < 4; ++g) {
            const int dv = dvb * 32 + 8 * g + 4 * hf;
            const f32x4 gg = *(const f32x4*)(gr + dv);
#pragma unroll
            for (int qb = 0; qb < 2; ++qb) {
                const size_t off = (t0 + qb * 32 + r) * 1024 + hd * 256 + w * 64 + dv;
                const uint2 cgv = *(const uint2*)(p.cg + off);
                f32x4 y;
#pragma unroll
                for (int jj = 0; jj < 4; ++jj) y[jj] = (acc[dvb][qb][4 * g + jj] - mu[qb]) * rstd[qb] * gg[jj];
                y[0] *= bflo(cgv.x); y[1] *= bfhi(cgv.x); y[2] *= bflo(cgv.y); y[3] *= bfhi(cgv.y);
                st4(p.yc + off, y);
            }
        }
}

DI void phase_mixers(const Params& p, int l, unsigned char* smem) {
    const int nF = 64 * 24, nC = 2 * 4 * 128;
    int* sitem = (int*)(smem + SMEM_BYTES - 16);
    for (;;) {
        __syncthreads();
        if (otid() == 0) *sitem = (int)atomicAdd(p.ctr + l, 1u);
        __syncthreads();
        const int it = *sitem;
        if (it >= nF + nC) break;
        if (it < nF) {
            const int qi = 63 - it / 24, r = it % 24;
            if (r < 8) flash_item<1>(p, r >> 2, r & 3, qi, smem);
            else flash_item<0>(p, (r - 8) >> 3, (r - 8) & 7, qi, smem);
        } else ret_state_item(p, it - nF);
    }
}

DI void phase_mixers_naive(const Params& p) {
    const int nA = 2 * 8 * 128, nB = 2 * 4 * 128, nC = 2 * 4 * 128;
    for (int it = obid(); it < nA + nB + nC; it += gridDim.x) {
        if (it < nB) naive_attn<1>(p, it);
        else if (it < nB + nC) naive_attn<2>(p, it - nB);
        else naive_attn<0>(p, it - nB - nC);
    }
}

DI void phase_post(const Params& p, int l) {
    const int lane = otid() & 63, wv = otid() >> 6;
    const float lam = p.lamv[2 * l], li = p.lamv[2 * l + 1];
    const float* gd = p.g_diff + (size_t)l * 512; const float* gr = p.g_ret + (size_t)l * 1024;
    for (int row = obid() * 4 + wv; row < T; row += gridDim.x * 4) {
#pragma unroll
        for (int hh = 0; hh < 4; ++hh) {
            const unsigned o0 = *(const unsigned*)(p.oa + (size_t)row * 1024 + (2 * hh) * 128 + lane * 2);
            const unsigned o1 = *(const unsigned*)(p.oa + (size_t)row * 1024 + (2 * hh + 1) * 128 + lane * 2);
            const float d0 = bflo(o0) - lam * bflo(o1), d1 = bfhi(o0) - lam * bfhi(o1);
            float ss = d0 * d0 + d1 * d1;
            for (int o = 32; o; o >>= 1) ss += __shfl_xor(ss, o);
            const float r = rsqrtf(ss * (1.f / 128.f) + LN_EPS) * (1.f - li);
            const int c = hh * 128 + lane * 2;
            *(unsigned*)(p.ya + (size_t)row * 512 + c) = pack2(d0 * r * gd[c], d1 * r * gd[c + 1]);
        }
    }
}

DI void grid_bar(unsigned* bar, unsigned& epoch) {
    asm volatile("s_waitcnt vmcnt(0) lgkmcnt(0)" ::: "memory");
    __syncthreads();
    epoch += gridDim.x;
    if (otid() == 0) {
        __builtin_amdgcn_fence(__ATOMIC_RELEASE, "agent");
        asm volatile("s_waitcnt vmcnt(0)" ::: "memory");
        __hip_atomic_fetch_add(bar, 1u, __ATOMIC_RELAXED, __HIP_MEMORY_SCOPE_AGENT);
        while (__hip_atomic_load(bar, __ATOMIC_RELAXED, __HIP_MEMORY_SCOPE_AGENT) < epoch) __builtin_amdgcn_s_sleep(1);
        __builtin_amdgcn_fence(__ATOMIC_ACQUIRE, "agent");
        asm volatile("s_waitcnt vmcnt(0)" ::: "memory");
    }
    __syncthreads();
}
#define GSYNC() grid_bar(p.bar, epoch)
__global__ void __launch_bounds__(256, 2) fwd_kernel(Params p) {
    __shared__ __attribute__((aligned(16))) unsigned char smem[SMEM_BYTES];
    cg::grid_group grid = cg::this_grid();
    bf16_t* sm = (bf16_t*)smem; float* smf = (float*)smem;

    unsigned epoch = 0;
    asm volatile("s_waitcnt vmcnt(0) lgkmcnt(0)" ::: "memory"); grid.sync();
    convert_layer(p, 0, smf);
    phase0_misc(p, smf);
    GSYNC();
    row_phase(p, p.x, false, nullptr, nullptr, nullptr, p.mod, 0, 1024, true, true);
    GSYNC();
    for (int l = 0; l < DEPTH; ++l) {
        const float* modl = p.mod + (size_t)l * 2 * 6144;
        const float* xcur = l == 0 ? p.x : p.xbuf;
        if (obid() >= gridDim.x - 8) scan_item(p, obid() - (gridDim.x - 8), smf);
        phase_inproj(p, sm);
        GSYNC();
        phase_mixers(p, l, smem);
        GSYNC();
        phase_post(p, l);
        ret_scan(p);
        GSYNC();
        for (int it = obid(); it < 1024; it += gridDim.x) ret_out_item(p, l, it, smem);
        GSYNC();
        phase_branch(p, sm);
        GSYNC();
        phase_gemm_res(p, p.h, 1024, p.WoutT, xcur, modl, 2048, sm);
        GSYNC();
        row_phase(p, p.vbuf, true, p.ln_g + (size_t)(l * 2) * Dm, p.ln_b + (size_t)(l * 2) * Dm, p.xbuf, modl, 3072, 4096, true, false);
        GSYNC();
        phase_up(p, sm);
        GSYNC();
        phase_conv(p, l);
        GSYNC();
        phase_gemm_res(p, p.act, DFF, p.WdownT, p.xbuf, modl, 5120, sm);
        GSYNC();
        if (l + 1 < DEPTH) {
            convert_layer(p, l + 1, smf);
            GSYNC();
            row_phase(p, p.vbuf, true, p.ln_g + (size_t)(l * 2 + 1) * Dm, p.ln_b + (size_t)(l * 2 + 1) * Dm, p.xbuf, modl + 2 * 6144, 0, 1024, true, true);
            GSYNC();
        } else {
            row_phase(p, p.vbuf, true, p.ln_g + (size_t)(l * 2 + 1) * Dm, p.ln_b + (size_t)(l * 2 + 1) * Dm, p.out, modl, 0, 1024, false, false);
        }
    }
}

extern "C" void kernel_launch(void* const* d_in, const int* in_sizes, int n_in, void* d_out, int out_size, void* d_ws, size_t ws_size, hipStream_t stream) {
    static int grid_blocks = 0;
    if (!grid_blocks) {
        int dev = 0, cus = 0, per_cu = 0;
        hipGetDevice(&dev);
        hipDeviceGetAttribute(&cus, hipDeviceAttributeMultiprocessorCount, dev);
        hipOccupancyMaxActiveBlocksPerMultiprocessor(&per_cu, fwd_kernel, 256, 0);
        if (per_cu > 2) per_cu = 2;
        if (per_cu < 1) per_cu = 1;
        grid_blocks = cus * per_cu;
    }
    Params p{};
    const float** ins = (const float**)&p.x;
    for (int i = 0; i < 22; ++i) ins[i] = (const float*)d_in[i];
    p.out = (float*)d_out;
    char* w = (char*)d_ws; size_t off = 0;
    auto take = [&](size_t bytes) { char* r = w + off; off += (bytes + 255) & ~(size_t)255; return r; };
    const size_t MB = 1u << 20;
    p.mod = (float*)take((size_t)DEPTH * 2 * 6144 * 4);
    p.lamv = (float*)take(256);
    p.ctr = (unsigned*)take(256);
    p.bar = (unsigned*)take(256);
    p.wf = (float*)take(4100 * 4);
    p.binp = (float*)take(NIN * 4);
    p.cstab = (float*)take((size_t)S * 64 * 2 * 4);
    p.logf = (float*)take((size_t)T * 4 * 4);
    p.F = (float*)take((size_t)T * 4 * 4);
    p.WinT = (bf16_t*)take((size_t)NIN * 1024 * 2);
    p.WpaT = (bf16_t*)take((size_t)1024 * 512 * 2);
    p.WpbT = (bf16_t*)take((size_t)1024 * 512 * 2);
    p.WpcT = (bf16_t*)take((size_t)1024 * 1024 * 2);
    p.WoutT = (bf16_t*)take((size_t)1024 * 1024 * 2);
    p.WupT = (bf16_t*)take((size_t)2 * DFF * 1024 * 2);
    p.WdownT = (bf16_t*)take((size_t)1024 * DFF * 2);
    p.xbuf = (float*)take((size_t)T * Dm * 4);
    p.h = (bf16_t*)take((size_t)T * Dm * 2);
    const size_t offA = off;
    p.qa = (bf16_t*)take((size_t)T * 512 * 2); p.ka = (bf16_t*)take((size_t)T * 512 * 2); p.vta = (bf16_t*)take((size_t)T * 512 * 2);
    p.qb = (bf16_t*)take((size_t)T * 512 * 2); p.kb = (bf16_t*)take((size_t)T * 512 * 2); p.vtb = (bf16_t*)take((size_t)T * 512 * 2);
    p.cq = (bf16_t*)take((size_t)T * 512 * 2); p.ck = (bf16_t*)take((size_t)T * 512 * 2);
    p.cv = (bf16_t*)take((size_t)T * 1024 * 2); p.cg = (bf16_t*)take((size_t)T * 1024 * 2);
    p.gates = (bf16_t*)take((size_t)T * 3072 * 2);
    const size_t endA = off;
    p.ug = (bf16_t*)(w + offA);
    p.act = (bf16_t*)(w + offA + (size_t)T * 2 * DFF * 2);
    const size_t offB = endA;
    off = offB;
    p.vbuf = (float*)(w + offB);
    p.oa = p.h;
    p.yb = (bf16_t*)take((size_t)T * 512 * 2);
    p.kv = (bf16_t*)take((size_t)8 * 128 * 256 * 128 * 2);
    p.ckT = (bf16_t*)take((size_t)T * 512 * 2);
    p.ya = (bf16_t*)take((size_t)T * 512 * 2);
    p.yc = (bf16_t*)take((size_t)T * 1024 * 2);
    if (off > ws_size || (size_t)T * 2 * DFF * 2 + (size_t)T * DFF * 2 > endA - offA) {
        fprintf(stderr, "kernel_launch: workspace too small: need %zu MB have %zu MB\n", off / MB, ws_size / MB);
        return;
    }
    (void)hipMemsetAsync(p.bar, 0, 256, stream);
    void* args[] = {&p};
    hipError_t e = hipLaunchCooperativeKernel((void*)fwd_kernel, dim3(grid_blocks), dim3(256), args, 0, stream);
    if (e != hipSuccess) fprintf(stderr, "cooperative launch failed: %s (grid %d)\n", hipGetErrorString(e), grid_blocks);
}
```

```cpp
#include <hip/hip_runtime.h>
#include <hip/hip_cooperative_groups.h>
#include <cstdio>
#include <cstdint>
namespace cg = cooperative_groups;

typedef unsigned short bf16_t;
typedef short bf16x8 __attribute__((ext_vector_type(8)));
typedef float f32x4 __attribute__((ext_vector_type(4)));

constexpr int Dm = 1024, NB = 2, S = 8192, T = NB * S, DEPTH = 4, DFF = 2816, DIN = 9220, NIN = 9216;
constexpr float LN_EPS = 1e-5f;
constexpr float LOG2E = 1.4426950408889634f;
#define ALPHA_F 1.681792830507429f

#define DI __device__ __forceinline__
DI int otid() { int t = threadIdx.x; asm volatile("" : "+v"(t)); return t; }
DI int obid() { int b = blockIdx.x; asm volatile("" : "+s"(b)); return b; }

typedef __bf16 hbf2 __attribute__((ext_vector_type(2)));
typedef float f32x2 __attribute__((ext_vector_type(2)));
DI bf16_t f2bf(float x) { return __builtin_bit_cast(unsigned short, (__bf16)x); }
DI float bf2f(bf16_t v) { return __uint_as_float(((unsigned)v) << 16); }
DI float bflo(unsigned w) { return __uint_as_float(w << 16); }
DI float bfhi(unsigned w) { return __uint_as_float(w & 0xffff0000u); }
DI unsigned pack2(float a, float b) { f32x2 v = {a, b}; return __builtin_bit_cast(unsigned, __builtin_convertvector(v, hbf2)); }

struct Params {
    const float *x, *c, *w_ada, *b_ada, *w_in, *b_in, *lq1, *lk1, *lq2, *lk2, *g_diff, *g_ret, *w_pa, *w_pb, *w_pc, *w_out, *ln_g, *ln_b, *w_up, *w_conv, *b_conv, *w_down;
    float* out;
    unsigned* ctr; unsigned* bar;
    float *mod, *lamv, *wf, *binp, *cstab, *xbuf, *vbuf, *logf, *F, *oc;
    bf16_t *WinT, *WpaT, *WpbT, *WpcT, *WoutT, *WupT, *WdownT;
    bf16_t *h, *qa, *ka, *vta, *qb, *kb, *vtb, *cq, *ck, *cv, *cg, *gates, *oa, *yb, *ya, *yc, *ug, *act, *ckT, *kv;
};

#define LDS_BARRIER() do { asm volatile("s_waitcnt lgkmcnt(0)" ::: "memory"); __builtin_amdgcn_s_barrier(); asm volatile("" ::: "memory"); } while (0)
constexpr int BM = 128, BN = 128, BK = 64, LDP = BK + 8;
constexpr int SMEM_BYTES = 2 * (BM + BN) * LDP * 2;

DI int win_map(int n) {
    if (n < 3072) return n;
    if (n < 4096) { int r = n - 3072; int seg = r >> 9; r &= 511; int head = r >> 7; int c = r & 127; return 3076 + seg * 512 + head * 128 + (c >> 1) + 64 * (c & 1); }
    return n + 4;
}

DI void convert_tile(const float* __restrict__ src, int ldsrc, bf16_t* __restrict__ dst, int K, int tiles_n, int tile, int kind, float* lds) {
    const int tn = tile % tiles_n, tk = tile / tiles_n;
    const int tx = otid() & 63, ty = otid() >> 6;
    const int n = tn * 64 + tx;
    const int sn = kind == 1 ? win_map(n) : n;
    __syncthreads();
#pragma unroll 4
    for (int r = 0; r < 16; ++r) {
        const int kk = ty * 16 + r;
        lds[kk * 65 + tx] = src[(size_t)(tk * 64 + kk) * ldsrc + sn];
    }
    __syncthreads();
#pragma unroll 4
    for (int r = 0; r < 16; ++r) {
        const int nn = ty * 16 + r;
        dst[(size_t)(tn * 64 + nn) * K + tk * 64 + tx] = f2bf(lds[tx * 65 + nn]);
    }
}

DI void convert_layer(const Params& p, int l, float* lds) {
    const int n_in = 16 * 144, n_pa = 8 * 16, n_pb = 8 * 16, n_pc = 16 * 16, n_out = 16 * 16, n_up = 16 * 88, n_dn = 44 * 16;
    const int total = n_in + n_pa + n_pb + n_pc + n_out + n_up + n_dn;
    for (int it = obid(); it < total; it += gridDim.x) {
        int t = it;
        if (t < n_in) { convert_tile(p.w_in + (size_t)l * Dm * DIN, DIN, p.WinT, 1024, 144, t, 1, lds); continue; } t -= n_in;
        if (t < n_pa) { convert_tile(p.w_pa + (size_t)l * 512 * Dm, Dm, p.WpaT, 512, 16, t, 0, lds); continue; } t -= n_pa;
        if (t < n_pb) { convert_tile(p.w_pb + (size_t)l * 512 * Dm, Dm, p.WpbT, 512, 16, t, 0, lds); continue; } t -= n_pb;
        if (t < n_pc) { convert_tile(p.w_pc + (size_t)l * 1024 * Dm, Dm, p.WpcT, 1024, 16, t, 0, lds); continue; } t -= n_pc;
        if (t < n_out) { convert_tile(p.w_out + (size_t)l * Dm * Dm, Dm, p.WoutT, 1024, 16, t, 0, lds); continue; } t -= n_out;
        if (t < n_up) { convert_tile(p.w_up + (size_t)l * Dm * 2 * DFF, 2 * DFF, p.WupT, 1024, 88, t, 0, lds); continue; } t -= n_up;
        convert_tile(p.w_down + (size_t)l * DFF * Dm, Dm, p.WdownT, DFF, 16, t, 0, lds);
    }
    const int gtid = obid() * blockDim.x + otid(), gsz = gridDim.x * blockDim.x;
    for (int i = gtid; i < NIN; i += gsz) p.binp[i] = p.b_in[(size_t)l * DIN + win_map(i)];
    for (int i = gtid; i < 4096; i += gsz) { const int k = i >> 2, hh = i & 3; p.wf[i] = p.w_in[(size_t)l * Dm * DIN + (size_t)k * DIN + 3072 + hh]; }
    for (int i = gtid; i < 4; i += gsz) p.wf[4096 + i] = p.b_in[(size_t)l * DIN + 3072 + i];
}

DI float ex2(float x) { return __builtin_amdgcn_exp2f(x); }
DI float lg2gamma(int hd) { return hd == 0 ? -0.04580368961312479f : hd == 1 ? -0.02272007650008353f : hd == 2 ? -0.011315313227834146f : -0.005646563141142063f; }
DI float silu_f(float v) { return v / (1.f + __expf(-v)); }
DI float sigmoid_f(float v) { return 1.f / (1.f + __expf(-v)); }

DI void phase0_misc(const Params& p, float* lds) {
    for (int it = obid(); it < DEPTH * 96; it += gridDim.x) {
        const int l = it / 96, jb = it % 96;
        const int tx = otid() & 63, ks = otid() >> 6;
        const int j = jb * 64 + tx;
        const float* w = p.w_ada + (size_t)l * Dm * 6144 + j;
        float a0 = 0.f, a1 = 0.f;
#pragma unroll 8
        for (int k = ks * 256; k < ks * 256 + 256; ++k) {
            const float wv = w[(size_t)k * 6144];
            a0 += silu_f(p.c[k]) * wv; a1 += silu_f(p.c[Dm + k]) * wv;
        }
        __syncthreads();
        lds[(ks * 64 + tx) * 2] = a0; lds[(ks * 64 + tx) * 2 + 1] = a1;
        __syncthreads();
        if (ks == 0) {
            float s0 = 0.f, s1 = 0.f;
            for (int q = 0; q < 4; ++q) { s0 += lds[(q * 64 + tx) * 2]; s1 += lds[(q * 64 + tx) * 2 + 1]; }
            const float bb = p.b_ada[(size_t)l * 6144 + j];
            p.mod[((size_t)l * 2 + 0) * 6144 + j] = s0 + bb;
            p.mod[((size_t)l * 2 + 1) * 6144 + j] = s1 + bb;
        }
    }
    const int gtid = obid() * blockDim.x + otid(), gsz = gridDim.x * blockDim.x;
    if (gtid < 64) p.ctr[gtid] = 0u;
    if (obid() == 0 && otid() < 64 * DEPTH) {
        const int l = otid() >> 6, ln = otid() & 63;
        float a = p.lq1[l * 64 + ln] * p.lk1[l * 64 + ln], b = p.lq2[l * 64 + ln] * p.lk2[l * 64 + ln];
        for (int o = 32; o; o >>= 1) { a += __shfl_xor(a, o); b += __shfl_xor(b, o); }
        if (ln == 0) { const float li = 0.8f - 0.6f * expf(-0.3f * (float)l); p.lamv[2 * l] = expf(a) - expf(b) + li; p.lamv[2 * l + 1] = li; }
    }
}

DI void row_phase(const Params& p, const float* __restrict__ src, bool do_ln, const float* __restrict__ lng, const float* __restrict__ lnb,
                  float* __restrict__ xdst, const float* __restrict__ modl  , int sh_off, int sc_off, bool want_h, bool want_logf) {
    const int lane = otid() & 63, wv = otid() >> 6;
    for (int row = obid() * 4 + wv; row < T; row += gridDim.x * 4) {
        const int b = row / S;
        const float* sp = src + (size_t)row * Dm;
        f32x4 v[4];
#pragma unroll
        for (int i = 0; i < 4; ++i) v[i] = *(const f32x4*)(sp + i * 256 + lane * 4);
        if (do_ln) {
            float s = 0.f;
#pragma unroll
            for (int i = 0; i < 4; ++i) s += (v[i][0] + v[i][1]) + (v[i][2] + v[i][3]);
            for (int o = 32; o; o >>= 1) s += __shfl_xor(s, o);
            const float mu = s * (1.f / 1024.f);
            float q = 0.f;
#pragma unroll
            for (int i = 0; i < 4; ++i) { f32x4 d = v[i] - mu; q += (d[0] * d[0] + d[1] * d[1]) + (d[2] * d[2] + d[3] * d[3]); }
            for (int o = 32; o; o >>= 1) q += __shfl_xor(q, o);
            const float rstd = rsqrtf(q * (1.f / 1024.f) + LN_EPS);
#pragma unroll
            for (int i = 0; i < 4; ++i) {
                const f32x4 g = *(const f32x4*)(lng + i * 256 + lane * 4), bb = *(const f32x4*)(lnb + i * 256 + lane * 4);
                v[i] = (v[i] - mu) * rstd * g + bb;
            }
        }
        if (xdst) {
#pragma unroll
            for (int i = 0; i < 4; ++i) *(f32x4*)(xdst + (size_t)row * Dm + i * 256 + lane * 4) = v[i];
        }
        if (want_h) {
            const float* mb = modl + (size_t)b * 6144;
            float d0 = 0.f, d1 = 0.f, d2 = 0.f, d3 = 0.f;
#pragma unroll
            for (int i = 0; i < 4; ++i) {
                const int c0 = i * 256 + lane * 4;
                const f32x4 sc = *(const f32x4*)(mb + sc_off + c0), sh = *(const f32x4*)(mb + sh_off + c0);
                const f32x4 hv = v[i] * (1.f + sc) + sh;
                uint2 w; w.x = pack2(hv[0], hv[1]); w.y = pack2(hv[2], hv[3]);
                *(uint2*)(p.h + (size_t)row * Dm + c0) = w;
                if (want_logf) {
#pragma unroll
                    for (int j = 0; j < 4; ++j) {
                        const f32x4 wf = *(const f32x4*)(p.wf + (c0 + j) * 4);
                        d0 += hv[j] * wf[0]; d1 += hv[j] * wf[1]; d2 += hv[j] * wf[2]; d3 += hv[j] * wf[3];
                    }
                }
            }
            if (want_logf) {
                for (int o = 32; o; o >>= 1) { d0 += __shfl_xor(d0, o); d1 += __shfl_xor(d1, o); d2 += __shfl_xor(d2, o); d3 += __shfl_xor(d3, o); }
                if (lane < 4) {
                    float z = (lane == 0 ? d0 : lane == 1 ? d1 : lane == 2 ? d2 : d3) + p.wf[4096 + lane];
                    const float ls = fminf(z, 0.f) - log1pf(__expf(-fabsf(z)));
                    p.logf[(size_t)row * 4 + lane] = ls * LOG2E;
                }
            }
        }
    }
}

DI void scan_item(const Params& p, int item, float* lds) {
    const int b = item >> 2, hh = item & 3, tid = otid();
    const float* lp = p.logf + (size_t)b * S * 4 + hh;
    float loc[32]; float s = 0.f;
#pragma unroll
    for (int i = 0; i < 32; ++i) { s += lp[(size_t)(tid * 32 + i) * 4]; loc[i] = s; }
    __syncthreads();
    lds[tid] = s;
    __syncthreads();
    float pre = 0.f;
    for (int i = 0; i < tid; ++i) pre += lds[i];
    float* fp = p.F + (size_t)(b * 4 + hh) * S + tid * 32;
#pragma unroll
    for (int i = 0; i < 32; ++i) fp[i] = pre + loc[i];
    __syncthreads();
}

DI void gemm_kloop(const bf16_t* __restrict__ Ag, int lda, const bf16_t* __restrict__ Bg, int ldb, int K, f32x4 (&acc)[4][4], bf16_t* sm) {
    const int tid = otid(), lane = tid & 63, wid = tid >> 6, wr = wid >> 1, wc = wid & 1;
    bf16_t* sa = sm; bf16_t* sb = sm + 2 * BM * LDP;
    const int lrow = tid >> 3, lcc = tid & 7;
    const bf16_t* ap = Ag + (size_t)lrow * lda + lcc * 8;
    const bf16_t* bp = Bg + (size_t)lrow * ldb + lcc * 8;
    const size_t sA = (size_t)32 * lda, sB = (size_t)32 * ldb;
    uint4 ra0, ra1, ra2, ra3, rb0, rb1, rb2, rb3;
#define G_LOAD(koff) do { ra0 = *(const uint4*)(ap + (koff)); ra1 = *(const uint4*)(ap + sA + (koff)); ra2 = *(const uint4*)(ap + 2 * sA + (koff)); ra3 = *(const uint4*)(ap + 3 * sA + (koff)); \
                          rb0 = *(const uint4*)(bp + (koff)); rb1 = *(const uint4*)(bp + sB + (koff)); rb2 = *(const uint4*)(bp + 2 * sB + (koff)); rb3 = *(const uint4*)(bp + 3 * sB + (koff)); } while (0)
#define G_STORE(buf) do { bf16_t* da_ = sa + (buf) * BM * LDP + lrow * LDP + lcc * 8; bf16_t* db_ = sb + (buf) * BN * LDP + lrow * LDP + lcc * 8; \
        *(uint4*)(da_) = ra0; *(uint4*)(da_ + 32 * LDP) = ra1; *(uint4*)(da_ + 64 * LDP) = ra2; *(uint4*)(da_ + 96 * LDP) = ra3; \
        *(uint4*)(db_) = rb0; *(uint4*)(db_ + 32 * LDP) = rb1; *(uint4*)(db_ + 64 * LDP) = rb2; *(uint4*)(db_ + 96 * LDP) = rb3; } while (0)
    G_LOAD(0);
    G_STORE(0);
    LDS_BARRIER();
    const int nk = K / BK;
    const int fr = lane & 15, fq = lane >> 4;
    for (int kt = 0; kt < nk; ++kt) {
        const int cur = kt & 1;
        const bool more = kt + 1 < nk;
        if (more) G_LOAD((kt + 1) * BK);
        const bf16_t* ca = sa + cur * BM * LDP + (wr * 64 + fr) * LDP + fq * 8;
        const bf16_t* cb = sb + cur * BN * LDP + (wc * 64 + fr) * LDP + fq * 8;
#pragma unroll
        for (int kk = 0; kk < 2; ++kk) {
            bf16x8 af[4], bfr[4];
#pragma unroll
            for (int m = 0; m < 4; ++m) af[m] = *(const bf16x8*)(ca + m * 16 * LDP + kk * 32);
#pragma unroll
            for (int n = 0; n < 4; ++n) bfr[n] = *(const bf16x8*)(cb + n * 16 * LDP + kk * 32);
#pragma unroll
            for (int m = 0; m < 4; ++m)
#pragma unroll
                for (int n = 0; n < 4; ++n) acc[m][n] = __builtin_amdgcn_mfma_f32_16x16x32_bf16(bfr[n], af[m], acc[m][n], 0, 0, 0);
        }
        if (more) G_STORE(cur ^ 1);
        LDS_BARRIER();
    }
#undef G_LOAD
#undef G_STORE
}

DI void gemm_kloop2(const bf16_t* __restrict__ Ag, int lda, const bf16_t* __restrict__ Bg, int ldb, int K, f32x4 (&acc)[4][4], bf16_t* sm) {
    const int tid = otid(), lane = tid & 63, wid = tid >> 6, wr = wid >> 1, wc = wid & 1;
    bf16_t* sa = sm; bf16_t* sb = sm + 2 * BM * LDP;
    const int lrow = tid >> 3, lcc = tid & 7;
    const bf16_t* ap = Ag + (size_t)lrow * lda + lcc * 8;
    const bf16_t* bp = Bg + (size_t)lrow * ldb + lcc * 8;
    const size_t sA = (size_t)32 * lda, sB = (size_t)32 * ldb;
    uint4 xa0, xa1, xa2, xa3, xb0, xb1, xb2, xb3;
    uint4 ya0, ya1, ya2, ya3, yb0, yb1, yb2, yb3;
#define G2_LOAD(P, koff) do { P##a0 = *(const uint4*)(ap + (koff)); P##a1 = *(const uint4*)(ap + sA + (koff)); P##a2 = *(const uint4*)(ap + 2 * sA + (koff)); P##a3 = *(const uint4*)(ap + 3 * sA + (koff)); \
                              P##b0 = *(const uint4*)(bp + (koff)); P##b1 = *(const uint4*)(bp + sB + (koff)); P##b2 = *(const uint4*)(bp + 2 * sB + (koff)); P##b3 = *(const uint4*)(bp + 3 * sB + (koff)); } while (0)
#define G2_STORE(P, buf) do { bf16_t* da_ = sa + (buf) * BM * LDP + lrow * LDP + lcc * 8; bf16_t* db_ = sb + (buf) * BN * LDP + lrow * LDP + lcc * 8; \
        *(uint4*)(da_) = P##a0; *(uint4*)(da_ + 32 * LDP) = P##a1; *(uint4*)(da_ + 64 * LDP) = P##a2; *(uint4*)(da_ + 96 * LDP) = P##a3; \
        *(uint4*)(db_) = P##b0; *(uint4*)(db_ + 32 * LDP) = P##b1; *(uint4*)(db_ + 64 * LDP) = P##b2; *(uint4*)(db_ + 96 * LDP) = P##b3; } while (0)
#define G2_COMPUTE(buf) do { \
        const bf16_t* ca = sa + (buf) * BM * LDP + (wr * 64 + fr) * LDP + fq * 8; \
        const bf16_t* cb = sb + (buf) * BN * LDP + (wc * 64 + fr) * LDP + fq * 8; \
        _Pragma("unroll") for (int kk = 0; kk < 2; ++kk) { \
            bf16x8 af[4], bfr[4]; \
            _Pragma("unroll") for (int m = 0; m < 4; ++m) af[m] = *(const bf16x8*)(ca + m * 16 * LDP + kk * 32); \
            _Pragma("unroll") for (int n = 0; n < 4; ++n) bfr[n] = *(const bf16x8*)(cb + n * 16 * LDP + kk * 32); \
            _Pragma("unroll") for (int m = 0; m < 4; ++m) _Pragma("unroll") for (int n = 0; n < 4; ++n) acc[m][n] = __builtin_amdgcn_mfma_f32_16x16x32_bf16(bfr[n], af[m], acc[m][n], 0, 0, 0); \
        } } while (0)
    const int nk = K / BK;
    const int fr = lane & 15, fq = lane >> 4;
    G2_LOAD(x, 0);
    G2_LOAD(y, BK);
    G2_STORE(x, 0);
    LDS_BARRIER();
    for (int kt = 0; kt < nk; kt += 2) {
        const int kx = kt + 2 < nk ? kt + 2 : nk - 2, ky = kt + 3 < nk ? kt + 3 : nk - 1;
        G2_LOAD(x, kx * BK);
        __builtin_amdgcn_sched_barrier(0);
        G2_COMPUTE(0);
        G2_STORE(y, 1);
        LDS_BARRIER();
        G2_LOAD(y, ky * BK);
        __builtin_amdgcn_sched_barrier(0);
        G2_COMPUTE(1);
        G2_STORE(x, 0);
        LDS_BARRIER();
    }
#undef G2_LOAD
#undef G2_STORE
#undef G2_COMPUTE
}

DI void tile_coords(int tile, int nM, int nN, int& mt, int& nt) {
    const int G = gridDim.x;
    if ((G & 7) == 0 && (nM & 63) == 0 && (nM * nN) % G == 0) {
        const int b = tile % G, k = tile / G, per = G >> 3;
        const int xcd = b & 7, slot = b >> 3;
        const int li = k * per + slot;
        const int mh = li / (8 * nN), rem = li % (8 * nN);
        nt = rem >> 3; mt = (mh * 8 + (rem & 7)) * 8 + xcd;
        return;
    }
    const int band = tile / (16 * nN), r = tile % (16 * nN);
    mt = band * 16 + (r & 15); nt = r >> 4;
}

DI void zero_acc(f32x4 (&acc)[4][4]) {
#pragma unroll
    for (int m = 0; m < 4; ++m)
#pragma unroll
        for (int n = 0; n < 4; ++n) acc[m][n] = (f32x4){0.f, 0.f, 0.f, 0.f};
}


constexpr int BM2 = 256, BK2 = 32, LDP2 = BK2 + 8;
DI void gemm_kloop3(const bf16_t* __restrict__ Ag, int lda, const bf16_t* __restrict__ Bg, int ldb, int K, f32x4 (&acc)[8][4], bf16_t* sm) {
    const int tid = otid(), lane = tid & 63, wid = tid >> 6, wr = wid >> 1, wc = wid & 1;
    bf16_t* sa = sm; bf16_t* sb = sm + 2 * BM2 * LDP2;
    const int lrow = tid >> 2, lcc = tid & 3;
    const bf16_t* ap = Ag + (size_t)lrow * lda + lcc * 8;
    const int prow = ((lrow >> 2) & 3) * 16 + (lrow >> 4) * 4 + (lrow & 3);
    const bf16_t* bp = Bg + (size_t)prow * ldb + lcc * 8;
    const size_t sA = (size_t)64 * lda, sB = (size_t)64 * ldb;
    const int fr = lane & 15, fq = lane >> 4;
    uint4 a0, a1, a2, a3, b0, b1;
#define G3_LOAD(koff) do { a0 = *(const uint4*)(ap + (koff)); a1 = *(const uint4*)(ap + sA + (koff)); a2 = *(const uint4*)(ap + 2 * sA + (koff)); a3 = *(const uint4*)(ap + 3 * sA + (koff)); \
                           b0 = *(const uint4*)(bp + (koff)); b1 = *(const uint4*)(bp + sB + (koff)); } while (0)
#define G3_STORE(buf) do { bf16_t* da_ = sa + (buf) * BM2 * LDP2 + lrow * LDP2 + lcc * 8; bf16_t* db_ = sb + (buf) * BN * LDP2 + lrow * LDP2 + lcc * 8; \
        *(uint4*)(da_) = a0; *(uint4*)(da_ + 64 * LDP2) = a1; *(uint4*)(da_ + 128 * LDP2) = a2; *(uint4*)(da_ + 192 * LDP2) = a3; \
        *(uint4*)(db_) = b0; *(uint4*)(db_ + 64 * LDP2) = b1; } while (0)
    G3_LOAD(0);
    G3_STORE(0);
    LDS_BARRIER();
    const int nk = K / BK2;
    for (int kt = 0; kt < nk; ++kt) {
        const int cur = kt & 1;
        const bool more = kt + 1 < nk;
        if (more) G3_LOAD((kt + 1) * BK2);
        const bf16_t* ca = sa + cur * BM2 * LDP2 + (wr * 128 + fr) * LDP2 + fq * 8;
        const bf16_t* cb = sb + cur * BN * LDP2 + (wc * 64 + fr) * LDP2 + fq * 8;
        bf16x8 af[8], bfr[4];
#pragma unroll
        for (int m = 0; m < 8; ++m) af[m] = *(const bf16x8*)(ca + m * 16 * LDP2);
#pragma unroll
        for (int n = 0; n < 4; ++n) bfr[n] = *(const bf16x8*)(cb + n * 16 * LDP2);
#pragma unroll
        for (int m = 0; m < 8; ++m)
#pragma unroll
            for (int n = 0; n < 4; ++n) acc[m][n] = __builtin_amdgcn_mfma_f32_16x16x32_bf16(bfr[n], af[m], acc[m][n], 0, 0, 0);
        if (more) G3_STORE(cur ^ 1);
        LDS_BARRIER();
    }
#undef G3_LOAD
#undef G3_STORE
}
DI void zero_acc8(f32x4 (&acc)[8][4]) {
#pragma unroll
    for (int m = 0; m < 8; ++m)
#pragma unroll
        for (int n = 0; n < 4; ++n) acc[m][n] = (f32x4){0.f, 0.f, 0.f, 0.f};
}
DI void st4_wt(bf16_t* dst, f32x4 v) { const unsigned long long w = (unsigned long long)pack2(v[0], v[1]) | ((unsigned long long)pack2(v[2], v[3]) << 32); __hip_atomic_store((unsigned long long*)dst, w, __ATOMIC_RELAXED, __HIP_MEMORY_SCOPE_AGENT); }
DI void st4(bf16_t* dst, f32x4 v) { uint2 w; w.x = pack2(v[0], v[1]); w.y = pack2(v[2], v[3]); *(uint2*)dst = w; }

DI void st8(bf16_t* dst, f32x4 a, f32x4 b) { uint4 w; w.x = pack2(a[0], a[1]); w.y = pack2(a[2], a[3]); w.z = pack2(b[0], b[1]); w.w = pack2(b[2], b[3]); *(uint4*)dst = w; }
DI f32x4 rot4(f32x4 v, int s, int i0) {
    const float a0 = (float)s * ex2(-(float)i0 * 0.21091607f), a1 = (float)s * ex2(-(float)(i0 + 1) * 0.21091607f);
    float r0 = a0 * 0.15915494309189535f, r1 = a1 * 0.15915494309189535f;
    r0 -= floorf(r0); r1 -= floorf(r1);
    float c0_ = __builtin_amdgcn_cosf(r0), s0_ = __builtin_amdgcn_sinf(r0), c1_ = __builtin_amdgcn_cosf(r1), s1_ = __builtin_amdgcn_sinf(r1);
    asm volatile("s_nop 15\n\ts_nop 15" : "+v"(c0_), "+v"(s0_), "+v"(c1_), "+v"(s1_));
    f32x4 o; o[0] = v[0] * c0_ - v[1] * s0_; o[1] = v[0] * s0_ + v[1] * c0_; o[2] = v[2] * c1_ - v[3] * s1_; o[3] = v[2] * s1_ + v[3] * c1_;
    return o;
}
DI void epi_inproj(const Params& p, int row, int col, f32x4 v0, f32x4 v1) {
    v0 += *(const f32x4*)(p.binp + col); v1 += *(const f32x4*)(p.binp + col + 4);
    const int b = row / S, s = row % S;
    if (col < 512) { st8(p.qa + (size_t)row * 512 + col, v0 * (0.125f * LOG2E), v1 * (0.125f * LOG2E)); }
    else if (col < 1024) { st8(p.ka + (size_t)row * 512 + (col - 512), v0, v1); }
    else if (col < 1536) { const int c = col - 1024, hh = c >> 7, e = c & 127; bf16_t* d = p.vta + ((size_t)(b * 4 + hh) * 128 + e) * S + s;
#pragma unroll
        for (int j = 0; j < 4; ++j) { d[(size_t)j * S] = f2bf(v0[j]); d[(size_t)(j + 4) * S] = f2bf(v1[j]); } }
    else if (col < 2048) { st8(p.qb + (size_t)row * 512 + (col - 1536), v0 * (0.08838834764831845f * LOG2E), v1 * (0.08838834764831845f * LOG2E)); }
    else if (col < 2560) { st8(p.kb + (size_t)row * 512 + (col - 2048), v0, v1); }
    else if (col < 3072) { const int c = col - 2560, hh = c >> 7, e = c & 127; bf16_t* d = p.vtb + ((size_t)(b * 4 + hh) * 128 + e) * S + s;
#pragma unroll
        for (int j = 0; j < 4; ++j) { d[(size_t)j * S] = f2bf(v0[j]); d[(size_t)(j + 4) * S] = f2bf(v1[j]); } }
    else if (col < 4096) {
        const int r = col - 3072, seg = r >> 9, c = r & 511, cc = c & 127, i0 = cc >> 1, hd = c >> 7;
        f32x4 o0 = rot4(v0, s, i0), o1 = rot4(v1, s, i0 + 2);
        const float lg = lg2gamma(hd);
        const int ic = s & 63;
        float e1_ = ex2(lg * (float)(ic + 1)), e2_ = ex2(-lg * (float)(ic + 1)), e3_ = ex2(lg * (float)(63 - ic));
        asm volatile("s_nop 15\n\ts_nop 15" : "+v"(e1_), "+v"(e2_), "+v"(e3_));
        if (seg == 0) st8(p.cq + (size_t)row * 512 + c, o0 * e1_, o1 * e1_);
        else {
            o0 = o0 * 0.08838834764831845f; o1 = o1 * 0.08838834764831845f;
            st8(p.ck + (size_t)row * 512 + c, o0 * e2_, o1 * e2_);
            const f32x4 d0 = o0 * e3_, d1 = o1 * e3_;
            bf16_t* d = p.ckT + ((size_t)(b * 4 + hd) * 128 + cc) * S + s;
#pragma unroll
            for (int j = 0; j < 4; ++j) { d[(size_t)j * S] = f2bf(d0[j]); d[(size_t)(j + 4) * S] = f2bf(d1[j]); }
        }
    }
    else if (col < 5120) { const int c = col - 4096; bf16_t* d = p.cv + ((size_t)b * 1024 + c) * S + s;
#pragma unroll
        for (int j = 0; j < 4; ++j) { d[(size_t)j * S] = f2bf(v0[j]); d[(size_t)(j + 4) * S] = f2bf(v1[j]); } }
    else if (col < 6144) { f32x4 o0, o1; for (int j = 0; j < 4; ++j) { o0[j] = silu_f(v0[j]); o1[j] = silu_f(v1[j]); } st8(p.cg + (size_t)row * 1024 + (col - 5120), o0, o1); }
    else { f32x4 o0, o1; for (int j = 0; j < 4; ++j) { o0[j] = sigmoid_f(v0[j]); o1[j] = sigmoid_f(v1[j]); } st8(p.gates + (size_t)row * 3072 + (col - 6144), o0, o1); }
}

DI void phase_inproj(const Params& p, bf16_t* sm) {
    const int nM = T / BM2, nN = NIN / BN;
    const int lane = otid() & 63, wid = otid() >> 6, wr = wid >> 1, wc = wid & 1;
    for (int tile = obid(); tile < nM * nN; tile += gridDim.x) {
        int mt, nt; tile_coords(tile, nM, nN, mt, nt);
        f32x4 acc[8][4]; zero_acc8(acc);
        gemm_kloop3(p.h + (size_t)mt * BM2 * Dm, Dm, p.WinT + (size_t)nt * BN * Dm, Dm, Dm, acc, sm);
#pragma unroll
        for (int m = 0; m < 8; ++m)
#pragma unroll
            for (int n2 = 0; n2 < 2; ++n2) epi_inproj(p, mt * BM2 + wr * 128 + m * 16 + (lane & 15), nt * BN + wc * 64 + (lane >> 4) * 16 + n2 * 8, acc[m][2 * n2], acc[m][2 * n2 + 1]);
    }
}

DI void phase_branch(const Params& p, bf16_t* sm) {
    const int nM = T / BM, nN = Dm / BN;
    const int lane = otid() & 63, wid = otid() >> 6, wr = wid >> 1, wc = wid & 1;
    for (int tile = obid(); tile < nM * nN; tile += gridDim.x) {
        int mt, nt; tile_coords(tile, nM, nN, mt, nt);
        f32x4 tot[4][4]; zero_acc(tot);
#pragma unroll 1
        for (int br = 0; br < 3; ++br) {
            const bf16_t* A = br == 0 ? p.ya : br == 1 ? p.yb : p.yc;
            const bf16_t* W = br == 0 ? p.WpaT : br == 1 ? p.WpbT : p.WpcT;
            const int K = br == 2 ? 1024 : 512;
            f32x4 acc[4][4]; zero_acc(acc);
            gemm_kloop(A + (size_t)mt * BM * K, K, W + (size_t)nt * BN * K, K, K, acc, sm);
#pragma unroll
            for (int m = 0; m < 4; ++m)
#pragma unroll
                for (int n = 0; n < 4; ++n) {
                    const int row = mt * BM + wr * 64 + m * 16 + (lane & 15), col = nt * BN + wc * 64 + n * 16 + (lane >> 4) * 4;
                    const uint2 g = *(const uint2*)(p.gates + (size_t)row * 3072 + br * 1024 + col);
                    tot[m][n][0] += bflo(g.x) * acc[m][n][0]; tot[m][n][1] += bfhi(g.x) * acc[m][n][1];
                    tot[m][n][2] += bflo(g.y) * acc[m][n][2]; tot[m][n][3] += bfhi(g.y) * acc[m][n][3];
                }
        }
#pragma unroll
        for (int m = 0; m < 4; ++m)
#pragma unroll
            for (int n = 0; n < 4; ++n) {
                const int row = mt * BM + wr * 64 + m * 16 + (lane & 15), col = nt * BN + wc * 64 + n * 16 + (lane >> 4) * 4;
                st4(p.h + (size_t)row * Dm + col, tot[m][n]);
            }
    }
}

DI void phase_gemm_res(const Params& p, const bf16_t* A, int K, const bf16_t* Wt, const float* xres, const float* modl, int gt_off, bf16_t* sm) {
    const int nM = T / BM2, nN = Dm / BN;
    const int lane = otid() & 63, wid = otid() >> 6, wr = wid >> 1, wc = wid & 1;
    for (int tile = obid(); tile < nM * nN; tile += gridDim.x) {
        int mt, nt; tile_coords(tile, nM, nN, mt, nt);
        f32x4 acc[8][4]; zero_acc8(acc);
        gemm_kloop3(A + (size_t)mt * BM2 * K, K, Wt + (size_t)nt * BN * K, K, K, acc, sm);
#pragma unroll
        for (int m = 0; m < 8; ++m)
#pragma unroll
            for (int n = 0; n < 4; ++n) {
                const int row = mt * BM2 + wr * 128 + m * 16 + (lane & 15), col = nt * BN + wc * 64 + (lane >> 4) * 16 + n * 4;
                const int b = row / S;
                const f32x4 xr = *(const f32x4*)(xres + (size_t)row * Dm + col);
                const f32x4 gt = *(const f32x4*)(modl + (size_t)b * 6144 + gt_off + col);
                *(f32x4*)(p.vbuf + (size_t)row * Dm + col) = xr * ALPHA_F + gt * acc[m][n];
            }
    }
}

DI void phase_up(const Params& p, bf16_t* sm) {
    const int nM = T / BM2, nN = 2 * DFF / BN;
    const int lane = otid() & 63, wid = otid() >> 6, wr = wid >> 1, wc = wid & 1;
    for (int tile = obid(); tile < nM * nN; tile += gridDim.x) {
        int mt, nt; tile_coords(tile, nM, nN, mt, nt);
        f32x4 acc[8][4]; zero_acc8(acc);
        gemm_kloop3(p.h + (size_t)mt * BM2 * Dm, Dm, p.WupT + (size_t)nt * BN * Dm, Dm, Dm, acc, sm);
#pragma unroll
        for (int m = 0; m < 8; ++m)
#pragma unroll
            for (int n2 = 0; n2 < 2; ++n2) {
                const int row = mt * BM2 + wr * 128 + m * 16 + (lane & 15), col = nt * BN + wc * 64 + (lane >> 4) * 16 + n2 * 8;
                st8(p.ug + (size_t)row * (2 * DFF) + col, acc[m][2 * n2], acc[m][2 * n2 + 1]);
            }
    }
}

DI void phase_conv(const Params& p, int l) {
    const int gtid = obid() * blockDim.x + otid(), gsz = gridDim.x * blockDim.x;
    const float* wc = p.w_conv + (size_t)l * 3 * DFF; const float* bc = p.b_conv + (size_t)l * DFF;
    for (int i = gtid; i < T * (DFF / 8); i += gsz) {
        const int row = i / (DFF / 8), c8 = (i % (DFF / 8)) * 8, s = row % S;
        const bf16_t* up = p.ug + (size_t)row * (2 * DFF) + c8;
        const uint4 u0 = *(const uint4*)up;
        uint4 u1 = make_uint4(0, 0, 0, 0), u2 = make_uint4(0, 0, 0, 0);
        if (s >= 1) u1 = *(const uint4*)(up - 2 * DFF);
        if (s >= 2) u2 = *(const uint4*)(up - 4 * DFF);
        const uint4 gg = *(const uint4*)(up + DFF);
        const unsigned a0[4] = {u0.x, u0.y, u0.z, u0.w}, a1[4] = {u1.x, u1.y, u1.z, u1.w}, a2[4] = {u2.x, u2.y, u2.z, u2.w}, ag[4] = {gg.x, gg.y, gg.z, gg.w};
        unsigned o[4];
#pragma unroll
        for (int j = 0; j < 4; ++j) {
            float r[2];
#pragma unroll
            for (int hl = 0; hl < 2; ++hl) {
                const int cidx = c8 + 2 * j + hl;
                const float x0 = hl ? bfhi(a0[j]) : bflo(a0[j]), x1 = hl ? bfhi(a1[j]) : bflo(a1[j]), x2 = hl ? bfhi(a2[j]) : bflo(a2[j]), g = hl ? bfhi(ag[j]) : bflo(ag[j]);
                const float cv = bc[cidx] + wc[cidx] * x2 + wc[DFF + cidx] * x1 + wc[2 * DFF + cidx] * x0;
                r[hl] = 0.5f * cv * (1.f + erff(cv * 0.7071067811865476f)) * g;
            }
            o[j] = pack2(r[0], r[1]);
        }
        *(uint4*)(p.act + (size_t)row * DFF + c8) = make_uint4(o[0], o[1], o[2], o[3]);
    }
}

template <int MODE>
DI void naive_attn(const Params& p, int item) {
    constexpr int D = MODE == 0 ? 64 : 128;
    constexpr int DV = MODE == 2 ? 256 : 128;
    constexpr int SW = DV / 4;
    constexpr int NH = MODE == 0 ? 8 : 4;
    const int tid = otid(), lane = tid & 63;
    const int sl = __builtin_amdgcn_readfirstlane(tid >> 6);
    const int qblk = 127 - (item % 128), hh = (item / 128) % NH, b = item / (128 * NH);
    const int q = qblk * 64 + lane; const size_t tq = (size_t)b * S + q;
    const bf16_t *Q, *Kp;
    if (MODE == 0) { Q = p.qa + tq * 512 + hh * 64; Kp = p.ka + (size_t)b * S * 512 + hh * 64; }
    else if (MODE == 1) { Q = p.qb + tq * 512 + hh * 128; Kp = p.kb + (size_t)b * S * 512 + hh * 128; }
    else { Q = p.cq + tq * 512 + hh * 128; Kp = p.ck + (size_t)b * S * 512 + hh * 128; }
    unsigned qp[D / 2];
#pragma unroll
    for (int i = 0; i < D / 8; ++i) { const uint4 t = ((const uint4*)Q)[i]; qp[4 * i] = t.x; qp[4 * i + 1] = t.y; qp[4 * i + 2] = t.z; qp[4 * i + 3] = t.w; }
    float acc[SW];
#pragma unroll
    for (int i = 0; i < SW; ++i) acc[i] = 0.f;
    float mx = -INFINITY, lsum = 0.f;
    const int send = (qblk + 1) * 64;
    float Fq = 0.f; const float* Fk = nullptr;
    if (MODE == 1) { Fk = p.F + (size_t)(b * 4 + hh) * S; Fq = Fk[q]; }
    float lg = 0.f;
    if (MODE == 2) lg = log2f(1.0f - exp2f(-5.0f - (float)hh));
    for (int s = 0; s < send; ++s) {
        const uint4* kr = (const uint4*)(Kp + (size_t)s * 512);
        float sc = 0.f;
#pragma unroll
        for (int i = 0; i < D / 8; ++i) {
            const uint4 kv = kr[i];
            sc += bflo(qp[4 * i]) * bflo(kv.x) + bfhi(qp[4 * i]) * bfhi(kv.x);
            sc += bflo(qp[4 * i + 1]) * bflo(kv.y) + bfhi(qp[4 * i + 1]) * bfhi(kv.y);
            sc += bflo(qp[4 * i + 2]) * bflo(kv.z) + bfhi(qp[4 * i + 2]) * bfhi(kv.z);
            sc += bflo(qp[4 * i + 3]) * bflo(kv.w) + bfhi(qp[4 * i + 3]) * bfhi(kv.w);
            if ((i & 3) == 3) asm volatile("" ::: "memory");
        }
        float w, corr = 1.f;
        if (MODE == 2) {
            w = (s <= q) ? sc * exp2f((float)(q - s) * lg) : 0.f;
        } else {
            if (MODE == 1) sc += Fq - Fk[s];
            const bool valid = (MODE == 0) || (s <= q);
            if (valid) {
                const float mn = fmaxf(mx, sc);
                corr = exp2f(mx - mn); w = exp2f(sc - mn); mx = mn;
                lsum = lsum * corr + w;
            } else { w = 0.f; }
        }
        if (MODE == 2) {
            const uint4* vr = (const uint4*)(p.cv + ((size_t)b * S + s) * 1024 + hh * 256 + sl * SW);
#pragma unroll
            for (int i = 0; i < SW / 8; ++i) {
                const uint4 vv = vr[i];
                acc[8 * i] += w * bflo(vv.x); acc[8 * i + 1] += w * bfhi(vv.x); acc[8 * i + 2] += w * bflo(vv.y); acc[8 * i + 3] += w * bfhi(vv.y);
                acc[8 * i + 4] += w * bflo(vv.z); acc[8 * i + 5] += w * bfhi(vv.z); acc[8 * i + 6] += w * bflo(vv.w); acc[8 * i + 7] += w * bfhi(vv.w);
            }
        } else {
            const bf16_t* vt = (MODE == 0 ? p.vta + ((size_t)(b * 4 + (hh >> 1)) * 128 + sl * SW) * S : p.vtb + ((size_t)(b * 4 + hh) * 128 + sl * SW) * S) + s;
#pragma unroll
            for (int i = 0; i < SW; ++i) { acc[i] = acc[i] * corr + w * bf2f(*vt); vt += S; asm volatile("" : "+v"(vt)); }
        }
    }
    if (MODE == 2) {
        float* o = p.oc + tq * 1024 + hh * 256 + sl * SW;
#pragma unroll
        for (int i = 0; i < SW / 4; ++i) *(f32x4*)(o + 4 * i) = (f32x4){acc[4 * i], acc[4 * i + 1], acc[4 * i + 2], acc[4 * i + 3]};
    } else {
        const float inv = 1.f / lsum;
        bf16_t* o = (MODE == 0 ? p.oa + tq * 1024 + hh * 128 : p.yb + tq * 512 + hh * 128) + sl * SW;
#pragma unroll
        for (int i = 0; i < SW / 8; ++i) {
            uint4 w4; w4.x = pack2(acc[8 * i] * inv, acc[8 * i + 1] * inv); w4.y = pack2(acc[8 * i + 2] * inv, acc[8 * i + 3] * inv);
            w4.z = pack2(acc[8 * i + 4] * inv, acc[8 * i + 5] * inv); w4.w = pack2(acc[8 * i + 6] * inv, acc[8 * i + 7] * inv);
            ((uint4*)o)[i] = w4;
        }
    }
}


typedef float f32x16 __attribute__((ext_vector_type(16)));
DI bf16x8 pack8(float a0, float a1, float a2, float a3, float a4, float a5, float a6, float a7) {
    typedef unsigned u32x4 __attribute__((ext_vector_type(4)));
    u32x4 w; w[0] = pack2(a0, a1); w[1] = pack2(a2, a3); w[2] = pack2(a4, a5); w[3] = pack2(a6, a7);
    return __builtin_bit_cast(bf16x8, w);
}

template <int MODE>
DI void flash_item(const Params& p, int b, int hh, int qi, unsigned char* smem) {
    constexpr int D = MODE == 0 ? 64 : 128, KST = D + 8, VST = 68, KS = D / 16;
    constexpr int KBYTES = 64 * KST * 2, VBYTES = 128 * VST * 2, BUFB = KBYTES + VBYTES + 256;
    constexpr int NKC = D / 32, CPR = D / 8;
    const int tid = otid(), lane = tid & 63, w = tid >> 6, r = lane & 31, hf = lane >> 5;
    const int q0 = qi * 128 + w * 32;
    const size_t tq = (size_t)b * S + q0 + r;
    bf16x8 qf[KS];
    {
        const bf16_t* qptr = (MODE == 0 ? p.qa + tq * 512 + hh * 64 : p.qb + tq * 512 + hh * 128) + hf * 8;
#pragma unroll
        for (int ks = 0; ks < KS; ++ks) qf[ks] = *(const bf16x8*)(qptr + ks * 16);
    }
    const float* fbase = p.F + (size_t)(b * 4 + (MODE == 1 ? hh : 0)) * S;
    float Fq = 0.f; if (MODE == 1) Fq = fbase[q0 + r];
    const bf16_t* kbase = MODE == 0 ? p.ka + (size_t)b * S * 512 + hh * 64 : p.kb + (size_t)b * S * 512 + hh * 128;
    const bf16_t* vbase = MODE == 0 ? p.vta + (size_t)(b * 4 + (hh >> 1)) * 128 * S : p.vtb + (size_t)(b * 4 + hh) * 128 * S;
    const int ntiles = 2 * qi + 2, wlast = 2 * qi + (w >> 1);
    uint4 kr[NKC], vr[4]; f32x4 frg = {0.f, 0.f, 0.f, 0.f};
#define FL_GLOAD(j) do { \
        _Pragma("unroll") for (int i_ = 0; i_ < NKC; ++i_) { const int c_ = tid + 256 * i_; kr[i_] = *(const uint4*)(kbase + (size_t)(64 * (j) + c_ / CPR) * 512 + (c_ % CPR) * 8); } \
        _Pragma("unroll") for (int i_ = 0; i_ < 4; ++i_) { const int c_ = tid + 256 * i_; vr[i_] = *(const uint4*)(vbase + (size_t)(c_ >> 3) * S + 64 * (j) + (c_ & 7) * 8); } \
        if (MODE == 1 && tid < 16) frg = *(const f32x4*)(fbase + 64 * (j) + tid * 4); } while (0)
#define FL_SSTORE(buf) do { unsigned char* B_ = smem + (buf) * BUFB; \
        _Pragma("unroll") for (int i_ = 0; i_ < NKC; ++i_) { const int c_ = tid + 256 * i_; *(uint4*)(B_ + ((c_ / CPR) * KST + (c_ % CPR) * 8) * 2) = kr[i_]; } \
        _Pragma("unroll") for (int i_ = 0; i_ < 4; ++i_) { const int c_ = tid + 256 * i_; uint2* d_ = (uint2*)(B_ + KBYTES + ((c_ >> 3) * VST + (c_ & 7) * 8) * 2); d_[0] = make_uint2(vr[i_].x, vr[i_].y); d_[1] = make_uint2(vr[i_].z, vr[i_].w); } \
        if (MODE == 1 && tid < 16) *(f32x4*)(B_ + KBYTES + VBYTES + tid * 16) = frg; } while (0)
    FL_GLOAD(0);
    FL_SSTORE(0);
    LDS_BARRIER();
    f32x16 acc[4];
#pragma unroll
    for (int eb = 0; eb < 4; ++eb)
#pragma unroll
        for (int i = 0; i < 16; ++i) acc[eb][i] = 0.f;
    float mrun = -INFINITY, lsum = 0.f;
    for (int j = 0; j < ntiles; ++j) {
        const bool more = j + 1 < ntiles;
        if (more) FL_GLOAD(j + 1);
        if (j <= wlast) {
            const unsigned char* B = smem + (j & 1) * BUFB;
            f32x16 st[2];
#pragma unroll
            for (int kb = 0; kb < 2; ++kb) {
#pragma unroll
                for (int i = 0; i < 16; ++i) st[kb][i] = 0.f;
#pragma unroll
                for (int ks = 0; ks < KS; ++ks) {
                    const bf16x8 a = *(const bf16x8*)(B + ((kb * 32 + r) * KST + ks * 16 + hf * 8) * 2);
                    st[kb] = __builtin_amdgcn_mfma_f32_32x32x16_bf16(a, qf[ks], st[kb], 0, 0, 0);
                }
            }
            if (MODE == 1) {
                const float* Fl = (const float*)(B + KBYTES + VBYTES);
#pragma unroll
                for (int kb = 0; kb < 2; ++kb)
#pragma unroll
                    for (int g = 0; g < 4; ++g) {
                        const f32x4 fk = *(const f32x4*)(Fl + kb * 32 + 8 * g + 4 * hf);
#pragma unroll
                        for (int jj = 0; jj < 4; ++jj) st[kb][4 * g + jj] += Fq - fk[jj];
                    }
                if (j >= 2 * qi) {
                    const int qabs = q0 + r;
#pragma unroll
                    for (int kb = 0; kb < 2; ++kb)
#pragma unroll
                        for (int g = 0; g < 4; ++g)
#pragma unroll
                            for (int jj = 0; jj < 4; ++jj) { const int key = 64 * j + kb * 32 + 8 * g + 4 * hf + jj; if (key > qabs) st[kb][4 * g + jj] = -INFINITY; }
                }
            }
            float mt = st[0][0];
#pragma unroll
            for (int i = 1; i < 16; ++i) mt = fmaxf(mt, st[0][i]);
#pragma unroll
            for (int i = 0; i < 16; ++i) mt = fmaxf(mt, st[1][i]);
            mt = fmaxf(mt, __shfl_xor(mt, 32));
            const float mn = fmaxf(mrun, mt);
            const float corr = ex2(mrun - mn);
            mrun = mn; lsum *= corr;
#pragma unroll
            for (int kb = 0; kb < 2; ++kb)
#pragma unroll
                for (int i = 0; i < 16; ++i) { const float pv = ex2(st[kb][i] - mn); st[kb][i] = pv; lsum += pv; }
#pragma unroll
            for (int eb = 0; eb < 4; ++eb) acc[eb] *= corr;
#pragma unroll
            for (int kb = 0; kb < 2; ++kb)
#pragma unroll
                for (int s2 = 0; s2 < 2; ++s2) {
                    const bf16x8 pf = pack8(st[kb][8 * s2], st[kb][8 * s2 + 1], st[kb][8 * s2 + 2], st[kb][8 * s2 + 3], st[kb][8 * s2 + 4], st[kb][8 * s2 + 5], st[kb][8 * s2 + 6], st[kb][8 * s2 + 7]);
#pragma unroll
                    for (int eb = 0; eb < 4; ++eb) {
                        const unsigned char* vp = B + KBYTES + ((eb * 32 + r) * VST + kb * 32 + 16 * s2 + 4 * hf) * 2;
                        const uint2 lo = *(const uint2*)vp, hi = *(const uint2*)(vp + 16);
                        typedef unsigned u32x4 __attribute__((ext_vector_type(4)));
                        u32x4 av; av[0] = lo.x; av[1] = lo.y; av[2] = hi.x; av[3] = hi.y;
                        acc[eb] = __builtin_amdgcn_mfma_f32_32x32x16_bf16(__builtin_bit_cast(bf16x8, av), pf, acc[eb], 0, 0, 0);
                    }
                }
        }
        if (more) FL_SSTORE((j + 1) & 1);
        LDS_BARRIER();
    }
#undef FL_GLOAD
#undef FL_SSTORE
    const float inv = 1.f / (lsum + __shfl_xor(lsum, 32));
    bf16_t* o = MODE == 0 ? p.oa + tq * 1024 + hh * 128 : p.yb + tq * 512 + hh * 128;
#pragma unroll
    for (int eb = 0; eb < 4; ++eb)
#pragma unroll
        for (int g = 0; g < 4; ++g) {
            f32x4 v = {acc[eb][4 * g] * inv, acc[eb][4 * g + 1] * inv, acc[eb][4 * g + 2] * inv, acc[eb][4 * g + 3] * inv};
            st4(o + eb * 32 + 8 * g + 4 * hf, v);
        }
}


DI void ret_state_item(const Params& p, int item) {
    const int n = item & 127, bh = item >> 7;
    const int tid = otid(), lane = tid & 63, w = tid >> 6, r = lane & 31, hf = lane >> 5;
    const bf16_t* kt = p.ckT + (size_t)bh * 128 * S + n * 64 + hf * 8;
    const bf16_t* vt = p.cv + ((size_t)bh * 256 + w * 64) * S + n * 64 + hf * 8;
    f32x16 acc[4][2];
#pragma unroll
    for (int a = 0; a < 4; ++a)
#pragma unroll
        for (int c = 0; c < 2; ++c)
#pragma unroll
            for (int i = 0; i < 16; ++i) acc[a][c][i] = 0.f;
#pragma unroll
    for (int s4 = 0; s4 < 4; ++s4) {
        bf16x8 af[4], bfr[2];
#pragma unroll
        for (int a = 0; a < 4; ++a) af[a] = *(const bf16x8*)(kt + (size_t)(a * 32 + r) * S + s4 * 16);
#pragma unroll
        for (int c = 0; c < 2; ++c) bfr[c] = *(const bf16x8*)(vt + (size_t)(c * 32 + r) * S + s4 * 16);
#pragma unroll
        for (int a = 0; a < 4; ++a)
#pragma unroll
            for (int c = 0; c < 2; ++c) acc[a][c] = __builtin_amdgcn_mfma_f32_32x32x16_bf16(af[a], bfr[c], acc[a][c], 0, 0, 0);
    }
    bf16_t* o = p.kv + ((size_t)(bh * 128 + n) * 256 + w * 64) * 128;
#pragma unroll
    for (int a = 0; a < 4; ++a)
#pragma unroll
        for (int c = 0; c < 2; ++c)
#pragma unroll
            for (int g = 0; g < 4; ++g) {
                f32x4 v = {acc[a][c][4 * g], acc[a][c][4 * g + 1], acc[a][c][4 * g + 2], acc[a][c][4 * g + 3]};
                st4_wt(o + (size_t)(c * 32 + r) * 128 + a * 32 + 8 * g + 4 * hf, v);
            }
}

DI void ret_scan(const Params& p) {
    const int gtid = obid() * 256 + otid(), gsz = gridDim.x * 256;
    for (int e = gtid; e < 8 * 8192; e += gsz) {
        const int bh = e >> 13, pi = e & 8191, hd = bh & 3;
        const float dec = ex2(64.0f * lg2gamma(hd));
        unsigned long long* ptr = (unsigned long long*)p.kv + (size_t)bh * 128 * 8192 + pi;
        float c0 = 0.f, c1 = 0.f, c2 = 0.f, c3 = 0.f;
        for (int n0 = 0; n0 < 128; n0 += 8) {
            unsigned long long v[8];
#pragma unroll
            for (int k = 0; k < 8; ++k) v[k] = ptr[(size_t)(n0 + k) * 8192];
            asm volatile("s_waitcnt vmcnt(0)" ::: "memory");
#pragma unroll
            for (int k = 0; k < 8; ++k) {
                const unsigned long long o = (unsigned long long)pack2(c0, c1) | ((unsigned long long)pack2(c2, c3) << 32);
                __hip_atomic_store(ptr + (size_t)(n0 + k) * 8192, o, __ATOMIC_RELAXED, __HIP_MEMORY_SCOPE_AGENT);
                const unsigned lo = (unsigned)v[k], hi = (unsigned)(v[k] >> 32);
                c0 = c0 * dec + bflo(lo); c1 = c1 * dec + bfhi(lo); c2 = c2 * dec + bflo(hi); c3 = c3 * dec + bfhi(hi);
            }
        }
    }
}

DI void ret_out_item(const Params& p, int l, int item, unsigned char* smem) {
    const int n = item & 127, bh = item >> 7, b = bh >> 2, hd = bh & 3;
    const int tid = otid(), lane = tid & 63, w = tid >> 6, r = lane & 31, hf = lane >> 5;
    const size_t t0 = (size_t)b * S + n * 64;
    f32x16 acc[2][2];
#pragma unroll
    for (int a = 0; a < 2; ++a)
#pragma unroll
        for (int c = 0; c < 2; ++c)
#pragma unroll
            for (int i = 0; i < 16; ++i) acc[a][c][i] = 0.f;
    bf16x8 pf[2][2][2];
    {
        bf16x8 qf[2][8];
#pragma unroll
        for (int qb = 0; qb < 2; ++qb)
#pragma unroll
            for (int ks = 0; ks < 8; ++ks) qf[qb][ks] = *(const bf16x8*)(p.cq + (t0 + qb * 32 + r) * 512 + hd * 128 + ks * 16 + hf * 8);
        const bf16_t* rt = p.kv + ((size_t)(bh * 128 + n) * 256 + w * 64) * 128 + hf * 8;
#pragma unroll
        for (int dvb = 0; dvb < 2; ++dvb)
#pragma unroll
            for (int ks = 0; ks < 8; ++ks) {
                const bf16x8 a = *(const bf16x8*)(rt + (size_t)(dvb * 32 + r) * 128 + ks * 16);
#pragma unroll
                for (int qb = 0; qb < 2; ++qb) acc[dvb][qb] = __builtin_amdgcn_mfma_f32_32x32x16_bf16(a, qf[qb][ks], acc[dvb][qb], 0, 0, 0);
            }
#pragma unroll
        for (int kb = 0; kb < 2; ++kb) {
            f32x16 st[2];
#pragma unroll
            for (int qb = 0; qb < 2; ++qb)
#pragma unroll
                for (int i = 0; i < 16; ++i) st[qb][i] = 0.f;
#pragma unroll
            for (int ks = 0; ks < 8; ++ks) {
                const bf16x8 a = *(const bf16x8*)(p.ck + (t0 + kb * 32 + r) * 512 + hd * 128 + ks * 16 + hf * 8);
#pragma unroll
                for (int qb = 0; qb < 2; ++qb) st[qb] = __builtin_amdgcn_mfma_f32_32x32x16_bf16(a, qf[qb][ks], st[qb], 0, 0, 0);
            }
#pragma unroll
            for (int qb = 0; qb < 2; ++qb) {
#pragma unroll
                for (int i = 0; i < 16; ++i) { const int key = kb * 32 + (i & 3) + 8 * (i >> 2) + 4 * hf; if (key > qb * 32 + r) st[qb][i] = 0.f; }
#pragma unroll
                for (int s2 = 0; s2 < 2; ++s2)
                    pf[kb][s2][qb] = pack8(st[qb][8 * s2], st[qb][8 * s2 + 1], st[qb][8 * s2 + 2], st[qb][8 * s2 + 3], st[qb][8 * s2 + 4], st[qb][8 * s2 + 5], st[qb][8 * s2 + 6], st[qb][8 * s2 + 7]);
            }
        }
    }
    {
        const bf16_t* vt = p.cv + ((size_t)bh * 256 + w * 64) * S + n * 64 + 4 * hf;
#pragma unroll
        for (int dvb = 0; dvb < 2; ++dvb)
#pragma unroll
            for (int kb = 0; kb < 2; ++kb)
#pragma unroll
                for (int s2 = 0; s2 < 2; ++s2) {
                    const bf16_t* vp = vt + (size_t)(dvb * 32 + r) * S + kb * 32 + 16 * s2;
                    const uint2 lo = *(const uint2*)vp, hi = *(const uint2*)(vp + 8);
                    typedef unsigned u32x4 __attribute__((ext_vector_type(4)));
                    u32x4 av; av[0] = lo.x; av[1] = lo.y; av[2] = hi.x; av[3] = hi.y;
                    const bf16x8 a = __builtin_bit_cast(bf16x8, av);
#pragma unroll
                    for (int qb = 0; qb < 2; ++qb) acc[dvb][qb] = __builtin_amdgcn_mfma_f32_32x32x16_bf16(a, pf[kb][s2][qb], acc[dvb][qb], 0, 0, 0);
                }
    }
    float* red = (float*)smem;
    float mu[2], rstd[2];
    __syncthreads();
#pragma unroll
    for (int qb = 0; qb < 2; ++qb) {
        float s1 = 0.f, s2 = 0.f;
#pragma unroll
        for (int dvb = 0; dvb < 2; ++dvb)
#pragma unroll
            for (int i = 0; i < 16; ++i) { const float x = acc[dvb][qb][i]; s1 += x; s2 += x * x; }
        s1 += __shfl_xor(s1, 32); s2 += __shfl_xor(s2, 32);
        if (hf == 0) { red[(w * 64 + qb * 32 + r) * 2] = s1; red[(w * 64 + qb * 32 + r) * 2 + 1] = s2; }
    }
    __syncthreads();
#pragma unroll
    for (int qb = 0; qb < 2; ++qb) {
        float s1 = 0.f, s2 = 0.f;
#pragma unroll
        for (int ww = 0; ww < 4; ++ww) { s1 += red[(ww * 64 + qb * 32 + r) * 2]; s2 += red[(ww * 64 + qb * 32 + r) * 2 + 1]; }
        const float m_ = s1 * (1.f / 256.f);
        mu[qb] = m_; rstd[qb] = rsqrtf(fmaxf(s2 * (1.f / 256.f) - m_ * m_, 0.f) + LN_EPS);
    }
    const float* gr = p.g_ret + (size_t)l * 1024 + hd * 256 + w * 64;
#pragma unroll
    for (int dvb = 0; dvb < 2; ++dvb)
#pragma unroll
        for (int g = 0; g < 4; ++g) {
            const int dv = dvb * 32 + 8 * g + 4 * hf;
            const f32x4 gg = *(const f32x4*)(gr + dv);
#pragma unroll
            for (int qb = 0; qb < 2; ++qb) {
                const size_t off = (t0 + qb * 32 + r) * 1024 + hd * 256 + w * 64 + dv;
                const uint2 cgv = *(const uint2*)(p.cg + off);
                f32x4 y;
#pragma unroll
                for (int jj = 0; jj < 4; ++jj) y[jj] = (acc[dvb][qb][4 * g + jj] - mu[qb]) * rstd[qb] * gg[jj];
                y[0] *= bflo(cgv.x); y[1] *= bfhi(cgv.x); y[2] *= bflo(cgv.y); y[3] *= bfhi(cgv.y);
                st4(p.yc + off, y);
            }
        }
}

DI void phase_mixers(const Params& p, int l, unsigned char* smem) {
    const int nF = 64 * 24, nC = 2 * 4 * 128;
    int* sitem = (int*)(smem + SMEM_BYTES - 16);
    for (;;) {
        __syncthreads();
        if (otid() == 0) *sitem = (int)atomicAdd(p.ctr + l, 1u);
        __syncthreads();
        const int it = *sitem;
        if (it >= nF + nC) break;
        if (it < nF) {
            const int qi = 63 - it / 24, r = it % 24;
            if (r < 8) flash_item<1>(p, r >> 2, r & 3, qi, smem);
            else flash_item<0>(p, (r - 8) >> 3, (r - 8) & 7, qi, smem);
        } else ret_state_item(p, it - nF);
    }
}

DI void phase_mixers_naive(const Params& p) {
    const int nA = 2 * 8 * 128, nB = 2 * 4 * 128, nC = 2 * 4 * 128;
    for (int it = obid(); it < nA + nB + nC; it += gridDim.x) {
        if (it < nB) naive_attn<1>(p, it);
        else if (it < nB + nC) naive_attn<2>(p, it - nB);
        else naive_attn<0>(p, it - nB - nC);
    }
}

DI void phase_post(const Params& p, int l) {
    const int lane = otid() & 63, wv = otid() >> 6;
    const float lam = p.lamv[2 * l], li = p.lamv[2 * l + 1];
    const float* gd = p.g_diff + (size_t)l * 512; const float* gr = p.g_ret + (size_t)l * 1024;
    for (int row = obid() * 4 + wv; row < T; row += gridDim.x * 4) {
#pragma unroll
        for (int hh = 0; hh < 4; ++hh) {
            const unsigned o0 = *(const unsigned*)(p.oa + (size_t)row * 1024 + (2 * hh) * 128 + lane * 2);
            const unsigned o1 = *(const unsigned*)(p.oa + (size_t)row * 1024 + (2 * hh + 1) * 128 + lane * 2);
            const float d0 = bflo(o0) - lam * bflo(o1), d1 = bfhi(o0) - lam * bfhi(o1);
            float ss = d0 * d0 + d1 * d1;
            for (int o = 32; o; o >>= 1) ss += __shfl_xor(ss, o);
            const float r = rsqrtf(ss * (1.f / 128.f) + LN_EPS) * (1.f - li);
            const int c = hh * 128 + lane * 2;
            *(unsigned*)(p.ya + (size_t)row * 512 + c) = pack2(d0 * r * gd[c], d1 * r * gd[c + 1]);
        }
    }
}

DI void grid_bar(unsigned* bar, unsigned& epoch) {
    asm volatile("s_waitcnt vmcnt(0) lgkmcnt(0)" ::: "memory");
    __syncthreads();
    epoch += gridDim.x;
    if (otid() == 0) {
        __builtin_amdgcn_fence(__ATOMIC_RELEASE, "agent");
        asm volatile("s_waitcnt vmcnt(0)" ::: "memory");
        __hip_atomic_fetch_add(bar, 1u, __ATOMIC_RELAXED, __HIP_MEMORY_SCOPE_AGENT);
        while (__hip_atomic_load(bar, __ATOMIC_RELAXED, __HIP_MEMORY_SCOPE_AGENT) < epoch) __builtin_amdgcn_s_sleep(1);
        __builtin_amdgcn_fence(__ATOMIC_ACQUIRE, "agent");
        asm volatile("s_waitcnt vmcnt(0)" ::: "memory");
    }
    __syncthreads();
}
#define GSYNC() grid_bar(p.bar, epoch)
__global__ void __launch_bounds__(256, 2) fwd_kernel(Params p) {
    __shared__ __attribute__((aligned(16))) unsigned char smem[SMEM_BYTES];
    cg::grid_group grid = cg::this_grid();
    bf16_t* sm = (bf16_t*)smem; float* smf = (float*)smem;

    unsigned epoch = 0;
    asm volatile("s_waitcnt vmcnt(0) lgkmcnt(0)" ::: "memory"); grid.sync();
    convert_layer(p, 0, smf);
    phase0_misc(p, smf);
    GSYNC();
    row_phase(p, p.x, false, nullptr, nullptr, nullptr, p.mod, 0, 1024, true, true);
    GSYNC();
    for (int l = 0; l < DEPTH; ++l) {
        const float* modl = p.mod + (size_t)l * 2 * 6144;
        const float* xcur = l == 0 ? p.x : p.xbuf;
        if (obid() >= gridDim.x - 8) scan_item(p, obid() - (gridDim.x - 8), smf);
        phase_inproj(p, sm);
        GSYNC();
        phase_mixers(p, l, smem);
        GSYNC();
        phase_post(p, l);
        ret_scan(p);
        GSYNC();
        for (int it = obid(); it < 1024; it += gridDim.x) ret_out_item(p, l, it, smem);
        GSYNC();
        phase_branch(p, sm);
        GSYNC();
        phase_gemm_res(p, p.h, 1024, p.WoutT, xcur, modl, 2048, sm);
        GSYNC();
        row_phase(p, p.vbuf, true, p.ln_g + (size_t)(l * 2) * Dm, p.ln_b + (size_t)(l * 2) * Dm, p.xbuf, modl, 3072, 4096, true, false);
        GSYNC();
        phase_up(p, sm);
        GSYNC();
        phase_conv(p, l);
        GSYNC();
        phase_gemm_res(p, p.act, DFF, p.WdownT, p.xbuf, modl, 5120, sm);
        GSYNC();
        if (l + 1 < DEPTH) {
            convert_layer(p, l + 1, smf);
            GSYNC();
            row_phase(p, p.vbuf, true, p.ln_g + (size_t)(l * 2 + 1) * Dm, p.ln_b + (size_t)(l * 2 + 1) * Dm, p.xbuf, modl + 2 * 6144, 0, 1024, true, true);
            GSYNC();
        } else {
            row_phase(p, p.vbuf, true, p.ln_g + (size_t)(l * 2 + 1) * Dm, p.ln_b + (size_t)(l * 2 + 1) * Dm, p.out, modl, 0, 1024, false, false);
        }
    }
}

extern "C" void kernel_launch(void* const* d_in, const int* in_sizes, int n_in, void* d_out, int out_size, void* d_ws, size_t ws_size, hipStream_t stream) {
    static int grid_blocks = 0;
    if (!grid_blocks) {
        int dev = 0, cus = 0, per_cu = 0;
        hipGetDevice(&dev);
        hipDeviceGetAttribute(&cus, hipDeviceAttributeMultiprocessorCount, dev);
        hipOccupancyMaxActiveBlocksPerMultiprocessor(&per_cu, fwd_kernel, 256, 0);
        if (per_cu > 2) per_cu = 2;
        if (per_cu < 1) per_cu = 1;
        grid_blocks = cus * per_cu;
    }
    Params p{};
    const float** ins = (const float**)&p.x;
    for (int i = 0; i < 22; ++i) ins[i] = (const float*)d_in[i];
    p.out = (float*)d_out;
    char* w = (char*)d_ws; size_t off = 0;
    auto take = [&](size_t bytes) { char* r = w + off; off += (bytes + 255) & ~(size_t)255; return r; };
    const size_t MB = 1u << 20;
    p.mod = (float*)take((size_t)DEPTH * 2 * 6144 * 4);
    p.lamv = (float*)take(256);
    p.ctr = (unsigned*)take(256);
    p.bar = (unsigned*)take(256);
    p.wf = (float*)take(4100 * 4);
    p.binp = (float*)take(NIN * 4);
    p.cstab = (float*)take((size_t)S * 64 * 2 * 4);
    p.logf = (float*)take((size_t)T * 4 * 4);
    p.F = (float*)take((size_t)T * 4 * 4);
    p.WinT = (bf16_t*)take((size_t)NIN * 1024 * 2);
    p.WpaT = (bf16_t*)take((size_t)1024 * 512 * 2);
    p.WpbT = (bf16_t*)take((size_t)1024 * 512 * 2);
    p.WpcT = (bf16_t*)take((size_t)1024 * 1024 * 2);
    p.WoutT = (bf16_t*)take((size_t)1024 * 1024 * 2);
    p.WupT = (bf16_t*)take((size_t)2 * DFF * 1024 * 2);
    p.WdownT = (bf16_t*)take((size_t)1024 * DFF * 2);
    p.xbuf = (float*)take((size_t)T * Dm * 4);
    p.h = (bf16_t*)take((size_t)T * Dm * 2);
    const size_t offA = off;
    p.qa = (bf16_t*)take((size_t)T * 512 * 2); p.ka = (bf16_t*)take((size_t)T * 512 * 2); p.vta = (bf16_t*)take((size_t)T * 512 * 2);
    p.qb = (bf16_t*)take((size_t)T * 512 * 2); p.kb = (bf16_t*)take((size_t)T * 512 * 2); p.vtb = (bf16_t*)take((size_t)T * 512 * 2);
    p.cq = (bf16_t*)take((size_t)T * 512 * 2); p.ck = (bf16_t*)take((size_t)T * 512 * 2);
    p.cv = (bf16_t*)take((size_t)T * 1024 * 2); p.cg = (bf16_t*)take((size_t)T * 1024 * 2);
    p.gates = (bf16_t*)take((size_t)T * 3072 * 2);
    const size_t endA = off;
    p.ug = (bf16_t*)(w + offA);
    p.act = (bf16_t*)(w + offA + (size_t)T * 2 * DFF * 2);
    const size_t offB = endA;
    off = offB;
    p.vbuf = (float*)(w + offB);
    p.oa = p.h;
    p.yb = (bf16_t*)take((size_t)T * 512 * 2);
    p.kv = (bf16_t*)take((size_t)8 * 128 * 256 * 128 * 2);
    p.ckT = (bf16_t*)take((size_t)T * 512 * 2);
    p.ya = (bf16_t*)take((size_t)T * 512 * 2);
    p.yc = (bf16_t*)take((size_t)T * 1024 * 2);
    if (off > ws_size || (size_t)T * 2 * DFF * 2 + (size_t)T * DFF * 2 > endA - offA) {
        fprintf(stderr, "kernel_launch: workspace too small: need %zu MB have %zu MB\n", off / MB, ws_size / MB);
        return;
    }
    (void)hipMemsetAsync(p.bar, 0, 256, stream);
    void* args[] = {&p};
    hipError_t e = hipLaunchCooperativeKernel((void*)fwd_kernel, dim3(grid_blocks), dim3(256), args, 0, stream);
    if (e != hipSuccess) fprintf(stderr, "cooperative launch failed: %s (grid %d)\n", hipGetErrorString(e), grid_blocks);
}
```

```cpp
#include <hip/hip_runtime.h>
#include <hip/hip_cooperative_groups.h>
#include <cstdio>
#include <cstdint>
namespace cg = cooperative_groups;

typedef unsigned short bf16_t;
typedef short bf16x8 __attribute__((ext_vector_type(8)));
typedef float f32x4 __attribute__((ext_vector_type(4)));

constexpr int Dm = 1024, NB = 2, S = 8192, T = NB * S, DEPTH = 4, DFF = 2816, DIN = 9220, NIN = 9216;
constexpr float LN_EPS = 1e-5f;
constexpr float LOG2E = 1.4426950408889634f;
#define ALPHA_F 1.681792830507429f

#define DI __device__ __forceinline__
DI int otid() { int t = threadIdx.x; asm volatile("" : "+v"(t)); return t; }
DI int obid() { int b = blockIdx.x; asm volatile("" : "+s"(b)); return b; }

typedef __bf16 hbf2 __attribute__((ext_vector_type(2)));
typedef float f32x2 __attribute__((ext_vector_type(2)));
DI bf16_t f2bf(float x) { return __builtin_bit_cast(unsigned short, (__bf16)x); }
DI float bf2f(bf16_t v) { return __uint_as_float(((unsigned)v) << 16); }
DI float bflo(unsigned w) { return __uint_as_float(w << 16); }
DI float bfhi(unsigned w) { return __uint_as_float(w & 0xffff0000u); }
DI unsigned pack2(float a, float b) { f32x2 v = {a, b}; return __builtin_bit_cast(unsigned, __builtin_convertvector(v, hbf2)); }

struct Params {
    const float *x, *c, *w_ada, *b_ada, *w_in, *b_in, *lq1, *lk1, *lq2, *lk2, *g_diff, *g_ret, *w_pa, *w_pb, *w_pc, *w_out, *ln_g, *ln_b, *w_up, *w_conv, *b_conv, *w_down;
    float* out;
    unsigned* ctr; unsigned* bar;
    float *mod, *lamv, *wf, *binp, *cstab, *xbuf, *vbuf, *logf, *F, *oc;
    bf16_t *WinT, *WpaT, *WpbT, *WpcT, *WoutT, *WupT, *WdownT;
    bf16_t *h, *qa, *ka, *vta, *qb, *kb, *vtb, *cq, *ck, *cv, *cg, *gates, *oa, *yb, *ya, *yc, *ug, *act, *ckT, *kv;
};

#define LDS_BARRIER() do { asm volatile("s_waitcnt lgkmcnt(0)" ::: "memory"); __builtin_amdgcn_s_barrier(); asm volatile("" ::: "memory"); } while (0)
constexpr int BM = 128, BN = 128, BK = 64, LDP = BK + 8;
constexpr int SMEM_BYTES = 2 * (BM + BN) * LDP * 2;

DI int win_map(int n) {
    if (n < 3072) return n;
    if (n < 4096) { int r = n - 3072; int seg = r >> 9; r &= 511; int head = r >> 7; int c = r & 127; return 3076 + seg * 512 + head * 128 + (c >> 1) + 64 * (c & 1); }
    return n + 4;
}

DI void convert_tile(const float* __restrict__ src, int ldsrc, bf16_t* __restrict__ dst, int K, int tiles_n, int tile, int kind, float* lds) {
    const int tn = tile % tiles_n, tk = tile / tiles_n;
    const int tx = otid() & 63, ty = otid() >> 6;
    const int n = tn * 64 + tx;
    const int sn = kind == 1 ? win_map(n) : n;
    __syncthreads();
#pragma unroll 4
    for (int r = 0; r < 16; ++r) {
        const int kk = ty * 16 + r;
        lds[kk * 65 + tx] = src[(size_t)(tk * 64 + kk) * ldsrc + sn];
    }
    __syncthreads();
#pragma unroll 4
    for (int r = 0; r < 16; ++r) {
        const int nn = ty * 16 + r;
        dst[(size_t)(tn * 64 + nn) * K + tk * 64 + tx] = f2bf(lds[tx * 65 + nn]);
    }
}

DI void convert_layer(const Params& p, int l, float* lds) {
    const int n_in = 16 * 144, n_pa = 8 * 16, n_pb = 8 * 16, n_pc = 16 * 16, n_out = 16 * 16, n_up = 16 * 88, n_dn = 44 * 16;
    const int total = n_in + n_pa + n_pb + n_pc + n_out + n_up + n_dn;
    for (int it = obid(); it < total; it += gridDim.x) {
        int t = it;
        if (t < n_in) { convert_tile(p.w_in + (size_t)l * Dm * DIN, DIN, p.WinT, 1024, 144, t, 1, lds); continue; } t -= n_in;
        if (t < n_pa) { convert_tile(p.w_pa + (size_t)l * 512 * Dm, Dm, p.WpaT, 512, 16, t, 0, lds); continue; } t -= n_pa;
        if (t < n_pb) { convert_tile(p.w_pb + (size_t)l * 512 * Dm, Dm, p.WpbT, 512, 16, t, 0, lds); continue; } t -= n_pb;
        if (t < n_pc) { convert_tile(p.w_pc + (size_t)l * 1024 * Dm, Dm, p.WpcT, 1024, 16, t, 0, lds); continue; } t -= n_pc;
        if (t < n_out) { convert_tile(p.w_out + (size_t)l * Dm * Dm, Dm, p.WoutT, 1024, 16, t, 0, lds); continue; } t -= n_out;
        if (t < n_up) { convert_tile(p.w_up + (size_t)l * Dm * 2 * DFF, 2 * DFF, p.WupT, 1024, 88, t, 0, lds); continue; } t -= n_up;
        convert_tile(p.w_down + (size_t)l * DFF * Dm, Dm, p.WdownT, DFF, 16, t, 0, lds);
    }
    const int gtid = obid() * blockDim.x + otid(), gsz = gridDim.x * blockDim.x;
    for (int i = gtid; i < NIN; i += gsz) p.binp[i] = p.b_in[(size_t)l * DIN + win_map(i)];
    for (int i = gtid; i < 4096; i += gsz) { const int k = i >> 2, hh = i & 3; p.wf[i] = p.w_in[(size_t)l * Dm * DIN + (size_t)k * DIN + 3072 + hh]; }
    for (int i = gtid; i < 4; i += gsz) p.wf[4096 + i] = p.b_in[(size_t)l * DIN + 3072 + i];
}

DI float ex2(float x) { return __builtin_amdgcn_exp2f(x); }
DI float lg2gamma(int hd) { return hd == 0 ? -0.04580368961312479f : hd == 1 ? -0.02272007650008353f : hd == 2 ? -0.011315313227834146f : -0.005646563141142063f; }
DI float silu_f(float v) { return v / (1.f + __expf(-v)); }
DI float sigmoid_f(float v) { return 1.f / (1.f + __expf(-v)); }

DI void phase0_misc(const Params& p, float* lds) {
    for (int it = obid(); it < DEPTH * 96; it += gridDim.x) {
        const int l = it / 96, jb = it % 96;
        const int tx = otid() & 63, ks = otid() >> 6;
        const int j = jb * 64 + tx;
        const float* w = p.w_ada + (size_t)l * Dm * 6144 + j;
        float a0 = 0.f, a1 = 0.f;
#pragma unroll 8
        for (int k = ks * 256; k < ks * 256 + 256; ++k) {
            const float wv = w[(size_t)k * 6144];
            a0 += silu_f(p.c[k]) * wv; a1 += silu_f(p.c[Dm + k]) * wv;
        }
        __syncthreads();
        lds[(ks * 64 + tx) * 2] = a0; lds[(ks * 64 + tx) * 2 + 1] = a1;
        __syncthreads();
        if (ks == 0) {
            float s0 = 0.f, s1 = 0.f;
            for (int q = 0; q < 4; ++q) { s0 += lds[(q * 64 + tx) * 2]; s1 += lds[(q * 64 + tx) * 2 + 1]; }
            const float bb = p.b_ada[(size_t)l * 6144 + j];
            p.mod[((size_t)l * 2 + 0) * 6144 + j] = s0 + bb;
            p.mod[((size_t)l * 2 + 1) * 6144 + j] = s1 + bb;
        }
    }
    const int gtid = obid() * blockDim.x + otid(), gsz = gridDim.x * blockDim.x;
    if (gtid < 64) p.ctr[gtid] = 0u;
    if (obid() == 0 && otid() < 64 * DEPTH) {
        const int l = otid() >> 6, ln = otid() & 63;
        float a = p.lq1[l * 64 + ln] * p.lk1[l * 64 + ln], b = p.lq2[l * 64 + ln] * p.lk2[l * 64 + ln];
        for (int o = 32; o; o >>= 1) { a += __shfl_xor(a, o); b += __shfl_xor(b, o); }
        if (ln == 0) { const float li = 0.8f - 0.6f * expf(-0.3f * (float)l); p.lamv[2 * l] = expf(a) - expf(b) + li; p.lamv[2 * l + 1] = li; }
    }
}

DI void row_phase(const Params& p, const float* __restrict__ src, bool do_ln, const float* __restrict__ lng, const float* __restrict__ lnb,
                  float* __restrict__ xdst, const float* __restrict__ modl  , int sh_off, int sc_off, bool want_h, bool want_logf) {
    const int lane = otid() & 63, wv = otid() >> 6;
    for (int row = obid() * 4 + wv; row < T; row += gridDim.x * 4) {
        const int b = row / S;
        const float* sp = src + (size_t)row * Dm;
        f32x4 v[4];
#pragma unroll
        for (int i = 0; i < 4; ++i) v[i] = *(const f32x4*)(sp + i * 256 + lane * 4);
        if (do_ln) {
            float s = 0.f;
#pragma unroll
            for (int i = 0; i < 4; ++i) s += (v[i][0] + v[i][1]) + (v[i][2] + v[i][3]);
            for (int o = 32; o; o >>= 1) s += __shfl_xor(s, o);
            const float mu = s * (1.f / 1024.f);
            float q = 0.f;
#pragma unroll
            for (int i = 0; i < 4; ++i) { f32x4 d = v[i] - mu; q += (d[0] * d[0] + d[1] * d[1]) + (d[2] * d[2] + d[3] * d[3]); }
            for (int o = 32; o; o >>= 1) q += __shfl_xor(q, o);
            const float rstd = rsqrtf(q * (1.f / 1024.f) + LN_EPS);
#pragma unroll
            for (int i = 0; i < 4; ++i) {
                const f32x4 g = *(const f32x4*)(lng + i * 256 + lane * 4), bb = *(const f32x4*)(lnb + i * 256 + lane * 4);
                v[i] = (v[i] - mu) * rstd * g + bb;
            }
        }
        if (xdst) {
#pragma unroll
            for (int i = 0; i < 4; ++i) *(f32x4*)(xdst + (size_t)row * Dm + i * 256 + lane * 4) = v[i];
        }
        if (want_h) {
            const float* mb = modl + (size_t)b * 6144;
            float d0 = 0.f, d1 = 0.f, d2 = 0.f, d3 = 0.f;
#pragma unroll
            for (int i = 0; i < 4; ++i) {
                const int c0 = i * 256 + lane * 4;
                const f32x4 sc = *(const f32x4*)(mb + sc_off + c0), sh = *(const f32x4*)(mb + sh_off + c0);
                const f32x4 hv = v[i] * (1.f + sc) + sh;
                uint2 w; w.x = pack2(hv[0], hv[1]); w.y = pack2(hv[2], hv[3]);
                *(uint2*)(p.h + (size_t)row * Dm + c0) = w;
                if (want_logf) {
#pragma unroll
                    for (int j = 0; j < 4; ++j) {
                        const f32x4 wf = *(const f32x4*)(p.wf + (c0 + j) * 4);
                        d0 += hv[j] * wf[0]; d1 += hv[j] * wf[1]; d2 += hv[j] * wf[2]; d3 += hv[j] * wf[3];
                    }
                }
            }
            if (want_logf) {
                for (int o = 32; o; o >>= 1) { d0 += __shfl_xor(d0, o); d1 += __shfl_xor(d1, o); d2 += __shfl_xor(d2, o); d3 += __shfl_xor(d3, o); }
                if (lane < 4) {
                    float z = (lane == 0 ? d0 : lane == 1 ? d1 : lane == 2 ? d2 : d3) + p.wf[4096 + lane];
                    const float ls = fminf(z, 0.f) - log1pf(__expf(-fabsf(z)));
                    p.logf[(size_t)row * 4 + lane] = ls * LOG2E;
                }
            }
        }
    }
}

DI void scan_item(const Params& p, int item, float* lds) {
    const int b = item >> 2, hh = item & 3, tid = otid();
    const float* lp = p.logf + (size_t)b * S * 4 + hh;
    float loc[32]; float s = 0.f;
#pragma unroll
    for (int i = 0; i < 32; ++i) { s += lp[(size_t)(tid * 32 + i) * 4]; loc[i] = s; }
    __syncthreads();
    lds[tid] = s;
    __syncthreads();
    float pre = 0.f;
    for (int i = 0; i < tid; ++i) pre += lds[i];
    float* fp = p.F + (size_t)(b * 4 + hh) * S + tid * 32;
#pragma unroll
    for (int i = 0; i < 32; ++i) fp[i] = pre + loc[i];
    __syncthreads();
}

DI void gemm_kloop(const bf16_t* __restrict__ Ag, int lda, const bf16_t* __restrict__ Bg, int ldb, int K, f32x4 (&acc)[4][4], bf16_t* sm) {
    const int tid = otid(), lane = tid & 63, wid = tid >> 6, wr = wid >> 1, wc = wid & 1;
    bf16_t* sa = sm; bf16_t* sb = sm + 2 * BM * LDP;
    const int lrow = tid >> 3, lcc = tid & 7;
    const bf16_t* ap = Ag + (size_t)lrow * lda + lcc * 8;
    const bf16_t* bp = Bg + (size_t)lrow * ldb + lcc * 8;
    const size_t sA = (size_t)32 * lda, sB = (size_t)32 * ldb;
    uint4 ra0, ra1, ra2, ra3, rb0, rb1, rb2, rb3;
#define G_LOAD(koff) do { ra0 = *(const uint4*)(ap + (koff)); ra1 = *(const uint4*)(ap + sA + (koff)); ra2 = *(const uint4*)(ap + 2 * sA + (koff)); ra3 = *(const uint4*)(ap + 3 * sA + (koff)); \
                          rb0 = *(const uint4*)(bp + (koff)); rb1 = *(const uint4*)(bp + sB + (koff)); rb2 = *(const uint4*)(bp + 2 * sB + (koff)); rb3 = *(const uint4*)(bp + 3 * sB + (koff)); } while (0)
#define G_STORE(buf) do { bf16_t* da_ = sa + (buf) * BM * LDP + lrow * LDP + lcc * 8; bf16_t* db_ = sb + (buf) * BN * LDP + lrow * LDP + lcc * 8; \
        *(uint4*)(da_) = ra0; *(uint4*)(da_ + 32 * LDP) = ra1; *(uint4*)(da_ + 64 * LDP) = ra2; *(uint4*)(da_ + 96 * LDP) = ra3; \
        *(uint4*)(db_) = rb0; *(uint4*)(db_ + 32 * LDP) = rb1; *(uint4*)(db_ + 64 * LDP) = rb2; *(uint4*)(db_ + 96 * LDP) = rb3; } while (0)
    G_LOAD(0);
    G_STORE(0);
    LDS_BARRIER();
    const int nk = K / BK;
    const int fr = lane & 15, fq = lane >> 4;
    for (int kt = 0; kt < nk; ++kt) {
        const int cur = kt & 1;
        const bool more = kt + 1 < nk;
        if (more) G_LOAD((kt + 1) * BK);
        const bf16_t* ca = sa + cur * BM * LDP + (wr * 64 + fr) * LDP + fq * 8;
        const bf16_t* cb = sb + cur * BN * LDP + (wc * 64 + fr) * LDP + fq * 8;
#pragma unroll
        for (int kk = 0; kk < 2; ++kk) {
            bf16x8 af[4], bfr[4];
#pragma unroll
            for (int m = 0; m < 4; ++m) af[m] = *(const bf16x8*)(ca + m * 16 * LDP + kk * 32);
#pragma unroll
            for (int n = 0; n < 4; ++n) bfr[n] = *(const bf16x8*)(cb + n * 16 * LDP + kk * 32);
#pragma unroll
            for (int m = 0; m < 4; ++m)
#pragma unroll
                for (int n = 0; n < 4; ++n) acc[m][n] = __builtin_amdgcn_mfma_f32_16x16x32_bf16(bfr[n], af[m], acc[m][n], 0, 0, 0);
        }
        if (more) G_STORE(cur ^ 1);
        LDS_BARRIER();
    }
#undef G_LOAD
#undef G_STORE
}

DI void gemm_kloop2(const bf16_t* __restrict__ Ag, int lda, const bf16_t* __restrict__ Bg, int ldb, int K, f32x4 (&acc)[4][4], bf16_t* sm) {
    const int tid = otid(), lane = tid & 63, wid = tid >> 6, wr = wid >> 1, wc = wid & 1;
    bf16_t* sa = sm; bf16_t* sb = sm + 2 * BM * LDP;
    const int lrow = tid >> 3, lcc = tid & 7;
    const bf16_t* ap = Ag + (size_t)lrow * lda + lcc * 8;
    const bf16_t* bp = Bg + (size_t)lrow * ldb + lcc * 8;
    const size_t sA = (size_t)32 * lda, sB = (size_t)32 * ldb;
    uint4 xa0, xa1, xa2, xa3, xb0, xb1, xb2, xb3;
    uint4 ya0, ya1, ya2, ya3, yb0, yb1, yb2, yb3;
#define G2_LOAD(P, koff) do { P##a0 = *(const uint4*)(ap + (koff)); P##a1 = *(const uint4*)(ap + sA + (koff)); P##a2 = *(const uint4*)(ap + 2 * sA + (koff)); P##a3 = *(const uint4*)(ap + 3 * sA + (koff)); \
                              P##b0 = *(const uint4*)(bp + (koff)); P##b1 = *(const uint4*)(bp + sB + (koff)); P##b2 = *(const uint4*)(bp + 2 * sB + (koff)); P##b3 = *(const uint4*)(bp + 3 * sB + (koff)); } while (0)
#define G2_STORE(P, buf) do { bf16_t* da_ = sa + (buf) * BM * LDP + lrow * LDP + lcc * 8; bf16_t* db_ = sb + (buf) * BN * LDP + lrow * LDP + lcc * 8; \
        *(uint4*)(da_) = P##a0; *(uint4*)(da_ + 32 * LDP) = P##a1; *(uint4*)(da_ + 64 * LDP) = P##a2; *(uint4*)(da_ + 96 * LDP) = P##a3; \
        *(uint4*)(db_) = P##b0; *(uint4*)(db_ + 32 * LDP) = P##b1; *(uint4*)(db_ + 64 * LDP) = P##b2; *(uint4*)(db_ + 96 * LDP) = P##b3; } while (0)
#define G2_COMPUTE(buf) do { \
        const bf16_t* ca = sa + (buf) * BM * LDP + (wr * 64 + fr) * LDP + fq * 8; \
        const bf16_t* cb = sb + (buf) * BN * LDP + (wc * 64 + fr) * LDP + fq * 8; \
        _Pragma("unroll") for (int kk = 0; kk < 2; ++kk) { \
            bf16x8 af[4], bfr[4]; \
            _Pragma("unroll") for (int m = 0; m < 4; ++m) af[m] = *(const bf16x8*)(ca + m * 16 * LDP + kk * 32); \
            _Pragma("unroll") for (int n = 0; n < 4; ++n) bfr[n] = *(const bf16x8*)(cb + n * 16 * LDP + kk * 32); \
            _Pragma("unroll") for (int m = 0; m < 4; ++m) _Pragma("unroll") for (int n = 0; n < 4; ++n) acc[m][n] = __builtin_amdgcn_mfma_f32_16x16x32_bf16(bfr[n], af[m], acc[m][n], 0, 0, 0); \
        } } while (0)
    const int nk = K / BK;
    const int fr = lane & 15, fq = lane >> 4;
    G2_LOAD(x, 0);
    G2_LOAD(y, BK);
    G2_STORE(x, 0);
    LDS_BARRIER();
    for (int kt = 0; kt < nk; kt += 2) {
        const int kx = kt + 2 < nk ? kt + 2 : nk - 2, ky = kt + 3 < nk ? kt + 3 : nk - 1;
        G2_LOAD(x, kx * BK);
        __builtin_amdgcn_sched_barrier(0);
        G2_COMPUTE(0);
        G2_STORE(y, 1);
        LDS_BARRIER();
        G2_LOAD(y, ky * BK);
        __builtin_amdgcn_sched_barrier(0);
        G2_COMPUTE(1);
        G2_STORE(x, 0);
        LDS_BARRIER();
    }
#undef G2_LOAD
#undef G2_STORE
#undef G2_COMPUTE
}

DI void tile_coords(int tile, int nM, int nN, int& mt, int& nt) {
    const int G = gridDim.x;
    if ((G & 7) == 0 && (nM & 63) == 0 && (nM * nN) % G == 0) {
        const int b = tile % G, k = tile / G, per = G >> 3;
        const int xcd = b & 7, slot = b >> 3;
        const int li = k * per + slot;
        const int mh = li / (8 * nN), rem = li % (8 * nN);
        nt = rem >> 3; mt = (mh * 8 + (rem & 7)) * 8 + xcd;
        return;
    }
    const int band = tile / (16 * nN), r = tile % (16 * nN);
    mt = band * 16 + (r & 15); nt = r >> 4;
}

DI void zero_acc(f32x4 (&acc)[4][4]) {
#pragma unroll
    for (int m = 0; m < 4; ++m)
#pragma unroll
        for (int n = 0; n < 4; ++n) acc[m][n] = (f32x4){0.f, 0.f, 0.f, 0.f};
}


constexpr int BM2 = 256, BK2 = 32, LDP2 = BK2 + 8;
DI void gemm_kloop3(const bf16_t* __restrict__ Ag, int lda, const bf16_t* __restrict__ Bg, int ldb, int K, f32x4 (&acc)[8][4], bf16_t* sm) {
    const int tid = otid(), lane = tid & 63, wid = tid >> 6, wr = wid >> 1, wc = wid & 1;
    bf16_t* sa = sm; bf16_t* sb = sm + 2 * BM2 * LDP2;
    const int lrow = tid >> 2, lcc = tid & 3;
    const bf16_t* ap = Ag + (size_t)lrow * lda + lcc * 8;
    const int prow = ((lrow >> 2) & 3) * 16 + (lrow >> 4) * 4 + (lrow & 3);
    const bf16_t* bp = Bg + (size_t)prow * ldb + lcc * 8;
    const size_t sA = (size_t)64 * lda, sB = (size_t)64 * ldb;
    const int fr = lane & 15, fq = lane >> 4;
    uint4 a0, a1, a2, a3, b0, b1;
#define G3_LOAD(koff) do { a0 = *(const uint4*)(ap + (koff)); a1 = *(const uint4*)(ap + sA + (koff)); a2 = *(const uint4*)(ap + 2 * sA + (koff)); a3 = *(const uint4*)(ap + 3 * sA + (koff)); \
                           b0 = *(const uint4*)(bp + (koff)); b1 = *(const uint4*)(bp + sB + (koff)); } while (0)
#define G3_STORE(buf) do { bf16_t* da_ = sa + (buf) * BM2 * LDP2 + lrow * LDP2 + lcc * 8; bf16_t* db_ = sb + (buf) * BN * LDP2 + lrow * LDP2 + lcc * 8; \
        *(uint4*)(da_) = a0; *(uint4*)(da_ + 64 * LDP2) = a1; *(uint4*)(da_ + 128 * LDP2) = a2; *(uint4*)(da_ + 192 * LDP2) = a3; \
        *(uint4*)(db_) = b0; *(uint4*)(db_ + 64 * LDP2) = b1; } while (0)
    G3_LOAD(0);
    G3_STORE(0);
    LDS_BARRIER();
    const int nk = K / BK2;
    for (int kt = 0; kt < nk; ++kt) {
        const int cur = kt & 1;
        const bool more = kt + 1 < nk;
        if (more) G3_LOAD((kt + 1) * BK2);
        const bf16_t* ca = sa + cur * BM2 * LDP2 + (wr * 128 + fr) * LDP2 + fq * 8;
        const bf16_t* cb = sb + cur * BN * LDP2 + (wc * 64 + fr) * LDP2 + fq * 8;
        bf16x8 af[8], bfr[4];
#pragma unroll
        for (int m = 0; m < 8; ++m) af[m] = *(const bf16x8*)(ca + m * 16 * LDP2);
#pragma unroll
        for (int n = 0; n < 4; ++n) bfr[n] = *(const bf16x8*)(cb + n * 16 * LDP2);
#pragma unroll
        for (int m = 0; m < 8; ++m)
#pragma unroll
            for (int n = 0; n < 4; ++n) acc[m][n] = __builtin_amdgcn_mfma_f32_16x16x32_bf16(bfr[n], af[m], acc[m][n], 0, 0, 0);
        if (more) G3_STORE(cur ^ 1);
        LDS_BARRIER();
    }
#undef G3_LOAD
#undef G3_STORE
}
DI void zero_acc8(f32x4 (&acc)[8][4]) {
#pragma unroll
    for (int m = 0; m < 8; ++m)
#pragma unroll
        for (int n = 0; n < 4; ++n) acc[m][n] = (f32x4){0.f, 0.f, 0.f, 0.f};
}
DI void st4_wt(bf16_t* dst, f32x4 v) { const unsigned long long w = (unsigned long long)pack2(v[0], v[1]) | ((unsigned long long)pack2(v[2], v[3]) << 32); __hip_atomic_store((unsigned long long*)dst, w, __ATOMIC_RELAXED, __HIP_MEMORY_SCOPE_AGENT); }
DI void st4(bf16_t* dst, f32x4 v) { uint2 w; w.x = pack2(v[0], v[1]); w.y = pack2(v[2], v[3]); *(uint2*)dst = w; }

DI void st8(bf16_t* dst, f32x4 a, f32x4 b) { uint4 w; w.x = pack2(a[0], a[1]); w.y = pack2(a[2], a[3]); w.z = pack2(b[0], b[1]); w.w = pack2(b[2], b[3]); *(uint4*)dst = w; }
DI f32x4 rot4(f32x4 v, int s, int i0) {
    const float a0 = (float)s * ex2(-(float)i0 * 0.21091607f), a1 = (float)s * ex2(-(float)(i0 + 1) * 0.21091607f);
    float r0 = a0 * 0.15915494309189535f, r1 = a1 * 0.15915494309189535f;
    r0 -= floorf(r0); r1 -= floorf(r1);
    float c0_ = __builtin_amdgcn_cosf(r0), s0_ = __builtin_amdgcn_sinf(r0), c1_ = __builtin_amdgcn_cosf(r1), s1_ = __builtin_amdgcn_sinf(r1);
    asm volatile("s_nop 15\n\ts_nop 15" : "+v"(c0_), "+v"(s0_), "+v"(c1_), "+v"(s1_));
    f32x4 o; o[0] = v[0] * c0_ - v[1] * s0_; o[1] = v[0] * s0_ + v[1] * c0_; o[2] = v[2] * c1_ - v[3] * s1_; o[3] = v[2] * s1_ + v[3] * c1_;
    return o;
}
DI void epi_inproj(const Params& p, int row, int col, f32x4 v0, f32x4 v1) {
    v0 += *(const f32x4*)(p.binp + col); v1 += *(const f32x4*)(p.binp + col + 4);
    const int b = row / S, s = row % S;
    if (col < 512) { st8(p.qa + (size_t)row * 512 + col, v0 * (0.125f * LOG2E), v1 * (0.125f * LOG2E)); }
    else if (col < 1024) { st8(p.ka + (size_t)row * 512 + (col - 512), v0, v1); }
    else if (col < 1536) { const int c = col - 1024, hh = c >> 7, e = c & 127; bf16_t* d = p.vta + ((size_t)(b * 4 + hh) * 128 + e) * S + s;
#pragma unroll
        for (int j = 0; j < 4; ++j) { d[(size_t)j * S] = f2bf(v0[j]); d[(size_t)(j + 4) * S] = f2bf(v1[j]); } }
    else if (col < 2048) { st8(p.qb + (size_t)row * 512 + (col - 1536), v0 * (0.08838834764831845f * LOG2E), v1 * (0.08838834764831845f * LOG2E)); }
    else if (col < 2560) { st8(p.kb + (size_t)row * 512 + (col - 2048), v0, v1); }
    else if (col < 3072) { const int c = col - 2560, hh = c >> 7, e = c & 127; bf16_t* d = p.vtb + ((size_t)(b * 4 + hh) * 128 + e) * S + s;
#pragma unroll
        for (int j = 0; j < 4; ++j) { d[(size_t)j * S] = f2bf(v0[j]); d[(size_t)(j + 4) * S] = f2bf(v1[j]); } }
    else if (col < 4096) {
        const int r = col - 3072, seg = r >> 9, c = r & 511, cc = c & 127, i0 = cc >> 1, hd = c >> 7;
        f32x4 o0 = rot4(v0, s, i0), o1 = rot4(v1, s, i0 + 2);
        const float lg = lg2gamma(hd);
        const int ic = s & 63;
        float e1_ = ex2(lg * (float)(ic + 1)), e2_ = ex2(-lg * (float)(ic + 1)), e3_ = ex2(lg * (float)(63 - ic));
        asm volatile("s_nop 15\n\ts_nop 15" : "+v"(e1_), "+v"(e2_), "+v"(e3_));
        if (seg == 0) st8(p.cq + (size_t)row * 512 + c, o0 * e1_, o1 * e1_);
        else {
            o0 = o0 * 0.08838834764831845f; o1 = o1 * 0.08838834764831845f;
            st8(p.ck + (size_t)row * 512 + c, o0 * e2_, o1 * e2_);
            const f32x4 d0 = o0 * e3_, d1 = o1 * e3_;
            bf16_t* d = p.ckT + ((size_t)(b * 4 + hd) * 128 + cc) * S + s;
#pragma unroll
            for (int j = 0; j < 4; ++j) { d[(size_t)j * S] = f2bf(d0[j]); d[(size_t)(j + 4) * S] = f2bf(d1[j]); }
        }
    }
    else if (col < 5120) { const int c = col - 4096; bf16_t* d = p.cv + ((size_t)b * 1024 + c) * S + s;
#pragma unroll
        for (int j = 0; j < 4; ++j) { d[(size_t)j * S] = f2bf(v0[j]); d[(size_t)(j + 4) * S] = f2bf(v1[j]); } }
    else if (col < 6144) { f32x4 o0, o1; for (int j = 0; j < 4; ++j) { o0[j] = silu_f(v0[j]); o1[j] = silu_f(v1[j]); } st8(p.cg + (size_t)row * 1024 + (col - 5120), o0, o1); }
    else { f32x4 o0, o1; for (int j = 0; j < 4; ++j) { o0[j] = sigmoid_f(v0[j]); o1[j] = sigmoid_f(v1[j]); } st8(p.gates + (size_t)row * 3072 + (col - 6144), o0, o1); }
}

DI void phase_inproj(const Params& p, bf16_t* sm) {
    const int nM = T / BM2, nN = NIN / BN;
    const int lane = otid() & 63, wid = otid() >> 6, wr = wid >> 1, wc = wid & 1;
    for (int tile = obid(); tile < nM * nN; tile += gridDim.x) {
        int mt, nt; tile_coords(tile, nM, nN, mt, nt);
        f32x4 acc[8][4]; zero_acc8(acc);
        gemm_kloop3(p.h + (size_t)mt * BM2 * Dm, Dm, p.WinT + (size_t)nt * BN * Dm, Dm, Dm, acc, sm);
#pragma unroll
        for (int m = 0; m < 8; ++m)
#pragma unroll
            for (int n2 = 0; n2 < 2; ++n2) epi_inproj(p, mt * BM2 + wr * 128 + m * 16 + (lane & 15), nt * BN + wc * 64 + (lane >> 4) * 16 + n2 * 8, acc[m][2 * n2], acc[m][2 * n2 + 1]);
    }
}

DI void phase_branch(const Params& p, bf16_t* sm) {
    const int nM = T / BM, nN = Dm / BN;
    const int lane = otid() & 63, wid = otid() >> 6, wr = wid >> 1, wc = wid & 1;
    for (int tile = obid(); tile < nM * nN; tile += gridDim.x) {
        int mt, nt; tile_coords(tile, nM, nN, mt, nt);
        f32x4 tot[4][4]; zero_acc(tot);
#pragma unroll 1
        for (int br = 0; br < 3; ++br) {
            const bf16_t* A = br == 0 ? p.ya : br == 1 ? p.yb : p.yc;
            const bf16_t* W = br == 0 ? p.WpaT : br == 1 ? p.WpbT : p.WpcT;
            const int K = br == 2 ? 1024 : 512;
            f32x4 acc[4][4]; zero_acc(acc);
            gemm_kloop(A + (size_t)mt * BM * K, K, W + (size_t)nt * BN * K, K, K, acc, sm);
#pragma unroll
            for (int m = 0; m < 4; ++m)
#pragma unroll
                for (int n = 0; n < 4; ++n) {
                    const int row = mt * BM + wr * 64 + m * 16 + (lane & 15), col = nt * BN + wc * 64 + n * 16 + (lane >> 4) * 4;
                    const uint2 g = *(const uint2*)(p.gates + (size_t)row * 3072 + br * 1024 + col);
                    tot[m][n][0] += bflo(g.x) * acc[m][n][0]; tot[m][n][1] += bfhi(g.x) * acc[m][n][1];
                    tot[m][n][2] += bflo(g.y) * acc[m][n][2]; tot[m][n][3] += bfhi(g.y) * acc[m][n][3];
                }
        }
#pragma unroll
        for (int m = 0; m < 4; ++m)
#pragma unroll
            for (int n = 0; n < 4; ++n) {
                const int row = mt * BM + wr * 64 + m * 16 + (lane & 15), col = nt * BN + wc * 64 + n * 16 + (lane >> 4) * 4;
                st4(p.h + (size_t)row * Dm + col, tot[m][n]);
            }
    }
}

DI void phase_gemm_res(const Params& p, const bf16_t* A, int K, const bf16_t* Wt, const float* xres, const float* modl, int gt_off, bf16_t* sm) {
    const int nM = T / BM2, nN = Dm / BN;
    const int lane = otid() & 63, wid = otid() >> 6, wr = wid >> 1, wc = wid & 1;
    for (int tile = obid(); tile < nM * nN; tile += gridDim.x) {
        int mt, nt; tile_coords(tile, nM, nN, mt, nt);
        f32x4 acc[8][4]; zero_acc8(acc);
        gemm_kloop3(A + (size_t)mt * BM2 * K, K, Wt + (size_t)nt * BN * K, K, K, acc, sm);
#pragma unroll
        for (int m = 0; m < 8; ++m)
#pragma unroll
            for (int n = 0; n < 4; ++n) {
                const int row = mt * BM2 + wr * 128 + m * 16 + (lane & 15), col = nt * BN + wc * 64 + (lane >> 4) * 16 + n * 4;
                const int b = row / S;
                const f32x4 xr = *(const f32x4*)(xres + (size_t)row * Dm + col);
                const f32x4 gt = *(const f32x4*)(modl + (size_t)b * 6144 + gt_off + col);
                *(f32x4*)(p.vbuf + (size_t)row * Dm + col) = xr * ALPHA_F + gt * acc[m][n];
            }
    }
}

DI void phase_up(const Params& p, bf16_t* sm) {
    const int nM = T / BM2, nN = 2 * DFF / BN;
    const int lane = otid() & 63, wid = otid() >> 6, wr = wid >> 1, wc = wid & 1;
    for (int tile = obid(); tile < nM * nN; tile += gridDim.x) {
        int mt, nt; tile_coords(tile, nM, nN, mt, nt);
        f32x4 acc[8][4]; zero_acc8(acc);
        gemm_kloop3(p.h + (size_t)mt * BM2 * Dm, Dm, p.WupT + (size_t)nt * BN * Dm, Dm, Dm, acc, sm);
#pragma unroll
        for (int m = 0; m < 8; ++m)
#pragma unroll
            for (int n2 = 0; n2 < 2; ++n2) {
                const int row = mt * BM2 + wr * 128 + m * 16 + (lane & 15), col = nt * BN + wc * 64 + (lane >> 4) * 16 + n2 * 8;
                st8(p.ug + (size_t)row * (2 * DFF) + col, acc[m][2 * n2], acc[m][2 * n2 + 1]);
            }
    }
}

DI void phase_conv(const Params& p, int l) {
    const int gtid = obid() * blockDim.x + otid(), gsz = gridDim.x * blockDim.x;
    const float* wc = p.w_conv + (size_t)l * 3 * DFF; const float* bc = p.b_conv + (size_t)l * DFF;
    for (int i = gtid; i < T * (DFF / 8); i += gsz) {
        const int row = i / (DFF / 8), c8 = (i % (DFF / 8)) * 8, s = row % S;
        const bf16_t* up = p.ug + (size_t)row * (2 * DFF) + c8;
        const uint4 u0 = *(const uint4*)up;
        uint4 u1 = make_uint4(0, 0, 0, 0), u2 = make_uint4(0, 0, 0, 0);
        if (s >= 1) u1 = *(const uint4*)(up - 2 * DFF);
        if (s >= 2) u2 = *(const uint4*)(up - 4 * DFF);
        const uint4 gg = *(const uint4*)(up + DFF);
        const unsigned a0[4] = {u0.x, u0.y, u0.z, u0.w}, a1[4] = {u1.x, u1.y, u1.z, u1.w}, a2[4] = {u2.x, u2.y, u2.z, u2.w}, ag[4] = {gg.x, gg.y, gg.z, gg.w};
        unsigned o[4];
#pragma unroll
        for (int j = 0; j < 4; ++j) {
            float r[2];
#pragma unroll
            for (int hl = 0; hl < 2; ++hl) {
                const int cidx = c8 + 2 * j + hl;
                const float x0 = hl ? bfhi(a0[j]) : bflo(a0[j]), x1 = hl ? bfhi(a1[j]) : bflo(a1[j]), x2 = hl ? bfhi(a2[j]) : bflo(a2[j]), g = hl ? bfhi(ag[j]) : bflo(ag[j]);
                const float cv = bc[cidx] + wc[cidx] * x2 + wc[DFF + cidx] * x1 + wc[2 * DFF + cidx] * x0;
                r[hl] = 0.5f * cv * (1.f + erff(cv * 0.7071067811865476f)) * g;
            }
            o[j] = pack2(r[0], r[1]);
        }
        *(uint4*)(p.act + (size_t)row * DFF + c8) = make_uint4(o[0], o[1], o[2], o[3]);
    }
}

template <int MODE>
DI void naive_attn(const Params& p, int item) {
    constexpr int D = MODE == 0 ? 64 : 128;
    constexpr int DV = MODE == 2 ? 256 : 128;
    constexpr int SW = DV / 4;
    constexpr int NH = MODE == 0 ? 8 : 4;
    const int tid = otid(), lane = tid & 63;
    const int sl = __builtin_amdgcn_readfirstlane(tid >> 6);
    const int qblk = 127 - (item % 128), hh = (item / 128) % NH, b = item / (128 * NH);
    const int q = qblk * 64 + lane; const size_t tq = (size_t)b * S + q;
    const bf16_t *Q, *Kp;
    if (MODE == 0) { Q = p.qa + tq * 512 + hh * 64; Kp = p.ka + (size_t)b * S * 512 + hh * 64; }
    else if (MODE == 1) { Q = p.qb + tq * 512 + hh * 128; Kp = p.kb + (size_t)b * S * 512 + hh * 128; }
    else { Q = p.cq + tq * 512 + hh * 128; Kp = p.ck + (size_t)b * S * 512 + hh * 128; }
    unsigned qp[D / 2];
#pragma unroll
    for (int i = 0; i < D / 8; ++i) { const uint4 t = ((const uint4*)Q)[i]; qp[4 * i] = t.x; qp[4 * i + 1] = t.y; qp[4 * i + 2] = t.z; qp[4 * i + 3] = t.w; }
    float acc[SW];
#pragma unroll
    for (int i = 0; i < SW; ++i) acc[i] = 0.f;
    float mx = -INFINITY, lsum = 0.f;
    const int send = (qblk + 1) * 64;
    float Fq = 0.f; const float* Fk = nullptr;
    if (MODE == 1) { Fk = p.F + (size_t)(b * 4 + hh) * S; Fq = Fk[q]; }
    float lg = 0.f;
    if (MODE == 2) lg = log2f(1.0f - exp2f(-5.0f - (float)hh));
    for (int s = 0; s < send; ++s) {
        const uint4* kr = (const uint4*)(Kp + (size_t)s * 512);
        float sc = 0.f;
#pragma unroll
        for (int i = 0; i < D / 8; ++i) {
            const uint4 kv = kr[i];
            sc += bflo(qp[4 * i]) * bflo(kv.x) + bfhi(qp[4 * i]) * bfhi(kv.x);
            sc += bflo(qp[4 * i + 1]) * bflo(kv.y) + bfhi(qp[4 * i + 1]) * bfhi(kv.y);
            sc += bflo(qp[4 * i + 2]) * bflo(kv.z) + bfhi(qp[4 * i + 2]) * bfhi(kv.z);
            sc += bflo(qp[4 * i + 3]) * bflo(kv.w) + bfhi(qp[4 * i + 3]) * bfhi(kv.w);
            if ((i & 3) == 3) asm volatile("" ::: "memory");
        }
        float w, corr = 1.f;
        if (MODE == 2) {
            w = (s <= q) ? sc * exp2f((float)(q - s) * lg) : 0.f;
        } else {
            if (MODE == 1) sc += Fq - Fk[s];
            const bool valid = (MODE == 0) || (s <= q);
            if (valid) {
                const float mn = fmaxf(mx, sc);
                corr = exp2f(mx - mn); w = exp2f(sc - mn); mx = mn;
                lsum = lsum * corr + w;
            } else { w = 0.f; }
        }
        if (MODE == 2) {
            const uint4* vr = (const uint4*)(p.cv + ((size_t)b * S + s) * 1024 + hh * 256 + sl * SW);
#pragma unroll
            for (int i = 0; i < SW / 8; ++i) {
                const uint4 vv = vr[i];
                acc[8 * i] += w * bflo(vv.x); acc[8 * i + 1] += w * bfhi(vv.x); acc[8 * i + 2] += w * bflo(vv.y); acc[8 * i + 3] += w * bfhi(vv.y);
                acc[8 * i + 4] += w * bflo(vv.z); acc[8 * i + 5] += w * bfhi(vv.z); acc[8 * i + 6] += w * bflo(vv.w); acc[8 * i + 7] += w * bfhi(vv.w);
            }
        } else {
            const bf16_t* vt = (MODE == 0 ? p.vta + ((size_t)(b * 4 + (hh >> 1)) * 128 + sl * SW) * S : p.vtb + ((size_t)(b * 4 + hh) * 128 + sl * SW) * S) + s;
#pragma unroll
            for (int i = 0; i < SW; ++i) { acc[i] = acc[i] * corr + w * bf2f(*vt); vt += S; asm volatile("" : "+v"(vt)); }
        }
    }
    if (MODE == 2) {
        float* o = p.oc + tq * 1024 + hh * 256 + sl * SW;
#pragma unroll
        for (int i = 0; i < SW / 4; ++i) *(f32x4*)(o + 4 * i) = (f32x4){acc[4 * i], acc[4 * i + 1], acc[4 * i + 2], acc[4 * i + 3]};
    } else {
        const float inv = 1.f / lsum;
        bf16_t* o = (MODE == 0 ? p.oa + tq * 1024 + hh * 128 : p.yb + tq * 512 + hh * 128) + sl * SW;
#pragma unroll
        for (int i = 0; i < SW / 8; ++i) {
            uint4 w4; w4.x = pack2(acc[8 * i] * inv, acc[8 * i + 1] * inv); w4.y = pack2(acc[8 * i + 2] * inv, acc[8 * i + 3] * inv);
            w4.z = pack2(acc[8 * i + 4] * inv, acc[8 * i + 5] * inv); w4.w = pack2(acc[8 * i + 6] * inv, acc[8 * i + 7] * inv);
            ((uint4*)o)[i] = w4;
        }
    }
}


typedef float f32x16 __attribute__((ext_vector_type(16)));
DI bf16x8 pack8(float a0, float a1, float a2, float a3, float a4, float a5, float a6, float a7) {
    typedef unsigned u32x4 __attribute__((ext_vector_type(4)));
    u32x4 w; w[0] = pack2(a0, a1); w[1] = pack2(a2, a3); w[2] = pack2(a4, a5); w[3] = pack2(a6, a7);
    return __builtin_bit_cast(bf16x8, w);
}

template <int MODE>
DI void flash_item(const Params& p, int b, int hh, int qi, unsigned char* smem) {
    constexpr int D = MODE == 0 ? 64 : 128, KST = D + 8, VST = 68, KS = D / 16;
    constexpr int KBYTES = 64 * KST * 2, VBYTES = 128 * VST * 2, BUFB = KBYTES + VBYTES + 256;
    constexpr int NKC = D / 32, CPR = D / 8;
    const int tid = otid(), lane = tid & 63, w = tid >> 6, r = lane & 31, hf = lane >> 5;
    const int q0 = qi * 128 + w * 32;
    const size_t tq = (size_t)b * S + q0 + r;
    bf16x8 qf[KS];
    {
        const bf16_t* qptr = (MODE == 0 ? p.qa + tq * 512 + hh * 64 : p.qb + tq * 512 + hh * 128) + hf * 8;
#pragma unroll
        for (int ks = 0; ks < KS; ++ks) qf[ks] = *(const bf16x8*)(qptr + ks * 16);
    }
    const float* fbase = p.F + (size_t)(b * 4 + (MODE == 1 ? hh : 0)) * S;
    float Fq = 0.f; if (MODE == 1) Fq = fbase[q0 + r];
    const bf16_t* kbase = MODE == 0 ? p.ka + (size_t)b * S * 512 + hh * 64 : p.kb + (size_t)b * S * 512 + hh * 128;
    const bf16_t* vbase = MODE == 0 ? p.vta + (size_t)(b * 4 + (hh >> 1)) * 128 * S : p.vtb + (size_t)(b * 4 + hh) * 128 * S;
    const int ntiles = 2 * qi + 2, wlast = 2 * qi + (w >> 1);
    uint4 kr[NKC], vr[4]; f32x4 frg = {0.f, 0.f, 0.f, 0.f};
#define FL_GLOAD(j) do { \
        _Pragma("unroll") for (int i_ = 0; i_ < NKC; ++i_) { const int c_ = tid + 256 * i_; kr[i_] = *(const uint4*)(kbase + (size_t)(64 * (j) + c_ / CPR) * 512 + (c_ % CPR) * 8); } \
        _Pragma("unroll") for (int i_ = 0; i_ < 4; ++i_) { const int c_ = tid + 256 * i_; vr[i_] = *(const uint4*)(vbase + (size_t)(c_ >> 3) * S + 64 * (j) + (c_ & 7) * 8); } \
        if (MODE == 1 && tid < 16) frg = *(const f32x4*)(fbase + 64 * (j) + tid * 4); } while (0)
#define FL_SSTORE(buf) do { unsigned char* B_ = smem + (buf) * BUFB; \
        _Pragma("unroll") for (int i_ = 0; i_ < NKC; ++i_) { const int c_ = tid + 256 * i_; *(uint4*)(B_ + ((c_ / CPR) * KST + (c_ % CPR) * 8) * 2) = kr[i_]; } \
        _Pragma("unroll") for (int i_ = 0; i_ < 4; ++i_) { const int c_ = tid + 256 * i_; uint2* d_ = (uint2*)(B_ + KBYTES + ((c_ >> 3) * VST + (c_ & 7) * 8) * 2); d_[0] = make_uint2(vr[i_].x, vr[i_].y); d_[1] = make_uint2(vr[i_].z, vr[i_].w); } \
        if (MODE == 1 && tid < 16) *(f32x4*)(B_ + KBYTES + VBYTES + tid * 16) = frg; } while (0)
    FL_GLOAD(0);
    FL_SSTORE(0);
    LDS_BARRIER();
    f32x16 acc[4];
#pragma unroll
    for (int eb = 0; eb < 4; ++eb)
#pragma unroll
        for (int i = 0; i < 16; ++i) acc[eb][i] = 0.f;
    float mrun = -INFINITY, lsum = 0.f;
    for (int j = 0; j < ntiles; ++j) {
        const bool more = j + 1 < ntiles;
        if (more) FL_GLOAD(j + 1);
        if (j <= wlast) {
            const unsigned char* B = smem + (j & 1) * BUFB;
            f32x16 st[2];
#pragma unroll
            for (int kb = 0; kb < 2; ++kb) {
#pragma unroll
                for (int i = 0; i < 16; ++i) st[kb][i] = 0.f;
#pragma unroll
                for (int ks = 0; ks < KS; ++ks) {
                    const bf16x8 a = *(const bf16x8*)(B + ((kb * 32 + r) * KST + ks * 16 + hf * 8) * 2);
                    st[kb] = __builtin_amdgcn_mfma_f32_32x32x16_bf16(a, qf[ks], st[kb], 0, 0, 0);
                }
            }
            if (MODE == 1) {
                const float* Fl = (const float*)(B + KBYTES + VBYTES);
#pragma unroll
                for (int kb = 0; kb < 2; ++kb)
#pragma unroll
                    for (int g = 0; g < 4; ++g) {
                        const f32x4 fk = *(const f32x4*)(Fl + kb * 32 + 8 * g + 4 * hf);
#pragma unroll
                        for (int jj = 0; jj < 4; ++jj) st[kb][4 * g + jj] += Fq - fk[jj];
                    }
                if (j >= 2 * qi) {
                    const int qabs = q0 + r;
#pragma unroll
                    for (int kb = 0; kb < 2; ++kb)
#pragma unroll
                        for (int g = 0; g < 4; ++g)
#pragma unroll
                            for (int jj = 0; jj < 4; ++jj) { const int key = 64 * j + kb * 32 + 8 * g + 4 * hf + jj; if (key > qabs) st[kb][4 * g + jj] = -INFINITY; }
                }
            }
            float mt = st[0][0];
#pragma unroll
            for (int i = 1; i < 16; ++i) mt = fmaxf(mt, st[0][i]);
#pragma unroll
            for (int i = 0; i < 16; ++i) mt = fmaxf(mt, st[1][i]);
            mt = fmaxf(mt, __shfl_xor(mt, 32));
            const float mn = fmaxf(mrun, mt);
            const float corr = ex2(mrun - mn);
            mrun = mn; lsum *= corr;
#pragma unroll
            for (int kb = 0; kb < 2; ++kb)
#pragma unroll
                for (int i = 0; i < 16; ++i) { const float pv = ex2(st[kb][i] - mn); st[kb][i] = pv; lsum += pv; }
#pragma unroll
            for (int eb = 0; eb < 4; ++eb) acc[eb] *= corr;
#pragma unroll
            for (int kb = 0; kb < 2; ++kb)
#pragma unroll
                for (int s2 = 0; s2 < 2; ++s2) {
                    const bf16x8 pf = pack8(st[kb][8 * s2], st[kb][8 * s2 + 1], st[kb][8 * s2 + 2], st[kb][8 * s2 + 3], st[kb][8 * s2 + 4], st[kb][8 * s2 + 5], st[kb][8 * s2 + 6], st[kb][8 * s2 + 7]);
#pragma unroll
                    for (int eb = 0; eb < 4; ++eb) {
                        const unsigned char* vp = B + KBYTES + ((eb * 32 + r) * VST + kb * 32 + 16 * s2 + 4 * hf) * 2;
                        const uint2 lo = *(const uint2*)vp, hi = *(const uint2*)(vp + 16);
                        typedef unsigned u32x4 __attribute__((ext_vector_type(4)));
                        u32x4 av; av[0] = lo.x; av[1] = lo.y; av[2] = hi.x; av[3] = hi.y;
                        acc[eb] = __builtin_amdgcn_mfma_f32_32x32x16_bf16(__builtin_bit_cast(bf16x8, av), pf, acc[eb], 0, 0, 0);
                    }
                }
        }
        if (more) FL_SSTORE((j + 1) & 1);
        LDS_BARRIER();
    }
#undef FL_GLOAD
#undef FL_SSTORE
    const float inv = 1.f / (lsum + __shfl_xor(lsum, 32));
    bf16_t* o = MODE == 0 ? p.oa + tq * 1024 + hh * 128 : p.yb + tq * 512 + hh * 128;
#pragma unroll
    for (int eb = 0; eb < 4; ++eb)
#pragma unroll
        for (int g = 0; g < 4; ++g) {
            f32x4 v = {acc[eb][4 * g] * inv, acc[eb][4 * g + 1] * inv, acc[eb][4 * g + 2] * inv, acc[eb][4 * g + 3] * inv};
            st4(o + eb * 32 + 8 * g + 4 * hf, v);
        }
}


DI void ret_state_item(const Params& p, int item) {
    const int n = item & 127, bh = item >> 7;
    const int tid = otid(), lane = tid & 63, w = tid >> 6, r = lane & 31, hf = lane >> 5;
    const bf16_t* kt = p.ckT + (size_t)bh * 128 * S + n * 64 + hf * 8;
    const bf16_t* vt = p.cv + ((size_t)bh * 256 + w * 64) * S + n * 64 + hf * 8;
    f32x16 acc[4][2];
#pragma unroll
    for (int a = 0; a < 4; ++a)
#pragma unroll
        for (int c = 0; c < 2; ++c)
#pragma unroll
            for (int i = 0; i < 16; ++i) acc[a][c][i] = 0.f;
#pragma unroll
    for (int s4 = 0; s4 < 4; ++s4) {
        bf16x8 af[4], bfr[2];
#pragma unroll
        for (int a = 0; a < 4; ++a) af[a] = *(const bf16x8*)(kt + (size_t)(a * 32 + r) * S + s4 * 16);
#pragma unroll
        for (int c = 0; c < 2; ++c) bfr[c] = *(const bf16x8*)(vt + (size_t)(c * 32 + r) * S + s4 * 16);
#pragma unroll
        for (int a = 0; a < 4; ++a)
#pragma unroll
            for (int c = 0; c < 2; ++c) acc[a][c] = __builtin_amdgcn_mfma_f32_32x32x16_bf16(af[a], bfr[c], acc[a][c], 0, 0, 0);
    }
    bf16_t* o = p.kv + ((size_t)(bh * 128 + n) * 256 + w * 64) * 128;
#pragma unroll
    for (int a = 0; a < 4; ++a)
#pragma unroll
        for (int c = 0; c < 2; ++c)
#pragma unroll
            for (int g = 0; g < 4; ++g) {
                f32x4 v = {acc[a][c][4 * g], acc[a][c][4 * g + 1], acc[a][c][4 * g + 2], acc[a][c][4 * g + 3]};
                st4_wt(o + (size_t)(c * 32 + r) * 128 + a * 32 + 8 * g + 4 * hf, v);
            }
}

DI void ret_scan(const Params& p) {
    const int gtid = obid() * 256 + otid(), gsz = gridDim.x * 256;
    for (int e = gtid; e < 8 * 8192; e += gsz) {
        const int bh = e >> 13, pi = e & 8191, hd = bh & 3;
        const float dec = ex2(64.0f * lg2gamma(hd));
        unsigned long long* ptr = (unsigned long long*)p.kv + (size_t)bh * 128 * 8192 + pi;
        float c0 = 0.f, c1 = 0.f, c2 = 0.f, c3 = 0.f;
        for (int n0 = 0; n0 < 128; n0 += 8) {
            unsigned long long v[8];
#pragma unroll
            for (int k = 0; k < 8; ++k) v[k] = ptr[(size_t)(n0 + k) * 8192];
            asm volatile("s_waitcnt vmcnt(0)" ::: "memory");
#pragma unroll
            for (int k = 0; k < 8; ++k) {
                const unsigned long long o = (unsigned long long)pack2(c0, c1) | ((unsigned long long)pack2(c2, c3) << 32);
                __hip_atomic_store(ptr + (size_t)(n0 + k) * 8192, o, __ATOMIC_RELAXED, __HIP_MEMORY_SCOPE_AGENT);
                const unsigned lo = (unsigned)v[k], hi = (unsigned)(v[k] >> 32);
                c0 = c0 * dec + bflo(lo); c1 = c1 * dec + bfhi(lo); c2 = c2 * dec + bflo(hi); c3 = c3 * dec + bfhi(hi);
            }
        }
    }
}

DI void ret_out_item(const Params& p, int l, int item, unsigned char* smem) {
    const int n = item & 127, bh = item >> 7, b = bh >> 2, hd = bh & 3;
    const int tid = otid(), lane = tid & 63, w = tid >> 6, r = lane & 31, hf = lane >> 5;
    const size_t t0 = (size_t)b * S + n * 64;
    f32x16 acc[2][2];
#pragma unroll
    for (int a = 0; a < 2; ++a)
#pragma unroll
        for (int c = 0; c < 2; ++c)
#pragma unroll
            for (int i = 0; i < 16; ++i) acc[a][c][i] = 0.f;
    bf16x8 pf[2][2][2];
    {
        bf16x8 qf[2][8];
#pragma unroll
        for (int qb = 0; qb < 2; ++qb)
#pragma unroll
            for (int ks = 0; ks < 8; ++ks) qf[qb][ks] = *(const bf16x8*)(p.cq + (t0 + qb * 32 + r) * 512 + hd * 128 + ks * 16 + hf * 8);
        const bf16_t* rt = p.kv + ((size_t)(bh * 128 + n) * 256 + w * 64) * 128 + hf * 8;
#pragma unroll
        for (int dvb = 0; dvb < 2; ++dvb)
#pragma unroll
            for (int ks = 0; ks < 8; ++ks) {
                const bf16x8 a = *(const bf16x8*)(rt + (size_t)(dvb * 32 + r) * 128 + ks * 16);
#pragma unroll
                for (int qb = 0; qb < 2; ++qb) acc[dvb][qb] = __builtin_amdgcn_mfma_f32_32x32x16_bf16(a, qf[qb][ks], acc[dvb][qb], 0, 0, 0);
            }
#pragma unroll
        for (int kb = 0; kb < 2; ++kb) {
            f32x16 st[2];
#pragma unroll
            for (int qb = 0; qb < 2; ++qb)
#pragma unroll
                for (int i = 0; i < 16; ++i) st[qb][i] = 0.f;
#pragma unroll
            for (int ks = 0; ks < 8; ++ks) {
                const bf16x8 a = *(const bf16x8*)(p.ck + (t0 + kb * 32 + r) * 512 + hd * 128 + ks * 16 + hf * 8);
#pragma unroll
                for (int qb = 0; qb < 2; ++qb) st[qb] = __builtin_amdgcn_mfma_f32_32x32x16_bf16(a, qf[qb][ks], st[qb], 0, 0, 0);
            }
#pragma unroll
            for (int qb = 0; qb < 2; ++qb) {
#pragma unroll
                for (int i = 0; i < 16; ++i) { const int key = kb * 32 + (i & 3) + 8 * (i >> 2) + 4 * hf; if (key > qb * 32 + r) st[qb][i] = 0.f; }
#pragma unroll
                for (int s2 = 0; s2 < 2; ++s2)
                    pf[kb][s2][qb] = pack8(st[qb][8 * s2], st[qb][8 * s2 + 1], st[qb][8 * s2 + 2], st[qb][8 * s2 + 3], st[qb][8 * s2 + 4], st[qb][8 * s2 + 5], st[qb][8 * s2 + 6], st[qb][8 * s2 + 7]);
            }
        }
    }
    {
        const bf16_t* vt = p.cv + ((size_t)bh * 256 + w * 64) * S + n * 64 + 4 * hf;
#pragma unroll
        for (int dvb = 0; dvb < 2; ++dvb)
#pragma unroll
            for (int kb = 0; kb < 2; ++kb)
#pragma unroll
                for (int s2 = 0; s2 < 2; ++s2) {
                    const bf16_t* vp = vt + (size_t)(dvb * 32 + r) * S + kb * 32 + 16 * s2;
                    const uint2 lo = *(const uint2*)vp, hi = *(const uint2*)(vp + 8);
                    typedef unsigned u32x4 __attribute__((ext_vector_type(4)));
                    u32x4 av; av[0] = lo.x; av[1] = lo.y; av[2] = hi.x; av[3] = hi.y;
                    const bf16x8 a = __builtin_bit_cast(bf16x8, av);
#pragma unroll
                    for (int qb = 0; qb < 2; ++qb) acc[dvb][qb] = __builtin_amdgcn_mfma_f32_32x32x16_bf16(a, pf[kb][s2][qb], acc[dvb][qb], 0, 0, 0);
                }
    }
    float* red = (float*)smem;
    float mu[2], rstd[2];
    __syncthreads();
#pragma unroll
    for (int qb = 0; qb < 2; ++qb) {
        float s1 = 0.f, s2 = 0.f;
#pragma unroll
        for (int dvb = 0; dvb < 2; ++dvb)
#pragma unroll
            for (int i = 0; i < 16; ++i) { const float x = acc[dvb][qb][i]; s1 += x; s2 += x * x; }
        s1 += __shfl_xor(s1, 32); s2 += __shfl_xor(s2, 32);
        if (hf == 0) { red[(w * 64 + qb * 32 + r) * 2] = s1; red[(w * 64 + qb * 32 + r) * 2 + 1] = s2; }
    }
    __syncthreads();
#pragma unroll
    for (int qb = 0; qb < 2; ++qb) {
        float s1 = 0.f, s2 = 0.f;
#pragma unroll
        for (int ww = 0; ww < 4; ++ww) { s1 += red[(ww * 64 + qb * 32 + r) * 2]; s2 += red[(ww * 64 + qb * 32 + r) * 2 + 1]; }
        const float m_ = s1 * (1.f / 256.f);
        mu[qb] = m_; rstd[qb] = rsqrtf(fmaxf(s2 * (1.f / 256.f) - m_ * m_, 0.f) + LN_EPS);
    }
    const float* gr = p.g_ret + (size_t)l * 1024 + hd * 256 + w * 64;
#pragma unroll
    for (int dvb = 0; dvb < 2; ++dvb)
#pragma unroll
        for (int g = 0; g < 4; ++g) {
            const int dv = dvb * 32 + 8 * g + 4 * hf;
            const f32x4 gg = *(const f32x4*)(gr + dv);
#pragma unroll
            for (int qb = 0; qb < 2; ++qb) {
                const size_t off = (t0 + qb * 32 + r) * 1024 + hd * 256 + w * 64 + dv;
                const uint2 cgv = *(const uint2*)(p.cg + off);
                f32x4 y;
#pragma unroll
                for (int jj = 0; jj < 4; ++jj) y[jj] = (acc[dvb][qb][4 * g + jj] - mu[qb]) * rstd[qb] * gg[jj];
                y[0] *= bflo(cgv.x); y[1] *= bfhi(cgv.x); y[2] *= bflo(cgv.y); y[3] *= bfhi(cgv.y);
                st4(p.yc + off, y);
            }
        }
}

DI void phase_mixers(const Params& p, int l, unsigned char* smem) {
    const int nF = 64 * 24, nC = 2 * 4 * 128;
    int* sitem = (int*)(smem + SMEM_BYTES - 16);
    for (;;) {
        __syncthreads();
        if (otid() == 0) *sitem = (int)atomicAdd(p.ctr + l, 1u);
        __syncthreads();
        const int it = *sitem;
        if (it >= nF + nC) break;
        if (it < nF) {
            const int qi = 63 - it / 24, r = it % 24;
            if (r < 8) flash_item<1>(p, r >> 2, r & 3, qi, smem);
            else flash_item<0>(p, (r - 8) >> 3, (r - 8) & 7, qi, smem);
        } else ret_state_item(p, it - nF);
    }
}

DI void phase_mixers_naive(const Params& p) {
    const int nA = 2 * 8 * 128, nB = 2 * 4 * 128, nC = 2 * 4 * 128;
    for (int it = obid(); it < nA + nB + nC; it += gridDim.x) {
        if (it < nB) naive_attn<1>(p, it);
        else if (it < nB + nC) naive_attn<2>(p, it - nB);
        else naive_attn<0>(p, it - nB - nC);
    }
}

DI void phase_post(const Params& p, int l) {
    const int lane = otid() & 63, wv = otid() >> 6;
    const float lam = p.lamv[2 * l], li = p.lamv[2 * l + 1];
    const float* gd = p.g_diff + (size_t)l * 512; const float* gr = p.g_ret + (size_t)l * 1024;
    for (int row = obid() * 4 + wv; row < T; row += gridDim.x * 4) {
#pragma unroll
        for (int hh = 0; hh < 4; ++hh) {
            const unsigned o0 = *(const unsigned*)(p.oa + (size_t)row * 1024 + (2 * hh) * 128 + lane * 2);
            const unsigned o1 = *(const unsigned*)(p.oa + (size_t)row * 1024 + (2 * hh + 1) * 128 + lane * 2);
            const float d0 = bflo(o0) - lam * bflo(o1), d1 = bfhi(o0) - lam * bfhi(o1);
            float ss = d0 * d0 + d1 * d1;
            for (int o = 32; o; o >>= 1) ss += __shfl_xor(ss, o);
            const float r = rsqrtf(ss * (1.f / 128.f) + LN_EPS) * (1.f - li);
            const int c = hh * 128 + lane * 2;
            *(unsigned*)(p.ya + (size_t)row * 512 + c) = pack2(d0 * r * gd[c], d1 * r * gd[c + 1]);
        }
    }
}

DI void grid_bar(unsigned* bar, unsigned& epoch) {
    asm volatile("s_waitcnt vmcnt(0) lgkmcnt(0)" ::: "memory");
    __syncthreads();
    epoch += 1;
    const int tid = otid();
    unsigned* go = bar;
    unsigned* flags = bar + 32;
    if (tid == 0) {
        __builtin_amdgcn_fence(__ATOMIC_RELEASE, "agent");
        asm volatile("s_waitcnt vmcnt(0)" ::: "memory");
        __hip_atomic_store(flags + 32 * obid(), epoch, __ATOMIC_RELAXED, __HIP_MEMORY_SCOPE_AGENT);
    }
    if (obid() == 0 && tid < 64) {
        const int nb = gridDim.x;
        for (int base = 0; base < nb; base += 64) {
            const int idx = base + tid;
            if (idx < nb) while (__hip_atomic_load(flags + 32 * idx, __ATOMIC_RELAXED, __HIP_MEMORY_SCOPE_AGENT) < epoch) __builtin_amdgcn_s_sleep(1);
        }
        asm volatile("s_waitcnt vmcnt(0)" ::: "memory");
        if (tid == 0) __hip_atomic_store(go, epoch, __ATOMIC_RELAXED, __HIP_MEMORY_SCOPE_AGENT);
    }
    if (tid == 0) {
        while (__hip_atomic_load(go, __ATOMIC_RELAXED, __HIP_MEMORY_SCOPE_AGENT) < epoch) __builtin_amdgcn_s_sleep(1);
        __builtin_amdgcn_fence(__ATOMIC_ACQUIRE, "agent");
        asm volatile("s_waitcnt vmcnt(0)" ::: "memory");
    }
    __syncthreads();
}
#define GSYNC() grid_bar(p.bar, epoch)
__global__ void __launch_bounds__(256, 2) fwd_kernel(Params p) {
    __shared__ __attribute__((aligned(16))) unsigned char smem[SMEM_BYTES];
    cg::grid_group grid = cg::this_grid();
    bf16_t* sm = (bf16_t*)smem; float* smf = (float*)smem;

    unsigned epoch = 0;
    asm volatile("s_waitcnt vmcnt(0) lgkmcnt(0)" ::: "memory"); grid.sync();
    convert_layer(p, 0, smf);
    phase0_misc(p, smf);
    GSYNC();
    row_phase(p, p.x, false, nullptr, nullptr, nullptr, p.mod, 0, 1024, true, true);
    GSYNC();
    for (int l = 0; l < DEPTH; ++l) {
        const float* modl = p.mod + (size_t)l * 2 * 6144;
        const float* xcur = l == 0 ? p.x : p.xbuf;
        if (obid() >= gridDim.x - 8) scan_item(p, obid() - (gridDim.x - 8), smf);
        phase_inproj(p, sm);
        GSYNC();
        phase_mixers(p, l, smem);
        GSYNC();
        phase_post(p, l);
        ret_scan(p);
        GSYNC();
        for (int it = obid(); it < 1024; it += gridDim.x) ret_out_item(p, l, it, smem);
        GSYNC();
        phase_branch(p, sm);
        GSYNC();
        phase_gemm_res(p, p.h, 1024, p.WoutT, xcur, modl, 2048, sm);
        GSYNC();
        row_phase(p, p.vbuf, true, p.ln_g + (size_t)(l * 2) * Dm, p.ln_b + (size_t)(l * 2) * Dm, p.xbuf, modl, 3072, 4096, true, false);
        GSYNC();
        phase_up(p, sm);
        GSYNC();
        phase_conv(p, l);
        GSYNC();
        phase_gemm_res(p, p.act, DFF, p.WdownT, p.xbuf, modl, 5120, sm);
        GSYNC();
        if (l + 1 < DEPTH) {
            convert_layer(p, l + 1, smf);
            GSYNC();
            row_phase(p, p.vbuf, true, p.ln_g + (size_t)(l * 2 + 1) * Dm, p.ln_b + (size_t)(l * 2 + 1) * Dm, p.xbuf, modl + 2 * 6144, 0, 1024, true, true);
            GSYNC();
        } else {
            row_phase(p, p.vbuf, true, p.ln_g + (size_t)(l * 2 + 1) * Dm, p.ln_b + (size_t)(l * 2 + 1) * Dm, p.out, modl, 0, 1024, false, false);
        }
    }
}

extern "C" void kernel_launch(void* const* d_in, const int* in_sizes, int n_in, void* d_out, int out_size, void* d_ws, size_t ws_size, hipStream_t stream) {
    static int grid_blocks = 0;
    if (!grid_blocks) {
        int dev = 0, cus = 0, per_cu = 0;
        hipGetDevice(&dev);
        hipDeviceGetAttribute(&cus, hipDeviceAttributeMultiprocessorCount, dev);
        hipOccupancyMaxActiveBlocksPerMultiprocessor(&per_cu, fwd_kernel, 256, 0);
        if (per_cu > 2) per_cu = 2;
        if (per_cu < 1) per_cu = 1;
        grid_blocks = cus * per_cu;
    }
    Params p{};
    const float** ins = (const float**)&p.x;
    for (int i = 0; i < 22; ++i) ins[i] = (const float*)d_in[i];
    p.out = (float*)d_out;
    char* w = (char*)d_ws; size_t off = 0;
    auto take = [&](size_t bytes) { char* r = w + off; off += (bytes + 255) & ~(size_t)255; return r; };
    const size_t MB = 1u << 20;
    p.mod = (float*)take((size_t)DEPTH * 2 * 6144 * 4);
    p.lamv = (float*)take(256);
    p.ctr = (unsigned*)take(256);
    p.bar = (unsigned*)take((size_t)(1 + 1024) * 128);
    p.wf = (float*)take(4100 * 4);
    p.binp = (float*)take(NIN * 4);
    p.cstab = (float*)take((size_t)S * 64 * 2 * 4);
    p.logf = (float*)take((size_t)T * 4 * 4);
    p.F = (float*)take((size_t)T * 4 * 4);
    p.WinT = (bf16_t*)take((size_t)NIN * 1024 * 2);
    p.WpaT = (bf16_t*)take((size_t)1024 * 512 * 2);
    p.WpbT = (bf16_t*)take((size_t)1024 * 512 * 2);
    p.WpcT = (bf16_t*)take((size_t)1024 * 1024 * 2);
    p.WoutT = (bf16_t*)take((size_t)1024 * 1024 * 2);
    p.WupT = (bf16_t*)take((size_t)2 * DFF * 1024 * 2);
    p.WdownT = (bf16_t*)take((size_t)1024 * DFF * 2);
    p.xbuf = (float*)take((size_t)T * Dm * 4);
    p.h = (bf16_t*)take((size_t)T * Dm * 2);
    const size_t offA = off;
    p.qa = (bf16_t*)take((size_t)T * 512 * 2); p.ka = (bf16_t*)take((size_t)T * 512 * 2); p.vta = (bf16_t*)take((size_t)T * 512 * 2);
    p.qb = (bf16_t*)take((size_t)T * 512 * 2); p.kb = (bf16_t*)take((size_t)T * 512 * 2); p.vtb = (bf16_t*)take((size_t)T * 512 * 2);
    p.cq = (bf16_t*)take((size_t)T * 512 * 2); p.ck = (bf16_t*)take((size_t)T * 512 * 2);
    p.cv = (bf16_t*)take((size_t)T * 1024 * 2); p.cg = (bf16_t*)take((size_t)T * 1024 * 2);
    p.gates = (bf16_t*)take((size_t)T * 3072 * 2);
    const size_t endA = off;
    p.ug = (bf16_t*)(w + offA);
    p.act = (bf16_t*)(w + offA + (size_t)T * 2 * DFF * 2);
    const size_t offB = endA;
    off = offB;
    p.vbuf = (float*)(w + offB);
    p.oa = p.h;
    p.yb = (bf16_t*)take((size_t)T * 512 * 2);
    p.kv = (bf16_t*)take((size_t)8 * 128 * 256 * 128 * 2);
    p.ckT = (bf16_t*)take((size_t)T * 512 * 2);
    p.ya = (bf16_t*)take((size_t)T * 512 * 2);
    p.yc = (bf16_t*)take((size_t)T * 1024 * 2);
    if (off > ws_size || (size_t)T * 2 * DFF * 2 + (size_t)T * DFF * 2 > endA - offA) {
        fprintf(stderr, "kernel_launch: workspace too small: need %zu MB have %zu MB\n", off / MB, ws_size / MB);
        return;
    }
    (void)hipMemsetAsync(p.bar, 0, (size_t)(1 + 1024) * 128, stream);
    void* args[] = {&p};
    hipError_t e = hipLaunchCooperativeKernel((void*)fwd_kernel, dim3(grid_blocks), dim3(256), args, 0, stream);
    if (e != hipSuccess) fprintf(stderr, "cooperative launch failed: %s (grid %d)\n", hipGetErrorString(e), grid_blocks);
}
```

```cpp
#include <hip/hip_runtime.h>
#include <hip/hip_cooperative_groups.h>
#include <cstdio>
#include <cstdint>
namespace cg = cooperative_groups;

typedef unsigned short bf16_t;
typedef short bf16x8 __attribute__((ext_vector_type(8)));
typedef float f32x4 __attribute__((ext_vector_type(4)));

constexpr int Dm = 1024, NB = 2, S = 8192, T = NB * S, DEPTH = 4, DFF = 2816, DIN = 9220, NIN = 9216;
constexpr float LN_EPS = 1e-5f;
constexpr float LOG2E = 1.4426950408889634f;
#define ALPHA_F 1.681792830507429f

#define DI __device__ __forceinline__
DI int otid() { int t = threadIdx.x; asm volatile("" : "+v"(t)); return t; }
DI int obid() { int b = blockIdx.x; asm volatile("" : "+s"(b)); return b; }

typedef __bf16 hbf2 __attribute__((ext_vector_type(2)));
typedef float f32x2 __attribute__((ext_vector_type(2)));
DI bf16_t f2bf(float x) { return __builtin_bit_cast(unsigned short, (__bf16)x); }
DI float bf2f(bf16_t v) { return __uint_as_float(((unsigned)v) << 16); }
DI float bflo(unsigned w) { return __uint_as_float(w << 16); }
DI float bfhi(unsigned w) { return __uint_as_float(w & 0xffff0000u); }
DI unsigned pack2(float a, float b) { f32x2 v = {a, b}; return __builtin_bit_cast(unsigned, __builtin_convertvector(v, hbf2)); }

struct Params {
    const float *x, *c, *w_ada, *b_ada, *w_in, *b_in, *lq1, *lk1, *lq2, *lk2, *g_diff, *g_ret, *w_pa, *w_pb, *w_pc, *w_out, *ln_g, *ln_b, *w_up, *w_conv, *b_conv, *w_down;
    float* out;
    unsigned* ctr; unsigned* bar;
    float *mod, *lamv, *wf, *binp, *cstab, *xbuf, *vbuf, *logf, *F, *oc;
    bf16_t *WinT, *WpaT, *WpbT, *WpcT, *WoutT, *WupT, *WdownT;
    bf16_t *h, *qa, *ka, *vta, *qb, *kb, *vtb, *cq, *ck, *cv, *cg, *gates, *oa, *yb, *ya, *yc, *ug, *act, *ckT, *kv;
};

#define LDS_BARRIER() do { asm volatile("s_waitcnt lgkmcnt(0)" ::: "memory"); __builtin_amdgcn_s_barrier(); asm volatile("" ::: "memory"); } while (0)
constexpr int BM = 128, BN = 128, BK = 64, LDP = BK + 8;
constexpr int SMEM_BYTES = 2 * (BM + BN) * LDP * 2;

DI int win_map(int n) {
    if (n < 3072) return n;
    if (n < 4096) { int r = n - 3072; int seg = r >> 9; r &= 511; int head = r >> 7; int c = r & 127; return 3076 + seg * 512 + head * 128 + (c >> 1) + 64 * (c & 1); }
    return n + 4;
}

DI void convert_tile(const float* __restrict__ src, int ldsrc, bf16_t* __restrict__ dst, int K, int tiles_n, int tile, int kind, float* lds) {
    const int tn = tile % tiles_n, tk = tile / tiles_n;
    const int tx = otid() & 63, ty = otid() >> 6;
    const int n = tn * 64 + tx;
    const int sn = kind == 1 ? win_map(n) : n;
    __syncthreads();
#pragma unroll 4
    for (int r = 0; r < 16; ++r) {
        const int kk = ty * 16 + r;
        lds[kk * 65 + tx] = src[(size_t)(tk * 64 + kk) * ldsrc + sn];
    }
    __syncthreads();
#pragma unroll 4
    for (int r = 0; r < 16; ++r) {
        const int nn = ty * 16 + r;
        dst[(size_t)(tn * 64 + nn) * K + tk * 64 + tx] = f2bf(lds[tx * 65 + nn]);
    }
}

DI void convert_layer(const Params& p, int l, float* lds) {
    const int n_in = 16 * 144, n_pa = 8 * 16, n_pb = 8 * 16, n_pc = 16 * 16, n_out = 16 * 16, n_up = 16 * 88, n_dn = 44 * 16;
    const int total = n_in + n_pa + n_pb + n_pc + n_out + n_up + n_dn;
    for (int it = obid(); it < total; it += gridDim.x) {
        int t = it;
        if (t < n_in) { convert_tile(p.w_in + (size_t)l * Dm * DIN, DIN, p.WinT, 1024, 144, t, 1, lds); continue; } t -= n_in;
        if (t < n_pa) { convert_tile(p.w_pa + (size_t)l * 512 * Dm, Dm, p.WpaT, 512, 16, t, 0, lds); continue; } t -= n_pa;
        if (t < n_pb) { convert_tile(p.w_pb + (size_t)l * 512 * Dm, Dm, p.WpbT, 512, 16, t, 0, lds); continue; } t -= n_pb;
        if (t < n_pc) { convert_tile(p.w_pc + (size_t)l * 1024 * Dm, Dm, p.WpcT, 1024, 16, t, 0, lds); continue; } t -= n_pc;
        if (t < n_out) { convert_tile(p.w_out + (size_t)l * Dm * Dm, Dm, p.WoutT, 1024, 16, t, 0, lds); continue; } t -= n_out;
        if (t < n_up) { convert_tile(p.w_up + (size_t)l * Dm * 2 * DFF, 2 * DFF, p.WupT, 1024, 88, t, 0, lds); continue; } t -= n_up;
        convert_tile(p.w_down + (size_t)l * DFF * Dm, Dm, p.WdownT, DFF, 16, t, 0, lds);
    }
    const int gtid = obid() * blockDim.x + otid(), gsz = gridDim.x * blockDim.x;
    for (int i = gtid; i < NIN; i += gsz) p.binp[i] = p.b_in[(size_t)l * DIN + win_map(i)];
    for (int i = gtid; i < 4096; i += gsz) { const int k = i >> 2, hh = i & 3; p.wf[i] = p.w_in[(size_t)l * Dm * DIN + (size_t)k * DIN + 3072 + hh]; }
    for (int i = gtid; i < 4; i += gsz) p.wf[4096 + i] = p.b_in[(size_t)l * DIN + 3072 + i];
}

DI float ex2(float x) { return __builtin_amdgcn_exp2f(x); }
DI float lg2gamma(int hd) { return hd == 0 ? -0.04580368961312479f : hd == 1 ? -0.02272007650008353f : hd == 2 ? -0.011315313227834146f : -0.005646563141142063f; }
DI float silu_f(float v) { return v / (1.f + __expf(-v)); }
DI float sigmoid_f(float v) { return 1.f / (1.f + __expf(-v)); }

DI void phase0_misc(const Params& p, float* lds) {
    for (int it = obid(); it < DEPTH * 96; it += gridDim.x) {
        const int l = it / 96, jb = it % 96;
        const int tx = otid() & 63, ks = otid() >> 6;
        const int j = jb * 64 + tx;
        const float* w = p.w_ada + (size_t)l * Dm * 6144 + j;
        float a0 = 0.f, a1 = 0.f;
#pragma unroll 8
        for (int k = ks * 256; k < ks * 256 + 256; ++k) {
            const float wv = w[(size_t)k * 6144];
            a0 += silu_f(p.c[k]) * wv; a1 += silu_f(p.c[Dm + k]) * wv;
        }
        __syncthreads();
        lds[(ks * 64 + tx) * 2] = a0; lds[(ks * 64 + tx) * 2 + 1] = a1;
        __syncthreads();
        if (ks == 0) {
            float s0 = 0.f, s1 = 0.f;
            for (int q = 0; q < 4; ++q) { s0 += lds[(q * 64 + tx) * 2]; s1 += lds[(q * 64 + tx) * 2 + 1]; }
            const float bb = p.b_ada[(size_t)l * 6144 + j];
            p.mod[((size_t)l * 2 + 0) * 6144 + j] = s0 + bb;
            p.mod[((size_t)l * 2 + 1) * 6144 + j] = s1 + bb;
        }
    }
    const int gtid = obid() * blockDim.x + otid(), gsz = gridDim.x * blockDim.x;
    if (gtid < 64) p.ctr[gtid] = 0u;
    if (obid() == 0 && otid() < 64 * DEPTH) {
        const int l = otid() >> 6, ln = otid() & 63;
        float a = p.lq1[l * 64 + ln] * p.lk1[l * 64 + ln], b = p.lq2[l * 64 + ln] * p.lk2[l * 64 + ln];
        for (int o = 32; o; o >>= 1) { a += __shfl_xor(a, o); b += __shfl_xor(b, o); }
        if (ln == 0) { const float li = 0.8f - 0.6f * expf(-0.3f * (float)l); p.lamv[2 * l] = expf(a) - expf(b) + li; p.lamv[2 * l + 1] = li; }
    }
}

DI void row_phase(const Params& p, const float* __restrict__ src, bool do_ln, const float* __restrict__ lng, const float* __restrict__ lnb,
                  float* __restrict__ xdst, const float* __restrict__ modl  , int sh_off, int sc_off, bool want_h, bool want_logf) {
    const int lane = otid() & 63, wv = otid() >> 6;
    for (int row = obid() * 4 + wv; row < T; row += gridDim.x * 4) {
        const int b = row / S;
        const float* sp = src + (size_t)row * Dm;
        f32x4 v[4];
#pragma unroll
        for (int i = 0; i < 4; ++i) v[i] = *(const f32x4*)(sp + i * 256 + lane * 4);
        if (do_ln) {
            float s = 0.f;
#pragma unroll
            for (int i = 0; i < 4; ++i) s += (v[i][0] + v[i][1]) + (v[i][2] + v[i][3]);
            for (int o = 32; o; o >>= 1) s += __shfl_xor(s, o);
            const float mu = s * (1.f / 1024.f);
            float q = 0.f;
#pragma unroll
            for (int i = 0; i < 4; ++i) { f32x4 d = v[i] - mu; q += (d[0] * d[0] + d[1] * d[1]) + (d[2] * d[2] + d[3] * d[3]); }
            for (int o = 32; o; o >>= 1) q += __shfl_xor(q, o);
            const float rstd = rsqrtf(q * (1.f / 1024.f) + LN_EPS);
#pragma unroll
            for (int i = 0; i < 4; ++i) {
                const f32x4 g = *(const f32x4*)(lng + i * 256 + lane * 4), bb = *(const f32x4*)(lnb + i * 256 + lane * 4);
                v[i] = (v[i] - mu) * rstd * g + bb;
            }
        }
        if (xdst) {
#pragma unroll
            for (int i = 0; i < 4; ++i) *(f32x4*)(xdst + (size_t)row * Dm + i * 256 + lane * 4) = v[i];
        }
        if (want_h) {
            const float* mb = modl + (size_t)b * 6144;
            float d0 = 0.f, d1 = 0.f, d2 = 0.f, d3 = 0.f;
#pragma unroll
            for (int i = 0; i < 4; ++i) {
                const int c0 = i * 256 + lane * 4;
                const f32x4 sc = *(const f32x4*)(mb + sc_off + c0), sh = *(const f32x4*)(mb + sh_off + c0);
                const f32x4 hv = v[i] * (1.f + sc) + sh;
                uint2 w; w.x = pack2(hv[0], hv[1]); w.y = pack2(hv[2], hv[3]);
                *(uint2*)(p.h + (size_t)row * Dm + c0) = w;
                if (want_logf) {
#pragma unroll
                    for (int j = 0; j < 4; ++j) {
                        const f32x4 wf = *(const f32x4*)(p.wf + (c0 + j) * 4);
                        d0 += hv[j] * wf[0]; d1 += hv[j] * wf[1]; d2 += hv[j] * wf[2]; d3 += hv[j] * wf[3];
                    }
                }
            }
            if (want_logf) {
                for (int o = 32; o; o >>= 1) { d0 += __shfl_xor(d0, o); d1 += __shfl_xor(d1, o); d2 += __shfl_xor(d2, o); d3 += __shfl_xor(d3, o); }
                if (lane < 4) {
                    float z = (lane == 0 ? d0 : lane == 1 ? d1 : lane == 2 ? d2 : d3) + p.wf[4096 + lane];
                    const float ls = fminf(z, 0.f) - log1pf(__expf(-fabsf(z)));
                    p.logf[(size_t)row * 4 + lane] = ls * LOG2E;
                }
            }
        }
    }
}

DI void scan_item(const Params& p, int item, float* lds) {
    const int b = item >> 2, hh = item & 3, tid = otid();
    const float* lp = p.logf + (size_t)b * S * 4 + hh;
    float loc[32]; float s = 0.f;
#pragma unroll
    for (int i = 0; i < 32; ++i) { s += lp[(size_t)(tid * 32 + i) * 4]; loc[i] = s; }
    __syncthreads();
    lds[tid] = s;
    __syncthreads();
    float pre = 0.f;
    for (int i = 0; i < tid; ++i) pre += lds[i];
    float* fp = p.F + (size_t)(b * 4 + hh) * S + tid * 32;
#pragma unroll
    for (int i = 0; i < 32; ++i) fp[i] = pre + loc[i];
    __syncthreads();
}

DI void gemm_kloop(const bf16_t* __restrict__ Ag, int lda, const bf16_t* __restrict__ Bg, int ldb, int K, f32x4 (&acc)[4][4], bf16_t* sm) {
    const int tid = otid(), lane = tid & 63, wid = tid >> 6, wr = wid >> 1, wc = wid & 1;
    bf16_t* sa = sm; bf16_t* sb = sm + 2 * BM * LDP;
    const int lrow = tid >> 3, lcc = tid & 7;
    const bf16_t* ap = Ag + (size_t)lrow * lda + lcc * 8;
    const bf16_t* bp = Bg + (size_t)lrow * ldb + lcc * 8;
    const size_t sA = (size_t)32 * lda, sB = (size_t)32 * ldb;
    uint4 ra0, ra1, ra2, ra3, rb0, rb1, rb2, rb3;
#define G_LOAD(koff) do { ra0 = *(const uint4*)(ap + (koff)); ra1 = *(const uint4*)(ap + sA + (koff)); ra2 = *(const uint4*)(ap + 2 * sA + (koff)); ra3 = *(const uint4*)(ap + 3 * sA + (koff)); \
                          rb0 = *(const uint4*)(bp + (koff)); rb1 = *(const uint4*)(bp + sB + (koff)); rb2 = *(const uint4*)(bp + 2 * sB + (koff)); rb3 = *(const uint4*)(bp + 3 * sB + (koff)); } while (0)
#define G_STORE(buf) do { bf16_t* da_ = sa + (buf) * BM * LDP + lrow * LDP + lcc * 8; bf16_t* db_ = sb + (buf) * BN * LDP + lrow * LDP + lcc * 8; \
        *(uint4*)(da_) = ra0; *(uint4*)(da_ + 32 * LDP) = ra1; *(uint4*)(da_ + 64 * LDP) = ra2; *(uint4*)(da_ + 96 * LDP) = ra3; \
        *(uint4*)(db_) = rb0; *(uint4*)(db_ + 32 * LDP) = rb1; *(uint4*)(db_ + 64 * LDP) = rb2; *(uint4*)(db_ + 96 * LDP) = rb3; } while (0)
    G_LOAD(0);
    G_STORE(0);
    LDS_BARRIER();
    const int nk = K / BK;
    const int fr = lane & 15, fq = lane >> 4;
    for (int kt = 0; kt < nk; ++kt) {
        const int cur = kt & 1;
        const bool more = kt + 1 < nk;
        if (more) G_LOAD((kt + 1) * BK);
        const bf16_t* ca = sa + cur * BM * LDP + (wr * 64 + fr) * LDP + fq * 8;
        const bf16_t* cb = sb + cur * BN * LDP + (wc * 64 + fr) * LDP + fq * 8;
#pragma unroll
        for (int kk = 0; kk < 2; ++kk) {
            bf16x8 af[4], bfr[4];
#pragma unroll
            for (int m = 0; m < 4; ++m) af[m] = *(const bf16x8*)(ca + m * 16 * LDP + kk * 32);
#pragma unroll
            for (int n = 0; n < 4; ++n) bfr[n] = *(const bf16x8*)(cb + n * 16 * LDP + kk * 32);
#pragma unroll
            for (int m = 0; m < 4; ++m)
#pragma unroll
                for (int n = 0; n < 4; ++n) acc[m][n] = __builtin_amdgcn_mfma_f32_16x16x32_bf16(bfr[n], af[m], acc[m][n], 0, 0, 0);
        }
        if (more) G_STORE(cur ^ 1);
        LDS_BARRIER();
    }
#undef G_LOAD
#undef G_STORE
}

DI void gemm_kloop2(const bf16_t* __restrict__ Ag, int lda, const bf16_t* __restrict__ Bg, int ldb, int K, f32x4 (&acc)[4][4], bf16_t* sm) {
    const int tid = otid(), lane = tid & 63, wid = tid >> 6, wr = wid >> 1, wc = wid & 1;
    bf16_t* sa = sm; bf16_t* sb = sm + 2 * BM * LDP;
    const int lrow = tid >> 3, lcc = tid & 7;
    const bf16_t* ap = Ag + (size_t)lrow * lda + lcc * 8;
    const bf16_t* bp = Bg + (size_t)lrow * ldb + lcc * 8;
    const size_t sA = (size_t)32 * lda, sB = (size_t)32 * ldb;
    uint4 xa0, xa1, xa2, xa3, xb0, xb1, xb2, xb3;
    uint4 ya0, ya1, ya2, ya3, yb0, yb1, yb2, yb3;
#define G2_LOAD(P, koff) do { P##a0 = *(const uint4*)(ap + (koff)); P##a1 = *(const uint4*)(ap + sA + (koff)); P##a2 = *(const uint4*)(ap + 2 * sA + (koff)); P##a3 = *(const uint4*)(ap + 3 * sA + (koff)); \
                              P##b0 = *(const uint4*)(bp + (koff)); P##b1 = *(const uint4*)(bp + sB + (koff)); P##b2 = *(const uint4*)(bp + 2 * sB + (koff)); P##b3 = *(const uint4*)(bp + 3 * sB + (koff)); } while (0)
#define G2_STORE(P, buf) do { bf16_t* da_ = sa + (buf) * BM * LDP + lrow * LDP + lcc * 8; bf16_t* db_ = sb + (buf) * BN * LDP + lrow * LDP + lcc * 8; \
        *(uint4*)(da_) = P##a0; *(uint4*)(da_ + 32 * LDP) = P##a1; *(uint4*)(da_ + 64 * LDP) = P##a2; *(uint4*)(da_ + 96 * LDP) = P##a3; \
        *(uint4*)(db_) = P##b0; *(uint4*)(db_ + 32 * LDP) = P##b1; *(uint4*)(db_ + 64 * LDP) = P##b2; *(uint4*)(db_ + 96 * LDP) = P##b3; } while (0)
#define G2_COMPUTE(buf) do { \
        const bf16_t* ca = sa + (buf) * BM * LDP + (wr * 64 + fr) * LDP + fq * 8; \
        const bf16_t* cb = sb + (buf) * BN * LDP + (wc * 64 + fr) * LDP + fq * 8; \
        _Pragma("unroll") for (int kk = 0; kk < 2; ++kk) { \
            bf16x8 af[4], bfr[4]; \
            _Pragma("unroll") for (int m = 0; m < 4; ++m) af[m] = *(const bf16x8*)(ca + m * 16 * LDP + kk * 32); \
            _Pragma("unroll") for (int n = 0; n < 4; ++n) bfr[n] = *(const bf16x8*)(cb + n * 16 * LDP + kk * 32); \
            _Pragma("unroll") for (int m = 0; m < 4; ++m) _Pragma("unroll") for (int n = 0; n < 4; ++n) acc[m][n] = __builtin_amdgcn_mfma_f32_16x16x32_bf16(bfr[n], af[m], acc[m][n], 0, 0, 0); \
        } } while (0)
    const int nk = K / BK;
    const int fr = lane & 15, fq = lane >> 4;
    G2_LOAD(x, 0);
    G2_LOAD(y, BK);
    G2_STORE(x, 0);
    LDS_BARRIER();
    for (int kt = 0; kt < nk; kt += 2) {
        const int kx = kt + 2 < nk ? kt + 2 : nk - 2, ky = kt + 3 < nk ? kt + 3 : nk - 1;
        G2_LOAD(x, kx * BK);
        __builtin_amdgcn_sched_barrier(0);
        G2_COMPUTE(0);
        G2_STORE(y, 1);
        LDS_BARRIER();
        G2_LOAD(y, ky * BK);
        __builtin_amdgcn_sched_barrier(0);
        G2_COMPUTE(1);
        G2_STORE(x, 0);
        LDS_BARRIER();
    }
#undef G2_LOAD
#undef G2_STORE
#undef G2_COMPUTE
}

DI void tile_coords(int tile, int nM, int nN, int& mt, int& nt) {
    const int G = gridDim.x;
    if ((G & 7) == 0 && (nM & 63) == 0 && (nM * nN) % G == 0) {
        const int b = tile % G, k = tile / G, per = G >> 3;
        const int xcd = b & 7, slot = b >> 3;
        const int li = k * per + slot;
        const int mh = li / (8 * nN), rem = li % (8 * nN);
        nt = rem >> 3; mt = (mh * 8 + (rem & 7)) * 8 + xcd;
        return;
    }
    const int band = tile / (16 * nN), r = tile % (16 * nN);
    mt = band * 16 + (r & 15); nt = r >> 4;
}

DI void zero_acc(f32x4 (&acc)[4][4]) {
#pragma unroll
    for (int m = 0; m < 4; ++m)
#pragma unroll
        for (int n = 0; n < 4; ++n) acc[m][n] = (f32x4){0.f, 0.f, 0.f, 0.f};
}


constexpr int BM2 = 256, BK2 = 32, LDP2 = BK2 + 8;
DI void gemm_kloop3(const bf16_t* __restrict__ Ag, int lda, const bf16_t* __restrict__ Bg, int ldb, int K, f32x4 (&acc)[8][4], bf16_t* sm) {
    const int tid = otid(), lane = tid & 63, wid = tid >> 6, wr = wid >> 1, wc = wid & 1;
    bf16_t* sa = sm; bf16_t* sb = sm + 2 * BM2 * LDP2;
    const int lrow = tid >> 2, lcc = tid & 3;
    const bf16_t* ap = Ag + (size_t)lrow * lda + lcc * 8;
    const int prow = ((lrow >> 2) & 3) * 16 + (lrow >> 4) * 4 + (lrow & 3);
    const bf16_t* bp = Bg + (size_t)prow * ldb + lcc * 8;
    const size_t sA = (size_t)64 * lda, sB = (size_t)64 * ldb;
    const int fr = lane & 15, fq = lane >> 4;
    uint4 a0, a1, a2, a3, b0, b1;
#define G3_LOAD(koff) do { a0 = *(const uint4*)(ap + (koff)); a1 = *(const uint4*)(ap + sA + (koff)); a2 = *(const uint4*)(ap + 2 * sA + (koff)); a3 = *(const uint4*)(ap + 3 * sA + (koff)); \
                           b0 = *(const uint4*)(bp + (koff)); b1 = *(const uint4*)(bp + sB + (koff)); } while (0)
#define G3_STORE(buf) do { bf16_t* da_ = sa + (buf) * BM2 * LDP2 + lrow * LDP2 + lcc * 8; bf16_t* db_ = sb + (buf) * BN * LDP2 + lrow * LDP2 + lcc * 8; \
        *(uint4*)(da_) = a0; *(uint4*)(da_ + 64 * LDP2) = a1; *(uint4*)(da_ + 128 * LDP2) = a2; *(uint4*)(da_ + 192 * LDP2) = a3; \
        *(uint4*)(db_) = b0; *(uint4*)(db_ + 64 * LDP2) = b1; } while (0)
    G3_LOAD(0);
    G3_STORE(0);
    LDS_BARRIER();
    const int nk = K / BK2;
    for (int kt = 0; kt < nk; ++kt) {
        const int cur = kt & 1;
        const bool more = kt + 1 < nk;
        if (more) G3_LOAD((kt + 1) * BK2);
        const bf16_t* ca = sa + cur * BM2 * LDP2 + (wr * 128 + fr) * LDP2 + fq * 8;
        const bf16_t* cb = sb + cur * BN * LDP2 + (wc * 64 + fr) * LDP2 + fq * 8;
        bf16x8 af[8], bfr[4];
#pragma unroll
        for (int m = 0; m < 8; ++m) af[m] = *(const bf16x8*)(ca + m * 16 * LDP2);
#pragma unroll
        for (int n = 0; n < 4; ++n) bfr[n] = *(const bf16x8*)(cb + n * 16 * LDP2);
#pragma unroll
        for (int m = 0; m < 8; ++m)
#pragma unroll
            for (int n = 0; n < 4; ++n) acc[m][n] = __builtin_amdgcn_mfma_f32_16x16x32_bf16(bfr[n], af[m], acc[m][n], 0, 0, 0);
        if (more) G3_STORE(cur ^ 1);
        LDS_BARRIER();
    }
#undef G3_LOAD
#undef G3_STORE
}
DI void zero_acc8(f32x4 (&acc)[8][4]) {
#pragma unroll
    for (int m = 0; m < 8; ++m)
#pragma unroll
        for (int n = 0; n < 4; ++n) acc[m][n] = (f32x4){0.f, 0.f, 0.f, 0.f};
}
DI void st4_wt(bf16_t* dst, f32x4 v) { const unsigned long long w = (unsigned long long)pack2(v[0], v[1]) | ((unsigned long long)pack2(v[2], v[3]) << 32); __hip_atomic_store((unsigned long long*)dst, w, __ATOMIC_RELAXED, __HIP_MEMORY_SCOPE_AGENT); }
DI void st4(bf16_t* dst, f32x4 v) { uint2 w; w.x = pack2(v[0], v[1]); w.y = pack2(v[2], v[3]); *(uint2*)dst = w; }

DI void st8(bf16_t* dst, f32x4 a, f32x4 b) { uint4 w; w.x = pack2(a[0], a[1]); w.y = pack2(a[2], a[3]); w.z = pack2(b[0], b[1]); w.w = pack2(b[2], b[3]); *(uint4*)dst = w; }
DI f32x4 rot4(f32x4 v, int s, int i0) {
    const float a0 = (float)s * ex2(-(float)i0 * 0.21091607f), a1 = (float)s * ex2(-(float)(i0 + 1) * 0.21091607f);
    float r0 = a0 * 0.15915494309189535f, r1 = a1 * 0.15915494309189535f;
    r0 -= floorf(r0); r1 -= floorf(r1);
    float c0_ = __builtin_amdgcn_cosf(r0), s0_ = __builtin_amdgcn_sinf(r0), c1_ = __builtin_amdgcn_cosf(r1), s1_ = __builtin_amdgcn_sinf(r1);
    asm volatile("s_nop 15\n\ts_nop 15" : "+v"(c0_), "+v"(s0_), "+v"(c1_), "+v"(s1_));
    f32x4 o; o[0] = v[0] * c0_ - v[1] * s0_; o[1] = v[0] * s0_ + v[1] * c0_; o[2] = v[2] * c1_ - v[3] * s1_; o[3] = v[2] * s1_ + v[3] * c1_;
    return o;
}
DI void epi_inproj(const Params& p, int row, int col, f32x4 v0, f32x4 v1) {
    v0 += *(const f32x4*)(p.binp + col); v1 += *(const f32x4*)(p.binp + col + 4);
    const int b = row / S, s = row % S;
    if (col < 512) { st8(p.qa + (size_t)row * 512 + col, v0 * (0.125f * LOG2E), v1 * (0.125f * LOG2E)); }
    else if (col < 1024) { st8(p.ka + (size_t)row * 512 + (col - 512), v0, v1); }
    else if (col < 1536) { const int c = col - 1024, hh = c >> 7, e = c & 127; bf16_t* d = p.vta + ((size_t)(b * 4 + hh) * 128 + e) * S + s;
#pragma unroll
        for (int j = 0; j < 4; ++j) { d[(size_t)j * S] = f2bf(v0[j]); d[(size_t)(j + 4) * S] = f2bf(v1[j]); } }
    else if (col < 2048) { st8(p.qb + (size_t)row * 512 + (col - 1536), v0 * (0.08838834764831845f * LOG2E), v1 * (0.08838834764831845f * LOG2E)); }
    else if (col < 2560) { st8(p.kb + (size_t)row * 512 + (col - 2048), v0, v1); }
    else if (col < 3072) { const int c = col - 2560, hh = c >> 7, e = c & 127; bf16_t* d = p.vtb + ((size_t)(b * 4 + hh) * 128 + e) * S + s;
#pragma unroll
        for (int j = 0; j < 4; ++j) { d[(size_t)j * S] = f2bf(v0[j]); d[(size_t)(j + 4) * S] = f2bf(v1[j]); } }
    else if (col < 4096) {
        const int r = col - 3072, seg = r >> 9, c = r & 511, cc = c & 127, i0 = cc >> 1, hd = c >> 7;
        f32x4 o0 = rot4(v0, s, i0), o1 = rot4(v1, s, i0 + 2);
        const float lg = lg2gamma(hd);
        const int ic = s & 63;
        float e1_ = ex2(lg * (float)(ic + 1)), e2_ = ex2(-lg * (float)(ic + 1)), e3_ = ex2(lg * (float)(63 - ic));
        asm volatile("s_nop 15\n\ts_nop 15" : "+v"(e1_), "+v"(e2_), "+v"(e3_));
        if (seg == 0) st8(p.cq + (size_t)row * 512 + c, o0 * e1_, o1 * e1_);
        else {
            o0 = o0 * 0.08838834764831845f; o1 = o1 * 0.08838834764831845f;
            st8(p.ck + (size_t)row * 512 + c, o0 * e2_, o1 * e2_);
            const f32x4 d0 = o0 * e3_, d1 = o1 * e3_;
            bf16_t* d = p.ckT + ((size_t)(b * 4 + hd) * 128 + cc) * S + s;
#pragma unroll
            for (int j = 0; j < 4; ++j) { d[(size_t)j * S] = f2bf(d0[j]); d[(size_t)(j + 4) * S] = f2bf(d1[j]); }
        }
    }
    else if (col < 5120) { const int c = col - 4096; bf16_t* d = p.cv + ((size_t)b * 1024 + c) * S + s;
#pragma unroll
        for (int j = 0; j < 4; ++j) { d[(size_t)j * S] = f2bf(v0[j]); d[(size_t)(j + 4) * S] = f2bf(v1[j]); } }
    else if (col < 6144) { f32x4 o0, o1; for (int j = 0; j < 4; ++j) { o0[j] = silu_f(v0[j]); o1[j] = silu_f(v1[j]); } st8(p.cg + (size_t)row * 1024 + (col - 5120), o0, o1); }
    else { f32x4 o0, o1; for (int j = 0; j < 4; ++j) { o0[j] = sigmoid_f(v0[j]); o1[j] = sigmoid_f(v1[j]); } st8(p.gates + (size_t)row * 3072 + (col - 6144), o0, o1); }
}

DI void phase_inproj(const Params& p, bf16_t* sm) {
    const int nM = T / BM2, nN = NIN / BN;
    const int lane = otid() & 63, wid = otid() >> 6, wr = wid >> 1, wc = wid & 1;
    for (int tile = obid(); tile < nM * nN; tile += gridDim.x) {
        int mt, nt; tile_coords(tile, nM, nN, mt, nt);
        f32x4 acc[8][4]; zero_acc8(acc);
        gemm_kloop3(p.h + (size_t)mt * BM2 * Dm, Dm, p.WinT + (size_t)nt * BN * Dm, Dm, Dm, acc, sm);
#pragma unroll
        for (int m = 0; m < 8; ++m)
#pragma unroll
            for (int n2 = 0; n2 < 2; ++n2) epi_inproj(p, mt * BM2 + wr * 128 + m * 16 + (lane & 15), nt * BN + wc * 64 + (lane >> 4) * 16 + n2 * 8, acc[m][2 * n2], acc[m][2 * n2 + 1]);
    }
}

DI void phase_branch(const Params& p, bf16_t* sm) {
    const int nM = T / BM, nN = Dm / BN;
    const int lane = otid() & 63, wid = otid() >> 6, wr = wid >> 1, wc = wid & 1;
    for (int tile = obid(); tile < nM * nN; tile += gridDim.x) {
        int mt, nt; tile_coords(tile, nM, nN, mt, nt);
        f32x4 tot[4][4]; zero_acc(tot);
#pragma unroll 1
        for (int br = 0; br < 3; ++br) {
            const bf16_t* A = br == 0 ? p.ya : br == 1 ? p.yb : p.yc;
            const bf16_t* W = br == 0 ? p.WpaT : br == 1 ? p.WpbT : p.WpcT;
            const int K = br == 2 ? 1024 : 512;
            f32x4 acc[4][4]; zero_acc(acc);
            gemm_kloop(A + (size_t)mt * BM * K, K, W + (size_t)nt * BN * K, K, K, acc, sm);
#pragma unroll
            for (int m = 0; m < 4; ++m)
#pragma unroll
                for (int n = 0; n < 4; ++n) {
                    const int row = mt * BM + wr * 64 + m * 16 + (lane & 15), col = nt * BN + wc * 64 + n * 16 + (lane >> 4) * 4;
                    const uint2 g = *(const uint2*)(p.gates + (size_t)row * 3072 + br * 1024 + col);
                    tot[m][n][0] += bflo(g.x) * acc[m][n][0]; tot[m][n][1] += bfhi(g.x) * acc[m][n][1];
                    tot[m][n][2] += bflo(g.y) * acc[m][n][2]; tot[m][n][3] += bfhi(g.y) * acc[m][n][3];
                }
        }
#pragma unroll
        for (int m = 0; m < 4; ++m)
#pragma unroll
            for (int n = 0; n < 4; ++n) {
                const int row = mt * BM + wr * 64 + m * 16 + (lane & 15), col = nt * BN + wc * 64 + n * 16 + (lane >> 4) * 4;
                st4(p.h + (size_t)row * Dm + col, tot[m][n]);
            }
    }
}

DI void phase_gemm_res(const Params& p, const bf16_t* A, int K, const bf16_t* Wt, const float* xres, const float* modl, int gt_off, bf16_t* sm) {
    const int nM = T / BM2, nN = Dm / BN;
    const int lane = otid() & 63, wid = otid() >> 6, wr = wid >> 1, wc = wid & 1;
    for (int tile = obid(); tile < nM * nN; tile += gridDim.x) {
        int mt, nt; tile_coords(tile, nM, nN, mt, nt);
        f32x4 acc[8][4]; zero_acc8(acc);
        gemm_kloop3(A + (size_t)mt * BM2 * K, K, Wt + (size_t)nt * BN * K, K, K, acc, sm);
#pragma unroll
        for (int m = 0; m < 8; ++m)
#pragma unroll
            for (int n = 0; n < 4; ++n) {
                const int row = mt * BM2 + wr * 128 + m * 16 + (lane & 15), col = nt * BN + wc * 64 + (lane >> 4) * 16 + n * 4;
                const int b = row / S;
                const f32x4 xr = *(const f32x4*)(xres + (size_t)row * Dm + col);
                const f32x4 gt = *(const f32x4*)(modl + (size_t)b * 6144 + gt_off + col);
                *(f32x4*)(p.vbuf + (size_t)row * Dm + col) = xr * ALPHA_F + gt * acc[m][n];
            }
    }
}

DI void phase_up(const Params& p, bf16_t* sm) {
    const int nM = T / BM2, nN = 2 * DFF / BN;
    const int lane = otid() & 63, wid = otid() >> 6, wr = wid >> 1, wc = wid & 1;
    for (int tile = obid(); tile < nM * nN; tile += gridDim.x) {
        int mt, nt; tile_coords(tile, nM, nN, mt, nt);
        f32x4 acc[8][4]; zero_acc8(acc);
        gemm_kloop3(p.h + (size_t)mt * BM2 * Dm, Dm, p.WupT + (size_t)nt * BN * Dm, Dm, Dm, acc, sm);
#pragma unroll
        for (int m = 0; m < 8; ++m)
#pragma unroll
            for (int n2 = 0; n2 < 2; ++n2) {
                const int row = mt * BM2 + wr * 128 + m * 16 + (lane & 15), col = nt * BN + wc * 64 + (lane >> 4) * 16 + n2 * 8;
                st8(p.ug + (size_t)row * (2 * DFF) + col, acc[m][2 * n2], acc[m][2 * n2 + 1]);
            }
    }
}

DI void phase_conv(const Params& p, int l) {
    const int gtid = obid() * blockDim.x + otid(), gsz = gridDim.x * blockDim.x;
    const float* wc = p.w_conv + (size_t)l * 3 * DFF; const float* bc = p.b_conv + (size_t)l * DFF;
    for (int i = gtid; i < T * (DFF / 8); i += gsz) {
        const int row = i / (DFF / 8), c8 = (i % (DFF / 8)) * 8, s = row % S;
        const bf16_t* up = p.ug + (size_t)row * (2 * DFF) + c8;
        const uint4 u0 = *(const uint4*)up;
        uint4 u1 = make_uint4(0, 0, 0, 0), u2 = make_uint4(0, 0, 0, 0);
        if (s >= 1) u1 = *(const uint4*)(up - 2 * DFF);
        if (s >= 2) u2 = *(const uint4*)(up - 4 * DFF);
        const uint4 gg = *(const uint4*)(up + DFF);
        const unsigned a0[4] = {u0.x, u0.y, u0.z, u0.w}, a1[4] = {u1.x, u1.y, u1.z, u1.w}, a2[4] = {u2.x, u2.y, u2.z, u2.w}, ag[4] = {gg.x, gg.y, gg.z, gg.w};
        float cv[8], t[8], e[8];
#pragma unroll
        for (int h4 = 0; h4 < 2; ++h4) {
            const f32x4 w0 = *(const f32x4*)(wc + c8 + 4 * h4), w1 = *(const f32x4*)(wc + DFF + c8 + 4 * h4), w2 = *(const f32x4*)(wc + 2 * DFF + c8 + 4 * h4), bb = *(const f32x4*)(bc + c8 + 4 * h4);
#pragma unroll
            for (int k = 0; k < 4; ++k) {
                const int j = 2 * h4 + (k >> 1); const bool hi = k & 1;
                const float x0 = hi ? bfhi(a0[j]) : bflo(a0[j]), x1 = hi ? bfhi(a1[j]) : bflo(a1[j]), x2 = hi ? bfhi(a2[j]) : bflo(a2[j]);
                cv[4 * h4 + k] = bb[k] + w0[k] * x2 + w1[k] * x1 + w2[k] * x0;
            }
        }
#pragma unroll
        for (int k = 0; k < 8; ++k) { t[k] = __builtin_amdgcn_rcpf(fabsf(cv[k]) * 0.2316418882f + 1.0f); e[k] = ex2(cv[k] * cv[k] * (-0.72134752044f)); }
        asm volatile("s_nop 15\n\ts_nop 15" : "+v"(t[0]), "+v"(t[1]), "+v"(t[2]), "+v"(t[3]), "+v"(t[4]), "+v"(t[5]), "+v"(t[6]), "+v"(t[7]));
        asm volatile("s_nop 3" : "+v"(e[0]), "+v"(e[1]), "+v"(e[2]), "+v"(e[3]), "+v"(e[4]), "+v"(e[5]), "+v"(e[6]), "+v"(e[7]));
        unsigned o[4];
#pragma unroll
        for (int j = 0; j < 4; ++j) {
            float rr[2];
#pragma unroll
            for (int hl = 0; hl < 2; ++hl) {
                const int k = 2 * j + hl;
                float q = t[k] * 0.5307027145f + (-0.7265760135f); q = q * t[k] + 0.7107068705f; q = q * t[k] + (-0.142248368f); q = q * t[k] + 0.127414796f; q = q * t[k];
                const float m = cv[k] * (q * e[k]);
                const float gl = cv[k] < 0.f ? m : cv[k] - m;
                rr[hl] = gl * (hl ? bfhi(ag[j]) : bflo(ag[j]));
            }
            o[j] = pack2(rr[0], rr[1]);
        }
        *(uint4*)(p.act + (size_t)row * DFF + c8) = make_uint4(o[0], o[1], o[2], o[3]);
    }
}

template <int MODE>
DI void naive_attn(const Params& p, int item) {
    constexpr int D = MODE == 0 ? 64 : 128;
    constexpr int DV = MODE == 2 ? 256 : 128;
    constexpr int SW = DV / 4;
    constexpr int NH = MODE == 0 ? 8 : 4;
    const int tid = otid(), lane = tid & 63;
    const int sl = __builtin_amdgcn_readfirstlane(tid >> 6);
    const int qblk = 127 - (item % 128), hh = (item / 128) % NH, b = item / (128 * NH);
    const int q = qblk * 64 + lane; const size_t tq = (size_t)b * S + q;
    const bf16_t *Q, *Kp;
    if (MODE == 0) { Q = p.qa + tq * 512 + hh * 64; Kp = p.ka + (size_t)b * S * 512 + hh * 64; }
    else if (MODE == 1) { Q = p.qb + tq * 512 + hh * 128; Kp = p.kb + (size_t)b * S * 512 + hh * 128; }
    else { Q = p.cq + tq * 512 + hh * 128; Kp = p.ck + (size_t)b * S * 512 + hh * 128; }
    unsigned qp[D / 2];
#pragma unroll
    for (int i = 0; i < D / 8; ++i) { const uint4 t = ((const uint4*)Q)[i]; qp[4 * i] = t.x; qp[4 * i + 1] = t.y; qp[4 * i + 2] = t.z; qp[4 * i + 3] = t.w; }
    float acc[SW];
#pragma unroll
    for (int i = 0; i < SW; ++i) acc[i] = 0.f;
    float mx = -INFINITY, lsum = 0.f;
    const int send = (qblk + 1) * 64;
    float Fq = 0.f; const float* Fk = nullptr;
    if (MODE == 1) { Fk = p.F + (size_t)(b * 4 + hh) * S; Fq = Fk[q]; }
    float lg = 0.f;
    if (MODE == 2) lg = log2f(1.0f - exp2f(-5.0f - (float)hh));
    for (int s = 0; s < send; ++s) {
        const uint4* kr = (const uint4*)(Kp + (size_t)s * 512);
        float sc = 0.f;
#pragma unroll
        for (int i = 0; i < D / 8; ++i) {
            const uint4 kv = kr[i];
            sc += bflo(qp[4 * i]) * bflo(kv.x) + bfhi(qp[4 * i]) * bfhi(kv.x);
            sc += bflo(qp[4 * i + 1]) * bflo(kv.y) + bfhi(qp[4 * i + 1]) * bfhi(kv.y);
            sc += bflo(qp[4 * i + 2]) * bflo(kv.z) + bfhi(qp[4 * i + 2]) * bfhi(kv.z);
            sc += bflo(qp[4 * i + 3]) * bflo(kv.w) + bfhi(qp[4 * i + 3]) * bfhi(kv.w);
            if ((i & 3) == 3) asm volatile("" ::: "memory");
        }
        float w, corr = 1.f;
        if (MODE == 2) {
            w = (s <= q) ? sc * exp2f((float)(q - s) * lg) : 0.f;
        } else {
            if (MODE == 1) sc += Fq - Fk[s];
            const bool valid = (MODE == 0) || (s <= q);
            if (valid) {
                const float mn = fmaxf(mx, sc);
                corr = exp2f(mx - mn); w = exp2f(sc - mn); mx = mn;
                lsum = lsum * corr + w;
            } else { w = 0.f; }
        }
        if (MODE == 2) {
            const uint4* vr = (const uint4*)(p.cv + ((size_t)b * S + s) * 1024 + hh * 256 + sl * SW);
#pragma unroll
            for (int i = 0; i < SW / 8; ++i) {
                const uint4 vv = vr[i];
                acc[8 * i] += w * bflo(vv.x); acc[8 * i + 1] += w * bfhi(vv.x); acc[8 * i + 2] += w * bflo(vv.y); acc[8 * i + 3] += w * bfhi(vv.y);
                acc[8 * i + 4] += w * bflo(vv.z); acc[8 * i + 5] += w * bfhi(vv.z); acc[8 * i + 6] += w * bflo(vv.w); acc[8 * i + 7] += w * bfhi(vv.w);
            }
        } else {
            const bf16_t* vt = (MODE == 0 ? p.vta + ((size_t)(b * 4 + (hh >> 1)) * 128 + sl * SW) * S : p.vtb + ((size_t)(b * 4 + hh) * 128 + sl * SW) * S) + s;
#pragma unroll
            for (int i = 0; i < SW; ++i) { acc[i] = acc[i] * corr + w * bf2f(*vt); vt += S; asm volatile("" : "+v"(vt)); }
        }
    }
    if (MODE == 2) {
        float* o = p.oc + tq * 1024 + hh * 256 + sl * SW;
#pragma unroll
        for (int i = 0; i < SW / 4; ++i) *(f32x4*)(o + 4 * i) = (f32x4){acc[4 * i], acc[4 * i + 1], acc[4 * i + 2], acc[4 * i + 3]};
    } else {
        const float inv = 1.f / lsum;
        bf16_t* o = (MODE == 0 ? p.oa + tq * 1024 + hh * 128 : p.yb + tq * 512 + hh * 128) + sl * SW;
#pragma unroll
        for (int i = 0; i < SW / 8; ++i) {
            uint4 w4; w4.x = pack2(acc[8 * i] * inv, acc[8 * i + 1] * inv); w4.y = pack2(acc[8 * i + 2] * inv, acc[8 * i + 3] * inv);
            w4.z = pack2(acc[8 * i + 4] * inv, acc[8 * i + 5] * inv); w4.w = pack2(acc[8 * i + 6] * inv, acc[8 * i + 7] * inv);
            ((uint4*)o)[i] = w4;
        }
    }
}


typedef float f32x16 __attribute__((ext_vector_type(16)));
DI bf16x8 pack8(float a0, float a1, float a2, float a3, float a4, float a5, float a6, float a7) {
    typedef unsigned u32x4 __attribute__((ext_vector_type(4)));
    u32x4 w; w[0] = pack2(a0, a1); w[1] = pack2(a2, a3); w[2] = pack2(a4, a5); w[3] = pack2(a6, a7);
    return __builtin_bit_cast(bf16x8, w);
}

template <int MODE>
DI void flash_item(const Params& p, int b, int hh, int qi, unsigned char* smem) {
    constexpr int D = MODE == 0 ? 64 : 128, KST = D + 8, VST = 68, KS = D / 16;
    constexpr int KBYTES = 64 * KST * 2, VBYTES = 128 * VST * 2, BUFB = KBYTES + VBYTES + 256;
    constexpr int NKC = D / 32, CPR = D / 8;
    const int tid = otid(), lane = tid & 63, w = tid >> 6, r = lane & 31, hf = lane >> 5;
    const int q0 = qi * 128 + w * 32;
    const size_t tq = (size_t)b * S + q0 + r;
    bf16x8 qf[KS];
    {
        const bf16_t* qptr = (MODE == 0 ? p.qa + tq * 512 + hh * 64 : p.qb + tq * 512 + hh * 128) + hf * 8;
#pragma unroll
        for (int ks = 0; ks < KS; ++ks) qf[ks] = *(const bf16x8*)(qptr + ks * 16);
    }
    const float* fbase = p.F + (size_t)(b * 4 + (MODE == 1 ? hh : 0)) * S;
    float Fq = 0.f; if (MODE == 1) Fq = fbase[q0 + r];
    const bf16_t* kbase = MODE == 0 ? p.ka + (size_t)b * S * 512 + hh * 64 : p.kb + (size_t)b * S * 512 + hh * 128;
    const bf16_t* vbase = MODE == 0 ? p.vta + (size_t)(b * 4 + (hh >> 1)) * 128 * S : p.vtb + (size_t)(b * 4 + hh) * 128 * S;
    const int ntiles = 2 * qi + 2, wlast = 2 * qi + (w >> 1);
    uint4 kr[NKC], vr[4]; f32x4 frg = {0.f, 0.f, 0.f, 0.f};
#define FL_GLOAD(j) do { \
        _Pragma("unroll") for (int i_ = 0; i_ < NKC; ++i_) { const int c_ = tid + 256 * i_; kr[i_] = *(const uint4*)(kbase + (size_t)(64 * (j) + c_ / CPR) * 512 + (c_ % CPR) * 8); } \
        _Pragma("unroll") for (int i_ = 0; i_ < 4; ++i_) { const int c_ = tid + 256 * i_; vr[i_] = *(const uint4*)(vbase + (size_t)(c_ >> 3) * S + 64 * (j) + (c_ & 7) * 8); } \
        if (MODE == 1 && tid < 16) frg = *(const f32x4*)(fbase + 64 * (j) + tid * 4); } while (0)
#define FL_SSTORE(buf) do { unsigned char* B_ = smem + (buf) * BUFB; \
        _Pragma("unroll") for (int i_ = 0; i_ < NKC; ++i_) { const int c_ = tid + 256 * i_; *(uint4*)(B_ + ((c_ / CPR) * KST + (c_ % CPR) * 8) * 2) = kr[i_]; } \
        _Pragma("unroll") for (int i_ = 0; i_ < 4; ++i_) { const int c_ = tid + 256 * i_; uint2* d_ = (uint2*)(B_ + KBYTES + ((c_ >> 3) * VST + (c_ & 7) * 8) * 2); d_[0] = make_uint2(vr[i_].x, vr[i_].y); d_[1] = make_uint2(vr[i_].z, vr[i_].w); } \
        if (MODE == 1 && tid < 16) *(f32x4*)(B_ + KBYTES + VBYTES + tid * 16) = frg; } while (0)
    FL_GLOAD(0);
    FL_SSTORE(0);
    LDS_BARRIER();
    f32x16 acc[4];
#pragma unroll
    for (int eb = 0; eb < 4; ++eb)
#pragma unroll
        for (int i = 0; i < 16; ++i) acc[eb][i] = 0.f;
    float mrun = -INFINITY, lsum = 0.f;
    for (int j = 0; j < ntiles; ++j) {
        const bool more = j + 1 < ntiles;
        if (more) FL_GLOAD(j + 1);
        if (j <= wlast) {
            const unsigned char* B = smem + (j & 1) * BUFB;
            f32x16 st[2];
#pragma unroll
            for (int kb = 0; kb < 2; ++kb) {
#pragma unroll
                for (int i = 0; i < 16; ++i) st[kb][i] = 0.f;
#pragma unroll
                for (int ks = 0; ks < KS; ++ks) {
                    const bf16x8 a = *(const bf16x8*)(B + ((kb * 32 + r) * KST + ks * 16 + hf * 8) * 2);
                    st[kb] = __builtin_amdgcn_mfma_f32_32x32x16_bf16(a, qf[ks], st[kb], 0, 0, 0);
                }
            }
            if (MODE == 1) {
                const float* Fl = (const float*)(B + KBYTES + VBYTES);
#pragma unroll
                for (int kb = 0; kb < 2; ++kb)
#pragma unroll
                    for (int g = 0; g < 4; ++g) {
                        const f32x4 fk = *(const f32x4*)(Fl + kb * 32 + 8 * g + 4 * hf);
#pragma unroll
                        for (int jj = 0; jj < 4; ++jj) st[kb][4 * g + jj] += Fq - fk[jj];
                    }
                if (j >= 2 * qi) {
                    const int qabs = q0 + r;
#pragma unroll
                    for (int kb = 0; kb < 2; ++kb)
#pragma unroll
                        for (int g = 0; g < 4; ++g)
#pragma unroll
                            for (int jj = 0; jj < 4; ++jj) { const int key = 64 * j + kb * 32 + 8 * g + 4 * hf + jj; if (key > qabs) st[kb][4 * g + jj] = -INFINITY; }
                }
            }
            float mt = st[0][0];
#pragma unroll
            for (int i = 1; i < 16; ++i) mt = fmaxf(mt, st[0][i]);
#pragma unroll
            for (int i = 0; i < 16; ++i) mt = fmaxf(mt, st[1][i]);
            mt = fmaxf(mt, __shfl_xor(mt, 32));
            const float mn = fmaxf(mrun, mt);
            const float corr = ex2(mrun - mn);
            mrun = mn; lsum *= corr;
#pragma unroll
            for (int kb = 0; kb < 2; ++kb)
#pragma unroll
                for (int i = 0; i < 16; ++i) { const float pv = ex2(st[kb][i] - mn); st[kb][i] = pv; lsum += pv; }
#pragma unroll
            for (int eb = 0; eb < 4; ++eb) acc[eb] *= corr;
#pragma unroll
            for (int kb = 0; kb < 2; ++kb)
#pragma unroll
                for (int s2 = 0; s2 < 2; ++s2) {
                    const bf16x8 pf = pack8(st[kb][8 * s2], st[kb][8 * s2 + 1], st[kb][8 * s2 + 2], st[kb][8 * s2 + 3], st[kb][8 * s2 + 4], st[kb][8 * s2 + 5], st[kb][8 * s2 + 6], st[kb][8 * s2 + 7]);
#pragma unroll
                    for (int eb = 0; eb < 4; ++eb) {
                        const unsigned char* vp = B + KBYTES + ((eb * 32 + r) * VST + kb * 32 + 16 * s2 + 4 * hf) * 2;
                        const uint2 lo = *(const uint2*)vp, hi = *(const uint2*)(vp + 16);
                        typedef unsigned u32x4 __attribute__((ext_vector_type(4)));
                        u32x4 av; av[0] = lo.x; av[1] = lo.y; av[2] = hi.x; av[3] = hi.y;
                        acc[eb] = __builtin_amdgcn_mfma_f32_32x32x16_bf16(__builtin_bit_cast(bf16x8, av), pf, acc[eb], 0, 0, 0);
                    }
                }
        }
        if (more) FL_SSTORE((j + 1) & 1);
        LDS_BARRIER();
    }
#undef FL_GLOAD
#undef FL_SSTORE
    const float inv = 1.f / (lsum + __shfl_xor(lsum, 32));
    bf16_t* o = MODE == 0 ? p.oa + tq * 1024 + hh * 128 : p.yb + tq * 512 + hh * 128;
#pragma unroll
    for (int eb = 0; eb < 4; ++eb)
#pragma unroll
        for (int g = 0; g < 4; ++g) {
            f32x4 v = {acc[eb][4 * g] * inv, acc[eb][4 * g + 1] * inv, acc[eb][4 * g + 2] * inv, acc[eb][4 * g + 3] * inv};
            st4(o + eb * 32 + 8 * g + 4 * hf, v);
        }
}


DI void ret_state_item(const Params& p, int item) {
    const int n = item & 127, bh = item >> 7;
    const int tid = otid(), lane = tid & 63, w = tid >> 6, r = lane & 31, hf = lane >> 5;
    const bf16_t* kt = p.ckT + (size_t)bh * 128 * S + n * 64 + hf * 8;
    const bf16_t* vt = p.cv + ((size_t)bh * 256 + w * 64) * S + n * 64 + hf * 8;
    f32x16 acc[4][2];
#pragma unroll
    for (int a = 0; a < 4; ++a)
#pragma unroll
        for (int c = 0; c < 2; ++c)
#pragma unroll
            for (int i = 0; i < 16; ++i) acc[a][c][i] = 0.f;
#pragma unroll
    for (int s4 = 0; s4 < 4; ++s4) {
        bf16x8 af[4], bfr[2];
#pragma unroll
        for (int a = 0; a < 4; ++a) af[a] = *(const bf16x8*)(kt + (size_t)(a * 32 + r) * S + s4 * 16);
#pragma unroll
        for (int c = 0; c < 2; ++c) bfr[c] = *(const bf16x8*)(vt + (size_t)(c * 32 + r) * S + s4 * 16);
#pragma unroll
        for (int a = 0; a < 4; ++a)
#pragma unroll
            for (int c = 0; c < 2; ++c) acc[a][c] = __builtin_amdgcn_mfma_f32_32x32x16_bf16(af[a], bfr[c], acc[a][c], 0, 0, 0);
    }
    bf16_t* o = p.kv + ((size_t)(bh * 128 + n) * 256 + w * 64) * 128;
#pragma unroll
    for (int a = 0; a < 4; ++a)
#pragma unroll
        for (int c = 0; c < 2; ++c)
#pragma unroll
            for (int g = 0; g < 4; ++g) {
                f32x4 v = {acc[a][c][4 * g], acc[a][c][4 * g + 1], acc[a][c][4 * g + 2], acc[a][c][4 * g + 3]};
                st4_wt(o + (size_t)(c * 32 + r) * 128 + a * 32 + 8 * g + 4 * hf, v);
            }
}

DI void ret_scan(const Params& p) {
    const int gtid = obid() * 256 + otid(), gsz = gridDim.x * 256;
    for (int e = gtid; e < 8 * 8192; e += gsz) {
        const int bh = e >> 13, pi = e & 8191, hd = bh & 3;
        const float dec = ex2(64.0f * lg2gamma(hd));
        unsigned long long* ptr = (unsigned long long*)p.kv + (size_t)bh * 128 * 8192 + pi;
        float c0 = 0.f, c1 = 0.f, c2 = 0.f, c3 = 0.f;
        for (int n0 = 0; n0 < 128; n0 += 8) {
            unsigned long long v[8];
#pragma unroll
            for (int k = 0; k < 8; ++k) v[k] = ptr[(size_t)(n0 + k) * 8192];
            asm volatile("s_waitcnt vmcnt(0)" ::: "memory");
#pragma unroll
            for (int k = 0; k < 8; ++k) {
                const unsigned long long o = (unsigned long long)pack2(c0, c1) | ((unsigned long long)pack2(c2, c3) << 32);
                __hip_atomic_store(ptr + (size_t)(n0 + k) * 8192, o, __ATOMIC_RELAXED, __HIP_MEMORY_SCOPE_AGENT);
                const unsigned lo = (unsigned)v[k], hi = (unsigned)(v[k] >> 32);
                c0 = c0 * dec + bflo(lo); c1 = c1 * dec + bfhi(lo); c2 = c2 * dec + bflo(hi); c3 = c3 * dec + bfhi(hi);
            }
        }
    }
}

DI void ret_out_item(const Params& p, int l, int item, unsigned char* smem) {
    const int n = item & 127, bh = item >> 7, b = bh >> 2, hd = bh & 3;
    const int tid = otid(), lane = tid & 63, w = tid >> 6, r = lane & 31, hf = lane >> 5;
    const size_t t0 = (size_t)b * S + n * 64;
    f32x16 acc[2][2];
#pragma unroll
    for (int a = 0; a < 2; ++a)
#pragma unroll
        for (int c = 0; c < 2; ++c)
#pragma unroll
            for (int i = 0; i < 16; ++i) acc[a][c][i] = 0.f;
    bf16x8 pf[2][2][2];
    typedef unsigned u32x4 __attribute__((ext_vector_type(4)));
    bf16x8 qf[2][8], rf[2][8];
    uint2 vlo[2][2][2], vhi[2][2][2];
    {
        const bf16_t* rt = p.kv + ((size_t)(bh * 128 + n) * 256 + w * 64) * 128 + hf * 8;
#pragma unroll
        for (int qb = 0; qb < 2; ++qb)
#pragma unroll
            for (int ks = 0; ks < 8; ++ks) qf[qb][ks] = *(const bf16x8*)(p.cq + (t0 + qb * 32 + r) * 512 + hd * 128 + ks * 16 + hf * 8);
#pragma unroll
        for (int dvb = 0; dvb < 2; ++dvb)
#pragma unroll
            for (int ks = 0; ks < 8; ++ks) rf[dvb][ks] = *(const bf16x8*)(rt + (size_t)(dvb * 32 + r) * 128 + ks * 16);
    }
    __builtin_amdgcn_sched_barrier(0);
#pragma unroll
    for (int dvb = 0; dvb < 2; ++dvb)
#pragma unroll
        for (int ks = 0; ks < 8; ++ks)
#pragma unroll
            for (int qb = 0; qb < 2; ++qb) acc[dvb][qb] = __builtin_amdgcn_mfma_f32_32x32x16_bf16(rf[dvb][ks], qf[qb][ks], acc[dvb][qb], 0, 0, 0);
#pragma unroll
    for (int kb = 0; kb < 2; ++kb)
#pragma unroll
        for (int ks = 0; ks < 8; ++ks) rf[kb][ks] = *(const bf16x8*)(p.ck + (t0 + kb * 32 + r) * 512 + hd * 128 + ks * 16 + hf * 8);
    __builtin_amdgcn_sched_barrier(0);
#pragma unroll
    for (int kb = 0; kb < 2; ++kb) {
        f32x16 st[2];
#pragma unroll
        for (int qb = 0; qb < 2; ++qb)
#pragma unroll
            for (int i = 0; i < 16; ++i) st[qb][i] = 0.f;
#pragma unroll
        for (int ks = 0; ks < 8; ++ks)
#pragma unroll
            for (int qb = 0; qb < 2; ++qb) st[qb] = __builtin_amdgcn_mfma_f32_32x32x16_bf16(rf[kb][ks], qf[qb][ks], st[qb], 0, 0, 0);
#pragma unroll
        for (int qb = 0; qb < 2; ++qb) {
#pragma unroll
            for (int i = 0; i < 16; ++i) { const int key = kb * 32 + (i & 3) + 8 * (i >> 2) + 4 * hf; if (key > qb * 32 + r) st[qb][i] = 0.f; }
#pragma unroll
            for (int s2 = 0; s2 < 2; ++s2)
                pf[kb][s2][qb] = pack8(st[qb][8 * s2], st[qb][8 * s2 + 1], st[qb][8 * s2 + 2], st[qb][8 * s2 + 3], st[qb][8 * s2 + 4], st[qb][8 * s2 + 5], st[qb][8 * s2 + 6], st[qb][8 * s2 + 7]);
        }
    }
    {
        const bf16_t* vt = p.cv + ((size_t)bh * 256 + w * 64) * S + n * 64 + 4 * hf;
#pragma unroll
        for (int dvb = 0; dvb < 2; ++dvb)
#pragma unroll
            for (int kb = 0; kb < 2; ++kb)
#pragma unroll
                for (int s2 = 0; s2 < 2; ++s2) {
                    const bf16_t* vp = vt + (size_t)(dvb * 32 + r) * S + kb * 32 + 16 * s2;
                    vlo[dvb][kb][s2] = *(const uint2*)vp; vhi[dvb][kb][s2] = *(const uint2*)(vp + 8);
                }
    }
    __builtin_amdgcn_sched_barrier(0);
#pragma unroll
    for (int dvb = 0; dvb < 2; ++dvb)
#pragma unroll
        for (int kb = 0; kb < 2; ++kb)
#pragma unroll
            for (int s2 = 0; s2 < 2; ++s2) {
                u32x4 av; av[0] = vlo[dvb][kb][s2].x; av[1] = vlo[dvb][kb][s2].y; av[2] = vhi[dvb][kb][s2].x; av[3] = vhi[dvb][kb][s2].y;
                const bf16x8 a = __builtin_bit_cast(bf16x8, av);
#pragma unroll
                for (int qb = 0; qb < 2; ++qb) acc[dvb][qb] = __builtin_amdgcn_mfma_f32_32x32x16_bf16(a, pf[kb][s2][qb], acc[dvb][qb], 0, 0, 0);
            }
    float* red = (float*)smem;
    float mu[2], rstd[2];
    __syncthreads();
#pragma unroll
    for (int qb = 0; qb < 2; ++qb) {
        float s1 = 0.f, s2 = 0.f;
#pragma unroll
        for (int dvb = 0; dvb < 2; ++dvb)
#pragma unroll
            for (int i = 0; i < 16; ++i) { const float x = acc[dvb][qb][i]; s1 += x; s2 += x * x; }
        s1 += __shfl_xor(s1, 32); s2 += __shfl_xor(s2, 32);
        if (hf == 0) { red[(w * 64 + qb * 32 + r) * 2] = s1; red[(w * 64 + qb * 32 + r) * 2 + 1] = s2; }
    }
    __syncthreads();
#pragma unroll
    for (int qb = 0; qb < 2; ++qb) {
        float s1 = 0.f, s2 = 0.f;
#pragma unroll
        for (int ww = 0; ww < 4; ++ww) { s1 += red[(ww * 64 + qb * 32 + r) * 2]; s2 += red[(ww * 64 + qb * 32 + r) * 2 + 1]; }
        const float m_ = s1 * (1.f / 256.f);
        mu[qb] = m_; rstd[qb] = rsqrtf(fmaxf(s2 * (1.f / 256.f) - m_ * m_, 0.f) + LN_EPS);
    }
    const float* gr = p.g_ret + (size_t)l * 1024 + hd * 256 + w * 64;
#pragma unroll
    for (int dvb = 0; dvb < 2; ++dvb)
#pragma unroll
        for (int g = 0; g < 4; ++g) {
            const int dv = dvb * 32 + 8 * g + 4 * hf;
            const f32x4 gg = *(const f32x4*)(gr + dv);
#pragma unroll
            for (int qb = 0; qb < 2; ++qb) {
                const size_t off = (t0 + qb * 32 + r) * 1024 + hd * 256 + w * 64 + dv;
                const uint2 cgv = *(const uint2*)(p.cg + off);
                f32x4 y;
#pragma unroll
                for (int jj = 0; jj < 4; ++jj) y[jj] = (acc[dvb][qb][4 * g + jj] - mu[qb]) * rstd[qb] * gg[jj];
                y[0] *= bflo(cgv.x); y[1] *= bfhi(cgv.x); y[2] *= bflo(cgv.y); y[3] *= bfhi(cgv.y);
                st4(p.yc + off, y);
            }
        }
}

DI void phase_mixers(const Params& p, int l, unsigned char* smem) {
    const int nF = 64 * 24, nC = 2 * 4 * 128;
    int* sitem = (int*)(smem + SMEM_BYTES - 16);
    for (;;) {
        __syncthreads();
        if (otid() == 0) *sitem = (int)atomicAdd(p.ctr + l, 1u);
        __syncthreads();
        const int it = *sitem;
        if (it >= nF + nC) break;
        if (it < nF) {
            const int qi = 63 - it / 24, r = it % 24;
            if (r < 8) flash_item<1>(p, r >> 2, r & 3, qi, smem);
            else flash_item<0>(p, (r - 8) >> 3, (r - 8) & 7, qi, smem);
        } else ret_state_item(p, it - nF);
    }
}

DI void phase_mixers_naive(const Params& p) {
    const int nA = 2 * 8 * 128, nB = 2 * 4 * 128, nC = 2 * 4 * 128;
    for (int it = obid(); it < nA + nB + nC; it += gridDim.x) {
        if (it < nB) naive_attn<1>(p, it);
        else if (it < nB + nC) naive_attn<2>(p, it - nB);
        else naive_attn<0>(p, it - nB - nC);
    }
}

DI void phase_post(const Params& p, int l) {
    const int lane = otid() & 63, wv = otid() >> 6;
    const float lam = p.lamv[2 * l], li = p.lamv[2 * l + 1];
    const float* gd = p.g_diff + (size_t)l * 512; const float* gr = p.g_ret + (size_t)l * 1024;
    for (int row = obid() * 4 + wv; row < T; row += gridDim.x * 4) {
#pragma unroll
        for (int hh = 0; hh < 4; ++hh) {
            const unsigned o0 = *(const unsigned*)(p.oa + (size_t)row * 1024 + (2 * hh) * 128 + lane * 2);
            const unsigned o1 = *(const unsigned*)(p.oa + (size_t)row * 1024 + (2 * hh + 1) * 128 + lane * 2);
            const float d0 = bflo(o0) - lam * bflo(o1), d1 = bfhi(o0) - lam * bfhi(o1);
            float ss = d0 * d0 + d1 * d1;
            for (int o = 32; o; o >>= 1) ss += __shfl_xor(ss, o);
            const float r = rsqrtf(ss * (1.f / 128.f) + LN_EPS) * (1.f - li);
            const int c = hh * 128 + lane * 2;
            *(unsigned*)(p.ya + (size_t)row * 512 + c) = pack2(d0 * r * gd[c], d1 * r * gd[c + 1]);
        }
    }
}

DI void grid_bar(unsigned* bar, unsigned& epoch) {
    asm volatile("s_waitcnt vmcnt(0) lgkmcnt(0)" ::: "memory");
    __syncthreads();
    epoch += 1;
    const int tid = otid();
    unsigned* go = bar;
    unsigned* flags = bar + 32;
    if (tid == 0) {
        __builtin_amdgcn_fence(__ATOMIC_RELEASE, "agent");
        asm volatile("s_waitcnt vmcnt(0)" ::: "memory");
        __hip_atomic_store(flags + 32 * obid(), epoch, __ATOMIC_RELAXED, __HIP_MEMORY_SCOPE_AGENT);
    }
    if (obid() == 0 && tid < 64) {
        const int nb = gridDim.x;
        for (int base = 0; base < nb; base += 64) {
            const int idx = base + tid;
            if (idx < nb) while (__hip_atomic_load(flags + 32 * idx, __ATOMIC_RELAXED, __HIP_MEMORY_SCOPE_AGENT) < epoch) __builtin_amdgcn_s_sleep(1);
        }
        asm volatile("s_waitcnt vmcnt(0)" ::: "memory");
        if (tid == 0) __hip_atomic_store(go, epoch, __ATOMIC_RELAXED, __HIP_MEMORY_SCOPE_AGENT);
    }
    if (tid == 0) {
        while (__hip_atomic_load(go, __ATOMIC_RELAXED, __HIP_MEMORY_SCOPE_AGENT) < epoch) __builtin_amdgcn_s_sleep(1);
        __builtin_amdgcn_fence(__ATOMIC_ACQUIRE, "agent");
        asm volatile("s_waitcnt vmcnt(0)" ::: "memory");
    }
    __syncthreads();
}
#define GSYNC() grid_bar(p.bar, epoch)
__global__ void __launch_bounds__(256, 2) fwd_kernel(Params p) {
    __shared__ __attribute__((aligned(16))) unsigned char smem[SMEM_BYTES];
    cg::grid_group grid = cg::this_grid();
    bf16_t* sm = (bf16_t*)smem; float* smf = (float*)smem;

    unsigned epoch = 0;
    asm volatile("s_waitcnt vmcnt(0) lgkmcnt(0)" ::: "memory"); grid.sync();
    convert_layer(p, 0, smf);
    phase0_misc(p, smf);
    GSYNC();
    row_phase(p, p.x, false, nullptr, nullptr, nullptr, p.mod, 0, 1024, true, true);
    GSYNC();
    for (int l = 0; l < DEPTH; ++l) {
        const float* modl = p.mod + (size_t)l * 2 * 6144;
        const float* xcur = l == 0 ? p.x : p.xbuf;
        if (obid() >= gridDim.x - 8) scan_item(p, obid() - (gridDim.x - 8), smf);
        phase_inproj(p, sm);
        GSYNC();
        phase_mixers(p, l, smem);
        GSYNC();
        phase_post(p, l);
        ret_scan(p);
        GSYNC();
        for (int it = obid(); it < 1024; it += gridDim.x) ret_out_item(p, l, it, smem);
        GSYNC();
        phase_branch(p, sm);
        GSYNC();
        phase_gemm_res(p, p.h, 1024, p.WoutT, xcur, modl, 2048, sm);
        GSYNC();
        row_phase(p, p.vbuf, true, p.ln_g + (size_t)(l * 2) * Dm, p.ln_b + (size_t)(l * 2) * Dm, p.xbuf, modl, 3072, 4096, true, false);
        GSYNC();
        phase_up(p, sm);
        GSYNC();
        phase_conv(p, l);
        GSYNC();
        phase_gemm_res(p, p.act, DFF, p.WdownT, p.xbuf, modl, 5120, sm);
        GSYNC();
        if (l + 1 < DEPTH) {
            convert_layer(p, l + 1, smf);
            GSYNC();
            row_phase(p, p.vbuf, true, p.ln_g + (size_t)(l * 2 + 1) * Dm, p.ln_b + (size_t)(l * 2 + 1) * Dm, p.xbuf, modl + 2 * 6144, 0, 1024, true, true);
            GSYNC();
        } else {
            row_phase(p, p.vbuf, true, p.ln_g + (size_t)(l * 2 + 1) * Dm, p.ln_b + (size_t)(l * 2 + 1) * Dm, p.out, modl, 0, 1024, false, false);
        }
    }
}

extern "C" void kernel_launch(void* const* d_in, const int* in_sizes, int n_in, void* d_out, int out_size, void* d_ws, size_t ws_size, hipStream_t stream) {
    static int grid_blocks = 0;
    if (!grid_blocks) {
        int dev = 0, cus = 0, per_cu = 0;
        hipGetDevice(&dev);
        hipDeviceGetAttribute(&cus, hipDeviceAttributeMultiprocessorCount, dev);
        hipOccupancyMaxActiveBlocksPerMultiprocessor(&per_cu, fwd_kernel, 256, 0);
        if (per_cu > 2) per_cu = 2;
        if (per_cu < 1) per_cu = 1;
        grid_blocks = cus * per_cu;
    }
    Params p{};
    const float** ins = (const float**)&p.x;
    for (int i = 0; i < 22; ++i) ins[i] = (const float*)d_in[i];
    p.out = (float*)d_out;
    char* w = (char*)d_ws; size_t off = 0;
    auto take = [&](size_t bytes) { char* r = w + off; off += (bytes + 255) & ~(size_t)255; return r; };
    const size_t MB = 1u << 20;
    p.mod = (float*)take((size_t)DEPTH * 2 * 6144 * 4);
    p.lamv = (float*)take(256);
    p.ctr = (unsigned*)take(256);
    p.bar = (unsigned*)take((size_t)(1 + 1024) * 128);
    p.wf = (float*)take(4100 * 4);
    p.binp = (float*)take(NIN * 4);
    p.cstab = (float*)take((size_t)S * 64 * 2 * 4);
    p.logf = (float*)take((size_t)T * 4 * 4);
    p.F = (float*)take((size_t)T * 4 * 4);
    p.WinT = (bf16_t*)take((size_t)NIN * 1024 * 2);
    p.WpaT = (bf16_t*)take((size_t)1024 * 512 * 2);
    p.WpbT = (bf16_t*)take((size_t)1024 * 512 * 2);
    p.WpcT = (bf16_t*)take((size_t)1024 * 1024 * 2);
    p.WoutT = (bf16_t*)take((size_t)1024 * 1024 * 2);
    p.WupT = (bf16_t*)take((size_t)2 * DFF * 1024 * 2);
    p.WdownT = (bf16_t*)take((size_t)1024 * DFF * 2);
    p.xbuf = (float*)take((size_t)T * Dm * 4);
    p.h = (bf16_t*)take((size_t)T * Dm * 2);
    const size_t offA = off;
    p.qa = (bf16_t*)take((size_t)T * 512 * 2); p.ka = (bf16_t*)take((size_t)T * 512 * 2); p.vta = (bf16_t*)take((size_t)T * 512 * 2);
    p.qb = (bf16_t*)take((size_t)T * 512 * 2); p.kb = (bf16_t*)take((size_t)T * 512 * 2); p.vtb = (bf16_t*)take((size_t)T * 512 * 2);
    p.cq = (bf16_t*)take((size_t)T * 512 * 2); p.ck = (bf16_t*)take((size_t)T * 512 * 2);
    p.cv = (bf16_t*)take((size_t)T * 1024 * 2); p.cg = (bf16_t*)take((size_t)T * 1024 * 2);
    p.gates = (bf16_t*)take((size_t)T * 3072 * 2);
    const size_t endA = off;
    p.ug = (bf16_t*)(w + offA);
    p.act = (bf16_t*)(w + offA + (size_t)T * 2 * DFF * 2);
    const size_t offB = endA;
    off = offB;
    p.vbuf = (float*)(w + offB);
    p.oa = p.h;
    p.yb = (bf16_t*)take((size_t)T * 512 * 2);
    p.kv = (bf16_t*)take((size_t)8 * 128 * 256 * 128 * 2);
    p.ckT = (bf16_t*)take((size_t)T * 512 * 2);
    p.ya = (bf16_t*)take((size_t)T * 512 * 2);
    p.yc = (bf16_t*)take((size_t)T * 1024 * 2);
    if (off > ws_size || (size_t)T * 2 * DFF * 2 + (size_t)T * DFF * 2 > endA - offA) {
        fprintf(stderr, "kernel_launch: workspace too small: need %zu MB have %zu MB\n", off / MB, ws_size / MB);
        return;
    }
    (void)hipMemsetAsync(p.bar, 0, (size_t)(1 + 1024) * 128, stream);
    void* args[] = {&p};
    hipError_t e = hipLaunchCooperativeKernel((void*)fwd_kernel, dim3(grid_blocks), dim3(256), args, 0, stream);
    if (e != hipSuccess) fprintf(stderr, "cooperative launch failed: %s (grid %d)\n", hipGetErrorString(e), grid_blocks);
}
```

```cpp
#include <hip/hip_runtime.h>
#include <hip/hip_cooperative_groups.h>
#include <cstdio>
#include <cstdint>
namespace cg = cooperative_groups;

typedef unsigned short bf16_t;
typedef short bf16x8 __attribute__((ext_vector_type(8)));
typedef float f32x4 __attribute__((ext_vector_type(4)));

constexpr int Dm = 1024, NB = 2, S = 8192, T = NB * S, DEPTH = 4, DFF = 2816, DIN = 9220, NIN = 9216;
constexpr float LN_EPS = 1e-5f;
constexpr float LOG2E = 1.4426950408889634f;
#define ALPHA_F 1.681792830507429f

#define DI __device__ __forceinline__
DI int otid() { int t = threadIdx.x; asm volatile("" : "+v"(t)); return t; }
DI int obid() { int b = blockIdx.x; asm volatile("" : "+s"(b)); return b; }

typedef __bf16 hbf2 __attribute__((ext_vector_type(2)));
typedef float f32x2 __attribute__((ext_vector_type(2)));
DI bf16_t f2bf(float x) { return __builtin_bit_cast(unsigned short, (__bf16)x); }
DI float bf2f(bf16_t v) { return __uint_as_float(((unsigned)v) << 16); }
DI float bflo(unsigned w) { return __uint_as_float(w << 16); }
DI float bfhi(unsigned w) { return __uint_as_float(w & 0xffff0000u); }
DI unsigned pack2(float a, float b) { f32x2 v = {a, b}; return __builtin_bit_cast(unsigned, __builtin_convertvector(v, hbf2)); }

struct Params {
    const float *x, *c, *w_ada, *b_ada, *w_in, *b_in, *lq1, *lk1, *lq2, *lk2, *g_diff, *g_ret, *w_pa, *w_pb, *w_pc, *w_out, *ln_g, *ln_b, *w_up, *w_conv, *b_conv, *w_down;
    float* out;
    unsigned* ctr; unsigned* bar;
    float *mod, *lamv, *wf, *binp, *cstab, *xbuf, *vbuf, *logf, *F, *oc;
    bf16_t *WinT, *WpaT, *WpbT, *WpcT, *WoutT, *WupT, *WdownT;
    bf16_t *h, *qa, *ka, *vta, *qb, *kb, *vtb, *cq, *ck, *cv, *cg, *gates, *oa, *yb, *ya, *yc, *ug, *act, *ckT, *kv;
};

#define LDS_BARRIER() do { asm volatile("s_waitcnt lgkmcnt(0)" ::: "memory"); __builtin_amdgcn_s_barrier(); asm volatile("" ::: "memory"); } while (0)
constexpr int BM = 128, BN = 128, BK = 64, LDP = BK + 8;
constexpr int SMEM_BYTES = 2 * (BM + BN) * LDP * 2;

DI int win_map(int n) {
    if (n < 3072) return n;
    if (n < 4096) { int r = n - 3072; int seg = r >> 9; r &= 511; int head = r >> 7; int c = r & 127; return 3076 + seg * 512 + head * 128 + (c >> 1) + 64 * (c & 1); }
    return n + 4;
}

DI void convert_tile(const float* __restrict__ src, int ldsrc, bf16_t* __restrict__ dst, int K, int tiles_n, int tile, int kind, float* lds) {
    const int tn = tile % tiles_n, tk = tile / tiles_n;
    const int tx = otid() & 63, ty = otid() >> 6;
    const int n = tn * 64 + tx;
    const int sn = kind == 1 ? win_map(n) : n;
    __syncthreads();
#pragma unroll 4
    for (int r = 0; r < 16; ++r) {
        const int kk = ty * 16 + r;
        lds[kk * 65 + tx] = src[(size_t)(tk * 64 + kk) * ldsrc + sn];
    }
    __syncthreads();
#pragma unroll 4
    for (int r = 0; r < 16; ++r) {
        const int nn = ty * 16 + r;
        dst[(size_t)(tn * 64 + nn) * K + tk * 64 + tx] = f2bf(lds[tx * 65 + nn]);
    }
}

DI void convert_layer(const Params& p, int l, float* lds) {
    const int n_in = 16 * 144, n_pa = 8 * 16, n_pb = 8 * 16, n_pc = 16 * 16, n_out = 16 * 16, n_up = 16 * 88, n_dn = 44 * 16;
    const int total = n_in + n_pa + n_pb + n_pc + n_out + n_up + n_dn;
    for (int it = obid(); it < total; it += gridDim.x) {
        int t = it;
        if (t < n_in) { convert_tile(p.w_in + (size_t)l * Dm * DIN, DIN, p.WinT, 1024, 144, t, 1, lds); continue; } t -= n_in;
        if (t < n_pa) { convert_tile(p.w_pa + (size_t)l * 512 * Dm, Dm, p.WpaT, 512, 16, t, 0, lds); continue; } t -= n_pa;
        if (t < n_pb) { convert_tile(p.w_pb + (size_t)l * 512 * Dm, Dm, p.WpbT, 512, 16, t, 0, lds); continue; } t -= n_pb;
        if (t < n_pc) { convert_tile(p.w_pc + (size_t)l * 1024 * Dm, Dm, p.WpcT, 1024, 16, t, 0, lds); continue; } t -= n_pc;
        if (t < n_out) { convert_tile(p.w_out + (size_t)l * Dm * Dm, Dm, p.WoutT, 1024, 16, t, 0, lds); continue; } t -= n_out;
        if (t < n_up) { convert_tile(p.w_up + (size_t)l * Dm * 2 * DFF, 2 * DFF, p.WupT, 1024, 88, t, 0, lds); continue; } t -= n_up;
        convert_tile(p.w_down + (size_t)l * DFF * Dm, Dm, p.WdownT, DFF, 16, t, 0, lds);
    }
    const int gtid = obid() * blockDim.x + otid(), gsz = gridDim.x * blockDim.x;
    for (int i = gtid; i < NIN; i += gsz) p.binp[i] = p.b_in[(size_t)l * DIN + win_map(i)];
    for (int i = gtid; i < 4096; i += gsz) { const int k = i >> 2, hh = i & 3; p.wf[i] = p.w_in[(size_t)l * Dm * DIN + (size_t)k * DIN + 3072 + hh]; }
    for (int i = gtid; i < 4; i += gsz) p.wf[4096 + i] = p.b_in[(size_t)l * DIN + 3072 + i];
}

DI float ex2(float x) { return __builtin_amdgcn_exp2f(x); }
DI float lg2gamma(int hd) { return hd == 0 ? -0.04580368961312479f : hd == 1 ? -0.02272007650008353f : hd == 2 ? -0.011315313227834146f : -0.005646563141142063f; }
DI float silu_f(float v) { return v / (1.f + __expf(-v)); }
DI float sigmoid_f(float v) { return 1.f / (1.f + __expf(-v)); }

DI void phase0_misc(const Params& p, float* lds) {
    for (int it = obid(); it < DEPTH * 96; it += gridDim.x) {
        const int l = it / 96, jb = it % 96;
        const int tx = otid() & 63, ks = otid() >> 6;
        const int j = jb * 64 + tx;
        const float* w = p.w_ada + (size_t)l * Dm * 6144 + j;
        float a0 = 0.f, a1 = 0.f;
#pragma unroll 8
        for (int k = ks * 256; k < ks * 256 + 256; ++k) {
            const float wv = w[(size_t)k * 6144];
            a0 += silu_f(p.c[k]) * wv; a1 += silu_f(p.c[Dm + k]) * wv;
        }
        __syncthreads();
        lds[(ks * 64 + tx) * 2] = a0; lds[(ks * 64 + tx) * 2 + 1] = a1;
        __syncthreads();
        if (ks == 0) {
            float s0 = 0.f, s1 = 0.f;
            for (int q = 0; q < 4; ++q) { s0 += lds[(q * 64 + tx) * 2]; s1 += lds[(q * 64 + tx) * 2 + 1]; }
            const float bb = p.b_ada[(size_t)l * 6144 + j];
            p.mod[((size_t)l * 2 + 0) * 6144 + j] = s0 + bb;
            p.mod[((size_t)l * 2 + 1) * 6144 + j] = s1 + bb;
        }
    }
    const int gtid = obid() * blockDim.x + otid(), gsz = gridDim.x * blockDim.x;
    if (gtid < 64) p.ctr[gtid] = 0u;
    if (obid() == 0 && otid() < 64 * DEPTH) {
        const int l = otid() >> 6, ln = otid() & 63;
        float a = p.lq1[l * 64 + ln] * p.lk1[l * 64 + ln], b = p.lq2[l * 64 + ln] * p.lk2[l * 64 + ln];
        for (int o = 32; o; o >>= 1) { a += __shfl_xor(a, o); b += __shfl_xor(b, o); }
        if (ln == 0) { const float li = 0.8f - 0.6f * expf(-0.3f * (float)l); p.lamv[2 * l] = expf(a) - expf(b) + li; p.lamv[2 * l + 1] = li; }
    }
}

DI void row_phase(const Params& p, const float* __restrict__ src, bool do_ln, const float* __restrict__ lng, const float* __restrict__ lnb,
                  float* __restrict__ xdst, const float* __restrict__ modl  , int sh_off, int sc_off, bool want_h, bool want_logf) {
    const int lane = otid() & 63, wv = otid() >> 6;
    for (int row = obid() * 4 + wv; row < T; row += gridDim.x * 4) {
        const int b = row / S;
        const float* sp = src + (size_t)row * Dm;
        f32x4 v[4];
#pragma unroll
        for (int i = 0; i < 4; ++i) v[i] = *(const f32x4*)(sp + i * 256 + lane * 4);
        if (do_ln) {
            float s = 0.f;
#pragma unroll
            for (int i = 0; i < 4; ++i) s += (v[i][0] + v[i][1]) + (v[i][2] + v[i][3]);
            for (int o = 32; o; o >>= 1) s += __shfl_xor(s, o);
            const float mu = s * (1.f / 1024.f);
            float q = 0.f;
#pragma unroll
            for (int i = 0; i < 4; ++i) { f32x4 d = v[i] - mu; q += (d[0] * d[0] + d[1] * d[1]) + (d[2] * d[2] + d[3] * d[3]); }
            for (int o = 32; o; o >>= 1) q += __shfl_xor(q, o);
            const float rstd = rsqrtf(q * (1.f / 1024.f) + LN_EPS);
#pragma unroll
            for (int i = 0; i < 4; ++i) {
                const f32x4 g = *(const f32x4*)(lng + i * 256 + lane * 4), bb = *(const f32x4*)(lnb + i * 256 + lane * 4);
                v[i] = (v[i] - mu) * rstd * g + bb;
            }
        }
        if (xdst) {
#pragma unroll
            for (int i = 0; i < 4; ++i) *(f32x4*)(xdst + (size_t)row * Dm + i * 256 + lane * 4) = v[i];
        }
        if (want_h) {
            const float* mb = modl + (size_t)b * 6144;
            float d0 = 0.f, d1 = 0.f, d2 = 0.f, d3 = 0.f;
#pragma unroll
            for (int i = 0; i < 4; ++i) {
                const int c0 = i * 256 + lane * 4;
                const f32x4 sc = *(const f32x4*)(mb + sc_off + c0), sh = *(const f32x4*)(mb + sh_off + c0);
                const f32x4 hv = v[i] * (1.f + sc) + sh;
                uint2 w; w.x = pack2(hv[0], hv[1]); w.y = pack2(hv[2], hv[3]);
                *(uint2*)(p.h + (size_t)row * Dm + c0) = w;
                if (want_logf) {
#pragma unroll
                    for (int j = 0; j < 4; ++j) {
                        const f32x4 wf = *(const f32x4*)(p.wf + (c0 + j) * 4);
                        d0 += hv[j] * wf[0]; d1 += hv[j] * wf[1]; d2 += hv[j] * wf[2]; d3 += hv[j] * wf[3];
                    }
                }
            }
            if (want_logf) {
                for (int o = 32; o; o >>= 1) { d0 += __shfl_xor(d0, o); d1 += __shfl_xor(d1, o); d2 += __shfl_xor(d2, o); d3 += __shfl_xor(d3, o); }
                if (lane < 4) {
                    float z = (lane == 0 ? d0 : lane == 1 ? d1 : lane == 2 ? d2 : d3) + p.wf[4096 + lane];
                    const float ls = fminf(z, 0.f) - log1pf(__expf(-fabsf(z)));
                    p.logf[(size_t)row * 4 + lane] = ls * LOG2E;
                }
            }
        }
    }
}

DI void scan_item(const Params& p, int item, float* lds) {
    const int b = item >> 2, hh = item & 3, tid = otid();
    const float* lp = p.logf + (size_t)b * S * 4 + hh;
    float loc[32]; float s = 0.f;
#pragma unroll
    for (int i = 0; i < 32; ++i) { s += lp[(size_t)(tid * 32 + i) * 4]; loc[i] = s; }
    __syncthreads();
    lds[tid] = s;
    __syncthreads();
    float pre = 0.f;
    for (int i = 0; i < tid; ++i) pre += lds[i];
    float* fp = p.F + (size_t)(b * 4 + hh) * S + tid * 32;
#pragma unroll
    for (int i = 0; i < 32; ++i) fp[i] = pre + loc[i];
    __syncthreads();
}

DI void gemm_kloop(const bf16_t* __restrict__ Ag, int lda, const bf16_t* __restrict__ Bg, int ldb, int K, f32x4 (&acc)[4][4], bf16_t* sm) {
    const int tid = otid(), lane = tid & 63, wid = tid >> 6, wr = wid >> 1, wc = wid & 1;
    bf16_t* sa = sm; bf16_t* sb = sm + 2 * BM * LDP;
    const int lrow = tid >> 3, lcc = tid & 7;
    const bf16_t* ap = Ag + (size_t)lrow * lda + lcc * 8;
    const bf16_t* bp = Bg + (size_t)lrow * ldb + lcc * 8;
    const size_t sA = (size_t)32 * lda, sB = (size_t)32 * ldb;
    uint4 ra0, ra1, ra2, ra3, rb0, rb1, rb2, rb3;
#define G_LOAD(koff) do { ra0 = *(const uint4*)(ap + (koff)); ra1 = *(const uint4*)(ap + sA + (koff)); ra2 = *(const uint4*)(ap + 2 * sA + (koff)); ra3 = *(const uint4*)(ap + 3 * sA + (koff)); \
                          rb0 = *(const uint4*)(bp + (koff)); rb1 = *(const uint4*)(bp + sB + (koff)); rb2 = *(const uint4*)(bp + 2 * sB + (koff)); rb3 = *(const uint4*)(bp + 3 * sB + (koff)); } while (0)
#define G_STORE(buf) do { bf16_t* da_ = sa + (buf) * BM * LDP + lrow * LDP + lcc * 8; bf16_t* db_ = sb + (buf) * BN * LDP + lrow * LDP + lcc * 8; \
        *(uint4*)(da_) = ra0; *(uint4*)(da_ + 32 * LDP) = ra1; *(uint4*)(da_ + 64 * LDP) = ra2; *(uint4*)(da_ + 96 * LDP) = ra3; \
        *(uint4*)(db_) = rb0; *(uint4*)(db_ + 32 * LDP) = rb1; *(uint4*)(db_ + 64 * LDP) = rb2; *(uint4*)(db_ + 96 * LDP) = rb3; } while (0)
    G_LOAD(0);
    G_STORE(0);
    LDS_BARRIER();
    const int nk = K / BK;
    const int fr = lane & 15, fq = lane >> 4;
    for (int kt = 0; kt < nk; ++kt) {
        const int cur = kt & 1;
        const bool more = kt + 1 < nk;
        if (more) G_LOAD((kt + 1) * BK);
        const bf16_t* ca = sa + cur * BM * LDP + (wr * 64 + fr) * LDP + fq * 8;
        const bf16_t* cb = sb + cur * BN * LDP + (wc * 64 + fr) * LDP + fq * 8;
#pragma unroll
        for (int kk = 0; kk < 2; ++kk) {
            bf16x8 af[4], bfr[4];
#pragma unroll
            for (int m = 0; m < 4; ++m) af[m] = *(const bf16x8*)(ca + m * 16 * LDP + kk * 32);
#pragma unroll
            for (int n = 0; n < 4; ++n) bfr[n] = *(const bf16x8*)(cb + n * 16 * LDP + kk * 32);
#pragma unroll
            for (int m = 0; m < 4; ++m)
#pragma unroll
                for (int n = 0; n < 4; ++n) acc[m][n] = __builtin_amdgcn_mfma_f32_16x16x32_bf16(bfr[n], af[m], acc[m][n], 0, 0, 0);
        }
        if (more) G_STORE(cur ^ 1);
        LDS_BARRIER();
    }
#undef G_LOAD
#undef G_STORE
}

DI void gemm_kloop2(const bf16_t* __restrict__ Ag, int lda, const bf16_t* __restrict__ Bg, int ldb, int K, f32x4 (&acc)[4][4], bf16_t* sm) {
    const int tid = otid(), lane = tid & 63, wid = tid >> 6, wr = wid >> 1, wc = wid & 1;
    bf16_t* sa = sm; bf16_t* sb = sm + 2 * BM * LDP;
    const int lrow = tid >> 3, lcc = tid & 7;
    const bf16_t* ap = Ag + (size_t)lrow * lda + lcc * 8;
    const bf16_t* bp = Bg + (size_t)lrow * ldb + lcc * 8;
    const size_t sA = (size_t)32 * lda, sB = (size_t)32 * ldb;
    uint4 xa0, xa1, xa2, xa3, xb0, xb1, xb2, xb3;
    uint4 ya0, ya1, ya2, ya3, yb0, yb1, yb2, yb3;
#define G2_LOAD(P, koff) do { P##a0 = *(const uint4*)(ap + (koff)); P##a1 = *(const uint4*)(ap + sA + (koff)); P##a2 = *(const uint4*)(ap + 2 * sA + (koff)); P##a3 = *(const uint4*)(ap + 3 * sA + (koff)); \
                              P##b0 = *(const uint4*)(bp + (koff)); P##b1 = *(const uint4*)(bp + sB + (koff)); P##b2 = *(const uint4*)(bp + 2 * sB + (koff)); P##b3 = *(const uint4*)(bp + 3 * sB + (koff)); } while (0)
#define G2_STORE(P, buf) do { bf16_t* da_ = sa + (buf) * BM * LDP + lrow * LDP + lcc * 8; bf16_t* db_ = sb + (buf) * BN * LDP + lrow * LDP + lcc * 8; \
        *(uint4*)(da_) = P##a0; *(uint4*)(da_ + 32 * LDP) = P##a1; *(uint4*)(da_ + 64 * LDP) = P##a2; *(uint4*)(da_ + 96 * LDP) = P##a3; \
        *(uint4*)(db_) = P##b0; *(uint4*)(db_ + 32 * LDP) = P##b1; *(uint4*)(db_ + 64 * LDP) = P##b2; *(uint4*)(db_ + 96 * LDP) = P##b3; } while (0)
#define G2_COMPUTE(buf) do { \
        const bf16_t* ca = sa + (buf) * BM * LDP + (wr * 64 + fr) * LDP + fq * 8; \
        const bf16_t* cb = sb + (buf) * BN * LDP + (wc * 64 + fr) * LDP + fq * 8; \
        _Pragma("unroll") for (int kk = 0; kk < 2; ++kk) { \
            bf16x8 af[4], bfr[4]; \
            _Pragma("unroll") for (int m = 0; m < 4; ++m) af[m] = *(const bf16x8*)(ca + m * 16 * LDP + kk * 32); \
            _Pragma("unroll") for (int n = 0; n < 4; ++n) bfr[n] = *(const bf16x8*)(cb + n * 16 * LDP + kk * 32); \
            _Pragma("unroll") for (int m = 0; m < 4; ++m) _Pragma("unroll") for (int n = 0; n < 4; ++n) acc[m][n] = __builtin_amdgcn_mfma_f32_16x16x32_bf16(bfr[n], af[m], acc[m][n], 0, 0, 0); \
        } } while (0)
    const int nk = K / BK;
    const int fr = lane & 15, fq = lane >> 4;
    G2_LOAD(x, 0);
    G2_LOAD(y, BK);
    G2_STORE(x, 0);
    LDS_BARRIER();
    for (int kt = 0; kt < nk; kt += 2) {
        const int kx = kt + 2 < nk ? kt + 2 : nk - 2, ky = kt + 3 < nk ? kt + 3 : nk - 1;
        G2_LOAD(x, kx * BK);
        __builtin_amdgcn_sched_barrier(0);
        G2_COMPUTE(0);
        G2_STORE(y, 1);
        LDS_BARRIER();
        G2_LOAD(y, ky * BK);
        __builtin_amdgcn_sched_barrier(0);
        G2_COMPUTE(1);
        G2_STORE(x, 0);
        LDS_BARRIER();
    }
#undef G2_LOAD
#undef G2_STORE
#undef G2_COMPUTE
}

DI void tile_coords(int tile, int nM, int nN, int& mt, int& nt) {
    const int G = gridDim.x;
    if ((G & 7) == 0 && (nM & 63) == 0 && (nM * nN) % G == 0) {
        const int b = tile % G, k = tile / G, per = G >> 3;
        const int xcd = b & 7, slot = b >> 3;
        const int li = k * per + slot;
        const int mh = li / (8 * nN), rem = li % (8 * nN);
        nt = rem >> 3; mt = (mh * 8 + (rem & 7)) * 8 + xcd;
        return;
    }
    const int band = tile / (16 * nN), r = tile % (16 * nN);
    mt = band * 16 + (r & 15); nt = r >> 4;
}

DI void zero_acc(f32x4 (&acc)[4][4]) {
#pragma unroll
    for (int m = 0; m < 4; ++m)
#pragma unroll
        for (int n = 0; n < 4; ++n) acc[m][n] = (f32x4){0.f, 0.f, 0.f, 0.f};
}


constexpr int BM2 = 256, BK2 = 32, LDP2 = BK2 + 8;
DI void gemm_kloop3(const bf16_t* __restrict__ Ag, int lda, const bf16_t* __restrict__ Bg, int ldb, int K, f32x4 (&acc)[8][4], bf16_t* sm) {
    const int tid = otid(), lane = tid & 63, wid = tid >> 6, wr = wid >> 1, wc = wid & 1;
    bf16_t* sa = sm; bf16_t* sb = sm + 2 * BM2 * LDP2;
    const int lrow = tid >> 2, lcc = tid & 3;
    const bf16_t* ap = Ag + (size_t)lrow * lda + lcc * 8;
    const int prow = ((lrow >> 2) & 3) * 16 + (lrow >> 4) * 4 + (lrow & 3);
    const bf16_t* bp = Bg + (size_t)prow * ldb + lcc * 8;
    const size_t sA = (size_t)64 * lda, sB = (size_t)64 * ldb;
    const int fr = lane & 15, fq = lane >> 4;
    uint4 a0, a1, a2, a3, b0, b1;
#define G3_LOAD(koff) do { a0 = *(const uint4*)(ap + (koff)); a1 = *(const uint4*)(ap + sA + (koff)); a2 = *(const uint4*)(ap + 2 * sA + (koff)); a3 = *(const uint4*)(ap + 3 * sA + (koff)); \
                           b0 = *(const uint4*)(bp + (koff)); b1 = *(const uint4*)(bp + sB + (koff)); } while (0)
#define G3_STORE(buf) do { bf16_t* da_ = sa + (buf) * BM2 * LDP2 + lrow * LDP2 + lcc * 8; bf16_t* db_ = sb + (buf) * BN * LDP2 + lrow * LDP2 + lcc * 8; \
        *(uint4*)(da_) = a0; *(uint4*)(da_ + 64 * LDP2) = a1; *(uint4*)(da_ + 128 * LDP2) = a2; *(uint4*)(da_ + 192 * LDP2) = a3; \
        *(uint4*)(db_) = b0; *(uint4*)(db_ + 64 * LDP2) = b1; } while (0)
    G3_LOAD(0);
    G3_STORE(0);
    LDS_BARRIER();
    const int nk = K / BK2;
    for (int kt = 0; kt < nk; ++kt) {
        const int cur = kt & 1;
        const bool more = kt + 1 < nk;
        if (more) G3_LOAD((kt + 1) * BK2);
        const bf16_t* ca = sa + cur * BM2 * LDP2 + (wr * 128 + fr) * LDP2 + fq * 8;
        const bf16_t* cb = sb + cur * BN * LDP2 + (wc * 64 + fr) * LDP2 + fq * 8;
        bf16x8 af[8], bfr[4];
#pragma unroll
        for (int m = 0; m < 8; ++m) af[m] = *(const bf16x8*)(ca + m * 16 * LDP2);
#pragma unroll
        for (int n = 0; n < 4; ++n) bfr[n] = *(const bf16x8*)(cb + n * 16 * LDP2);
#pragma unroll
        for (int m = 0; m < 8; ++m)
#pragma unroll
            for (int n = 0; n < 4; ++n) acc[m][n] = __builtin_amdgcn_mfma_f32_16x16x32_bf16(bfr[n], af[m], acc[m][n], 0, 0, 0);
        if (more) G3_STORE(cur ^ 1);
        LDS_BARRIER();
    }
#undef G3_LOAD
#undef G3_STORE
}
DI void zero_acc8(f32x4 (&acc)[8][4]) {
#pragma unroll
    for (int m = 0; m < 8; ++m)
#pragma unroll
        for (int n = 0; n < 4; ++n) acc[m][n] = (f32x4){0.f, 0.f, 0.f, 0.f};
}
DI void st4_wt(bf16_t* dst, f32x4 v) { const unsigned long long w = (unsigned long long)pack2(v[0], v[1]) | ((unsigned long long)pack2(v[2], v[3]) << 32); __hip_atomic_store((unsigned long long*)dst, w, __ATOMIC_RELAXED, __HIP_MEMORY_SCOPE_AGENT); }
DI void st4(bf16_t* dst, f32x4 v) { uint2 w; w.x = pack2(v[0], v[1]); w.y = pack2(v[2], v[3]); *(uint2*)dst = w; }

DI void st8(bf16_t* dst, f32x4 a, f32x4 b) { uint4 w; w.x = pack2(a[0], a[1]); w.y = pack2(a[2], a[3]); w.z = pack2(b[0], b[1]); w.w = pack2(b[2], b[3]); *(uint4*)dst = w; }
DI f32x4 rot4(f32x4 v, int s, int i0) {
    const float a0 = (float)s * ex2(-(float)i0 * 0.21091607f), a1 = (float)s * ex2(-(float)(i0 + 1) * 0.21091607f);
    float r0 = a0 * 0.15915494309189535f, r1 = a1 * 0.15915494309189535f;
    r0 -= floorf(r0); r1 -= floorf(r1);
    float c0_ = __builtin_amdgcn_cosf(r0), s0_ = __builtin_amdgcn_sinf(r0), c1_ = __builtin_amdgcn_cosf(r1), s1_ = __builtin_amdgcn_sinf(r1);
    asm volatile("s_nop 15\n\ts_nop 15" : "+v"(c0_), "+v"(s0_), "+v"(c1_), "+v"(s1_));
    f32x4 o; o[0] = v[0] * c0_ - v[1] * s0_; o[1] = v[0] * s0_ + v[1] * c0_; o[2] = v[2] * c1_ - v[3] * s1_; o[3] = v[2] * s1_ + v[3] * c1_;
    return o;
}
DI void epi_inproj(const Params& p, int row, int col, f32x4 v0, f32x4 v1) {
    v0 += *(const f32x4*)(p.binp + col); v1 += *(const f32x4*)(p.binp + col + 4);
    const int b = row / S, s = row % S;
    if (col < 512) { st8(p.qa + (size_t)row * 512 + col, v0 * (0.125f * LOG2E), v1 * (0.125f * LOG2E)); }
    else if (col < 1024) { st8(p.ka + (size_t)row * 512 + (col - 512), v0, v1); }
    else if (col < 1536) { const int c = col - 1024, hh = c >> 7, e = c & 127; bf16_t* d = p.vta + ((size_t)(b * 4 + hh) * 128 + e) * S + s;
#pragma unroll
        for (int j = 0; j < 4; ++j) { d[(size_t)j * S] = f2bf(v0[j]); d[(size_t)(j + 4) * S] = f2bf(v1[j]); } }
    else if (col < 2048) { st8(p.qb + (size_t)row * 512 + (col - 1536), v0 * (0.08838834764831845f * LOG2E), v1 * (0.08838834764831845f * LOG2E)); }
    else if (col < 2560) { st8(p.kb + (size_t)row * 512 + (col - 2048), v0, v1); }
    else if (col < 3072) { const int c = col - 2560, hh = c >> 7, e = c & 127; bf16_t* d = p.vtb + ((size_t)(b * 4 + hh) * 128 + e) * S + s;
#pragma unroll
        for (int j = 0; j < 4; ++j) { d[(size_t)j * S] = f2bf(v0[j]); d[(size_t)(j + 4) * S] = f2bf(v1[j]); } }
    else if (col < 4096) {
        const int r = col - 3072, seg = r >> 9, c = r & 511, cc = c & 127, i0 = cc >> 1, hd = c >> 7;
        f32x4 o0 = rot4(v0, s, i0), o1 = rot4(v1, s, i0 + 2);
        const float lg = lg2gamma(hd);
        const int ic = s & 63;
        float e1_ = ex2(lg * (float)(ic + 1)), e2_ = ex2(-lg * (float)(ic + 1)), e3_ = ex2(lg * (float)(63 - ic));
        asm volatile("s_nop 15\n\ts_nop 15" : "+v"(e1_), "+v"(e2_), "+v"(e3_));
        if (seg == 0) st8(p.cq + (size_t)row * 512 + c, o0 * e1_, o1 * e1_);
        else {
            o0 = o0 * 0.08838834764831845f; o1 = o1 * 0.08838834764831845f;
            st8(p.ck + (size_t)row * 512 + c, o0 * e2_, o1 * e2_);
            const f32x4 d0 = o0 * e3_, d1 = o1 * e3_;
            bf16_t* d = p.ckT + ((size_t)(b * 4 + hd) * 128 + cc) * S + s;
#pragma unroll
            for (int j = 0; j < 4; ++j) { d[(size_t)j * S] = f2bf(d0[j]); d[(size_t)(j + 4) * S] = f2bf(d1[j]); }
        }
    }
    else if (col < 5120) { const int c = col - 4096; bf16_t* d = p.cv + ((size_t)b * 1024 + c) * S + s;
#pragma unroll
        for (int j = 0; j < 4; ++j) { d[(size_t)j * S] = f2bf(v0[j]); d[(size_t)(j + 4) * S] = f2bf(v1[j]); } }
    else if (col < 6144) { f32x4 o0, o1; for (int j = 0; j < 4; ++j) { o0[j] = silu_f(v0[j]); o1[j] = silu_f(v1[j]); } st8(p.cg + (size_t)row * 1024 + (col - 5120), o0, o1); }
    else { f32x4 o0, o1; for (int j = 0; j < 4; ++j) { o0[j] = sigmoid_f(v0[j]); o1[j] = sigmoid_f(v1[j]); } st8(p.gates + (size_t)row * 3072 + (col - 6144), o0, o1); }
}

DI void phase_inproj(const Params& p, bf16_t* sm) {
    const int nM = T / BM2, nN = NIN / BN;
    const int lane = otid() & 63, wid = otid() >> 6, wr = wid >> 1, wc = wid & 1;
    for (int tile = obid(); tile < nM * nN; tile += gridDim.x) {
        int mt, nt; tile_coords(tile, nM, nN, mt, nt);
        f32x4 acc[8][4]; zero_acc8(acc);
        gemm_kloop3(p.h + (size_t)mt * BM2 * Dm, Dm, p.WinT + (size_t)nt * BN * Dm, Dm, Dm, acc, sm);
#pragma unroll
        for (int m = 0; m < 8; ++m)
#pragma unroll
            for (int n2 = 0; n2 < 2; ++n2) epi_inproj(p, mt * BM2 + wr * 128 + m * 16 + (lane & 15), nt * BN + wc * 64 + (lane >> 4) * 16 + n2 * 8, acc[m][2 * n2], acc[m][2 * n2 + 1]);
    }
}

DI void phase_branch(const Params& p, bf16_t* sm) {
    const int nM = T / BM, nN = Dm / BN;
    const int lane = otid() & 63, wid = otid() >> 6, wr = wid >> 1, wc = wid & 1;
    for (int tile = obid(); tile < nM * nN; tile += gridDim.x) {
        int mt, nt; tile_coords(tile, nM, nN, mt, nt);
        f32x4 tot[4][4]; zero_acc(tot);
#pragma unroll 1
        for (int br = 0; br < 3; ++br) {
            const bf16_t* A = br == 0 ? p.ya : br == 1 ? p.yb : p.yc;
            const bf16_t* W = br == 0 ? p.WpaT : br == 1 ? p.WpbT : p.WpcT;
            const int K = br == 2 ? 1024 : 512;
            f32x4 acc[4][4]; zero_acc(acc);
            gemm_kloop(A + (size_t)mt * BM * K, K, W + (size_t)nt * BN * K, K, K, acc, sm);
#pragma unroll
            for (int m = 0; m < 4; ++m)
#pragma unroll
                for (int n = 0; n < 4; ++n) {
                    const int row = mt * BM + wr * 64 + m * 16 + (lane & 15), col = nt * BN + wc * 64 + n * 16 + (lane >> 4) * 4;
                    const uint2 g = *(const uint2*)(p.gates + (size_t)row * 3072 + br * 1024 + col);
                    tot[m][n][0] += bflo(g.x) * acc[m][n][0]; tot[m][n][1] += bfhi(g.x) * acc[m][n][1];
                    tot[m][n][2] += bflo(g.y) * acc[m][n][2]; tot[m][n][3] += bfhi(g.y) * acc[m][n][3];
                }
        }
#pragma unroll
        for (int m = 0; m < 4; ++m)
#pragma unroll
            for (int n = 0; n < 4; ++n) {
                const int row = mt * BM + wr * 64 + m * 16 + (lane & 15), col = nt * BN + wc * 64 + n * 16 + (lane >> 4) * 4;
                st4(p.h + (size_t)row * Dm + col, tot[m][n]);
            }
    }
}

DI void phase_gemm_res(const Params& p, const bf16_t* A, int K, const bf16_t* Wt, const float* xres, const float* modl, int gt_off, bf16_t* sm) {
    const int nM = T / BM2, nN = Dm / BN;
    const int lane = otid() & 63, wid = otid() >> 6, wr = wid >> 1, wc = wid & 1;
    for (int tile = obid(); tile < nM * nN; tile += gridDim.x) {
        int mt, nt; tile_coords(tile, nM, nN, mt, nt);
        f32x4 acc[8][4]; zero_acc8(acc);
        gemm_kloop3(A + (size_t)mt * BM2 * K, K, Wt + (size_t)nt * BN * K, K, K, acc, sm);
#pragma unroll
        for (int m = 0; m < 8; ++m)
#pragma unroll
            for (int n = 0; n < 4; ++n) {
                const int row = mt * BM2 + wr * 128 + m * 16 + (lane & 15), col = nt * BN + wc * 64 + (lane >> 4) * 16 + n * 4;
                const int b = row / S;
                const f32x4 xr = *(const f32x4*)(xres + (size_t)row * Dm + col);
                const f32x4 gt = *(const f32x4*)(modl + (size_t)b * 6144 + gt_off + col);
                *(f32x4*)(p.vbuf + (size_t)row * Dm + col) = xr * ALPHA_F + gt * acc[m][n];
            }
    }
}

DI void phase_up(const Params& p, bf16_t* sm) {
    const int nM = T / BM2, nN = 2 * DFF / BN;
    const int lane = otid() & 63, wid = otid() >> 6, wr = wid >> 1, wc = wid & 1;
    for (int tile = obid(); tile < nM * nN; tile += gridDim.x) {
        int mt, nt; tile_coords(tile, nM, nN, mt, nt);
        f32x4 acc[8][4]; zero_acc8(acc);
        gemm_kloop3(p.h + (size_t)mt * BM2 * Dm, Dm, p.WupT + (size_t)nt * BN * Dm, Dm, Dm, acc, sm);
#pragma unroll
        for (int m = 0; m < 8; ++m)
#pragma unroll
            for (int n2 = 0; n2 < 2; ++n2) {
                const int row = mt * BM2 + wr * 128 + m * 16 + (lane & 15), col = nt * BN + wc * 64 + (lane >> 4) * 16 + n2 * 8;
                st8(p.ug + (size_t)row * (2 * DFF) + col, acc[m][2 * n2], acc[m][2 * n2 + 1]);
            }
    }
}

DI void phase_conv(const Params& p, int l) {
    const int gtid = obid() * blockDim.x + otid(), gsz = gridDim.x * blockDim.x;
    const float* wc = p.w_conv + (size_t)l * 3 * DFF; const float* bc = p.b_conv + (size_t)l * DFF;
    for (int i = gtid; i < T * (DFF / 8); i += gsz) {
        const int row = i / (DFF / 8), c8 = (i % (DFF / 8)) * 8, s = row % S;
        const bf16_t* up = p.ug + (size_t)row * (2 * DFF) + c8;
        const uint4 u0 = *(const uint4*)up;
        uint4 u1 = make_uint4(0, 0, 0, 0), u2 = make_uint4(0, 0, 0, 0);
        if (s >= 1) u1 = *(const uint4*)(up - 2 * DFF);
        if (s >= 2) u2 = *(const uint4*)(up - 4 * DFF);
        const uint4 gg = *(const uint4*)(up + DFF);
        const unsigned a0[4] = {u0.x, u0.y, u0.z, u0.w}, a1[4] = {u1.x, u1.y, u1.z, u1.w}, a2[4] = {u2.x, u2.y, u2.z, u2.w}, ag[4] = {gg.x, gg.y, gg.z, gg.w};
        float cv[8], t[8], e[8];
#pragma unroll
        for (int h4 = 0; h4 < 2; ++h4) {
            const f32x4 w0 = *(const f32x4*)(wc + c8 + 4 * h4), w1 = *(const f32x4*)(wc + DFF + c8 + 4 * h4), w2 = *(const f32x4*)(wc + 2 * DFF + c8 + 4 * h4), bb = *(const f32x4*)(bc + c8 + 4 * h4);
#pragma unroll
            for (int k = 0; k < 4; ++k) {
                const int j = 2 * h4 + (k >> 1); const bool hi = k & 1;
                const float x0 = hi ? bfhi(a0[j]) : bflo(a0[j]), x1 = hi ? bfhi(a1[j]) : bflo(a1[j]), x2 = hi ? bfhi(a2[j]) : bflo(a2[j]);
                cv[4 * h4 + k] = bb[k] + w0[k] * x2 + w1[k] * x1 + w2[k] * x0;
            }
        }
#pragma unroll
        for (int k = 0; k < 8; ++k) { t[k] = __builtin_amdgcn_rcpf(fabsf(cv[k]) * 0.2316418882f + 1.0f); e[k] = ex2(cv[k] * cv[k] * (-0.72134752044f)); }
        asm volatile("s_nop 15\n\ts_nop 15" : "+v"(t[0]), "+v"(t[1]), "+v"(t[2]), "+v"(t[3]), "+v"(t[4]), "+v"(t[5]), "+v"(t[6]), "+v"(t[7]));
        asm volatile("s_nop 3" : "+v"(e[0]), "+v"(e[1]), "+v"(e[2]), "+v"(e[3]), "+v"(e[4]), "+v"(e[5]), "+v"(e[6]), "+v"(e[7]));
        unsigned o[4];
#pragma unroll
        for (int j = 0; j < 4; ++j) {
            float rr[2];
#pragma unroll
            for (int hl = 0; hl < 2; ++hl) {
                const int k = 2 * j + hl;
                float q = t[k] * 0.5307027145f + (-0.7265760135f); q = q * t[k] + 0.7107068705f; q = q * t[k] + (-0.142248368f); q = q * t[k] + 0.127414796f; q = q * t[k];
                const float m = cv[k] * (q * e[k]);
                const float gl = cv[k] < 0.f ? m : cv[k] - m;
                rr[hl] = gl * (hl ? bfhi(ag[j]) : bflo(ag[j]));
            }
            o[j] = pack2(rr[0], rr[1]);
        }
        *(uint4*)(p.act + (size_t)row * DFF + c8) = make_uint4(o[0], o[1], o[2], o[3]);
    }
}

template <int MODE>
DI void naive_attn(const Params& p, int item) {
    constexpr int D = MODE == 0 ? 64 : 128;
    constexpr int DV = MODE == 2 ? 256 : 128;
    constexpr int SW = DV / 4;
    constexpr int NH = MODE == 0 ? 8 : 4;
    const int tid = otid(), lane = tid & 63;
    const int sl = __builtin_amdgcn_readfirstlane(tid >> 6);
    const int qblk = 127 - (item % 128), hh = (item / 128) % NH, b = item / (128 * NH);
    const int q = qblk * 64 + lane; const size_t tq = (size_t)b * S + q;
    const bf16_t *Q, *Kp;
    if (MODE == 0) { Q = p.qa + tq * 512 + hh * 64; Kp = p.ka + (size_t)b * S * 512 + hh * 64; }
    else if (MODE == 1) { Q = p.qb + tq * 512 + hh * 128; Kp = p.kb + (size_t)b * S * 512 + hh * 128; }
    else { Q = p.cq + tq * 512 + hh * 128; Kp = p.ck + (size_t)b * S * 512 + hh * 128; }
    unsigned qp[D / 2];
#pragma unroll
    for (int i = 0; i < D / 8; ++i) { const uint4 t = ((const uint4*)Q)[i]; qp[4 * i] = t.x; qp[4 * i + 1] = t.y; qp[4 * i + 2] = t.z; qp[4 * i + 3] = t.w; }
    float acc[SW];
#pragma unroll
    for (int i = 0; i < SW; ++i) acc[i] = 0.f;
    float mx = -INFINITY, lsum = 0.f;
    const int send = (qblk + 1) * 64;
    float Fq = 0.f; const float* Fk = nullptr;
    if (MODE == 1) { Fk = p.F + (size_t)(b * 4 + hh) * S; Fq = Fk[q]; }
    float lg = 0.f;
    if (MODE == 2) lg = log2f(1.0f - exp2f(-5.0f - (float)hh));
    for (int s = 0; s < send; ++s) {
        const uint4* kr = (const uint4*)(Kp + (size_t)s * 512);
        float sc = 0.f;
#pragma unroll
        for (int i = 0; i < D / 8; ++i) {
            const uint4 kv = kr[i];
            sc += bflo(qp[4 * i]) * bflo(kv.x) + bfhi(qp[4 * i]) * bfhi(kv.x);
            sc += bflo(qp[4 * i + 1]) * bflo(kv.y) + bfhi(qp[4 * i + 1]) * bfhi(kv.y);
            sc += bflo(qp[4 * i + 2]) * bflo(kv.z) + bfhi(qp[4 * i + 2]) * bfhi(kv.z);
            sc += bflo(qp[4 * i + 3]) * bflo(kv.w) + bfhi(qp[4 * i + 3]) * bfhi(kv.w);
            if ((i & 3) == 3) asm volatile("" ::: "memory");
        }
        float w, corr = 1.f;
        if (MODE == 2) {
            w = (s <= q) ? sc * exp2f((float)(q - s) * lg) : 0.f;
        } else {
            if (MODE == 1) sc += Fq - Fk[s];
            const bool valid = (MODE == 0) || (s <= q);
            if (valid) {
                const float mn = fmaxf(mx, sc);
                corr = exp2f(mx - mn); w = exp2f(sc - mn); mx = mn;
                lsum = lsum * corr + w;
            } else { w = 0.f; }
        }
        if (MODE == 2) {
            const uint4* vr = (const uint4*)(p.cv + ((size_t)b * S + s) * 1024 + hh * 256 + sl * SW);
#pragma unroll
            for (int i = 0; i < SW / 8; ++i) {
                const uint4 vv = vr[i];
                acc[8 * i] += w * bflo(vv.x); acc[8 * i + 1] += w * bfhi(vv.x); acc[8 * i + 2] += w * bflo(vv.y); acc[8 * i + 3] += w * bfhi(vv.y);
                acc[8 * i + 4] += w * bflo(vv.z); acc[8 * i + 5] += w * bfhi(vv.z); acc[8 * i + 6] += w * bflo(vv.w); acc[8 * i + 7] += w * bfhi(vv.w);
            }
        } else {
            const bf16_t* vt = (MODE == 0 ? p.vta + ((size_t)(b * 4 + (hh >> 1)) * 128 + sl * SW) * S : p.vtb + ((size_t)(b * 4 + hh) * 128 + sl * SW) * S) + s;
#pragma unroll
            for (int i = 0; i < SW; ++i) { acc[i] = acc[i] * corr + w * bf2f(*vt); vt += S; asm volatile("" : "+v"(vt)); }
        }
    }
    if (MODE == 2) {
        float* o = p.oc + tq * 1024 + hh * 256 + sl * SW;
#pragma unroll
        for (int i = 0; i < SW / 4; ++i) *(f32x4*)(o + 4 * i) = (f32x4){acc[4 * i], acc[4 * i + 1], acc[4 * i + 2], acc[4 * i + 3]};
    } else {
        const float inv = 1.f / lsum;
        bf16_t* o = (MODE == 0 ? p.oa + tq * 1024 + hh * 128 : p.yb + tq * 512 + hh * 128) + sl * SW;
#pragma unroll
        for (int i = 0; i < SW / 8; ++i) {
            uint4 w4; w4.x = pack2(acc[8 * i] * inv, acc[8 * i + 1] * inv); w4.y = pack2(acc[8 * i + 2] * inv, acc[8 * i + 3] * inv);
            w4.z = pack2(acc[8 * i + 4] * inv, acc[8 * i + 5] * inv); w4.w = pack2(acc[8 * i + 6] * inv, acc[8 * i + 7] * inv);
            ((uint4*)o)[i] = w4;
        }
    }
}


typedef float f32x16 __attribute__((ext_vector_type(16)));
DI bf16x8 pack8(float a0, float a1, float a2, float a3, float a4, float a5, float a6, float a7) {
    typedef unsigned u32x4 __attribute__((ext_vector_type(4)));
    u32x4 w; w[0] = pack2(a0, a1); w[1] = pack2(a2, a3); w[2] = pack2(a4, a5); w[3] = pack2(a6, a7);
    return __builtin_bit_cast(bf16x8, w);
}

template <int MODE>
DI void flash_item(const Params& p, int b, int hh, int qi, unsigned char* smem) {
    constexpr int D = MODE == 0 ? 64 : 128, KST = D + 8, VST = 68, KS = D / 16;
    constexpr int KBYTES = 64 * KST * 2, VBYTES = 128 * VST * 2, BUFB = KBYTES + VBYTES + 256;
    constexpr int NKC = D / 32, CPR = D / 8;
    const int tid = otid(), lane = tid & 63, w = tid >> 6, r = lane & 31, hf = lane >> 5;
    const int q0 = qi * 128 + w * 32;
    const size_t tq = (size_t)b * S + q0 + r;
    bf16x8 qf[KS];
    {
        const bf16_t* qptr = (MODE == 0 ? p.qa + tq * 512 + hh * 64 : p.qb + tq * 512 + hh * 128) + hf * 8;
#pragma unroll
        for (int ks = 0; ks < KS; ++ks) qf[ks] = *(const bf16x8*)(qptr + ks * 16);
    }
    const float* fbase = p.F + (size_t)(b * 4 + (MODE == 1 ? hh : 0)) * S;
    float Fq = 0.f; if (MODE == 1) Fq = fbase[q0 + r];
    const bf16_t* kbase = MODE == 0 ? p.ka + (size_t)b * S * 512 + hh * 64 : p.kb + (size_t)b * S * 512 + hh * 128;
    const bf16_t* vbase = MODE == 0 ? p.vta + (size_t)(b * 4 + (hh >> 1)) * 128 * S : p.vtb + (size_t)(b * 4 + hh) * 128 * S;
    const int ntiles = 2 * qi + 2, wlast = 2 * qi + (w >> 1);
    uint4 kr[NKC], vr[4]; f32x4 frg = {0.f, 0.f, 0.f, 0.f};
#define FL_GLOAD(j) do { \
        _Pragma("unroll") for (int i_ = 0; i_ < NKC; ++i_) { const int c_ = tid + 256 * i_; kr[i_] = *(const uint4*)(kbase + (size_t)(64 * (j) + c_ / CPR) * 512 + (c_ % CPR) * 8); } \
        _Pragma("unroll") for (int i_ = 0; i_ < 4; ++i_) { const int c_ = tid + 256 * i_; vr[i_] = *(const uint4*)(vbase + (size_t)(c_ >> 3) * S + 64 * (j) + (c_ & 7) * 8); } \
        if (MODE == 1 && tid < 16) frg = *(const f32x4*)(fbase + 64 * (j) + tid * 4); } while (0)
#define FL_SSTORE(buf) do { unsigned char* B_ = smem + (buf) * BUFB; \
        _Pragma("unroll") for (int i_ = 0; i_ < NKC; ++i_) { const int c_ = tid + 256 * i_; *(uint4*)(B_ + ((c_ / CPR) * KST + (c_ % CPR) * 8) * 2) = kr[i_]; } \
        _Pragma("unroll") for (int i_ = 0; i_ < 4; ++i_) { const int c_ = tid + 256 * i_; uint2* d_ = (uint2*)(B_ + KBYTES + ((c_ >> 3) * VST + (c_ & 7) * 8) * 2); d_[0] = make_uint2(vr[i_].x, vr[i_].y); d_[1] = make_uint2(vr[i_].z, vr[i_].w); } \
        if (MODE == 1 && tid < 16) *(f32x4*)(B_ + KBYTES + VBYTES + tid * 16) = frg; } while (0)
    FL_GLOAD(MODE == 1 ? ntiles - 1 : 0);
    FL_SSTORE(0);
    LDS_BARRIER();
    f32x16 acc[4];
#pragma unroll
    for (int eb = 0; eb < 4; ++eb)
#pragma unroll
        for (int i = 0; i < 16; ++i) acc[eb][i] = 0.f;
    float mrun = -INFINITY, lsum = 0.f;
    for (int it = 0; it < ntiles; ++it) {
        const int j = MODE == 1 ? ntiles - 1 - it : it;
        const bool more = it + 1 < ntiles;
        if (more) FL_GLOAD(MODE == 1 ? j - 1 : j + 1);
        if (j <= wlast) {
            const unsigned char* B = smem + (it & 1) * BUFB;
            f32x16 st[2];
#pragma unroll
            for (int kb = 0; kb < 2; ++kb) {
#pragma unroll
                for (int i = 0; i < 16; ++i) st[kb][i] = 0.f;
#pragma unroll
                for (int ks = 0; ks < KS; ++ks) {
                    const bf16x8 a = *(const bf16x8*)(B + ((kb * 32 + r) * KST + ks * 16 + hf * 8) * 2);
                    st[kb] = __builtin_amdgcn_mfma_f32_32x32x16_bf16(a, qf[ks], st[kb], 0, 0, 0);
                }
            }
            if (MODE == 1) {
                const float* Fl = (const float*)(B + KBYTES + VBYTES);
#pragma unroll
                for (int kb = 0; kb < 2; ++kb)
#pragma unroll
                    for (int g = 0; g < 4; ++g) {
                        const f32x4 fk = *(const f32x4*)(Fl + kb * 32 + 8 * g + 4 * hf);
#pragma unroll
                        for (int jj = 0; jj < 4; ++jj) st[kb][4 * g + jj] += Fq - fk[jj];
                    }
                if (j >= 2 * qi) {
                    const int qabs = q0 + r;
#pragma unroll
                    for (int kb = 0; kb < 2; ++kb)
#pragma unroll
                        for (int g = 0; g < 4; ++g)
#pragma unroll
                            for (int jj = 0; jj < 4; ++jj) { const int key = 64 * j + kb * 32 + 8 * g + 4 * hf + jj; if (key > qabs) st[kb][4 * g + jj] = -INFINITY; }
                }
            }
            float mt = st[0][0];
#pragma unroll
            for (int i = 1; i < 16; ++i) mt = fmaxf(mt, st[0][i]);
#pragma unroll
            for (int i = 0; i < 16; ++i) mt = fmaxf(mt, st[1][i]);
            mt = fmaxf(mt, __shfl_xor(mt, 32));
            if (!(MODE == 1 && __all(mt < mrun - 40.0f))) {
            const float mn = fmaxf(mrun, mt);
            const float corr = ex2(mrun - mn);
            mrun = mn; lsum *= corr;
#pragma unroll
            for (int kb = 0; kb < 2; ++kb)
#pragma unroll
                for (int i = 0; i < 16; ++i) { const float pv = ex2(st[kb][i] - mn); st[kb][i] = pv; lsum += pv; }
#pragma unroll
            for (int eb = 0; eb < 4; ++eb) acc[eb] *= corr;
#pragma unroll
            for (int kb = 0; kb < 2; ++kb)
#pragma unroll
                for (int s2 = 0; s2 < 2; ++s2) {
                    const bf16x8 pf = pack8(st[kb][8 * s2], st[kb][8 * s2 + 1], st[kb][8 * s2 + 2], st[kb][8 * s2 + 3], st[kb][8 * s2 + 4], st[kb][8 * s2 + 5], st[kb][8 * s2 + 6], st[kb][8 * s2 + 7]);
#pragma unroll
                    for (int eb = 0; eb < 4; ++eb) {
                        const unsigned char* vp = B + KBYTES + ((eb * 32 + r) * VST + kb * 32 + 16 * s2 + 4 * hf) * 2;
                        const uint2 lo = *(const uint2*)vp, hi = *(const uint2*)(vp + 16);
                        typedef unsigned u32x4 __attribute__((ext_vector_type(4)));
                        u32x4 av; av[0] = lo.x; av[1] = lo.y; av[2] = hi.x; av[3] = hi.y;
                        acc[eb] = __builtin_amdgcn_mfma_f32_32x32x16_bf16(__builtin_bit_cast(bf16x8, av), pf, acc[eb], 0, 0, 0);
                    }
                }
            }
        }
        if (more) FL_SSTORE((it + 1) & 1);
        LDS_BARRIER();
    }
#undef FL_GLOAD
#undef FL_SSTORE
    const float inv = 1.f / (lsum + __shfl_xor(lsum, 32));
    bf16_t* o = MODE == 0 ? p.oa + tq * 1024 + hh * 128 : p.yb + tq * 512 + hh * 128;
#pragma unroll
    for (int eb = 0; eb < 4; ++eb)
#pragma unroll
        for (int g = 0; g < 4; ++g) {
            f32x4 v = {acc[eb][4 * g] * inv, acc[eb][4 * g + 1] * inv, acc[eb][4 * g + 2] * inv, acc[eb][4 * g + 3] * inv};
            st4(o + eb * 32 + 8 * g + 4 * hf, v);
        }
}


DI void ret_state_item(const Params& p, int item) {
    const int n = item & 127, bh = item >> 7;
    const int tid = otid(), lane = tid & 63, w = tid >> 6, r = lane & 31, hf = lane >> 5;
    const bf16_t* kt = p.ckT + (size_t)bh * 128 * S + n * 64 + hf * 8;
    const bf16_t* vt = p.cv + ((size_t)bh * 256 + w * 64) * S + n * 64 + hf * 8;
    f32x16 acc[4][2];
#pragma unroll
    for (int a = 0; a < 4; ++a)
#pragma unroll
        for (int c = 0; c < 2; ++c)
#pragma unroll
            for (int i = 0; i < 16; ++i) acc[a][c][i] = 0.f;
#pragma unroll
    for (int s4 = 0; s4 < 4; ++s4) {
        bf16x8 af[4], bfr[2];
#pragma unroll
        for (int a = 0; a < 4; ++a) af[a] = *(const bf16x8*)(kt + (size_t)(a * 32 + r) * S + s4 * 16);
#pragma unroll
        for (int c = 0; c < 2; ++c) bfr[c] = *(const bf16x8*)(vt + (size_t)(c * 32 + r) * S + s4 * 16);
#pragma unroll
        for (int a = 0; a < 4; ++a)
#pragma unroll
            for (int c = 0; c < 2; ++c) acc[a][c] = __builtin_amdgcn_mfma_f32_32x32x16_bf16(af[a], bfr[c], acc[a][c], 0, 0, 0);
    }
    bf16_t* o = p.kv + ((size_t)(bh * 128 + n) * 256 + w * 64) * 128;
#pragma unroll
    for (int a = 0; a < 4; ++a)
#pragma unroll
        for (int c = 0; c < 2; ++c)
#pragma unroll
            for (int g = 0; g < 4; ++g) {
                f32x4 v = {acc[a][c][4 * g], acc[a][c][4 * g + 1], acc[a][c][4 * g + 2], acc[a][c][4 * g + 3]};
                st4_wt(o + (size_t)(c * 32 + r) * 128 + a * 32 + 8 * g + 4 * hf, v);
            }
}

DI void ret_scan(const Params& p) {
    const int gtid = obid() * 256 + otid(), gsz = gridDim.x * 256;
    for (int e = gtid; e < 8 * 8192; e += gsz) {
        const int bh = e >> 13, pi = e & 8191, hd = bh & 3;
        const float dec = ex2(64.0f * lg2gamma(hd));
        unsigned long long* ptr = (unsigned long long*)p.kv + (size_t)bh * 128 * 8192 + pi;
        float c0 = 0.f, c1 = 0.f, c2 = 0.f, c3 = 0.f;
        for (int n0 = 0; n0 < 128; n0 += 8) {
            unsigned long long v[8];
#pragma unroll
            for (int k = 0; k < 8; ++k) v[k] = ptr[(size_t)(n0 + k) * 8192];
            asm volatile("s_waitcnt vmcnt(0)" ::: "memory");
#pragma unroll
            for (int k = 0; k < 8; ++k) {
                const unsigned long long o = (unsigned long long)pack2(c0, c1) | ((unsigned long long)pack2(c2, c3) << 32);
                __hip_atomic_store(ptr + (size_t)(n0 + k) * 8192, o, __ATOMIC_RELAXED, __HIP_MEMORY_SCOPE_AGENT);
                const unsigned lo = (unsigned)v[k], hi = (unsigned)(v[k] >> 32);
                c0 = c0 * dec + bflo(lo); c1 = c1 * dec + bfhi(lo); c2 = c2 * dec + bflo(hi); c3 = c3 * dec + bfhi(hi);
            }
        }
    }
}

DI void ret_out_item(const Params& p, int l, int item, unsigned char* smem) {
    const int n = item & 127, bh = item >> 7, b = bh >> 2, hd = bh & 3;
    const int tid = otid(), lane = tid & 63, w = tid >> 6, r = lane & 31, hf = lane >> 5;
    const size_t t0 = (size_t)b * S + n * 64;
    f32x16 acc[2][2];
#pragma unroll
    for (int a = 0; a < 2; ++a)
#pragma unroll
        for (int c = 0; c < 2; ++c)
#pragma unroll
            for (int i = 0; i < 16; ++i) acc[a][c][i] = 0.f;
    bf16x8 pf[2][2][2];
    typedef unsigned u32x4 __attribute__((ext_vector_type(4)));
    bf16x8 qf[2][8], rf[2][8];
    uint2 vlo[2][2][2], vhi[2][2][2];
    {
        const bf16_t* rt = p.kv + ((size_t)(bh * 128 + n) * 256 + w * 64) * 128 + hf * 8;
#pragma unroll
        for (int qb = 0; qb < 2; ++qb)
#pragma unroll
            for (int ks = 0; ks < 8; ++ks) qf[qb][ks] = *(const bf16x8*)(p.cq + (t0 + qb * 32 + r) * 512 + hd * 128 + ks * 16 + hf * 8);
#pragma unroll
        for (int dvb = 0; dvb < 2; ++dvb)
#pragma unroll
            for (int ks = 0; ks < 8; ++ks) rf[dvb][ks] = *(const bf16x8*)(rt + (size_t)(dvb * 32 + r) * 128 + ks * 16);
    }
    __builtin_amdgcn_sched_barrier(0);
#pragma unroll
    for (int dvb = 0; dvb < 2; ++dvb)
#pragma unroll
        for (int ks = 0; ks < 8; ++ks)
#pragma unroll
            for (int qb = 0; qb < 2; ++qb) acc[dvb][qb] = __builtin_amdgcn_mfma_f32_32x32x16_bf16(rf[dvb][ks], qf[qb][ks], acc[dvb][qb], 0, 0, 0);
#pragma unroll
    for (int kb = 0; kb < 2; ++kb)
#pragma unroll
        for (int ks = 0; ks < 8; ++ks) rf[kb][ks] = *(const bf16x8*)(p.ck + (t0 + kb * 32 + r) * 512 + hd * 128 + ks * 16 + hf * 8);
    __builtin_amdgcn_sched_barrier(0);
#pragma unroll
    for (int kb = 0; kb < 2; ++kb) {
        f32x16 st[2];
#pragma unroll
        for (int qb = 0; qb < 2; ++qb)
#pragma unroll
            for (int i = 0; i < 16; ++i) st[qb][i] = 0.f;
#pragma unroll
        for (int ks = 0; ks < 8; ++ks)
#pragma unroll
            for (int qb = 0; qb < 2; ++qb) st[qb] = __builtin_amdgcn_mfma_f32_32x32x16_bf16(rf[kb][ks], qf[qb][ks], st[qb], 0, 0, 0);
#pragma unroll
        for (int qb = 0; qb < 2; ++qb) {
#pragma unroll
            for (int i = 0; i < 16; ++i) { const int key = kb * 32 + (i & 3) + 8 * (i >> 2) + 4 * hf; if (key > qb * 32 + r) st[qb][i] = 0.f; }
#pragma unroll
            for (int s2 = 0; s2 < 2; ++s2)
                pf[kb][s2][qb] = pack8(st[qb][8 * s2], st[qb][8 * s2 + 1], st[qb][8 * s2 + 2], st[qb][8 * s2 + 3], st[qb][8 * s2 + 4], st[qb][8 * s2 + 5], st[qb][8 * s2 + 6], st[qb][8 * s2 + 7]);
        }
    }
    {
        const bf16_t* vt = p.cv + ((size_t)bh * 256 + w * 64) * S + n * 64 + 4 * hf;
#pragma unroll
        for (int dvb = 0; dvb < 2; ++dvb)
#pragma unroll
            for (int kb = 0; kb < 2; ++kb)
#pragma unroll
                for (int s2 = 0; s2 < 2; ++s2) {
                    const bf16_t* vp = vt + (size_t)(dvb * 32 + r) * S + kb * 32 + 16 * s2;
                    vlo[dvb][kb][s2] = *(const uint2*)vp; vhi[dvb][kb][s2] = *(const uint2*)(vp + 8);
                }
    }
    __builtin_amdgcn_sched_barrier(0);
#pragma unroll
    for (int dvb = 0; dvb < 2; ++dvb)
#pragma unroll
        for (int kb = 0; kb < 2; ++kb)
#pragma unroll
            for (int s2 = 0; s2 < 2; ++s2) {
                u32x4 av; av[0] = vlo[dvb][kb][s2].x; av[1] = vlo[dvb][kb][s2].y; av[2] = vhi[dvb][kb][s2].x; av[3] = vhi[dvb][kb][s2].y;
                const bf16x8 a = __builtin_bit_cast(bf16x8, av);
#pragma unroll
                for (int qb = 0; qb < 2; ++qb) acc[dvb][qb] = __builtin_amdgcn_mfma_f32_32x32x16_bf16(a, pf[kb][s2][qb], acc[dvb][qb], 0, 0, 0);
            }
    float* red = (float*)smem;
    float mu[2], rstd[2];
    __syncthreads();
#pragma unroll
    for (int qb = 0; qb < 2; ++qb) {
        float s1 = 0.f, s2 = 0.f;
#pragma unroll
        for (int dvb = 0; dvb < 2; ++dvb)
#pragma unroll
            for (int i = 0; i < 16; ++i) { const float x = acc[dvb][qb][i]; s1 += x; s2 += x * x; }
        s1 += __shfl_xor(s1, 32); s2 += __shfl_xor(s2, 32);
        if (hf == 0) { red[(w * 64 + qb * 32 + r) * 2] = s1; red[(w * 64 + qb * 32 + r) * 2 + 1] = s2; }
    }
    __syncthreads();
#pragma unroll
    for (int qb = 0; qb < 2; ++qb) {
        float s1 = 0.f, s2 = 0.f;
#pragma unroll
        for (int ww = 0; ww < 4; ++ww) { s1 += red[(ww * 64 + qb * 32 + r) * 2]; s2 += red[(ww * 64 + qb * 32 + r) * 2 + 1]; }
        const float m_ = s1 * (1.f / 256.f);
        mu[qb] = m_; rstd[qb] = rsqrtf(fmaxf(s2 * (1.f / 256.f) - m_ * m_, 0.f) + LN_EPS);
    }
    const float* gr = p.g_ret + (size_t)l * 1024 + hd * 256 + w * 64;
#pragma unroll
    for (int dvb = 0; dvb < 2; ++dvb)
#pragma unroll
        for (int g = 0; g < 4; ++g) {
            const int dv = dvb * 32 + 8 * g + 4 * hf;
            const f32x4 gg = *(const f32x4*)(gr + dv);
#pragma unroll
            for (int qb = 0; qb < 2; ++qb) {
                const size_t off = (t0 + qb * 32 + r) * 1024 + hd * 256 + w * 64 + dv;
                const uint2 cgv = *(const uint2*)(p.cg + off);
                f32x4 y;
#pragma unroll
                for (int jj = 0; jj < 4; ++jj) y[jj] = (acc[dvb][qb][4 * g + jj] - mu[qb]) * rstd[qb] * gg[jj];
                y[0] *= bflo(cgv.x); y[1] *= bfhi(cgv.x); y[2] *= bflo(cgv.y); y[3] *= bfhi(cgv.y);
                st4(p.yc + off, y);
            }
        }
}

DI void phase_mixers(const Params& p, int l, unsigned char* smem) {
    const int nF = 64 * 24, nC = 2 * 4 * 128;
    int* sitem = (int*)(smem + SMEM_BYTES - 16);
    for (;;) {
        __syncthreads();
        if (otid() == 0) *sitem = (int)atomicAdd(p.ctr + l, 1u);
        __syncthreads();
        const int it = *sitem;
        if (it >= nF + nC) break;
        if (it < nF) {
            const int qi = 63 - it / 24, r = it % 24;
            if (r < 8) flash_item<1>(p, r >> 2, r & 3, qi, smem);
            else flash_item<0>(p, (r - 8) >> 3, (r - 8) & 7, qi, smem);
        } else ret_state_item(p, it - nF);
    }
}

DI void phase_mixers_naive(const Params& p) {
    const int nA = 2 * 8 * 128, nB = 2 * 4 * 128, nC = 2 * 4 * 128;
    for (int it = obid(); it < nA + nB + nC; it += gridDim.x) {
        if (it < nB) naive_attn<1>(p, it);
        else if (it < nB + nC) naive_attn<2>(p, it - nB);
        else naive_attn<0>(p, it - nB - nC);
    }
}

DI void phase_post(const Params& p, int l) {
    const int lane = otid() & 63, wv = otid() >> 6;
    const float lam = p.lamv[2 * l], li = p.lamv[2 * l + 1];
    const float* gd = p.g_diff + (size_t)l * 512; const float* gr = p.g_ret + (size_t)l * 1024;
    for (int row = obid() * 4 + wv; row < T; row += gridDim.x * 4) {
#pragma unroll
        for (int hh = 0; hh < 4; ++hh) {
            const unsigned o0 = *(const unsigned*)(p.oa + (size_t)row * 1024 + (2 * hh) * 128 + lane * 2);
            const unsigned o1 = *(const unsigned*)(p.oa + (size_t)row * 1024 + (2 * hh + 1) * 128 + lane * 2);
            const float d0 = bflo(o0) - lam * bflo(o1), d1 = bfhi(o0) - lam * bfhi(o1);
            float ss = d0 * d0 + d1 * d1;
            for (int o = 32; o; o >>= 1) ss += __shfl_xor(ss, o);
            const float r = rsqrtf(ss * (1.f / 128.f) + LN_EPS) * (1.f - li);
            const int c = hh * 128 + lane * 2;
            *(unsigned*)(p.ya + (size_t)row * 512 + c) = pack2(d0 * r * gd[c], d1 * r * gd[c + 1]);
        }
    }
}

DI void grid_bar(unsigned* bar, unsigned& epoch) {
    asm volatile("s_waitcnt vmcnt(0) lgkmcnt(0)" ::: "memory");
    __syncthreads();
    epoch += 1;
    const int tid = otid();
    unsigned* go = bar;
    unsigned* flags = bar + 32;
    if (tid == 0) {
        __builtin_amdgcn_fence(__ATOMIC_RELEASE, "agent");
        asm volatile("s_waitcnt vmcnt(0)" ::: "memory");
        __hip_atomic_store(flags + 32 * obid(), epoch, __ATOMIC_RELAXED, __HIP_MEMORY_SCOPE_AGENT);
    }
    if (obid() == 0 && tid < 64) {
        const int nb = gridDim.x;
        for (int base = 0; base < nb; base += 64) {
            const int idx = base + tid;
            if (idx < nb) while (__hip_atomic_load(flags + 32 * idx, __ATOMIC_RELAXED, __HIP_MEMORY_SCOPE_AGENT) < epoch) __builtin_amdgcn_s_sleep(1);
        }
        asm volatile("s_waitcnt vmcnt(0)" ::: "memory");
        if (tid == 0) __hip_atomic_store(go, epoch, __ATOMIC_RELAXED, __HIP_MEMORY_SCOPE_AGENT);
    }
    if (tid == 0) {
        while (__hip_atomic_load(go, __ATOMIC_RELAXED, __HIP_MEMORY_SCOPE_AGENT) < epoch) __builtin_amdgcn_s_sleep(1);
        __builtin_amdgcn_fence(__ATOMIC_ACQUIRE, "agent");
        asm volatile("s_waitcnt vmcnt(0)" ::: "memory");
    }
    __syncthreads();
}
#define GSYNC() grid_bar(p.bar, epoch)
__global__ void __launch_bounds__(256, 2) fwd_kernel(Params p) {
    __shared__ __attribute__((aligned(16))) unsigned char smem[SMEM_BYTES];
    cg::grid_group grid = cg::this_grid();
    bf16_t* sm = (bf16_t*)smem; float* smf = (float*)smem;

    unsigned epoch = 0;
    asm volatile("s_waitcnt vmcnt(0) lgkmcnt(0)" ::: "memory"); grid.sync();
    convert_layer(p, 0, smf);
    phase0_misc(p, smf);
    GSYNC();
    row_phase(p, p.x, false, nullptr, nullptr, nullptr, p.mod, 0, 1024, true, true);
    GSYNC();
    for (int l = 0; l < DEPTH; ++l) {
        const float* modl = p.mod + (size_t)l * 2 * 6144;
        const float* xcur = l == 0 ? p.x : p.xbuf;
        if (obid() >= gridDim.x - 8) scan_item(p, obid() - (gridDim.x - 8), smf);
        phase_inproj(p, sm);
        GSYNC();
        phase_mixers(p, l, smem);
        GSYNC();
        phase_post(p, l);
        ret_scan(p);
        GSYNC();
        for (int it = obid(); it < 1024; it += gridDim.x) ret_out_item(p, l, it, smem);
        GSYNC();
        phase_branch(p, sm);
        GSYNC();
        phase_gemm_res(p, p.h, 1024, p.WoutT, xcur, modl, 2048, sm);
        GSYNC();
        row_phase(p, p.vbuf, true, p.ln_g + (size_t)(l * 2) * Dm, p.ln_b + (size_t)(l * 2) * Dm, p.xbuf, modl, 3072, 4096, true, false);
        GSYNC();
        phase_up(p, sm);
        GSYNC();
        phase_conv(p, l);
        GSYNC();
        phase_gemm_res(p, p.act, DFF, p.WdownT, p.xbuf, modl, 5120, sm);
        GSYNC();
        if (l + 1 < DEPTH) {
            convert_layer(p, l + 1, smf);
            GSYNC();
            row_phase(p, p.vbuf, true, p.ln_g + (size_t)(l * 2 + 1) * Dm, p.ln_b + (size_t)(l * 2 + 1) * Dm, p.xbuf, modl + 2 * 6144, 0, 1024, true, true);
            GSYNC();
        } else {
            row_phase(p, p.vbuf, true, p.ln_g + (size_t)(l * 2 + 1) * Dm, p.ln_b + (size_t)(l * 2 + 1) * Dm, p.out, modl, 0, 1024, false, false);
        }
    }
}

extern "C" void kernel_launch(void* const* d_in, const int* in_sizes, int n_in, void* d_out, int out_size, void* d_ws, size_t ws_size, hipStream_t stream) {
    static int grid_blocks = 0;
    if (!grid_blocks) {
        int dev = 0, cus = 0, per_cu = 0;
        hipGetDevice(&dev);
        hipDeviceGetAttribute(&cus, hipDeviceAttributeMultiprocessorCount, dev);
        hipOccupancyMaxActiveBlocksPerMultiprocessor(&per_cu, fwd_kernel, 256, 0);
        if (per_cu > 2) per_cu = 2;
        if (per_cu < 1) per_cu = 1;
        grid_blocks = cus * per_cu;
    }
    Params p{};
    const float** ins = (const float**)&p.x;
    for (int i = 0; i < 22; ++i) ins[i] = (const float*)d_in[i];
    p.out = (float*)d_out;
    char* w = (char*)d_ws; size_t off = 0;
    auto take = [&](size_t bytes) { char* r = w + off; off += (bytes + 255) & ~(size_t)255; return r; };
    const size_t MB = 1u << 20;
    p.mod = (float*)take((size_t)DEPTH * 2 * 6144 * 4);
    p.lamv = (float*)take(256);
    p.ctr = (unsigned*)take(256);
    p.bar = (unsigned*)take((size_t)(1 + 1024) * 128);
    p.wf = (float*)take(4100 * 4);
    p.binp = (float*)take(NIN * 4);
    p.cstab = (float*)take((size_t)S * 64 * 2 * 4);
    p.logf = (float*)take((size_t)T * 4 * 4);
    p.F = (float*)take((size_t)T * 4 * 4);
    p.WinT = (bf16_t*)take((size_t)NIN * 1024 * 2);
    p.WpaT = (bf16_t*)take((size_t)1024 * 512 * 2);
    p.WpbT = (bf16_t*)take((size_t)1024 * 512 * 2);
    p.WpcT = (bf16_t*)take((size_t)1024 * 1024 * 2);
    p.WoutT = (bf16_t*)take((size_t)1024 * 1024 * 2);
    p.WupT = (bf16_t*)take((size_t)2 * DFF * 1024 * 2);
    p.WdownT = (bf16_t*)take((size_t)1024 * DFF * 2);
    p.xbuf = (float*)take((size_t)T * Dm * 4);
    p.h = (bf16_t*)take((size_t)T * Dm * 2);
    const size_t offA = off;
    p.qa = (bf16_t*)take((size_t)T * 512 * 2); p.ka = (bf16_t*)take((size_t)T * 512 * 2); p.vta = (bf16_t*)take((size_t)T * 512 * 2);
    p.qb = (bf16_t*)take((size_t)T * 512 * 2); p.kb = (bf16_t*)take((size_t)T * 512 * 2); p.vtb = (bf16_t*)take((size_t)T * 512 * 2);
    p.cq = (bf16_t*)take((size_t)T * 512 * 2); p.ck = (bf16_t*)take((size_t)T * 512 * 2);
    p.cv = (bf16_t*)take((size_t)T * 1024 * 2); p.cg = (bf16_t*)take((size_t)T * 1024 * 2);
    p.gates = (bf16_t*)take((size_t)T * 3072 * 2);
    const size_t endA = off;
    p.ug = (bf16_t*)(w + offA);
    p.act = (bf16_t*)(w + offA + (size_t)T * 2 * DFF * 2);
    const size_t offB = endA;
    off = offB;
    p.vbuf = (float*)(w + offB);
    p.oa = p.h;
    p.yb = (bf16_t*)take((size_t)T * 512 * 2);
    p.kv = (bf16_t*)take((size_t)8 * 128 * 256 * 128 * 2);
    p.ckT = (bf16_t*)take((size_t)T * 512 * 2);
    p.ya = (bf16_t*)take((size_t)T * 512 * 2);
    p.yc = (bf16_t*)take((size_t)T * 1024 * 2);
    if (off > ws_size || (size_t)T * 2 * DFF * 2 + (size_t)T * DFF * 2 > endA - offA) {
        fprintf(stderr, "kernel_launch: workspace too small: need %zu MB have %zu MB\n", off / MB, ws_size / MB);
        return;
    }
    (void)hipMemsetAsync(p.bar, 0, (size_t)(1 + 1024) * 128, stream);
    void* args[] = {&p};
    hipError_t e = hipLaunchCooperativeKernel((void*)fwd_kernel, dim3(grid_blocks), dim3(256), args, 0, stream);
    if (e != hipSuccess) fprintf(stderr, "cooperative launch failed: %s (grid %d)\n", hipGetErrorString(e), grid_blocks);
}
```

```cpp
#include <hip/hip_runtime.h>
#include <hip/hip_cooperative_groups.h>
#include <cstdio>
#include <cstdint>
namespace cg = cooperative_groups;

typedef unsigned short bf16_t;
typedef short bf16x8 __attribute__((ext_vector_type(8)));
typedef float f32x4 __attribute__((ext_vector_type(4)));

constexpr int Dm = 1024, NB = 2, S = 8192, T = NB * S, DEPTH = 4, DFF = 2816, DIN = 9220, NIN = 9216;
constexpr float LN_EPS = 1e-5f;
constexpr float LOG2E = 1.4426950408889634f;
#define ALPHA_F 1.681792830507429f

#define DI __device__ __forceinline__
DI int otid() { int t = threadIdx.x; asm volatile("" : "+v"(t)); return t; }
DI int obid() { int b = blockIdx.x; asm volatile("" : "+s"(b)); return b; }

typedef __bf16 hbf2 __attribute__((ext_vector_type(2)));
typedef float f32x2 __attribute__((ext_vector_type(2)));
DI bf16_t f2bf(float x) { return __builtin_bit_cast(unsigned short, (__bf16)x); }
DI float bf2f(bf16_t v) { return __uint_as_float(((unsigned)v) << 16); }
DI float bflo(unsigned w) { return __uint_as_float(w << 16); }
DI float bfhi(unsigned w) { return __uint_as_float(w & 0xffff0000u); }
DI unsigned pack2(float a, float b) { f32x2 v = {a, b}; return __builtin_bit_cast(unsigned, __builtin_convertvector(v, hbf2)); }

struct Params {
    const float *x, *c, *w_ada, *b_ada, *w_in, *b_in, *lq1, *lk1, *lq2, *lk2, *g_diff, *g_ret, *w_pa, *w_pb, *w_pc, *w_out, *ln_g, *ln_b, *w_up, *w_conv, *b_conv, *w_down;
    float* out;
    unsigned* ctr; unsigned* bar; unsigned* kn;
    float *mod, *lamv, *wf, *binp, *cstab, *xbuf, *vbuf, *logf, *F, *oc;
    bf16_t *WinT, *WpaT, *WpbT, *WpcT, *WoutT, *WupT, *WdownT;
    bf16_t *h, *qa, *ka, *vta, *qb, *kb, *vtb, *cq, *ck, *cv, *cg, *gates, *oa, *yb, *ya, *yc, *ug, *act, *ckT, *kv;
};

#define LDS_BARRIER() do { asm volatile("s_waitcnt lgkmcnt(0)" ::: "memory"); __builtin_amdgcn_s_barrier(); asm volatile("" ::: "memory"); } while (0)
constexpr int BM = 128, BN = 128, BK = 64, LDP = BK + 8;
constexpr int SMEM_BYTES = 2 * (BM + BN) * LDP * 2;

DI int win_map(int n) {
    if (n < 3072) return n;
    if (n < 4096) { int r = n - 3072; int seg = r >> 9; r &= 511; int head = r >> 7; int c = r & 127; return 3076 + seg * 512 + head * 128 + (c >> 1) + 64 * (c & 1); }
    return n + 4;
}

DI void convert_tile(const float* __restrict__ src, int ldsrc, bf16_t* __restrict__ dst, int K, int tiles_n, int tile, int kind, float* lds) {
    const int tn = tile % tiles_n, tk = tile / tiles_n;
    const int tx = otid() & 63, ty = otid() >> 6;
    const int n = tn * 64 + tx;
    const int sn = kind == 1 ? win_map(n) : n;
    __syncthreads();
#pragma unroll 4
    for (int r = 0; r < 16; ++r) {
        const int kk = ty * 16 + r;
        lds[kk * 65 + tx] = src[(size_t)(tk * 64 + kk) * ldsrc + sn];
    }
    __syncthreads();
#pragma unroll 4
    for (int r = 0; r < 16; ++r) {
        const int nn = ty * 16 + r;
        dst[(size_t)(tn * 64 + nn) * K + tk * 64 + tx] = f2bf(lds[tx * 65 + nn]);
    }
}

DI void convert_layer(const Params& p, int l, float* lds) {
    const int n_in = 16 * 144, n_pa = 8 * 16, n_pb = 8 * 16, n_pc = 16 * 16, n_out = 16 * 16, n_up = 16 * 88, n_dn = 44 * 16;
    const int total = n_in + n_pa + n_pb + n_pc + n_out + n_up + n_dn;
    for (int it = obid(); it < total; it += gridDim.x) {
        int t = it;
        if (t < n_in) { convert_tile(p.w_in + (size_t)l * Dm * DIN, DIN, p.WinT, 1024, 144, t, 1, lds); continue; } t -= n_in;
        if (t < n_pa) { convert_tile(p.w_pa + (size_t)l * 512 * Dm, Dm, p.WpaT, 512, 16, t, 0, lds); continue; } t -= n_pa;
        if (t < n_pb) { convert_tile(p.w_pb + (size_t)l * 512 * Dm, Dm, p.WpbT, 512, 16, t, 0, lds); continue; } t -= n_pb;
        if (t < n_pc) { convert_tile(p.w_pc + (size_t)l * 1024 * Dm, Dm, p.WpcT, 1024, 16, t, 0, lds); continue; } t -= n_pc;
        if (t < n_out) { convert_tile(p.w_out + (size_t)l * Dm * Dm, Dm, p.WoutT, 1024, 16, t, 0, lds); continue; } t -= n_out;
        if (t < n_up) { convert_tile(p.w_up + (size_t)l * Dm * 2 * DFF, 2 * DFF, p.WupT, 1024, 88, t, 0, lds); continue; } t -= n_up;
        convert_tile(p.w_down + (size_t)l * DFF * Dm, Dm, p.WdownT, DFF, 16, t, 0, lds);
    }
    const int gtid = obid() * blockDim.x + otid(), gsz = gridDim.x * blockDim.x;
    for (int i = gtid; i < NIN; i += gsz) p.binp[i] = p.b_in[(size_t)l * DIN + win_map(i)];
    for (int i = gtid; i < 4096; i += gsz) { const int k = i >> 2, hh = i & 3; p.wf[i] = p.w_in[(size_t)l * Dm * DIN + (size_t)k * DIN + 3072 + hh]; }
    for (int i = gtid; i < 4; i += gsz) p.wf[4096 + i] = p.b_in[(size_t)l * DIN + 3072 + i];
}

DI float ex2(float x) { return __builtin_amdgcn_exp2f(x); }
DI float lg2gamma(int hd) { return hd == 0 ? -0.04580368961312479f : hd == 1 ? -0.02272007650008353f : hd == 2 ? -0.011315313227834146f : -0.005646563141142063f; }
DI float silu_f(float v) { return v / (1.f + __expf(-v)); }
DI float sigmoid_f(float v) { return 1.f / (1.f + __expf(-v)); }

DI void phase0_misc(const Params& p, float* lds) {
    for (int it = obid(); it < DEPTH * 96; it += gridDim.x) {
        const int l = it / 96, jb = it % 96;
        const int tx = otid() & 63, ks = otid() >> 6;
        const int j = jb * 64 + tx;
        const float* w = p.w_ada + (size_t)l * Dm * 6144 + j;
        float a0 = 0.f, a1 = 0.f;
#pragma unroll 8
        for (int k = ks * 256; k < ks * 256 + 256; ++k) {
            const float wv = w[(size_t)k * 6144];
            a0 += silu_f(p.c[k]) * wv; a1 += silu_f(p.c[Dm + k]) * wv;
        }
        __syncthreads();
        lds[(ks * 64 + tx) * 2] = a0; lds[(ks * 64 + tx) * 2 + 1] = a1;
        __syncthreads();
        if (ks == 0) {
            float s0 = 0.f, s1 = 0.f;
            for (int q = 0; q < 4; ++q) { s0 += lds[(q * 64 + tx) * 2]; s1 += lds[(q * 64 + tx) * 2 + 1]; }
            const float bb = p.b_ada[(size_t)l * 6144 + j];
            p.mod[((size_t)l * 2 + 0) * 6144 + j] = s0 + bb;
            p.mod[((size_t)l * 2 + 1) * 6144 + j] = s1 + bb;
        }
    }
    const int gtid = obid() * blockDim.x + otid(), gsz = gridDim.x * blockDim.x;
    if (gtid < 64) p.ctr[gtid] = 0u;
    if (obid() == 0 && otid() < 64 * DEPTH) {
        const int l = otid() >> 6, ln = otid() & 63;
        float a = p.lq1[l * 64 + ln] * p.lk1[l * 64 + ln], b = p.lq2[l * 64 + ln] * p.lk2[l * 64 + ln];
        for (int o = 32; o; o >>= 1) { a += __shfl_xor(a, o); b += __shfl_xor(b, o); }
        if (ln == 0) { const float li = 0.8f - 0.6f * expf(-0.3f * (float)l); p.lamv[2 * l] = expf(a) - expf(b) + li; p.lamv[2 * l + 1] = li; }
    }
}

DI void row_phase(const Params& p, const float* __restrict__ src, bool do_ln, const float* __restrict__ lng, const float* __restrict__ lnb,
                  float* __restrict__ xdst, const float* __restrict__ modl  , int sh_off, int sc_off, bool want_h, bool want_logf) {
    const int lane = otid() & 63, wv = otid() >> 6;
    if (want_logf && obid() == 0 && otid() < 32) p.kn[otid()] = 0u;
    for (int row = obid() * 4 + wv; row < T; row += gridDim.x * 4) {
        const int b = row / S;
        const float* sp = src + (size_t)row * Dm;
        f32x4 v[4];
#pragma unroll
        for (int i = 0; i < 4; ++i) v[i] = *(const f32x4*)(sp + i * 256 + lane * 4);
        if (do_ln) {
            float s = 0.f;
#pragma unroll
            for (int i = 0; i < 4; ++i) s += (v[i][0] + v[i][1]) + (v[i][2] + v[i][3]);
            for (int o = 32; o; o >>= 1) s += __shfl_xor(s, o);
            const float mu = s * (1.f / 1024.f);
            float q = 0.f;
#pragma unroll
            for (int i = 0; i < 4; ++i) { f32x4 d = v[i] - mu; q += (d[0] * d[0] + d[1] * d[1]) + (d[2] * d[2] + d[3] * d[3]); }
            for (int o = 32; o; o >>= 1) q += __shfl_xor(q, o);
            const float rstd = rsqrtf(q * (1.f / 1024.f) + LN_EPS);
#pragma unroll
            for (int i = 0; i < 4; ++i) {
                const f32x4 g = *(const f32x4*)(lng + i * 256 + lane * 4), bb = *(const f32x4*)(lnb + i * 256 + lane * 4);
                v[i] = (v[i] - mu) * rstd * g + bb;
            }
        }
        if (xdst) {
#pragma unroll
            for (int i = 0; i < 4; ++i) *(f32x4*)(xdst + (size_t)row * Dm + i * 256 + lane * 4) = v[i];
        }
        if (want_h) {
            const float* mb = modl + (size_t)b * 6144;
            float d0 = 0.f, d1 = 0.f, d2 = 0.f, d3 = 0.f;
#pragma unroll
            for (int i = 0; i < 4; ++i) {
                const int c0 = i * 256 + lane * 4;
                const f32x4 sc = *(const f32x4*)(mb + sc_off + c0), sh = *(const f32x4*)(mb + sh_off + c0);
                const f32x4 hv = v[i] * (1.f + sc) + sh;
                uint2 w; w.x = pack2(hv[0], hv[1]); w.y = pack2(hv[2], hv[3]);
                *(uint2*)(p.h + (size_t)row * Dm + c0) = w;
                if (want_logf) {
#pragma unroll
                    for (int j = 0; j < 4; ++j) {
                        const f32x4 wf = *(const f32x4*)(p.wf + (c0 + j) * 4);
                        d0 += hv[j] * wf[0]; d1 += hv[j] * wf[1]; d2 += hv[j] * wf[2]; d3 += hv[j] * wf[3];
                    }
                }
            }
            if (want_logf) {
                for (int o = 32; o; o >>= 1) { d0 += __shfl_xor(d0, o); d1 += __shfl_xor(d1, o); d2 += __shfl_xor(d2, o); d3 += __shfl_xor(d3, o); }
                if (lane < 4) {
                    float z = (lane == 0 ? d0 : lane == 1 ? d1 : lane == 2 ? d2 : d3) + p.wf[4096 + lane];
                    const float ls = fminf(z, 0.f) - log1pf(__expf(-fabsf(z)));
                    p.logf[(size_t)row * 4 + lane] = ls * LOG2E;
                }
            }
        }
    }
}

DI void scan_item(const Params& p, int item, float* lds) {
    const int b = item >> 2, hh = item & 3, tid = otid();
    const float* lp = p.logf + (size_t)b * S * 4 + hh;
    float loc[32]; float s = 0.f;
#pragma unroll
    for (int i = 0; i < 32; ++i) { s += lp[(size_t)(tid * 32 + i) * 4]; loc[i] = s; }
    __syncthreads();
    lds[tid] = s;
    __syncthreads();
    float pre = 0.f;
    for (int i = 0; i < tid; ++i) pre += lds[i];
    float* fp = p.F + (size_t)(b * 4 + hh) * S + tid * 32;
#pragma unroll
    for (int i = 0; i < 32; ++i) fp[i] = pre + loc[i];
    __syncthreads();
}

DI void gemm_kloop(const bf16_t* __restrict__ Ag, int lda, const bf16_t* __restrict__ Bg, int ldb, int K, f32x4 (&acc)[4][4], bf16_t* sm) {
    const int tid = otid(), lane = tid & 63, wid = tid >> 6, wr = wid >> 1, wc = wid & 1;
    bf16_t* sa = sm; bf16_t* sb = sm + 2 * BM * LDP;
    const int lrow = tid >> 3, lcc = tid & 7;
    const bf16_t* ap = Ag + (size_t)lrow * lda + lcc * 8;
    const bf16_t* bp = Bg + (size_t)lrow * ldb + lcc * 8;
    const size_t sA = (size_t)32 * lda, sB = (size_t)32 * ldb;
    uint4 ra0, ra1, ra2, ra3, rb0, rb1, rb2, rb3;
#define G_LOAD(koff) do { ra0 = *(const uint4*)(ap + (koff)); ra1 = *(const uint4*)(ap + sA + (koff)); ra2 = *(const uint4*)(ap + 2 * sA + (koff)); ra3 = *(const uint4*)(ap + 3 * sA + (koff)); \
                          rb0 = *(const uint4*)(bp + (koff)); rb1 = *(const uint4*)(bp + sB + (koff)); rb2 = *(const uint4*)(bp + 2 * sB + (koff)); rb3 = *(const uint4*)(bp + 3 * sB + (koff)); } while (0)
#define G_STORE(buf) do { bf16_t* da_ = sa + (buf) * BM * LDP + lrow * LDP + lcc * 8; bf16_t* db_ = sb + (buf) * BN * LDP + lrow * LDP + lcc * 8; \
        *(uint4*)(da_) = ra0; *(uint4*)(da_ + 32 * LDP) = ra1; *(uint4*)(da_ + 64 * LDP) = ra2; *(uint4*)(da_ + 96 * LDP) = ra3; \
        *(uint4*)(db_) = rb0; *(uint4*)(db_ + 32 * LDP) = rb1; *(uint4*)(db_ + 64 * LDP) = rb2; *(uint4*)(db_ + 96 * LDP) = rb3; } while (0)
    G_LOAD(0);
    G_STORE(0);
    LDS_BARRIER();
    const int nk = K / BK;
    const int fr = lane & 15, fq = lane >> 4;
    for (int kt = 0; kt < nk; ++kt) {
        const int cur = kt & 1;
        const bool more = kt + 1 < nk;
        if (more) G_LOAD((kt + 1) * BK);
        const bf16_t* ca = sa + cur * BM * LDP + (wr * 64 + fr) * LDP + fq * 8;
        const bf16_t* cb = sb + cur * BN * LDP + (wc * 64 + fr) * LDP + fq * 8;
#pragma unroll
        for (int kk = 0; kk < 2; ++kk) {
            bf16x8 af[4], bfr[4];
#pragma unroll
            for (int m = 0; m < 4; ++m) af[m] = *(const bf16x8*)(ca + m * 16 * LDP + kk * 32);
#pragma unroll
            for (int n = 0; n < 4; ++n) bfr[n] = *(const bf16x8*)(cb + n * 16 * LDP + kk * 32);
#pragma unroll
            for (int m = 0; m < 4; ++m)
#pragma unroll
                for (int n = 0; n < 4; ++n) acc[m][n] = __builtin_amdgcn_mfma_f32_16x16x32_bf16(bfr[n], af[m], acc[m][n], 0, 0, 0);
        }
        if (more) G_STORE(cur ^ 1);
        LDS_BARRIER();
    }
#undef G_LOAD
#undef G_STORE
}

DI void gemm_kloop2(const bf16_t* __restrict__ Ag, int lda, const bf16_t* __restrict__ Bg, int ldb, int K, f32x4 (&acc)[4][4], bf16_t* sm) {
    const int tid = otid(), lane = tid & 63, wid = tid >> 6, wr = wid >> 1, wc = wid & 1;
    bf16_t* sa = sm; bf16_t* sb = sm + 2 * BM * LDP;
    const int lrow = tid >> 3, lcc = tid & 7;
    const bf16_t* ap = Ag + (size_t)lrow * lda + lcc * 8;
    const bf16_t* bp = Bg + (size_t)lrow * ldb + lcc * 8;
    const size_t sA = (size_t)32 * lda, sB = (size_t)32 * ldb;
    uint4 xa0, xa1, xa2, xa3, xb0, xb1, xb2, xb3;
    uint4 ya0, ya1, ya2, ya3, yb0, yb1, yb2, yb3;
#define G2_LOAD(P, koff) do { P##a0 = *(const uint4*)(ap + (koff)); P##a1 = *(const uint4*)(ap + sA + (koff)); P##a2 = *(const uint4*)(ap + 2 * sA + (koff)); P##a3 = *(const uint4*)(ap + 3 * sA + (koff)); \
                              P##b0 = *(const uint4*)(bp + (koff)); P##b1 = *(const uint4*)(bp + sB + (koff)); P##b2 = *(const uint4*)(bp + 2 * sB + (koff)); P##b3 = *(const uint4*)(bp + 3 * sB + (koff)); } while (0)
#define G2_STORE(P, buf) do { bf16_t* da_ = sa + (buf) * BM * LDP + lrow * LDP + lcc * 8; bf16_t* db_ = sb + (buf) * BN * LDP + lrow * LDP + lcc * 8; \
        *(uint4*)(da_) = P##a0; *(uint4*)(da_ + 32 * LDP) = P##a1; *(uint4*)(da_ + 64 * LDP) = P##a2; *(uint4*)(da_ + 96 * LDP) = P##a3; \
        *(uint4*)(db_) = P##b0; *(uint4*)(db_ + 32 * LDP) = P##b1; *(uint4*)(db_ + 64 * LDP) = P##b2; *(uint4*)(db_ + 96 * LDP) = P##b3; } while (0)
#define G2_COMPUTE(buf) do { \
        const bf16_t* ca = sa + (buf) * BM * LDP + (wr * 64 + fr) * LDP + fq * 8; \
        const bf16_t* cb = sb + (buf) * BN * LDP + (wc * 64 + fr) * LDP + fq * 8; \
        _Pragma("unroll") for (int kk = 0; kk < 2; ++kk) { \
            bf16x8 af[4], bfr[4]; \
            _Pragma("unroll") for (int m = 0; m < 4; ++m) af[m] = *(const bf16x8*)(ca + m * 16 * LDP + kk * 32); \
            _Pragma("unroll") for (int n = 0; n < 4; ++n) bfr[n] = *(const bf16x8*)(cb + n * 16 * LDP + kk * 32); \
            _Pragma("unroll") for (int m = 0; m < 4; ++m) _Pragma("unroll") for (int n = 0; n < 4; ++n) acc[m][n] = __builtin_amdgcn_mfma_f32_16x16x32_bf16(bfr[n], af[m], acc[m][n], 0, 0, 0); \
        } } while (0)
    const int nk = K / BK;
    const int fr = lane & 15, fq = lane >> 4;
    G2_LOAD(x, 0);
    G2_LOAD(y, BK);
    G2_STORE(x, 0);
    LDS_BARRIER();
    for (int kt = 0; kt < nk; kt += 2) {
        const int kx = kt + 2 < nk ? kt + 2 : nk - 2, ky = kt + 3 < nk ? kt + 3 : nk - 1;
        G2_LOAD(x, kx * BK);
        __builtin_amdgcn_sched_barrier(0);
        G2_COMPUTE(0);
        G2_STORE(y, 1);
        LDS_BARRIER();
        G2_LOAD(y, ky * BK);
        __builtin_amdgcn_sched_barrier(0);
        G2_COMPUTE(1);
        G2_STORE(x, 0);
        LDS_BARRIER();
    }
#undef G2_LOAD
#undef G2_STORE
#undef G2_COMPUTE
}

DI void tile_coords(int tile, int nM, int nN, int& mt, int& nt) {
    const int G = gridDim.x;
    if ((G & 7) == 0 && (nM & 63) == 0 && (nM * nN) % G == 0) {
        const int b = tile % G, k = tile / G, per = G >> 3;
        const int xcd = b & 7, slot = b >> 3;
        const int li = k * per + slot;
        const int mh = li / (8 * nN), rem = li % (8 * nN);
        nt = rem >> 3; mt = (mh * 8 + (rem & 7)) * 8 + xcd;
        return;
    }
    const int band = tile / (16 * nN), r = tile % (16 * nN);
    mt = band * 16 + (r & 15); nt = r >> 4;
}

DI void zero_acc(f32x4 (&acc)[4][4]) {
#pragma unroll
    for (int m = 0; m < 4; ++m)
#pragma unroll
        for (int n = 0; n < 4; ++n) acc[m][n] = (f32x4){0.f, 0.f, 0.f, 0.f};
}


constexpr int BM2 = 256, BK2 = 32, LDP2 = BK2 + 8;
DI void gemm_kloop3(const bf16_t* __restrict__ Ag, int lda, const bf16_t* __restrict__ Bg, int ldb, int K, f32x4 (&acc)[8][4], bf16_t* sm) {
    const int tid = otid(), lane = tid & 63, wid = tid >> 6, wr = wid >> 1, wc = wid & 1;
    bf16_t* sa = sm; bf16_t* sb = sm + 2 * BM2 * LDP2;
    const int lrow = tid >> 2, lcc = tid & 3;
    const bf16_t* ap = Ag + (size_t)lrow * lda + lcc * 8;
    const int prow = ((lrow >> 2) & 3) * 16 + (lrow >> 4) * 4 + (lrow & 3);
    const bf16_t* bp = Bg + (size_t)prow * ldb + lcc * 8;
    const size_t sA = (size_t)64 * lda, sB = (size_t)64 * ldb;
    const int fr = lane & 15, fq = lane >> 4;
    uint4 a0, a1, a2, a3, b0, b1;
#define G3_LOAD(koff) do { a0 = *(const uint4*)(ap + (koff)); a1 = *(const uint4*)(ap + sA + (koff)); a2 = *(const uint4*)(ap + 2 * sA + (koff)); a3 = *(const uint4*)(ap + 3 * sA + (koff)); \
                           b0 = *(const uint4*)(bp + (koff)); b1 = *(const uint4*)(bp + sB + (koff)); } while (0)
#define G3_STORE(buf) do { bf16_t* da_ = sa + (buf) * BM2 * LDP2 + lrow * LDP2 + lcc * 8; bf16_t* db_ = sb + (buf) * BN * LDP2 + lrow * LDP2 + lcc * 8; \
        *(uint4*)(da_) = a0; *(uint4*)(da_ + 64 * LDP2) = a1; *(uint4*)(da_ + 128 * LDP2) = a2; *(uint4*)(da_ + 192 * LDP2) = a3; \
        *(uint4*)(db_) = b0; *(uint4*)(db_ + 64 * LDP2) = b1; } while (0)
    G3_LOAD(0);
    G3_STORE(0);
    LDS_BARRIER();
    const int nk = K / BK2;
    for (int kt = 0; kt < nk; ++kt) {
        const int cur = kt & 1;
        const bool more = kt + 1 < nk;
        if (more) G3_LOAD((kt + 1) * BK2);
        const bf16_t* ca = sa + cur * BM2 * LDP2 + (wr * 128 + fr) * LDP2 + fq * 8;
        const bf16_t* cb = sb + cur * BN * LDP2 + (wc * 64 + fr) * LDP2 + fq * 8;
        bf16x8 af[8], bfr[4];
#pragma unroll
        for (int m = 0; m < 8; ++m) af[m] = *(const bf16x8*)(ca + m * 16 * LDP2);
#pragma unroll
        for (int n = 0; n < 4; ++n) bfr[n] = *(const bf16x8*)(cb + n * 16 * LDP2);
#pragma unroll
        for (int m = 0; m < 8; ++m)
#pragma unroll
            for (int n = 0; n < 4; ++n) acc[m][n] = __builtin_amdgcn_mfma_f32_16x16x32_bf16(bfr[n], af[m], acc[m][n], 0, 0, 0);
        if (more) G3_STORE(cur ^ 1);
        LDS_BARRIER();
    }
#undef G3_LOAD
#undef G3_STORE
}
DI void zero_acc8(f32x4 (&acc)[8][4]) {
#pragma unroll
    for (int m = 0; m < 8; ++m)
#pragma unroll
        for (int n = 0; n < 4; ++n) acc[m][n] = (f32x4){0.f, 0.f, 0.f, 0.f};
}
DI void st4_wt(bf16_t* dst, f32x4 v) { const unsigned long long w = (unsigned long long)pack2(v[0], v[1]) | ((unsigned long long)pack2(v[2], v[3]) << 32); __hip_atomic_store((unsigned long long*)dst, w, __ATOMIC_RELAXED, __HIP_MEMORY_SCOPE_AGENT); }
DI void st4(bf16_t* dst, f32x4 v) { uint2 w; w.x = pack2(v[0], v[1]); w.y = pack2(v[2], v[3]); *(uint2*)dst = w; }

DI void st8(bf16_t* dst, f32x4 a, f32x4 b) { uint4 w; w.x = pack2(a[0], a[1]); w.y = pack2(a[2], a[3]); w.z = pack2(b[0], b[1]); w.w = pack2(b[2], b[3]); *(uint4*)dst = w; }
DI f32x4 rot4(f32x4 v, int s, int i0) {
    const float a0 = (float)s * ex2(-(float)i0 * 0.21091607f), a1 = (float)s * ex2(-(float)(i0 + 1) * 0.21091607f);
    float r0 = a0 * 0.15915494309189535f, r1 = a1 * 0.15915494309189535f;
    r0 -= floorf(r0); r1 -= floorf(r1);
    float c0_ = __builtin_amdgcn_cosf(r0), s0_ = __builtin_amdgcn_sinf(r0), c1_ = __builtin_amdgcn_cosf(r1), s1_ = __builtin_amdgcn_sinf(r1);
    asm volatile("s_nop 15\n\ts_nop 15" : "+v"(c0_), "+v"(s0_), "+v"(c1_), "+v"(s1_));
    f32x4 o; o[0] = v[0] * c0_ - v[1] * s0_; o[1] = v[0] * s0_ + v[1] * c0_; o[2] = v[2] * c1_ - v[3] * s1_; o[3] = v[2] * s1_ + v[3] * c1_;
    return o;
}
DI void epi_inproj(const Params& p, int row, int col, f32x4 v0, f32x4 v1) {
    v0 += *(const f32x4*)(p.binp + col); v1 += *(const f32x4*)(p.binp + col + 4);
    const int b = row / S, s = row % S;
    if (col < 512) { st8(p.qa + (size_t)row * 512 + col, v0 * (0.125f * LOG2E), v1 * (0.125f * LOG2E)); }
    else if (col < 1024) { st8(p.ka + (size_t)row * 512 + (col - 512), v0, v1); }
    else if (col < 1536) { const int c = col - 1024, hh = c >> 7, e = c & 127; bf16_t* d = p.vta + ((size_t)(b * 4 + hh) * 128 + e) * S + s;
#pragma unroll
        for (int j = 0; j < 4; ++j) { d[(size_t)j * S] = f2bf(v0[j]); d[(size_t)(j + 4) * S] = f2bf(v1[j]); } }
    else if (col < 2048) { st8(p.qb + (size_t)row * 512 + (col - 1536), v0 * (0.08838834764831845f * LOG2E), v1 * (0.08838834764831845f * LOG2E)); }
    else if (col < 2560) {
        st8(p.kb + (size_t)row * 512 + (col - 2048), v0, v1);
        float ss = 0.f;
#pragma unroll
        for (int j = 0; j < 4; ++j) { const float x0 = bf2f(f2bf(v0[j])), x1 = bf2f(f2bf(v1[j])); ss += x0 * x0 + x1 * x1; }
        ss += __shfl_xor(ss, 16); ss += __shfl_xor(ss, 32);
#pragma unroll
        for (int o = 8; o; o >>= 1) ss = fmaxf(ss, __shfl_xor(ss, o));
        const int c = col - 2048, grp = ((c >> 6) & 1) * 2 + ((c >> 3) & 1);
        if ((otid() & 63) == 0) atomicMax(p.kn + (b * 4 + (c >> 7)) * 4 + grp, __float_as_uint(ss));
    }
    else if (col < 3072) { const int c = col - 2560, hh = c >> 7, e = c & 127; bf16_t* d = p.vtb + ((size_t)(b * 4 + hh) * 128 + e) * S + s;
#pragma unroll
        for (int j = 0; j < 4; ++j) { d[(size_t)j * S] = f2bf(v0[j]); d[(size_t)(j + 4) * S] = f2bf(v1[j]); } }
    else if (col < 4096) {
        const int r = col - 3072, seg = r >> 9, c = r & 511, cc = c & 127, i0 = cc >> 1, hd = c >> 7;
        f32x4 o0 = rot4(v0, s, i0), o1 = rot4(v1, s, i0 + 2);
        const float lg = lg2gamma(hd);
        const int ic = s & 63;
        float e1_ = ex2(lg * (float)(ic + 1)), e2_ = ex2(-lg * (float)(ic + 1)), e3_ = ex2(lg * (float)(63 - ic));
        asm volatile("s_nop 15\n\ts_nop 15" : "+v"(e1_), "+v"(e2_), "+v"(e3_));
        if (seg == 0) st8(p.cq + (size_t)row * 512 + c, o0 * e1_, o1 * e1_);
        else {
            o0 = o0 * 0.08838834764831845f; o1 = o1 * 0.08838834764831845f;
            st8(p.ck + (size_t)row * 512 + c, o0 * e2_, o1 * e2_);
            const f32x4 d0 = o0 * e3_, d1 = o1 * e3_;
            bf16_t* d = p.ckT + ((size_t)(b * 4 + hd) * 128 + cc) * S + s;
#pragma unroll
            for (int j = 0; j < 4; ++j) { d[(size_t)j * S] = f2bf(d0[j]); d[(size_t)(j + 4) * S] = f2bf(d1[j]); }
        }
    }
    else if (col < 5120) { const int c = col - 4096; bf16_t* d = p.cv + ((size_t)b * 1024 + c) * S + s;
#pragma unroll
        for (int j = 0; j < 4; ++j) { d[(size_t)j * S] = f2bf(v0[j]); d[(size_t)(j + 4) * S] = f2bf(v1[j]); } }
    else if (col < 6144) { f32x4 o0, o1; for (int j = 0; j < 4; ++j) { o0[j] = silu_f(v0[j]); o1[j] = silu_f(v1[j]); } st8(p.cg + (size_t)row * 1024 + (col - 5120), o0, o1); }
    else { f32x4 o0, o1; for (int j = 0; j < 4; ++j) { o0[j] = sigmoid_f(v0[j]); o1[j] = sigmoid_f(v1[j]); } st8(p.gates + (size_t)row * 3072 + (col - 6144), o0, o1); }
}

DI void phase_inproj(const Params& p, bf16_t* sm) {
    const int nM = T / BM2, nN = NIN / BN;
    const int lane = otid() & 63, wid = otid() >> 6, wr = wid >> 1, wc = wid & 1;
    for (int tile = obid(); tile < nM * nN; tile += gridDim.x) {
        int mt, nt; tile_coords(tile, nM, nN, mt, nt);
        f32x4 acc[8][4]; zero_acc8(acc);
        gemm_kloop3(p.h + (size_t)mt * BM2 * Dm, Dm, p.WinT + (size_t)nt * BN * Dm, Dm, Dm, acc, sm);
#pragma unroll
        for (int m = 0; m < 8; ++m)
#pragma unroll
            for (int n2 = 0; n2 < 2; ++n2) epi_inproj(p, mt * BM2 + wr * 128 + m * 16 + (lane & 15), nt * BN + wc * 64 + (lane >> 4) * 16 + n2 * 8, acc[m][2 * n2], acc[m][2 * n2 + 1]);
    }
}

DI void phase_branch(const Params& p, bf16_t* sm) {
    const int nM = T / BM, nN = Dm / BN;
    const int lane = otid() & 63, wid = otid() >> 6, wr = wid >> 1, wc = wid & 1;
    for (int tile = obid(); tile < nM * nN; tile += gridDim.x) {
        int mt, nt; tile_coords(tile, nM, nN, mt, nt);
        f32x4 tot[4][4]; zero_acc(tot);
#pragma unroll 1
        for (int br = 0; br < 3; ++br) {
            const bf16_t* A = br == 0 ? p.ya : br == 1 ? p.yb : p.yc;
            const bf16_t* W = br == 0 ? p.WpaT : br == 1 ? p.WpbT : p.WpcT;
            const int K = br == 2 ? 1024 : 512;
            f32x4 acc[4][4]; zero_acc(acc);
            gemm_kloop(A + (size_t)mt * BM * K, K, W + (size_t)nt * BN * K, K, K, acc, sm);
#pragma unroll
            for (int m = 0; m < 4; ++m)
#pragma unroll
                for (int n = 0; n < 4; ++n) {
                    const int row = mt * BM + wr * 64 + m * 16 + (lane & 15), col = nt * BN + wc * 64 + n * 16 + (lane >> 4) * 4;
                    const uint2 g = *(const uint2*)(p.gates + (size_t)row * 3072 + br * 1024 + col);
                    tot[m][n][0] += bflo(g.x) * acc[m][n][0]; tot[m][n][1] += bfhi(g.x) * acc[m][n][1];
                    tot[m][n][2] += bflo(g.y) * acc[m][n][2]; tot[m][n][3] += bfhi(g.y) * acc[m][n][3];
                }
        }
#pragma unroll
        for (int m = 0; m < 4; ++m)
#pragma unroll
            for (int n = 0; n < 4; ++n) {
                const int row = mt * BM + wr * 64 + m * 16 + (lane & 15), col = nt * BN + wc * 64 + n * 16 + (lane >> 4) * 4;
                st4(p.h + (size_t)row * Dm + col, tot[m][n]);
            }
    }
}

DI void phase_gemm_res(const Params& p, const bf16_t* A, int K, const bf16_t* Wt, const float* xres, const float* modl, int gt_off, bf16_t* sm) {
    const int nM = T / BM2, nN = Dm / BN;
    const int lane = otid() & 63, wid = otid() >> 6, wr = wid >> 1, wc = wid & 1;
    for (int tile = obid(); tile < nM * nN; tile += gridDim.x) {
        int mt, nt; tile_coords(tile, nM, nN, mt, nt);
        f32x4 acc[8][4]; zero_acc8(acc);
        gemm_kloop3(A + (size_t)mt * BM2 * K, K, Wt + (size_t)nt * BN * K, K, K, acc, sm);
#pragma unroll
        for (int m = 0; m < 8; ++m)
#pragma unroll
            for (int n = 0; n < 4; ++n) {
                const int row = mt * BM2 + wr * 128 + m * 16 + (lane & 15), col = nt * BN + wc * 64 + (lane >> 4) * 16 + n * 4;
                const int b = row / S;
                const f32x4 xr = *(const f32x4*)(xres + (size_t)row * Dm + col);
                const f32x4 gt = *(const f32x4*)(modl + (size_t)b * 6144 + gt_off + col);
                *(f32x4*)(p.vbuf + (size_t)row * Dm + col) = xr * ALPHA_F + gt * acc[m][n];
            }
    }
}

DI void phase_up(const Params& p, bf16_t* sm) {
    const int nM = T / BM2, nN = 2 * DFF / BN;
    const int lane = otid() & 63, wid = otid() >> 6, wr = wid >> 1, wc = wid & 1;
    for (int tile = obid(); tile < nM * nN; tile += gridDim.x) {
        int mt, nt; tile_coords(tile, nM, nN, mt, nt);
        f32x4 acc[8][4]; zero_acc8(acc);
        gemm_kloop3(p.h + (size_t)mt * BM2 * Dm, Dm, p.WupT + (size_t)nt * BN * Dm, Dm, Dm, acc, sm);
#pragma unroll
        for (int m = 0; m < 8; ++m)
#pragma unroll
            for (int n2 = 0; n2 < 2; ++n2) {
                const int row = mt * BM2 + wr * 128 + m * 16 + (lane & 15), col = nt * BN + wc * 64 + (lane >> 4) * 16 + n2 * 8;
                st8(p.ug + (size_t)row * (2 * DFF) + col, acc[m][2 * n2], acc[m][2 * n2 + 1]);
            }
    }
}

DI void phase_conv(const Params& p, int l) {
    const int gtid = obid() * blockDim.x + otid(), gsz = gridDim.x * blockDim.x;
    const float* wc = p.w_conv + (size_t)l * 3 * DFF; const float* bc = p.b_conv + (size_t)l * DFF;
    for (int i = gtid; i < T * (DFF / 8); i += gsz) {
        const int row = i / (DFF / 8), c8 = (i % (DFF / 8)) * 8, s = row % S;
        const bf16_t* up = p.ug + (size_t)row * (2 * DFF) + c8;
        const uint4 u0 = *(const uint4*)up;
        uint4 u1 = make_uint4(0, 0, 0, 0), u2 = make_uint4(0, 0, 0, 0);
        if (s >= 1) u1 = *(const uint4*)(up - 2 * DFF);
        if (s >= 2) u2 = *(const uint4*)(up - 4 * DFF);
        const uint4 gg = *(const uint4*)(up + DFF);
        const unsigned a0[4] = {u0.x, u0.y, u0.z, u0.w}, a1[4] = {u1.x, u1.y, u1.z, u1.w}, a2[4] = {u2.x, u2.y, u2.z, u2.w}, ag[4] = {gg.x, gg.y, gg.z, gg.w};
        float cv[8], t[8], e[8];
#pragma unroll
        for (int h4 = 0; h4 < 2; ++h4) {
            const f32x4 w0 = *(const f32x4*)(wc + c8 + 4 * h4), w1 = *(const f32x4*)(wc + DFF + c8 + 4 * h4), w2 = *(const f32x4*)(wc + 2 * DFF + c8 + 4 * h4), bb = *(const f32x4*)(bc + c8 + 4 * h4);
#pragma unroll
            for (int k = 0; k < 4; ++k) {
                const int j = 2 * h4 + (k >> 1); const bool hi = k & 1;
                const float x0 = hi ? bfhi(a0[j]) : bflo(a0[j]), x1 = hi ? bfhi(a1[j]) : bflo(a1[j]), x2 = hi ? bfhi(a2[j]) : bflo(a2[j]);
                cv[4 * h4 + k] = bb[k] + w0[k] * x2 + w1[k] * x1 + w2[k] * x0;
            }
        }
#pragma unroll
        for (int k = 0; k < 8; ++k) { t[k] = __builtin_amdgcn_rcpf(fabsf(cv[k]) * 0.2316418882f + 1.0f); e[k] = ex2(cv[k] * cv[k] * (-0.72134752044f)); }
        asm volatile("s_nop 15\n\ts_nop 15" : "+v"(t[0]), "+v"(t[1]), "+v"(t[2]), "+v"(t[3]), "+v"(t[4]), "+v"(t[5]), "+v"(t[6]), "+v"(t[7]));
        asm volatile("s_nop 3" : "+v"(e[0]), "+v"(e[1]), "+v"(e[2]), "+v"(e[3]), "+v"(e[4]), "+v"(e[5]), "+v"(e[6]), "+v"(e[7]));
        unsigned o[4];
#pragma unroll
        for (int j = 0; j < 4; ++j) {
            float rr[2];
#pragma unroll
            for (int hl = 0; hl < 2; ++hl) {
                const int k = 2 * j + hl;
                float q = t[k] * 0.5307027145f + (-0.7265760135f); q = q * t[k] + 0.7107068705f; q = q * t[k] + (-0.142248368f); q = q * t[k] + 0.127414796f; q = q * t[k];
                const float m = cv[k] * (q * e[k]);
                const float gl = cv[k] < 0.f ? m : cv[k] - m;
                rr[hl] = gl * (hl ? bfhi(ag[j]) : bflo(ag[j]));
            }
            o[j] = pack2(rr[0], rr[1]);
        }
        *(uint4*)(p.act + (size_t)row * DFF + c8) = make_uint4(o[0], o[1], o[2], o[3]);
    }
}

template <int MODE>
DI void naive_attn(const Params& p, int item) {
    constexpr int D = MODE == 0 ? 64 : 128;
    constexpr int DV = MODE == 2 ? 256 : 128;
    constexpr int SW = DV / 4;
    constexpr int NH = MODE == 0 ? 8 : 4;
    const int tid = otid(), lane = tid & 63;
    const int sl = __builtin_amdgcn_readfirstlane(tid >> 6);
    const int qblk = 127 - (item % 128), hh = (item / 128) % NH, b = item / (128 * NH);
    const int q = qblk * 64 + lane; const size_t tq = (size_t)b * S + q;
    const bf16_t *Q, *Kp;
    if (MODE == 0) { Q = p.qa + tq * 512 + hh * 64; Kp = p.ka + (size_t)b * S * 512 + hh * 64; }
    else if (MODE == 1) { Q = p.qb + tq * 512 + hh * 128; Kp = p.kb + (size_t)b * S * 512 + hh * 128; }
    else { Q = p.cq + tq * 512 + hh * 128; Kp = p.ck + (size_t)b * S * 512 + hh * 128; }
    unsigned qp[D / 2];
#pragma unroll
    for (int i = 0; i < D / 8; ++i) { const uint4 t = ((const uint4*)Q)[i]; qp[4 * i] = t.x; qp[4 * i + 1] = t.y; qp[4 * i + 2] = t.z; qp[4 * i + 3] = t.w; }
    float acc[SW];
#pragma unroll
    for (int i = 0; i < SW; ++i) acc[i] = 0.f;
    float mx = -INFINITY, lsum = 0.f;
    const int send = (qblk + 1) * 64;
    float Fq = 0.f; const float* Fk = nullptr;
    if (MODE == 1) { Fk = p.F + (size_t)(b * 4 + hh) * S; Fq = Fk[q]; }
    float lg = 0.f;
    if (MODE == 2) lg = log2f(1.0f - exp2f(-5.0f - (float)hh));
    for (int s = 0; s < send; ++s) {
        const uint4* kr = (const uint4*)(Kp + (size_t)s * 512);
        float sc = 0.f;
#pragma unroll
        for (int i = 0; i < D / 8; ++i) {
            const uint4 kv = kr[i];
            sc += bflo(qp[4 * i]) * bflo(kv.x) + bfhi(qp[4 * i]) * bfhi(kv.x);
            sc += bflo(qp[4 * i + 1]) * bflo(kv.y) + bfhi(qp[4 * i + 1]) * bfhi(kv.y);
            sc += bflo(qp[4 * i + 2]) * bflo(kv.z) + bfhi(qp[4 * i + 2]) * bfhi(kv.z);
            sc += bflo(qp[4 * i + 3]) * bflo(kv.w) + bfhi(qp[4 * i + 3]) * bfhi(kv.w);
            if ((i & 3) == 3) asm volatile("" ::: "memory");
        }
        float w, corr = 1.f;
        if (MODE == 2) {
            w = (s <= q) ? sc * exp2f((float)(q - s) * lg) : 0.f;
        } else {
            if (MODE == 1) sc += Fq - Fk[s];
            const bool valid = (MODE == 0) || (s <= q);
            if (valid) {
                const float mn = fmaxf(mx, sc);
                corr = exp2f(mx - mn); w = exp2f(sc - mn); mx = mn;
                lsum = lsum * corr + w;
            } else { w = 0.f; }
        }
        if (MODE == 2) {
            const uint4* vr = (const uint4*)(p.cv + ((size_t)b * S + s) * 1024 + hh * 256 + sl * SW);
#pragma unroll
            for (int i = 0; i < SW / 8; ++i) {
                const uint4 vv = vr[i];
                acc[8 * i] += w * bflo(vv.x); acc[8 * i + 1] += w * bfhi(vv.x); acc[8 * i + 2] += w * bflo(vv.y); acc[8 * i + 3] += w * bfhi(vv.y);
                acc[8 * i + 4] += w * bflo(vv.z); acc[8 * i + 5] += w * bfhi(vv.z); acc[8 * i + 6] += w * bflo(vv.w); acc[8 * i + 7] += w * bfhi(vv.w);
            }
        } else {
            const bf16_t* vt = (MODE == 0 ? p.vta + ((size_t)(b * 4 + (hh >> 1)) * 128 + sl * SW) * S : p.vtb + ((size_t)(b * 4 + hh) * 128 + sl * SW) * S) + s;
#pragma unroll
            for (int i = 0; i < SW; ++i) { acc[i] = acc[i] * corr + w * bf2f(*vt); vt += S; asm volatile("" : "+v"(vt)); }
        }
    }
    if (MODE == 2) {
        float* o = p.oc + tq * 1024 + hh * 256 + sl * SW;
#pragma unroll
        for (int i = 0; i < SW / 4; ++i) *(f32x4*)(o + 4 * i) = (f32x4){acc[4 * i], acc[4 * i + 1], acc[4 * i + 2], acc[4 * i + 3]};
    } else {
        const float inv = 1.f / lsum;
        bf16_t* o = (MODE == 0 ? p.oa + tq * 1024 + hh * 128 : p.yb + tq * 512 + hh * 128) + sl * SW;
#pragma unroll
        for (int i = 0; i < SW / 8; ++i) {
            uint4 w4; w4.x = pack2(acc[8 * i] * inv, acc[8 * i + 1] * inv); w4.y = pack2(acc[8 * i + 2] * inv, acc[8 * i + 3] * inv);
            w4.z = pack2(acc[8 * i + 4] * inv, acc[8 * i + 5] * inv); w4.w = pack2(acc[8 * i + 6] * inv, acc[8 * i + 7] * inv);
            ((uint4*)o)[i] = w4;
        }
    }
}


typedef float f32x16 __attribute__((ext_vector_type(16)));
DI bf16x8 pack8(float a0, float a1, float a2, float a3, float a4, float a5, float a6, float a7) {
    typedef unsigned u32x4 __attribute__((ext_vector_type(4)));
    u32x4 w; w[0] = pack2(a0, a1); w[1] = pack2(a2, a3); w[2] = pack2(a4, a5); w[3] = pack2(a6, a7);
    return __builtin_bit_cast(bf16x8, w);
}

template <int MODE>
DI void flash_item(const Params& p, int b, int hh, int qi, unsigned char* smem) {
    constexpr int D = MODE == 0 ? 64 : 128, KST = D + 8, VST = 68, KS = D / 16;
    constexpr int KBYTES = 64 * KST * 2, VBYTES = 128 * VST * 2, BUFB = KBYTES + VBYTES + 256;
    constexpr int NKC = D / 32, CPR = D / 8;
    const int tid = otid(), lane = tid & 63, w = tid >> 6, r = lane & 31, hf = lane >> 5;
    const int q0 = qi * 128 + w * 32;
    const size_t tq = (size_t)b * S + q0 + r;
    bf16x8 qf[KS];
    {
        const bf16_t* qptr = (MODE == 0 ? p.qa + tq * 512 + hh * 64 : p.qb + tq * 512 + hh * 128) + hf * 8;
#pragma unroll
        for (int ks = 0; ks < KS; ++ks) qf[ks] = *(const bf16x8*)(qptr + ks * 16);
    }
    const float* fbase = p.F + (size_t)(b * 4 + (MODE == 1 ? hh : 0)) * S;
    float Fq = 0.f; if (MODE == 1) Fq = fbase[q0 + r];
    const bf16_t* kbase = MODE == 0 ? p.ka + (size_t)b * S * 512 + hh * 64 : p.kb + (size_t)b * S * 512 + hh * 128;
    const bf16_t* vbase = MODE == 0 ? p.vta + (size_t)(b * 4 + (hh >> 1)) * 128 * S : p.vtb + (size_t)(b * 4 + hh) * 128 * S;
    const int ntiles = 2 * qi + 2, wlast = 2 * qi + (w >> 1);
    uint4 kr0 = make_uint4(0, 0, 0, 0), kr1 = kr0, kr2 = kr0, kr3 = kr0, vr0 = kr0, vr1 = kr0, vr2 = kr0, vr3 = kr0; f32x4 frg = {0.f, 0.f, 0.f, 0.f};
#define FL_K(i_, jx) (*(const uint4*)(kbase + (size_t)(64 * (jx) + (tid + 256 * (i_)) / CPR) * 512 + ((tid + 256 * (i_)) % CPR) * 8))
#define FL_V(i_, jx) (*(const uint4*)(vbase + (size_t)((tid + 256 * (i_)) >> 3) * S + 64 * (jx) + ((tid + 256 * (i_)) & 7) * 8))
#define FL_GLOAD(jx) do { kr0 = FL_K(0, jx); kr1 = FL_K(1, jx); if (NKC == 4) { kr2 = FL_K(2, jx); kr3 = FL_K(3, jx); } \
        vr0 = FL_V(0, jx); vr1 = FL_V(1, jx); vr2 = FL_V(2, jx); vr3 = FL_V(3, jx); \
        if (MODE == 1 && tid < 16) frg = *(const f32x4*)(fbase + 64 * (jx) + tid * 4); } while (0)
#define FL_KS(i_, reg) (*(uint4*)(B_ + (((tid + 256 * (i_)) / CPR) * KST + ((tid + 256 * (i_)) % CPR) * 8) * 2) = (reg))
#define FL_VS(i_, reg) do { uint2* d_ = (uint2*)(B_ + KBYTES + (((tid + 256 * (i_)) >> 3) * VST + ((tid + 256 * (i_)) & 7) * 8) * 2); d_[0] = make_uint2((reg).x, (reg).y); d_[1] = make_uint2((reg).z, (reg).w); } while (0)
#define FL_SSTORE(buf) do { unsigned char* B_ = smem + (buf) * BUFB; FL_KS(0, kr0); FL_KS(1, kr1); if (NKC == 4) { FL_KS(2, kr2); FL_KS(3, kr3); } \
        FL_VS(0, vr0); FL_VS(1, vr1); FL_VS(2, vr2); FL_VS(3, vr3); \
        if (MODE == 1 && tid < 16) *(f32x4*)(B_ + KBYTES + VBYTES + tid * 16) = frg; } while (0)
    FL_GLOAD(MODE == 1 ? ntiles - 1 : 0);
    FL_SSTORE(0);
    LDS_BARRIER();
    f32x16 acc[4];
#pragma unroll
    for (int eb = 0; eb < 4; ++eb)
#pragma unroll
        for (int i = 0; i < 16; ++i) acc[eb][i] = 0.f;
    float mrun = -INFINITY, lsum = 0.f;
    unsigned* donef = (unsigned*)(smem + SMEM_BYTES - 64);
    float qk_bound = 0.f, Fq0 = 0.f;
    if (MODE == 1) {
        float qs = 0.f;
#pragma unroll
        for (int ks = 0; ks < KS; ++ks)
#pragma unroll
            for (int e = 0; e < 8; ++e) { const float x = bf2f((bf16_t)qf[ks][e]); qs += x * x; }
        qs += __shfl_xor(qs, 32);
#pragma unroll
        for (int o = 16; o; o >>= 1) qs = fmaxf(qs, __shfl_xor(qs, o));
        const unsigned* kn = p.kn + (b * 4 + hh) * 4;
        const float k2 = __uint_as_float(kn[0]) + __uint_as_float(kn[1]) + __uint_as_float(kn[2]) + __uint_as_float(kn[3]);
        qk_bound = sqrtf(qs) * sqrtf(k2) * 1.0001f + 1e-3f;
        Fq0 = __shfl(Fq, 0);
        if (lane == 0) donef[w] = 0u;
    }
    for (int it = 0; it < ntiles; ++it) {
        const int j = MODE == 1 ? ntiles - 1 - it : it;
        const bool more = it + 1 < ntiles;
        if (more) FL_GLOAD(MODE == 1 ? j - 1 : j + 1);
        if (j <= wlast) {
            const unsigned char* B = smem + (it & 1) * BUFB;
            f32x16 st[2];
#pragma unroll
            for (int kb = 0; kb < 2; ++kb) {
#pragma unroll
                for (int i = 0; i < 16; ++i) st[kb][i] = 0.f;
#pragma unroll
                for (int ks = 0; ks < KS; ++ks) {
                    const bf16x8 a = *(const bf16x8*)(B + ((kb * 32 + r) * KST + ks * 16 + hf * 8) * 2);
                    st[kb] = __builtin_amdgcn_mfma_f32_32x32x16_bf16(a, qf[ks], st[kb], 0, 0, 0);
                }
            }
            if (MODE == 1) {
                const float* Fl = (const float*)(B + KBYTES + VBYTES);
#pragma unroll
                for (int kb = 0; kb < 2; ++kb)
#pragma unroll
                    for (int g = 0; g < 4; ++g) {
                        const f32x4 fk = *(const f32x4*)(Fl + kb * 32 + 8 * g + 4 * hf);
#pragma unroll
                        for (int jj = 0; jj < 4; ++jj) st[kb][4 * g + jj] += Fq - fk[jj];
                    }
                if (j >= 2 * qi) {
                    const int qabs = q0 + r;
#pragma unroll
                    for (int kb = 0; kb < 2; ++kb)
#pragma unroll
                        for (int g = 0; g < 4; ++g)
#pragma unroll
                            for (int jj = 0; jj < 4; ++jj) { const int key = 64 * j + kb * 32 + 8 * g + 4 * hf + jj; if (key > qabs) st[kb][4 * g + jj] = -INFINITY; }
                }
            }
            float mt = st[0][0];
#pragma unroll
            for (int i = 1; i < 16; ++i) mt = fmaxf(mt, st[0][i]);
#pragma unroll
            for (int i = 0; i < 16; ++i) mt = fmaxf(mt, st[1][i]);
            mt = fmaxf(mt, __shfl_xor(mt, 32));
            if (!(MODE == 1 && __all(mt < mrun - 40.0f))) {
            const float mn = fmaxf(mrun, mt);
            const float corr = ex2(mrun - mn);
            mrun = mn; lsum *= corr;
#pragma unroll
            for (int kb = 0; kb < 2; ++kb)
#pragma unroll
                for (int i = 0; i < 16; ++i) { const float pv = ex2(st[kb][i] - mn); st[kb][i] = pv; lsum += pv; }
#pragma unroll
            for (int eb = 0; eb < 4; ++eb) acc[eb] *= corr;
#pragma unroll
            for (int kb = 0; kb < 2; ++kb)
#pragma unroll
                for (int s2 = 0; s2 < 2; ++s2) {
                    const bf16x8 pf = pack8(st[kb][8 * s2], st[kb][8 * s2 + 1], st[kb][8 * s2 + 2], st[kb][8 * s2 + 3], st[kb][8 * s2 + 4], st[kb][8 * s2 + 5], st[kb][8 * s2 + 6], st[kb][8 * s2 + 7]);
#pragma unroll
                    for (int eb = 0; eb < 4; ++eb) {
                        const unsigned char* vp = B + KBYTES + ((eb * 32 + r) * VST + kb * 32 + 16 * s2 + 4 * hf) * 2;
                        const uint2 lo = *(const uint2*)vp, hi = *(const uint2*)(vp + 16);
                        typedef unsigned u32x4 __attribute__((ext_vector_type(4)));
                        u32x4 av; av[0] = lo.x; av[1] = lo.y; av[2] = hi.x; av[3] = hi.y;
                        acc[eb] = __builtin_amdgcn_mfma_f32_32x32x16_bf16(__builtin_bit_cast(bf16x8, av), pf, acc[eb], 0, 0, 0);
                    }
                }
            }
        }
        if (MODE == 1 && j <= wlast) {
            const float* Fl0 = (const float*)(smem + (it & 1) * BUFB + KBYTES + VBYTES);
            float mmin = mrun;
#pragma unroll
            for (int o = 16; o; o >>= 1) mmin = fminf(mmin, __shfl_xor(mmin, o));
            if (lane == 0 && qk_bound + (Fq0 - Fl0[0]) < mmin - 40.0f) donef[w] = 1u;
        }
        if (more) FL_SSTORE((it + 1) & 1);
        LDS_BARRIER();
        if (MODE == 1 && (donef[0] & donef[1] & donef[2] & donef[3])) break;
    }
#undef FL_GLOAD
#undef FL_SSTORE
#undef FL_K
#undef FL_V
#undef FL_KS
#undef FL_VS
    const float inv = 1.f / (lsum + __shfl_xor(lsum, 32));
    bf16_t* o = MODE == 0 ? p.oa + tq * 1024 + hh * 128 : p.yb + tq * 512 + hh * 128;
#pragma unroll
    for (int eb = 0; eb < 4; ++eb)
#pragma unroll
        for (int g = 0; g < 4; ++g) {
            f32x4 v = {acc[eb][4 * g] * inv, acc[eb][4 * g + 1] * inv, acc[eb][4 * g + 2] * inv, acc[eb][4 * g + 3] * inv};
            st4(o + eb * 32 + 8 * g + 4 * hf, v);
        }
}


DI void ret_state_item(const Params& p, int item) {
    const int n = item & 127, bh = item >> 7;
    const int tid = otid(), lane = tid & 63, w = tid >> 6, r = lane & 31, hf = lane >> 5;
    const bf16_t* kt = p.ckT + (size_t)bh * 128 * S + n * 64 + hf * 8;
    const bf16_t* vt = p.cv + ((size_t)bh * 256 + w * 64) * S + n * 64 + hf * 8;
    f32x16 acc[4][2];
#pragma unroll
    for (int a = 0; a < 4; ++a)
#pragma unroll
        for (int c = 0; c < 2; ++c)
#pragma unroll
            for (int i = 0; i < 16; ++i) acc[a][c][i] = 0.f;
#pragma unroll
    for (int s4 = 0; s4 < 4; ++s4) {
        bf16x8 af[4], bfr[2];
#pragma unroll
        for (int a = 0; a < 4; ++a) af[a] = *(const bf16x8*)(kt + (size_t)(a * 32 + r) * S + s4 * 16);
#pragma unroll
        for (int c = 0; c < 2; ++c) bfr[c] = *(const bf16x8*)(vt + (size_t)(c * 32 + r) * S + s4 * 16);
#pragma unroll
        for (int a = 0; a < 4; ++a)
#pragma unroll
            for (int c = 0; c < 2; ++c) acc[a][c] = __builtin_amdgcn_mfma_f32_32x32x16_bf16(af[a], bfr[c], acc[a][c], 0, 0, 0);
    }
    bf16_t* o = p.kv + ((size_t)(bh * 128 + n) * 256 + w * 64) * 128;
#pragma unroll
    for (int a = 0; a < 4; ++a)
#pragma unroll
        for (int c = 0; c < 2; ++c)
#pragma unroll
            for (int g = 0; g < 4; ++g) {
                f32x4 v = {acc[a][c][4 * g], acc[a][c][4 * g + 1], acc[a][c][4 * g + 2], acc[a][c][4 * g + 3]};
                st4_wt(o + (size_t)(c * 32 + r) * 128 + a * 32 + 8 * g + 4 * hf, v);
            }
}

DI void ret_scan(const Params& p) {
    const int gtid = obid() * 256 + otid(), gsz = gridDim.x * 256;
    for (int e = gtid; e < 8 * 8192; e += gsz) {
        const int bh = e >> 13, pi = e & 8191, hd = bh & 3;
        const float dec = ex2(64.0f * lg2gamma(hd));
        unsigned long long* ptr = (unsigned long long*)p.kv + (size_t)bh * 128 * 8192 + pi;
        float c0 = 0.f, c1 = 0.f, c2 = 0.f, c3 = 0.f;
        for (int n0 = 0; n0 < 128; n0 += 8) {
            unsigned long long v[8];
#pragma unroll
            for (int k = 0; k < 8; ++k) v[k] = ptr[(size_t)(n0 + k) * 8192];
            asm volatile("s_waitcnt vmcnt(0)" ::: "memory");
#pragma unroll
            for (int k = 0; k < 8; ++k) {
                const unsigned long long o = (unsigned long long)pack2(c0, c1) | ((unsigned long long)pack2(c2, c3) << 32);
                __hip_atomic_store(ptr + (size_t)(n0 + k) * 8192, o, __ATOMIC_RELAXED, __HIP_MEMORY_SCOPE_AGENT);
                const unsigned lo = (unsigned)v[k], hi = (unsigned)(v[k] >> 32);
                c0 = c0 * dec + bflo(lo); c1 = c1 * dec + bfhi(lo); c2 = c2 * dec + bflo(hi); c3 = c3 * dec + bfhi(hi);
            }
        }
    }
}

DI void ret_out_item(const Params& p, int l, int item, unsigned char* smem) {
    const int n = item & 127, bh = item >> 7, b = bh >> 2, hd = bh & 3;
    const int tid = otid(), lane = tid & 63, w = tid >> 6, r = lane & 31, hf = lane >> 5;
    const size_t t0 = (size_t)b * S + n * 64;
    f32x16 acc[2][2];
#pragma unroll
    for (int a = 0; a < 2; ++a)
#pragma unroll
        for (int c = 0; c < 2; ++c)
#pragma unroll
            for (int i = 0; i < 16; ++i) acc[a][c][i] = 0.f;
    bf16x8 pf[2][2][2];
    typedef unsigned u32x4 __attribute__((ext_vector_type(4)));
    bf16x8 qf[2][8], rf[2][8];
    uint2 vlo[2][2][2], vhi[2][2][2];
    {
        const bf16_t* rt = p.kv + ((size_t)(bh * 128 + n) * 256 + w * 64) * 128 + hf * 8;
#pragma unroll
        for (int qb = 0; qb < 2; ++qb)
#pragma unroll
            for (int ks = 0; ks < 8; ++ks) qf[qb][ks] = *(const bf16x8*)(p.cq + (t0 + qb * 32 + r) * 512 + hd * 128 + ks * 16 + hf * 8);
#pragma unroll
        for (int dvb = 0; dvb < 2; ++dvb)
#pragma unroll
            for (int ks = 0; ks < 8; ++ks) rf[dvb][ks] = *(const bf16x8*)(rt + (size_t)(dvb * 32 + r) * 128 + ks * 16);
    }
    __builtin_amdgcn_sched_barrier(0);
#pragma unroll
    for (int dvb = 0; dvb < 2; ++dvb)
#pragma unroll
        for (int ks = 0; ks < 8; ++ks)
#pragma unroll
            for (int qb = 0; qb < 2; ++qb) acc[dvb][qb] = __builtin_amdgcn_mfma_f32_32x32x16_bf16(rf[dvb][ks], qf[qb][ks], acc[dvb][qb], 0, 0, 0);
#pragma unroll
    for (int kb = 0; kb < 2; ++kb)
#pragma unroll
        for (int ks = 0; ks < 8; ++ks) rf[kb][ks] = *(const bf16x8*)(p.ck + (t0 + kb * 32 + r) * 512 + hd * 128 + ks * 16 + hf * 8);
    __builtin_amdgcn_sched_barrier(0);
#pragma unroll
    for (int kb = 0; kb < 2; ++kb) {
        f32x16 st[2];
#pragma unroll
        for (int qb = 0; qb < 2; ++qb)
#pragma unroll
            for (int i = 0; i < 16; ++i) st[qb][i] = 0.f;
#pragma unroll
        for (int ks = 0; ks < 8; ++ks)
#pragma unroll
            for (int qb = 0; qb < 2; ++qb) st[qb] = __builtin_amdgcn_mfma_f32_32x32x16_bf16(rf[kb][ks], qf[qb][ks], st[qb], 0, 0, 0);
#pragma unroll
        for (int qb = 0; qb < 2; ++qb) {
#pragma unroll
            for (int i = 0; i < 16; ++i) { const int key = kb * 32 + (i & 3) + 8 * (i >> 2) + 4 * hf; if (key > qb * 32 + r) st[qb][i] = 0.f; }
#pragma unroll
            for (int s2 = 0; s2 < 2; ++s2)
                pf[kb][s2][qb] = pack8(st[qb][8 * s2], st[qb][8 * s2 + 1], st[qb][8 * s2 + 2], st[qb][8 * s2 + 3], st[qb][8 * s2 + 4], st[qb][8 * s2 + 5], st[qb][8 * s2 + 6], st[qb][8 * s2 + 7]);
        }
    }
    {
        const bf16_t* vt = p.cv + ((size_t)bh * 256 + w * 64) * S + n * 64 + 4 * hf;
#pragma unroll
        for (int dvb = 0; dvb < 2; ++dvb)
#pragma unroll
            for (int kb = 0; kb < 2; ++kb)
#pragma unroll
                for (int s2 = 0; s2 < 2; ++s2) {
                    const bf16_t* vp = vt + (size_t)(dvb * 32 + r) * S + kb * 32 + 16 * s2;
                    vlo[dvb][kb][s2] = *(const uint2*)vp; vhi[dvb][kb][s2] = *(const uint2*)(vp + 8);
                }
    }
    __builtin_amdgcn_sched_barrier(0);
#pragma unroll
    for (int dvb = 0; dvb < 2; ++dvb)
#pragma unroll
        for (int kb = 0; kb < 2; ++kb)
#pragma unroll
            for (int s2 = 0; s2 < 2; ++s2) {
                u32x4 av; av[0] = vlo[dvb][kb][s2].x; av[1] = vlo[dvb][kb][s2].y; av[2] = vhi[dvb][kb][s2].x; av[3] = vhi[dvb][kb][s2].y;
                const bf16x8 a = __builtin_bit_cast(bf16x8, av);
#pragma unroll
                for (int qb = 0; qb < 2; ++qb) acc[dvb][qb] = __builtin_amdgcn_mfma_f32_32x32x16_bf16(a, pf[kb][s2][qb], acc[dvb][qb], 0, 0, 0);
            }
    float* red = (float*)smem;
    float mu[2], rstd[2];
    __syncthreads();
#pragma unroll
    for (int qb = 0; qb < 2; ++qb) {
        float s1 = 0.f, s2 = 0.f;
#pragma unroll
        for (int dvb = 0; dvb < 2; ++dvb)
#pragma unroll
            for (int i = 0; i < 16; ++i) { const float x = acc[dvb][qb][i]; s1 += x; s2 += x * x; }
        s1 += __shfl_xor(s1, 32); s2 += __shfl_xor(s2, 32);
        if (hf == 0) { red[(w * 64 + qb * 32 + r) * 2] = s1; red[(w * 64 + qb * 32 + r) * 2 + 1] = s2; }
    }
    __syncthreads();
#pragma unroll
    for (int qb = 0; qb < 2; ++qb) {
        float s1 = 0.f, s2 = 0.f;
#pragma unroll
        for (int ww = 0; ww < 4; ++ww) { s1 += red[(ww * 64 + qb * 32 + r) * 2]; s2 += red[(ww * 64 + qb * 32 + r) * 2 + 1]; }
        const float m_ = s1 * (1.f / 256.f);
        mu[qb] = m_; rstd[qb] = rsqrtf(fmaxf(s2 * (1.f / 256.f) - m_ * m_, 0.f) + LN_EPS);
    }
    const float* gr = p.g_ret + (size_t)l * 1024 + hd * 256 + w * 64;
#pragma unroll
    for (int dvb = 0; dvb < 2; ++dvb)
#pragma unroll
        for (int g = 0; g < 4; ++g) {
            const int dv = dvb * 32 + 8 * g + 4 * hf;
            const f32x4 gg = *(const f32x4*)(gr + dv);
#pragma unroll
            for (int qb = 0; qb < 2; ++qb) {
                const size_t off = (t0 + qb * 32 + r) * 1024 + hd * 256 + w * 64 + dv;
                const uint2 cgv = *(const uint2*)(p.cg + off);
                f32x4 y;
#pragma unroll
                for (int jj = 0; jj < 4; ++jj) y[jj] = (acc[dvb][qb][4 * g + jj] - mu[qb]) * rstd[qb] * gg[jj];
                y[0] *= bflo(cgv.x); y[1] *= bfhi(cgv.x); y[2] *= bflo(cgv.y); y[3] *= bfhi(cgv.y);
                st4(p.yc + off, y);
            }
        }
}

DI void phase_mixers(const Params& p, int l, unsigned char* smem) {
    const int nF = 64 * 24, nC = 2 * 4 * 128;
    int* sitem = (int*)(smem + SMEM_BYTES - 16);
    for (;;) {
        __syncthreads();
        if (otid() == 0) *sitem = (int)atomicAdd(p.ctr + l, 1u);
        __syncthreads();
        const int it = *sitem;
        if (it >= nF + nC) break;
        if (it < nF) {
            const int qi = 63 - it / 24, r = it % 24;
            if (r < 8) flash_item<1>(p, r >> 2, r & 3, qi, smem);
            else flash_item<0>(p, (r - 8) >> 3, (r - 8) & 7, qi, smem);
        } else ret_state_item(p, it - nF);
    }
}

DI void phase_mixers_naive(const Params& p) {
    const int nA = 2 * 8 * 128, nB = 2 * 4 * 128, nC = 2 * 4 * 128;
    for (int it = obid(); it < nA + nB + nC; it += gridDim.x) {
        if (it < nB) naive_attn<1>(p, it);
        else if (it < nB + nC) naive_attn<2>(p, it - nB);
        else naive_attn<0>(p, it - nB - nC);
    }
}

DI void phase_post(const Params& p, int l) {
    const int lane = otid() & 63, wv = otid() >> 6;
    const float lam = p.lamv[2 * l], li = p.lamv[2 * l + 1];
    const float* gd = p.g_diff + (size_t)l * 512; const float* gr = p.g_ret + (size_t)l * 1024;
    for (int row = obid() * 4 + wv; row < T; row += gridDim.x * 4) {
#pragma unroll
        for (int hh = 0; hh < 4; ++hh) {
            const unsigned o0 = *(const unsigned*)(p.oa + (size_t)row * 1024 + (2 * hh) * 128 + lane * 2);
            const unsigned o1 = *(const unsigned*)(p.oa + (size_t)row * 1024 + (2 * hh + 1) * 128 + lane * 2);
            const float d0 = bflo(o0) - lam * bflo(o1), d1 = bfhi(o0) - lam * bfhi(o1);
            float ss = d0 * d0 + d1 * d1;
            for (int o = 32; o; o >>= 1) ss += __shfl_xor(ss, o);
            const float r = rsqrtf(ss * (1.f / 128.f) + LN_EPS) * (1.f - li);
            const int c = hh * 128 + lane * 2;
            *(unsigned*)(p.ya + (size_t)row * 512 + c) = pack2(d0 * r * gd[c], d1 * r * gd[c + 1]);
        }
    }
}

DI void grid_bar(unsigned* bar, unsigned& epoch) {
    asm volatile("s_waitcnt vmcnt(0) lgkmcnt(0)" ::: "memory");
    __syncthreads();
    epoch += 1;
    const int tid = otid();
    unsigned* go = bar;
    unsigned* flags = bar + 32;
    if (tid == 0) {
        __builtin_amdgcn_fence(__ATOMIC_RELEASE, "agent");
        asm volatile("s_waitcnt vmcnt(0)" ::: "memory");
        __hip_atomic_store(flags + 32 * obid(), epoch, __ATOMIC_RELAXED, __HIP_MEMORY_SCOPE_AGENT);
    }
    if (obid() == 0 && tid < 64) {
        const int nb = gridDim.x;
        for (int base = 0; base < nb; base += 64) {
            const int idx = base + tid;
            if (idx < nb) while (__hip_atomic_load(flags + 32 * idx, __ATOMIC_RELAXED, __HIP_MEMORY_SCOPE_AGENT) < epoch) __builtin_amdgcn_s_sleep(1);
        }
        asm volatile("s_waitcnt vmcnt(0)" ::: "memory");
        if (tid == 0) __hip_atomic_store(go, epoch, __ATOMIC_RELAXED, __HIP_MEMORY_SCOPE_AGENT);
    }
    if (tid == 0) {
        while (__hip_atomic_load(go, __ATOMIC_RELAXED, __HIP_MEMORY_SCOPE_AGENT) < epoch) __builtin_amdgcn_s_sleep(1);
        __builtin_amdgcn_fence(__ATOMIC_ACQUIRE, "agent");
        asm volatile("s_waitcnt vmcnt(0)" ::: "memory");
    }
    __syncthreads();
}
#define GSYNC() grid_bar(p.bar, epoch)
__global__ void __launch_bounds__(256, 2) fwd_kernel(Params p) {
    __shared__ __attribute__((aligned(16))) unsigned char smem[SMEM_BYTES];
    cg::grid_group grid = cg::this_grid();
    bf16_t* sm = (bf16_t*)smem; float* smf = (float*)smem;

    unsigned epoch = 0;
    asm volatile("s_waitcnt vmcnt(0) lgkmcnt(0)" ::: "memory"); grid.sync();
    convert_layer(p, 0, smf);
    phase0_misc(p, smf);
    GSYNC();
    row_phase(p, p.x, false, nullptr, nullptr, nullptr, p.mod, 0, 1024, true, true);
    GSYNC();
    for (int l = 0; l < DEPTH; ++l) {
        const float* modl = p.mod + (size_t)l * 2 * 6144;
        const float* xcur = l == 0 ? p.x : p.xbuf;
        if (obid() >= gridDim.x - 8) scan_item(p, obid() - (gridDim.x - 8), smf);
        phase_inproj(p, sm);
        GSYNC();
        phase_mixers(p, l, smem);
        GSYNC();
        phase_post(p, l);
        ret_scan(p);
        GSYNC();
        for (int it = obid(); it < 1024; it += gridDim.x) ret_out_item(p, l, it, smem);
        GSYNC();
        phase_branch(p, sm);
        GSYNC();
        phase_gemm_res(p, p.h, 1024, p.WoutT, xcur, modl, 2048, sm);
        GSYNC();
        row_phase(p, p.vbuf, true, p.ln_g + (size_t)(l * 2) * Dm, p.ln_b + (size_t)(l * 2) * Dm, p.xbuf, modl, 3072, 4096, true, false);
        GSYNC();
        phase_up(p, sm);
        GSYNC();
        phase_conv(p, l);
        GSYNC();
        phase_gemm_res(p, p.act, DFF, p.WdownT, p.xbuf, modl, 5120, sm);
        GSYNC();
        if (l + 1 < DEPTH) {
            convert_layer(p, l + 1, smf);
            GSYNC();
            row_phase(p, p.vbuf, true, p.ln_g + (size_t)(l * 2 + 1) * Dm, p.ln_b + (size_t)(l * 2 + 1) * Dm, p.xbuf, modl + 2 * 6144, 0, 1024, true, true);
            GSYNC();
        } else {
            row_phase(p, p.vbuf, true, p.ln_g + (size_t)(l * 2 + 1) * Dm, p.ln_b + (size_t)(l * 2 + 1) * Dm, p.out, modl, 0, 1024, false, false);
        }
    }
}

extern "C" void kernel_launch(void* const* d_in, const int* in_sizes, int n_in, void* d_out, int out_size, void* d_ws, size_t ws_size, hipStream_t stream) {
    static int grid_blocks = 0;
    if (!grid_blocks) {
        int dev = 0, cus = 0, per_cu = 0;
        hipGetDevice(&dev);
        hipDeviceGetAttribute(&cus, hipDeviceAttributeMultiprocessorCount, dev);
        hipOccupancyMaxActiveBlocksPerMultiprocessor(&per_cu, fwd_kernel, 256, 0);
        if (per_cu > 2) per_cu = 2;
        if (per_cu < 1) per_cu = 1;
        grid_blocks = cus * per_cu;
    }
    Params p{};
    const float** ins = (const float**)&p.x;
    for (int i = 0; i < 22; ++i) ins[i] = (const float*)d_in[i];
    p.out = (float*)d_out;
    char* w = (char*)d_ws; size_t off = 0;
    auto take = [&](size_t bytes) { char* r = w + off; off += (bytes + 255) & ~(size_t)255; return r; };
    const size_t MB = 1u << 20;
    p.mod = (float*)take((size_t)DEPTH * 2 * 6144 * 4);
    p.lamv = (float*)take(256);
    p.ctr = (unsigned*)take(256);
    p.kn = (unsigned*)take(256);
    p.bar = (unsigned*)take((size_t)(1 + 1024) * 128);
    p.wf = (float*)take(4100 * 4);
    p.binp = (float*)take(NIN * 4);
    p.cstab = (float*)take((size_t)S * 64 * 2 * 4);
    p.logf = (float*)take((size_t)T * 4 * 4);
    p.F = (float*)take((size_t)T * 4 * 4);
    p.WinT = (bf16_t*)take((size_t)NIN * 1024 * 2);
    p.WpaT = (bf16_t*)take((size_t)1024 * 512 * 2);
    p.WpbT = (bf16_t*)take((size_t)1024 * 512 * 2);
    p.WpcT = (bf16_t*)take((size_t)1024 * 1024 * 2);
    p.WoutT = (bf16_t*)take((size_t)1024 * 1024 * 2);
    p.WupT = (bf16_t*)take((size_t)2 * DFF * 1024 * 2);
    p.WdownT = (bf16_t*)take((size_t)1024 * DFF * 2);
    p.xbuf = (float*)take((size_t)T * Dm * 4);
    p.h = (bf16_t*)take((size_t)T * Dm * 2);
    const size_t offA = off;
    p.qa = (bf16_t*)take((size_t)T * 512 * 2); p.ka = (bf16_t*)take((size_t)T * 512 * 2); p.vta = (bf16_t*)take((size_t)T * 512 * 2);
    p.qb = (bf16_t*)take((size_t)T * 512 * 2); p.kb = (bf16_t*)take((size_t)T * 512 * 2); p.vtb = (bf16_t*)take((size_t)T * 512 * 2);
    p.cq = (bf16_t*)take((size_t)T * 512 * 2); p.ck = (bf16_t*)take((size_t)T * 512 * 2);
    p.cv = (bf16_t*)take((size_t)T * 1024 * 2); p.cg = (bf16_t*)take((size_t)T * 1024 * 2);
    p.gates = (bf16_t*)take((size_t)T * 3072 * 2);
    const size_t endA = off;
    p.ug = (bf16_t*)(w + offA);
    p.act = (bf16_t*)(w + offA + (size_t)T * 2 * DFF * 2);
    const size_t offB = endA;
    off = offB;
    p.vbuf = (float*)(w + offB);
    p.oa = p.h;
    p.yb = (bf16_t*)take((size_t)T * 512 * 2);
    p.kv = (bf16_t*)take((size_t)8 * 128 * 256 * 128 * 2);
    p.ckT = (bf16_t*)take((size_t)T * 512 * 2);
    p.ya = (bf16_t*)take((size_t)T * 512 * 2);
    p.yc = (bf16_t*)take((size_t)T * 1024 * 2);
    if (off > ws_size || (size_t)T * 2 * DFF * 2 + (size_t)T * DFF * 2 > endA - offA) {
        fprintf(stderr, "kernel_launch: workspace too small: need %zu MB have %zu MB\n", off / MB, ws_size / MB);
        return;
    }
    (void)hipMemsetAsync(p.bar, 0, (size_t)(1 + 1024) * 128, stream);
    void* args[] = {&p};
    hipError_t e = hipLaunchCooperativeKernel((void*)fwd_kernel, dim3(grid_blocks), dim3(256), args, 0, stream);
    if (e != hipSuccess) fprintf(stderr, "cooperative launch failed: %s (grid %d)\n", hipGetErrorString(e), grid_blocks);
}
```

```cpp
#include <hip/hip_runtime.h>
#include <hip/hip_cooperative_groups.h>
#include <cstdio>
#include <cstdint>
namespace cg = cooperative_groups;

typedef unsigned short bf16_t;
typedef short bf16x8 __attribute__((ext_vector_type(8)));
typedef float f32x4 __attribute__((ext_vector_type(4)));

constexpr int Dm = 1024, NB = 2, S = 8192, T = NB * S, DEPTH = 4, DFF = 2816, DIN = 9220, NIN = 9216;
constexpr float LN_EPS = 1e-5f;
constexpr float LOG2E = 1.4426950408889634f;
#define ALPHA_F 1.681792830507429f

#define DI __device__ __forceinline__
DI int otid() { int t = threadIdx.x; asm volatile("" : "+v"(t)); return t; }
DI int obid() { int b = blockIdx.x; asm volatile("" : "+s"(b)); return b; }

typedef __bf16 hbf2 __attribute__((ext_vector_type(2)));
typedef float f32x2 __attribute__((ext_vector_type(2)));
DI bf16_t f2bf(float x) { return __builtin_bit_cast(unsigned short, (__bf16)x); }
DI float bf2f(bf16_t v) { return __uint_as_float(((unsigned)v) << 16); }
DI float bflo(unsigned w) { return __uint_as_float(w << 16); }
DI float bfhi(unsigned w) { return __uint_as_float(w & 0xffff0000u); }
DI unsigned pack2(float a, float b) { f32x2 v = {a, b}; return __builtin_bit_cast(unsigned, __builtin_convertvector(v, hbf2)); }

struct Params {
    const float *x, *c, *w_ada, *b_ada, *w_in, *b_in, *lq1, *lk1, *lq2, *lk2, *g_diff, *g_ret, *w_pa, *w_pb, *w_pc, *w_out, *ln_g, *ln_b, *w_up, *w_conv, *b_conv, *w_down;
    float* out;
    unsigned* ctr; unsigned* bar; unsigned* kn;
    float *mod, *lamv, *wf, *binp, *cstab, *xbuf, *vbuf, *logf, *F, *oc;
    bf16_t *WinT, *WpaT, *WpbT, *WpcT, *WoutT, *WupT, *WdownT;
    bf16_t *h, *qa, *ka, *vta, *qb, *kb, *vtb, *cq, *ck, *cv, *cg, *gates, *oa, *yb, *ya, *yc, *ug, *act, *ckT, *kv;
};

#define LDS_BARRIER() do { asm volatile("s_waitcnt lgkmcnt(0)" ::: "memory"); __builtin_amdgcn_s_barrier(); asm volatile("" ::: "memory"); } while (0)
constexpr int BM = 128, BN = 128, BK = 64, LDP = BK + 8;
constexpr int SMEM_BYTES = 2 * (BM + BN) * LDP * 2;

DI int win_map(int n) {
    if (n < 3072) return n;
    if (n < 4096) { int r = n - 3072; int seg = r >> 9; r &= 511; int head = r >> 7; int c = r & 127; return 3076 + seg * 512 + head * 128 + (c >> 1) + 64 * (c & 1); }
    return n + 4;
}

DI void convert_tile(const float* __restrict__ src, int ldsrc, bf16_t* __restrict__ dst, int K, int tiles_n, int tile, int kind, float* lds) {
    const int tn = tile % tiles_n, tk = tile / tiles_n;
    const int tx = otid() & 63, ty = otid() >> 6;
    const int n = tn * 64 + tx;
    const int sn = kind == 1 ? win_map(n) : n;
    __syncthreads();
#pragma unroll 4
    for (int r = 0; r < 16; ++r) {
        const int kk = ty * 16 + r;
        lds[kk * 65 + tx] = src[(size_t)(tk * 64 + kk) * ldsrc + sn];
    }
    __syncthreads();
#pragma unroll 4
    for (int r = 0; r < 16; ++r) {
        const int nn = ty * 16 + r;
        dst[(size_t)(tn * 64 + nn) * K + tk * 64 + tx] = f2bf(lds[tx * 65 + nn]);
    }
}

DI void convert_layer(const Params& p, int l, float* lds) {
    const int n_in = 16 * 144, n_pa = 8 * 16, n_pb = 8 * 16, n_pc = 16 * 16, n_out = 16 * 16, n_up = 16 * 88, n_dn = 44 * 16;
    const int total = n_in + n_pa + n_pb + n_pc + n_out + n_up + n_dn;
    for (int it = obid(); it < total; it += gridDim.x) {
        int t = it;
        if (t < n_in) { convert_tile(p.w_in + (size_t)l * Dm * DIN, DIN, p.WinT, 1024, 144, t, 1, lds); continue; } t -= n_in;
        if (t < n_pa) { convert_tile(p.w_pa + (size_t)l * 512 * Dm, Dm, p.WpaT, 512, 16, t, 0, lds); continue; } t -= n_pa;
        if (t < n_pb) { convert_tile(p.w_pb + (size_t)l * 512 * Dm, Dm, p.WpbT, 512, 16, t, 0, lds); continue; } t -= n_pb;
        if (t < n_pc) { convert_tile(p.w_pc + (size_t)l * 1024 * Dm, Dm, p.WpcT, 1024, 16, t, 0, lds); continue; } t -= n_pc;
        if (t < n_out) { convert_tile(p.w_out + (size_t)l * Dm * Dm, Dm, p.WoutT, 1024, 16, t, 0, lds); continue; } t -= n_out;
        if (t < n_up) { convert_tile(p.w_up + (size_t)l * Dm * 2 * DFF, 2 * DFF, p.WupT, 1024, 88, t, 0, lds); continue; } t -= n_up;
        convert_tile(p.w_down + (size_t)l * DFF * Dm, Dm, p.WdownT, DFF, 16, t, 0, lds);
    }
    const int gtid = obid() * blockDim.x + otid(), gsz = gridDim.x * blockDim.x;
    for (int i = gtid; i < NIN; i += gsz) p.binp[i] = p.b_in[(size_t)l * DIN + win_map(i)];
    for (int i = gtid; i < 4096; i += gsz) { const int k = i >> 2, hh = i & 3; p.wf[i] = p.w_in[(size_t)l * Dm * DIN + (size_t)k * DIN + 3072 + hh]; }
    for (int i = gtid; i < 4; i += gsz) p.wf[4096 + i] = p.b_in[(size_t)l * DIN + 3072 + i];
}

DI float ex2(float x) { return __builtin_amdgcn_exp2f(x); }
DI float lg2gamma(int hd) { return hd == 0 ? -0.04580368961312479f : hd == 1 ? -0.02272007650008353f : hd == 2 ? -0.011315313227834146f : -0.005646563141142063f; }
DI float silu_f(float v) { return v / (1.f + __expf(-v)); }
DI float sigmoid_f(float v) { return 1.f / (1.f + __expf(-v)); }

DI void phase0_misc(const Params& p, float* lds) {
    for (int it = obid(); it < DEPTH * 96; it += gridDim.x) {
        const int l = it / 96, jb = it % 96;
        const int tx = otid() & 63, ks = otid() >> 6;
        const int j = jb * 64 + tx;
        const float* w = p.w_ada + (size_t)l * Dm * 6144 + j;
        float a0 = 0.f, a1 = 0.f;
#pragma unroll 8
        for (int k = ks * 256; k < ks * 256 + 256; ++k) {
            const float wv = w[(size_t)k * 6144];
            a0 += silu_f(p.c[k]) * wv; a1 += silu_f(p.c[Dm + k]) * wv;
        }
        __syncthreads();
        lds[(ks * 64 + tx) * 2] = a0; lds[(ks * 64 + tx) * 2 + 1] = a1;
        __syncthreads();
        if (ks == 0) {
            float s0 = 0.f, s1 = 0.f;
            for (int q = 0; q < 4; ++q) { s0 += lds[(q * 64 + tx) * 2]; s1 += lds[(q * 64 + tx) * 2 + 1]; }
            const float bb = p.b_ada[(size_t)l * 6144 + j];
            p.mod[((size_t)l * 2 + 0) * 6144 + j] = s0 + bb;
            p.mod[((size_t)l * 2 + 1) * 6144 + j] = s1 + bb;
        }
    }
    const int gtid = obid() * blockDim.x + otid(), gsz = gridDim.x * blockDim.x;
    if (gtid < 64) p.ctr[gtid] = 0u;
    if (obid() == 0 && otid() < 64 * DEPTH) {
        const int l = otid() >> 6, ln = otid() & 63;
        float a = p.lq1[l * 64 + ln] * p.lk1[l * 64 + ln], b = p.lq2[l * 64 + ln] * p.lk2[l * 64 + ln];
        for (int o = 32; o; o >>= 1) { a += __shfl_xor(a, o); b += __shfl_xor(b, o); }
        if (ln == 0) { const float li = 0.8f - 0.6f * expf(-0.3f * (float)l); p.lamv[2 * l] = expf(a) - expf(b) + li; p.lamv[2 * l + 1] = li; }
    }
}

DI void row_phase(const Params& p, const float* __restrict__ src, bool do_ln, const float* __restrict__ lng, const float* __restrict__ lnb,
                  float* __restrict__ xdst, const float* __restrict__ modl  , int sh_off, int sc_off, bool want_h, bool want_logf) {
    const int lane = otid() & 63, wv = otid() >> 6;
    if (want_logf && obid() == 0 && otid() < 32) p.kn[otid()] = 0u;
    for (int row = obid() * 4 + wv; row < T; row += gridDim.x * 4) {
        const int b = row / S;
        const float* sp = src + (size_t)row * Dm;
        f32x4 v[4];
#pragma unroll
        for (int i = 0; i < 4; ++i) v[i] = *(const f32x4*)(sp + i * 256 + lane * 4);
        if (do_ln) {
            float s = 0.f;
#pragma unroll
            for (int i = 0; i < 4; ++i) s += (v[i][0] + v[i][1]) + (v[i][2] + v[i][3]);
            for (int o = 32; o; o >>= 1) s += __shfl_xor(s, o);
            const float mu = s * (1.f / 1024.f);
            float q = 0.f;
#pragma unroll
            for (int i = 0; i < 4; ++i) { f32x4 d = v[i] - mu; q += (d[0] * d[0] + d[1] * d[1]) + (d[2] * d[2] + d[3] * d[3]); }
            for (int o = 32; o; o >>= 1) q += __shfl_xor(q, o);
            const float rstd = rsqrtf(q * (1.f / 1024.f) + LN_EPS);
#pragma unroll
            for (int i = 0; i < 4; ++i) {
                const f32x4 g = *(const f32x4*)(lng + i * 256 + lane * 4), bb = *(const f32x4*)(lnb + i * 256 + lane * 4);
                v[i] = (v[i] - mu) * rstd * g + bb;
            }
        }
        if (xdst) {
#pragma unroll
            for (int i = 0; i < 4; ++i) *(f32x4*)(xdst + (size_t)row * Dm + i * 256 + lane * 4) = v[i];
        }
        if (want_h) {
            const float* mb = modl + (size_t)b * 6144;
            float d0 = 0.f, d1 = 0.f, d2 = 0.f, d3 = 0.f;
#pragma unroll
            for (int i = 0; i < 4; ++i) {
                const int c0 = i * 256 + lane * 4;
                const f32x4 sc = *(const f32x4*)(mb + sc_off + c0), sh = *(const f32x4*)(mb + sh_off + c0);
                const f32x4 hv = v[i] * (1.f + sc) + sh;
                uint2 w; w.x = pack2(hv[0], hv[1]); w.y = pack2(hv[2], hv[3]);
                *(uint2*)(p.h + (size_t)row * Dm + c0) = w;
                if (want_logf) {
#pragma unroll
                    for (int j = 0; j < 4; ++j) {
                        const f32x4 wf = *(const f32x4*)(p.wf + (c0 + j) * 4);
                        d0 += hv[j] * wf[0]; d1 += hv[j] * wf[1]; d2 += hv[j] * wf[2]; d3 += hv[j] * wf[3];
                    }
                }
            }
            if (want_logf) {
                for (int o = 32; o; o >>= 1) { d0 += __shfl_xor(d0, o); d1 += __shfl_xor(d1, o); d2 += __shfl_xor(d2, o); d3 += __shfl_xor(d3, o); }
                if (lane < 4) {
                    float z = (lane == 0 ? d0 : lane == 1 ? d1 : lane == 2 ? d2 : d3) + p.wf[4096 + lane];
                    const float ls = fminf(z, 0.f) - log1pf(__expf(-fabsf(z)));
                    p.logf[(size_t)row * 4 + lane] = ls * LOG2E;
                }
            }
        }
    }
}

DI void scan_item(const Params& p, int item, float* lds) {
    const int b = item >> 2, hh = item & 3, tid = otid();
    const float* lp = p.logf + (size_t)b * S * 4 + hh;
    float loc[32]; float s = 0.f;
#pragma unroll
    for (int i = 0; i < 32; ++i) { s += lp[(size_t)(tid * 32 + i) * 4]; loc[i] = s; }
    __syncthreads();
    lds[tid] = s;
    __syncthreads();
    float pre = 0.f;
    for (int i = 0; i < tid; ++i) pre += lds[i];
    float* fp = p.F + (size_t)(b * 4 + hh) * S + tid * 32;
#pragma unroll
    for (int i = 0; i < 32; ++i) fp[i] = pre + loc[i];
    __syncthreads();
}

DI void gemm_kloop(const bf16_t* __restrict__ Ag, int lda, const bf16_t* __restrict__ Bg, int ldb, int K, f32x4 (&acc)[4][4], bf16_t* sm) {
    const int tid = otid(), lane = tid & 63, wid = tid >> 6, wr = wid >> 1, wc = wid & 1;
    bf16_t* sa = sm; bf16_t* sb = sm + 2 * BM * LDP;
    const int lrow = tid >> 3, lcc = tid & 7;
    const bf16_t* ap = Ag + (size_t)lrow * lda + lcc * 8;
    const bf16_t* bp = Bg + (size_t)lrow * ldb + lcc * 8;
    const size_t sA = (size_t)32 * lda, sB = (size_t)32 * ldb;
    uint4 ra0, ra1, ra2, ra3, rb0, rb1, rb2, rb3;
#define G_LOAD(koff) do { ra0 = *(const uint4*)(ap + (koff)); ra1 = *(const uint4*)(ap + sA + (koff)); ra2 = *(const uint4*)(ap + 2 * sA + (koff)); ra3 = *(const uint4*)(ap + 3 * sA + (koff)); \
                          rb0 = *(const uint4*)(bp + (koff)); rb1 = *(const uint4*)(bp + sB + (koff)); rb2 = *(const uint4*)(bp + 2 * sB + (koff)); rb3 = *(const uint4*)(bp + 3 * sB + (koff)); } while (0)
#define G_STORE(buf) do { bf16_t* da_ = sa + (buf) * BM * LDP + lrow * LDP + lcc * 8; bf16_t* db_ = sb + (buf) * BN * LDP + lrow * LDP + lcc * 8; \
        *(uint4*)(da_) = ra0; *(uint4*)(da_ + 32 * LDP) = ra1; *(uint4*)(da_ + 64 * LDP) = ra2; *(uint4*)(da_ + 96 * LDP) = ra3; \
        *(uint4*)(db_) = rb0; *(uint4*)(db_ + 32 * LDP) = rb1; *(uint4*)(db_ + 64 * LDP) = rb2; *(uint4*)(db_ + 96 * LDP) = rb3; } while (0)
    G_LOAD(0);
    G_STORE(0);
    LDS_BARRIER();
    const int nk = K / BK;
    const int fr = lane & 15, fq = lane >> 4;
    for (int kt = 0; kt < nk; ++kt) {
        const int cur = kt & 1;
        const bool more = kt + 1 < nk;
        if (more) G_LOAD((kt + 1) * BK);
        const bf16_t* ca = sa + cur * BM * LDP + (wr * 64 + fr) * LDP + fq * 8;
        const bf16_t* cb = sb + cur * BN * LDP + (wc * 64 + fr) * LDP + fq * 8;
#pragma unroll
        for (int kk = 0; kk < 2; ++kk) {
            bf16x8 af[4], bfr[4];
#pragma unroll
            for (int m = 0; m < 4; ++m) af[m] = *(const bf16x8*)(ca + m * 16 * LDP + kk * 32);
#pragma unroll
            for (int n = 0; n < 4; ++n) bfr[n] = *(const bf16x8*)(cb + n * 16 * LDP + kk * 32);
#pragma unroll
            for (int m = 0; m < 4; ++m)
#pragma unroll
                for (int n = 0; n < 4; ++n) acc[m][n] = __builtin_amdgcn_mfma_f32_16x16x32_bf16(bfr[n], af[m], acc[m][n], 0, 0, 0);
        }
        if (more) G_STORE(cur ^ 1);
        LDS_BARRIER();
    }
#undef G_LOAD
#undef G_STORE
}

DI void gemm_kloop2(const bf16_t* __restrict__ Ag, int lda, const bf16_t* __restrict__ Bg, int ldb, int K, f32x4 (&acc)[4][4], bf16_t* sm) {
    const int tid = otid(), lane = tid & 63, wid = tid >> 6, wr = wid >> 1, wc = wid & 1;
    bf16_t* sa = sm; bf16_t* sb = sm + 2 * BM * LDP;
    const int lrow = tid >> 3, lcc = tid & 7;
    const bf16_t* ap = Ag + (size_t)lrow * lda + lcc * 8;
    const bf16_t* bp = Bg + (size_t)lrow * ldb + lcc * 8;
    const size_t sA = (size_t)32 * lda, sB = (size_t)32 * ldb;
    uint4 xa0, xa1, xa2, xa3, xb0, xb1, xb2, xb3;
    uint4 ya0, ya1, ya2, ya3, yb0, yb1, yb2, yb3;
#define G2_LOAD(P, koff) do { P##a0 = *(const uint4*)(ap + (koff)); P##a1 = *(const uint4*)(ap + sA + (koff)); P##a2 = *(const uint4*)(ap + 2 * sA + (koff)); P##a3 = *(const uint4*)(ap + 3 * sA + (koff)); \
                              P##b0 = *(const uint4*)(bp + (koff)); P##b1 = *(const uint4*)(bp + sB + (koff)); P##b2 = *(const uint4*)(bp + 2 * sB + (koff)); P##b3 = *(const uint4*)(bp + 3 * sB + (koff)); } while (0)
#define G2_STORE(P, buf) do { bf16_t* da_ = sa + (buf) * BM * LDP + lrow * LDP + lcc * 8; bf16_t* db_ = sb + (buf) * BN * LDP + lrow * LDP + lcc * 8; \
        *(uint4*)(da_) = P##a0; *(uint4*)(da_ + 32 * LDP) = P##a1; *(uint4*)(da_ + 64 * LDP) = P##a2; *(uint4*)(da_ + 96 * LDP) = P##a3; \
        *(uint4*)(db_) = P##b0; *(uint4*)(db_ + 32 * LDP) = P##b1; *(uint4*)(db_ + 64 * LDP) = P##b2; *(uint4*)(db_ + 96 * LDP) = P##b3; } while (0)
#define G2_COMPUTE(buf) do { \
        const bf16_t* ca = sa + (buf) * BM * LDP + (wr * 64 + fr) * LDP + fq * 8; \
        const bf16_t* cb = sb + (buf) * BN * LDP + (wc * 64 + fr) * LDP + fq * 8; \
        _Pragma("unroll") for (int kk = 0; kk < 2; ++kk) { \
            bf16x8 af[4], bfr[4]; \
            _Pragma("unroll") for (int m = 0; m < 4; ++m) af[m] = *(const bf16x8*)(ca + m * 16 * LDP + kk * 32); \
            _Pragma("unroll") for (int n = 0; n < 4; ++n) bfr[n] = *(const bf16x8*)(cb + n * 16 * LDP + kk * 32); \
            _Pragma("unroll") for (int m = 0; m < 4; ++m) _Pragma("unroll") for (int n = 0; n < 4; ++n) acc[m][n] = __builtin_amdgcn_mfma_f32_16x16x32_bf16(bfr[n], af[m], acc[m][n], 0, 0, 0); \
        } } while (0)
    const int nk = K / BK;
    const int fr = lane & 15, fq = lane >> 4;
    G2_LOAD(x, 0);
    G2_LOAD(y, BK);
    G2_STORE(x, 0);
    LDS_BARRIER();
    for (int kt = 0; kt < nk; kt += 2) {
        const int kx = kt + 2 < nk ? kt + 2 : nk - 2, ky = kt + 3 < nk ? kt + 3 : nk - 1;
        G2_LOAD(x, kx * BK);
        __builtin_amdgcn_sched_barrier(0);
        G2_COMPUTE(0);
        G2_STORE(y, 1);
        LDS_BARRIER();
        G2_LOAD(y, ky * BK);
        __builtin_amdgcn_sched_barrier(0);
        G2_COMPUTE(1);
        G2_STORE(x, 0);
        LDS_BARRIER();
    }
#undef G2_LOAD
#undef G2_STORE
#undef G2_COMPUTE
}

DI void tile_coords(int tile, int nM, int nN, int& mt, int& nt) {
    const int G = gridDim.x;
    if ((G & 7) == 0 && (nM & 63) == 0 && (nM * nN) % G == 0) {
        const int b = tile % G, k = tile / G, per = G >> 3;
        const int xcd = b & 7, slot = b >> 3;
        const int li = k * per + slot;
        const int mh = li / (8 * nN), rem = li % (8 * nN);
        nt = rem >> 3; mt = (mh * 8 + (rem & 7)) * 8 + xcd;
        return;
    }
    const int band = tile / (16 * nN), r = tile % (16 * nN);
    mt = band * 16 + (r & 15); nt = r >> 4;
}

DI void zero_acc(f32x4 (&acc)[4][4]) {
#pragma unroll
    for (int m = 0; m < 4; ++m)
#pragma unroll
        for (int n = 0; n < 4; ++n) acc[m][n] = (f32x4){0.f, 0.f, 0.f, 0.f};
}


constexpr int BM2 = 256, BK2 = 32, LDP2 = BK2 + 8;
DI void gemm_kloop3(const bf16_t* __restrict__ Ag, int lda, const bf16_t* __restrict__ Bg, int ldb, int K, f32x4 (&acc)[8][4], bf16_t* sm) {
    const int tid = otid(), lane = tid & 63, wid = tid >> 6, wr = wid >> 1, wc = wid & 1;
    bf16_t* sa = sm; bf16_t* sb = sm + 2 * BM2 * LDP2;
    const int lrow = tid >> 2, lcc = tid & 3;
    const bf16_t* ap = Ag + (size_t)lrow * lda + lcc * 8;
    const int prow = ((lrow >> 2) & 3) * 16 + (lrow >> 4) * 4 + (lrow & 3);
    const bf16_t* bp = Bg + (size_t)prow * ldb + lcc * 8;
    const size_t sA = (size_t)64 * lda, sB = (size_t)64 * ldb;
    const int fr = lane & 15, fq = lane >> 4;
    uint4 a0, a1, a2, a3, b0, b1;
#define G3_LOAD(koff) do { a0 = *(const uint4*)(ap + (koff)); a1 = *(const uint4*)(ap + sA + (koff)); a2 = *(const uint4*)(ap + 2 * sA + (koff)); a3 = *(const uint4*)(ap + 3 * sA + (koff)); \
                           b0 = *(const uint4*)(bp + (koff)); b1 = *(const uint4*)(bp + sB + (koff)); } while (0)
#define G3_STORE(buf) do { bf16_t* da_ = sa + (buf) * BM2 * LDP2 + lrow * LDP2 + lcc * 8; bf16_t* db_ = sb + (buf) * BN * LDP2 + lrow * LDP2 + lcc * 8; \
        *(uint4*)(da_) = a0; *(uint4*)(da_ + 64 * LDP2) = a1; *(uint4*)(da_ + 128 * LDP2) = a2; *(uint4*)(da_ + 192 * LDP2) = a3; \
        *(uint4*)(db_) = b0; *(uint4*)(db_ + 64 * LDP2) = b1; } while (0)
    G3_LOAD(0);
    G3_STORE(0);
    LDS_BARRIER();
    const int nk = K / BK2;
    for (int kt = 0; kt < nk; ++kt) {
        const int cur = kt & 1;
        const bool more = kt + 1 < nk;
        if (more) G3_LOAD((kt + 1) * BK2);
        const bf16_t* ca = sa + cur * BM2 * LDP2 + (wr * 128 + fr) * LDP2 + fq * 8;
        const bf16_t* cb = sb + cur * BN * LDP2 + (wc * 64 + fr) * LDP2 + fq * 8;
        bf16x8 af[8], bfr[4];
#pragma unroll
        for (int m = 0; m < 8; ++m) af[m] = *(const bf16x8*)(ca + m * 16 * LDP2);
#pragma unroll
        for (int n = 0; n < 4; ++n) bfr[n] = *(const bf16x8*)(cb + n * 16 * LDP2);
        __builtin_amdgcn_s_setprio(1);
#pragma unroll
        for (int m = 0; m < 8; ++m)
#pragma unroll
            for (int n = 0; n < 4; ++n) acc[m][n] = __builtin_amdgcn_mfma_f32_16x16x32_bf16(bfr[n], af[m], acc[m][n], 0, 0, 0);
        __builtin_amdgcn_s_setprio(0);
        if (more) G3_STORE(cur ^ 1);
        LDS_BARRIER();
    }
#undef G3_LOAD
#undef G3_STORE
}
DI void zero_acc8(f32x4 (&acc)[8][4]) {
#pragma unroll
    for (int m = 0; m < 8; ++m)
#pragma unroll
        for (int n = 0; n < 4; ++n) acc[m][n] = (f32x4){0.f, 0.f, 0.f, 0.f};
}
DI void st4_wt(bf16_t* dst, f32x4 v) { const unsigned long long w = (unsigned long long)pack2(v[0], v[1]) | ((unsigned long long)pack2(v[2], v[3]) << 32); __hip_atomic_store((unsigned long long*)dst, w, __ATOMIC_RELAXED, __HIP_MEMORY_SCOPE_AGENT); }
DI void st4(bf16_t* dst, f32x4 v) { uint2 w; w.x = pack2(v[0], v[1]); w.y = pack2(v[2], v[3]); *(uint2*)dst = w; }

DI void st8(bf16_t* dst, f32x4 a, f32x4 b) { uint4 w; w.x = pack2(a[0], a[1]); w.y = pack2(a[2], a[3]); w.z = pack2(b[0], b[1]); w.w = pack2(b[2], b[3]); *(uint4*)dst = w; }
DI f32x4 rot4(f32x4 v, int s, int i0) {
    const float a0 = (float)s * ex2(-(float)i0 * 0.21091607f), a1 = (float)s * ex2(-(float)(i0 + 1) * 0.21091607f);
    float r0 = a0 * 0.15915494309189535f, r1 = a1 * 0.15915494309189535f;
    r0 -= floorf(r0); r1 -= floorf(r1);
    float c0_ = __builtin_amdgcn_cosf(r0), s0_ = __builtin_amdgcn_sinf(r0), c1_ = __builtin_amdgcn_cosf(r1), s1_ = __builtin_amdgcn_sinf(r1);
    asm volatile("s_nop 15\n\ts_nop 15" : "+v"(c0_), "+v"(s0_), "+v"(c1_), "+v"(s1_));
    f32x4 o; o[0] = v[0] * c0_ - v[1] * s0_; o[1] = v[0] * s0_ + v[1] * c0_; o[2] = v[2] * c1_ - v[3] * s1_; o[3] = v[2] * s1_ + v[3] * c1_;
    return o;
}
DI void epi_inproj(const Params& p, int row, int col, f32x4 v0, f32x4 v1) {
    v0 += *(const f32x4*)(p.binp + col); v1 += *(const f32x4*)(p.binp + col + 4);
    const int b = row / S, s = row % S;
    if (col < 512) { st8(p.qa + (size_t)row * 512 + col, v0 * (0.125f * LOG2E), v1 * (0.125f * LOG2E)); }
    else if (col < 1024) { st8(p.ka + (size_t)row * 512 + (col - 512), v0, v1); }
    else if (col < 1536) { const int c = col - 1024, hh = c >> 7, e = c & 127; bf16_t* d = p.vta + ((size_t)(b * 4 + hh) * 128 + e) * S + s;
#pragma unroll
        for (int j = 0; j < 4; ++j) { d[(size_t)j * S] = f2bf(v0[j]); d[(size_t)(j + 4) * S] = f2bf(v1[j]); } }
    else if (col < 2048) { st8(p.qb + (size_t)row * 512 + (col - 1536), v0 * (0.08838834764831845f * LOG2E), v1 * (0.08838834764831845f * LOG2E)); }
    else if (col < 2560) {
        st8(p.kb + (size_t)row * 512 + (col - 2048), v0, v1);
        float ss = 0.f;
#pragma unroll
        for (int j = 0; j < 4; ++j) { const float x0 = bf2f(f2bf(v0[j])), x1 = bf2f(f2bf(v1[j])); ss += x0 * x0 + x1 * x1; }
        ss += __shfl_xor(ss, 16); ss += __shfl_xor(ss, 32);
#pragma unroll
        for (int o = 8; o; o >>= 1) ss = fmaxf(ss, __shfl_xor(ss, o));
        const int c = col - 2048, grp = ((c >> 6) & 1) * 2 + ((c >> 3) & 1);
        if ((otid() & 63) == 0) atomicMax(p.kn + (b * 4 + (c >> 7)) * 4 + grp, __float_as_uint(ss));
    }
    else if (col < 3072) { const int c = col - 2560, hh = c >> 7, e = c & 127; bf16_t* d = p.vtb + ((size_t)(b * 4 + hh) * 128 + e) * S + s;
#pragma unroll
        for (int j = 0; j < 4; ++j) { d[(size_t)j * S] = f2bf(v0[j]); d[(size_t)(j + 4) * S] = f2bf(v1[j]); } }
    else if (col < 4096) {
        const int r = col - 3072, seg = r >> 9, c = r & 511, cc = c & 127, i0 = cc >> 1, hd = c >> 7;
        f32x4 o0 = rot4(v0, s, i0), o1 = rot4(v1, s, i0 + 2);
        const float lg = lg2gamma(hd);
        const int ic = s & 63;
        float e1_ = ex2(lg * (float)(ic + 1)), e2_ = ex2(-lg * (float)(ic + 1)), e3_ = ex2(lg * (float)(63 - ic));
        asm volatile("s_nop 15\n\ts_nop 15" : "+v"(e1_), "+v"(e2_), "+v"(e3_));
        if (seg == 0) st8(p.cq + (size_t)row * 512 + c, o0 * e1_, o1 * e1_);
        else {
            o0 = o0 * 0.08838834764831845f; o1 = o1 * 0.08838834764831845f;
            st8(p.ck + (size_t)row * 512 + c, o0 * e2_, o1 * e2_);
            const f32x4 d0 = o0 * e3_, d1 = o1 * e3_;
            bf16_t* d = p.ckT + ((size_t)(b * 4 + hd) * 128 + cc) * S + s;
#pragma unroll
            for (int j = 0; j < 4; ++j) { d[(size_t)j * S] = f2bf(d0[j]); d[(size_t)(j + 4) * S] = f2bf(d1[j]); }
        }
    }
    else if (col < 5120) { const int c = col - 4096; bf16_t* d = p.cv + ((size_t)b * 1024 + c) * S + s;
#pragma unroll
        for (int j = 0; j < 4; ++j) { d[(size_t)j * S] = f2bf(v0[j]); d[(size_t)(j + 4) * S] = f2bf(v1[j]); } }
    else if (col < 6144) { f32x4 o0, o1; for (int j = 0; j < 4; ++j) { o0[j] = silu_f(v0[j]); o1[j] = silu_f(v1[j]); } st8(p.cg + (size_t)row * 1024 + (col - 5120), o0, o1); }
    else { f32x4 o0, o1; for (int j = 0; j < 4; ++j) { o0[j] = sigmoid_f(v0[j]); o1[j] = sigmoid_f(v1[j]); } st8(p.gates + (size_t)row * 3072 + (col - 6144), o0, o1); }
}

DI void phase_inproj(const Params& p, bf16_t* sm) {
    const int nM = T / BM2, nN = NIN / BN;
    const int lane = otid() & 63, wid = otid() >> 6, wr = wid >> 1, wc = wid & 1;
    for (int tile = obid(); tile < nM * nN; tile += gridDim.x) {
        int mt, nt; tile_coords(tile, nM, nN, mt, nt);
        f32x4 acc[8][4]; zero_acc8(acc);
        gemm_kloop3(p.h + (size_t)mt * BM2 * Dm, Dm, p.WinT + (size_t)nt * BN * Dm, Dm, Dm, acc, sm);
#pragma unroll
        for (int m = 0; m < 8; ++m)
#pragma unroll
            for (int n2 = 0; n2 < 2; ++n2) epi_inproj(p, mt * BM2 + wr * 128 + m * 16 + (lane & 15), nt * BN + wc * 64 + (lane >> 4) * 16 + n2 * 8, acc[m][2 * n2], acc[m][2 * n2 + 1]);
    }
}

DI void phase_branch(const Params& p, bf16_t* sm) {
    const int nM = T / BM, nN = Dm / BN;
    const int lane = otid() & 63, wid = otid() >> 6, wr = wid >> 1, wc = wid & 1;
    for (int tile = obid(); tile < nM * nN; tile += gridDim.x) {
        int mt, nt; tile_coords(tile, nM, nN, mt, nt);
        f32x4 tot[4][4]; zero_acc(tot);
#pragma unroll 1
        for (int br = 0; br < 3; ++br) {
            const bf16_t* A = br == 0 ? p.ya : br == 1 ? p.yb : p.yc;
            const bf16_t* W = br == 0 ? p.WpaT : br == 1 ? p.WpbT : p.WpcT;
            const int K = br == 2 ? 1024 : 512;
            f32x4 acc[4][4]; zero_acc(acc);
            gemm_kloop(A + (size_t)mt * BM * K, K, W + (size_t)nt * BN * K, K, K, acc, sm);
#pragma unroll
            for (int m = 0; m < 4; ++m)
#pragma unroll
                for (int n = 0; n < 4; ++n) {
                    const int row = mt * BM + wr * 64 + m * 16 + (lane & 15), col = nt * BN + wc * 64 + n * 16 + (lane >> 4) * 4;
                    const uint2 g = *(const uint2*)(p.gates + (size_t)row * 3072 + br * 1024 + col);
                    tot[m][n][0] += bflo(g.x) * acc[m][n][0]; tot[m][n][1] += bfhi(g.x) * acc[m][n][1];
                    tot[m][n][2] += bflo(g.y) * acc[m][n][2]; tot[m][n][3] += bfhi(g.y) * acc[m][n][3];
                }
        }
#pragma unroll
        for (int m = 0; m < 4; ++m)
#pragma unroll
            for (int n = 0; n < 4; ++n) {
                const int row = mt * BM + wr * 64 + m * 16 + (lane & 15), col = nt * BN + wc * 64 + n * 16 + (lane >> 4) * 4;
                st4(p.h + (size_t)row * Dm + col, tot[m][n]);
            }
    }
}

DI void phase_gemm_res(const Params& p, const bf16_t* A, int K, const bf16_t* Wt, const float* xres, const float* modl, int gt_off, bf16_t* sm) {
    const int nM = T / BM2, nN = Dm / BN;
    const int lane = otid() & 63, wid = otid() >> 6, wr = wid >> 1, wc = wid & 1;
    for (int tile = obid(); tile < nM * nN; tile += gridDim.x) {
        int mt, nt; tile_coords(tile, nM, nN, mt, nt);
        f32x4 acc[8][4]; zero_acc8(acc);
        gemm_kloop3(A + (size_t)mt * BM2 * K, K, Wt + (size_t)nt * BN * K, K, K, acc, sm);
#pragma unroll
        for (int m = 0; m < 8; ++m)
#pragma unroll
            for (int n = 0; n < 4; ++n) {
                const int row = mt * BM2 + wr * 128 + m * 16 + (lane & 15), col = nt * BN + wc * 64 + (lane >> 4) * 16 + n * 4;
                const int b = row / S;
                const f32x4 xr = *(const f32x4*)(xres + (size_t)row * Dm + col);
                const f32x4 gt = *(const f32x4*)(modl + (size_t)b * 6144 + gt_off + col);
                *(f32x4*)(p.vbuf + (size_t)row * Dm + col) = xr * ALPHA_F + gt * acc[m][n];
            }
    }
}

DI void phase_up(const Params& p, bf16_t* sm) {
    const int nM = T / BM2, nN = 2 * DFF / BN;
    const int lane = otid() & 63, wid = otid() >> 6, wr = wid >> 1, wc = wid & 1;
    for (int tile = obid(); tile < nM * nN; tile += gridDim.x) {
        int mt, nt; tile_coords(tile, nM, nN, mt, nt);
        f32x4 acc[8][4]; zero_acc8(acc);
        gemm_kloop3(p.h + (size_t)mt * BM2 * Dm, Dm, p.WupT + (size_t)nt * BN * Dm, Dm, Dm, acc, sm);
#pragma unroll
        for (int m = 0; m < 8; ++m)
#pragma unroll
            for (int n2 = 0; n2 < 2; ++n2) {
                const int row = mt * BM2 + wr * 128 + m * 16 + (lane & 15), col = nt * BN + wc * 64 + (lane >> 4) * 16 + n2 * 8;
                st8(p.ug + (size_t)row * (2 * DFF) + col, acc[m][2 * n2], acc[m][2 * n2 + 1]);
            }
    }
}

DI void phase_conv(const Params& p, int l) {
    const int gtid = obid() * blockDim.x + otid(), gsz = gridDim.x * blockDim.x;
    const float* wc = p.w_conv + (size_t)l * 3 * DFF; const float* bc = p.b_conv + (size_t)l * DFF;
    for (int i = gtid; i < T * (DFF / 8); i += gsz) {
        const int row = i / (DFF / 8), c8 = (i % (DFF / 8)) * 8, s = row % S;
        const bf16_t* up = p.ug + (size_t)row * (2 * DFF) + c8;
        const uint4 u0 = *(const uint4*)up;
        uint4 u1 = make_uint4(0, 0, 0, 0), u2 = make_uint4(0, 0, 0, 0);
        if (s >= 1) u1 = *(const uint4*)(up - 2 * DFF);
        if (s >= 2) u2 = *(const uint4*)(up - 4 * DFF);
        const uint4 gg = *(const uint4*)(up + DFF);
        const unsigned a0[4] = {u0.x, u0.y, u0.z, u0.w}, a1[4] = {u1.x, u1.y, u1.z, u1.w}, a2[4] = {u2.x, u2.y, u2.z, u2.w}, ag[4] = {gg.x, gg.y, gg.z, gg.w};
        float cv[8], t[8], e[8];
#pragma unroll
        for (int h4 = 0; h4 < 2; ++h4) {
            const f32x4 w0 = *(const f32x4*)(wc + c8 + 4 * h4), w1 = *(const f32x4*)(wc + DFF + c8 + 4 * h4), w2 = *(const f32x4*)(wc + 2 * DFF + c8 + 4 * h4), bb = *(const f32x4*)(bc + c8 + 4 * h4);
#pragma unroll
            for (int k = 0; k < 4; ++k) {
                const int j = 2 * h4 + (k >> 1); const bool hi = k & 1;
                const float x0 = hi ? bfhi(a0[j]) : bflo(a0[j]), x1 = hi ? bfhi(a1[j]) : bflo(a1[j]), x2 = hi ? bfhi(a2[j]) : bflo(a2[j]);
                cv[4 * h4 + k] = bb[k] + w0[k] * x2 + w1[k] * x1 + w2[k] * x0;
            }
        }
#pragma unroll
        for (int k = 0; k < 8; ++k) { t[k] = __builtin_amdgcn_rcpf(fabsf(cv[k]) * 0.2316418882f + 1.0f); e[k] = ex2(cv[k] * cv[k] * (-0.72134752044f)); }
        asm volatile("s_nop 15\n\ts_nop 15" : "+v"(t[0]), "+v"(t[1]), "+v"(t[2]), "+v"(t[3]), "+v"(t[4]), "+v"(t[5]), "+v"(t[6]), "+v"(t[7]));
        asm volatile("s_nop 3" : "+v"(e[0]), "+v"(e[1]), "+v"(e[2]), "+v"(e[3]), "+v"(e[4]), "+v"(e[5]), "+v"(e[6]), "+v"(e[7]));
        unsigned o[4];
#pragma unroll
        for (int j = 0; j < 4; ++j) {
            float rr[2];
#pragma unroll
            for (int hl = 0; hl < 2; ++hl) {
                const int k = 2 * j + hl;
                float q = t[k] * 0.5307027145f + (-0.7265760135f); q = q * t[k] + 0.7107068705f; q = q * t[k] + (-0.142248368f); q = q * t[k] + 0.127414796f; q = q * t[k];
                const float m = cv[k] * (q * e[k]);
                const float gl = cv[k] < 0.f ? m : cv[k] - m;
                rr[hl] = gl * (hl ? bfhi(ag[j]) : bflo(ag[j]));
            }
            o[j] = pack2(rr[0], rr[1]);
        }
        *(uint4*)(p.act + (size_t)row * DFF + c8) = make_uint4(o[0], o[1], o[2], o[3]);
    }
}

template <int MODE>
DI void naive_attn(const Params& p, int item) {
    constexpr int D = MODE == 0 ? 64 : 128;
    constexpr int DV = MODE == 2 ? 256 : 128;
    constexpr int SW = DV / 4;
    constexpr int NH = MODE == 0 ? 8 : 4;
    const int tid = otid(), lane = tid & 63;
    const int sl = __builtin_amdgcn_readfirstlane(tid >> 6);
    const int qblk = 127 - (item % 128), hh = (item / 128) % NH, b = item / (128 * NH);
    const int q = qblk * 64 + lane; const size_t tq = (size_t)b * S + q;
    const bf16_t *Q, *Kp;
    if (MODE == 0) { Q = p.qa + tq * 512 + hh * 64; Kp = p.ka + (size_t)b * S * 512 + hh * 64; }
    else if (MODE == 1) { Q = p.qb + tq * 512 + hh * 128; Kp = p.kb + (size_t)b * S * 512 + hh * 128; }
    else { Q = p.cq + tq * 512 + hh * 128; Kp = p.ck + (size_t)b * S * 512 + hh * 128; }
    unsigned qp[D / 2];
#pragma unroll
    for (int i = 0; i < D / 8; ++i) { const uint4 t = ((const uint4*)Q)[i]; qp[4 * i] = t.x; qp[4 * i + 1] = t.y; qp[4 * i + 2] = t.z; qp[4 * i + 3] = t.w; }
    float acc[SW];
#pragma unroll
    for (int i = 0; i < SW; ++i) acc[i] = 0.f;
    float mx = -INFINITY, lsum = 0.f;
    const int send = (qblk + 1) * 64;
    float Fq = 0.f; const float* Fk = nullptr;
    if (MODE == 1) { Fk = p.F + (size_t)(b * 4 + hh) * S; Fq = Fk[q]; }
    float lg = 0.f;
    if (MODE == 2) lg = log2f(1.0f - exp2f(-5.0f - (float)hh));
    for (int s = 0; s < send; ++s) {
        const uint4* kr = (const uint4*)(Kp + (size_t)s * 512);
        float sc = 0.f;
#pragma unroll
        for (int i = 0; i < D / 8; ++i) {
            const uint4 kv = kr[i];
            sc += bflo(qp[4 * i]) * bflo(kv.x) + bfhi(qp[4 * i]) * bfhi(kv.x);
            sc += bflo(qp[4 * i + 1]) * bflo(kv.y) + bfhi(qp[4 * i + 1]) * bfhi(kv.y);
            sc += bflo(qp[4 * i + 2]) * bflo(kv.z) + bfhi(qp[4 * i + 2]) * bfhi(kv.z);
            sc += bflo(qp[4 * i + 3]) * bflo(kv.w) + bfhi(qp[4 * i + 3]) * bfhi(kv.w);
            if ((i & 3) == 3) asm volatile("" ::: "memory");
        }
        float w, corr = 1.f;
        if (MODE == 2) {
            w = (s <= q) ? sc * exp2f((float)(q - s) * lg) : 0.f;
        } else {
            if (MODE == 1) sc += Fq - Fk[s];
            const bool valid = (MODE == 0) || (s <= q);
            if (valid) {
                const float mn = fmaxf(mx, sc);
                corr = exp2f(mx - mn); w = exp2f(sc - mn); mx = mn;
                lsum = lsum * corr + w;
            } else { w = 0.f; }
        }
        if (MODE == 2) {
            const uint4* vr = (const uint4*)(p.cv + ((size_t)b * S + s) * 1024 + hh * 256 + sl * SW);
#pragma unroll
            for (int i = 0; i < SW / 8; ++i) {
                const uint4 vv = vr[i];
                acc[8 * i] += w * bflo(vv.x); acc[8 * i + 1] += w * bfhi(vv.x); acc[8 * i + 2] += w * bflo(vv.y); acc[8 * i + 3] += w * bfhi(vv.y);
                acc[8 * i + 4] += w * bflo(vv.z); acc[8 * i + 5] += w * bfhi(vv.z); acc[8 * i + 6] += w * bflo(vv.w); acc[8 * i + 7] += w * bfhi(vv.w);
            }
        } else {
            const bf16_t* vt = (MODE == 0 ? p.vta + ((size_t)(b * 4 + (hh >> 1)) * 128 + sl * SW) * S : p.vtb + ((size_t)(b * 4 + hh) * 128 + sl * SW) * S) + s;
#pragma unroll
            for (int i = 0; i < SW; ++i) { acc[i] = acc[i] * corr + w * bf2f(*vt); vt += S; asm volatile("" : "+v"(vt)); }
        }
    }
    if (MODE == 2) {
        float* o = p.oc + tq * 1024 + hh * 256 + sl * SW;
#pragma unroll
        for (int i = 0; i < SW / 4; ++i) *(f32x4*)(o + 4 * i) = (f32x4){acc[4 * i], acc[4 * i + 1], acc[4 * i + 2], acc[4 * i + 3]};
    } else {
        const float inv = 1.f / lsum;
        bf16_t* o = (MODE == 0 ? p.oa + tq * 1024 + hh * 128 : p.yb + tq * 512 + hh * 128) + sl * SW;
#pragma unroll
        for (int i = 0; i < SW / 8; ++i) {
            uint4 w4; w4.x = pack2(acc[8 * i] * inv, acc[8 * i + 1] * inv); w4.y = pack2(acc[8 * i + 2] * inv, acc[8 * i + 3] * inv);
            w4.z = pack2(acc[8 * i + 4] * inv, acc[8 * i + 5] * inv); w4.w = pack2(acc[8 * i + 6] * inv, acc[8 * i + 7] * inv);
            ((uint4*)o)[i] = w4;
        }
    }
}


typedef float f32x16 __attribute__((ext_vector_type(16)));
DI bf16x8 pack8(float a0, float a1, float a2, float a3, float a4, float a5, float a6, float a7) {
    typedef unsigned u32x4 __attribute__((ext_vector_type(4)));
    u32x4 w; w[0] = pack2(a0, a1); w[1] = pack2(a2, a3); w[2] = pack2(a4, a5); w[3] = pack2(a6, a7);
    return __builtin_bit_cast(bf16x8, w);
}

template <int MODE>
DI void flash_item(const Params& p, int b, int hh, int qi, unsigned char* smem) {
    constexpr int D = MODE == 0 ? 64 : 128, KST = D + 8, VST = 68, KS = D / 16;
    constexpr int KBYTES = 64 * KST * 2, VBYTES = 128 * VST * 2, BUFB = KBYTES + VBYTES + 256;
    constexpr int NKC = D / 32, CPR = D / 8;
    const int tid = otid(), lane = tid & 63, w = tid >> 6, r = lane & 31, hf = lane >> 5;
    const int q0 = qi * 128 + w * 32;
    const size_t tq = (size_t)b * S + q0 + r;
    bf16x8 qf[KS];
    {
        const bf16_t* qptr = (MODE == 0 ? p.qa + tq * 512 + hh * 64 : p.qb + tq * 512 + hh * 128) + hf * 8;
#pragma unroll
        for (int ks = 0; ks < KS; ++ks) qf[ks] = *(const bf16x8*)(qptr + ks * 16);
    }
    const float* fbase = p.F + (size_t)(b * 4 + (MODE == 1 ? hh : 0)) * S;
    float Fq = 0.f; if (MODE == 1) Fq = fbase[q0 + r];
    const bf16_t* kbase = MODE == 0 ? p.ka + (size_t)b * S * 512 + hh * 64 : p.kb + (size_t)b * S * 512 + hh * 128;
    const bf16_t* vbase = MODE == 0 ? p.vta + (size_t)(b * 4 + (hh >> 1)) * 128 * S : p.vtb + (size_t)(b * 4 + hh) * 128 * S;
    const int ntiles = 2 * qi + 2, wlast = 2 * qi + (w >> 1);
    uint4 kr0 = make_uint4(0, 0, 0, 0), kr1 = kr0, kr2 = kr0, kr3 = kr0, vr0 = kr0, vr1 = kr0, vr2 = kr0, vr3 = kr0; f32x4 frg = {0.f, 0.f, 0.f, 0.f};
#define FL_K(i_, jx) (*(const uint4*)(kbase + (size_t)(64 * (jx) + (tid + 256 * (i_)) / CPR) * 512 + ((tid + 256 * (i_)) % CPR) * 8))
#define FL_V(i_, jx) (*(const uint4*)(vbase + (size_t)((tid + 256 * (i_)) >> 3) * S + 64 * (jx) + ((tid + 256 * (i_)) & 7) * 8))
#define FL_GLOAD(jx) do { kr0 = FL_K(0, jx); kr1 = FL_K(1, jx); if (NKC == 4) { kr2 = FL_K(2, jx); kr3 = FL_K(3, jx); } \
        vr0 = FL_V(0, jx); vr1 = FL_V(1, jx); vr2 = FL_V(2, jx); vr3 = FL_V(3, jx); \
        if (MODE == 1 && tid < 16) frg = *(const f32x4*)(fbase + 64 * (jx) + tid * 4); } while (0)
#define FL_KS(i_, reg) (*(uint4*)(B_ + (((tid + 256 * (i_)) / CPR) * KST + ((tid + 256 * (i_)) % CPR) * 8) * 2) = (reg))
#define FL_VS(i_, reg) do { uint2* d_ = (uint2*)(B_ + KBYTES + (((tid + 256 * (i_)) >> 3) * VST + ((tid + 256 * (i_)) & 7) * 8) * 2); d_[0] = make_uint2((reg).x, (reg).y); d_[1] = make_uint2((reg).z, (reg).w); } while (0)
#define FL_SSTORE(buf) do { unsigned char* B_ = smem + (buf) * BUFB; FL_KS(0, kr0); FL_KS(1, kr1); if (NKC == 4) { FL_KS(2, kr2); FL_KS(3, kr3); } \
        FL_VS(0, vr0); FL_VS(1, vr1); FL_VS(2, vr2); FL_VS(3, vr3); \
        if (MODE == 1 && tid < 16) *(f32x4*)(B_ + KBYTES + VBYTES + tid * 16) = frg; } while (0)
    FL_GLOAD(MODE == 1 ? ntiles - 1 : 0);
    FL_SSTORE(0);
    LDS_BARRIER();
    f32x16 acc[4];
#pragma unroll
    for (int eb = 0; eb < 4; ++eb)
#pragma unroll
        for (int i = 0; i < 16; ++i) acc[eb][i] = 0.f;
    float mrun = -INFINITY, lsum = 0.f;
    unsigned* donef = (unsigned*)(smem + SMEM_BYTES - 64);
    float qk_bound = 0.f, Fq0 = 0.f;
    if (MODE == 1) {
        float qs = 0.f;
#pragma unroll
        for (int ks = 0; ks < KS; ++ks)
#pragma unroll
            for (int e = 0; e < 8; ++e) { const float x = bf2f((bf16_t)qf[ks][e]); qs += x * x; }
        qs += __shfl_xor(qs, 32);
#pragma unroll
        for (int o = 16; o; o >>= 1) qs = fmaxf(qs, __shfl_xor(qs, o));
        const unsigned* kn = p.kn + (b * 4 + hh) * 4;
        const float k2 = __uint_as_float(kn[0]) + __uint_as_float(kn[1]) + __uint_as_float(kn[2]) + __uint_as_float(kn[3]);
        qk_bound = sqrtf(qs) * sqrtf(k2) * 1.0001f + 1e-3f;
        Fq0 = __shfl(Fq, 0);
        if (lane == 0) donef[w] = 0u;
    }
    for (int it = 0; it < ntiles; ++it) {
        const int j = MODE == 1 ? ntiles - 1 - it : it;
        const bool more = it + 1 < ntiles;
        if (more) FL_GLOAD(MODE == 1 ? j - 1 : j + 1);
        if (j <= wlast) {
            const unsigned char* B = smem + (it & 1) * BUFB;
            f32x16 st[2];
#pragma unroll
            for (int kb = 0; kb < 2; ++kb) {
#pragma unroll
                for (int i = 0; i < 16; ++i) st[kb][i] = 0.f;
#pragma unroll
                for (int ks = 0; ks < KS; ++ks) {
                    const bf16x8 a = *(const bf16x8*)(B + ((kb * 32 + r) * KST + ks * 16 + hf * 8) * 2);
                    st[kb] = __builtin_amdgcn_mfma_f32_32x32x16_bf16(a, qf[ks], st[kb], 0, 0, 0);
                }
            }
            if (MODE == 1) {
                const float* Fl = (const float*)(B + KBYTES + VBYTES);
#pragma unroll
                for (int kb = 0; kb < 2; ++kb)
#pragma unroll
                    for (int g = 0; g < 4; ++g) {
                        const f32x4 fk = *(const f32x4*)(Fl + kb * 32 + 8 * g + 4 * hf);
#pragma unroll
                        for (int jj = 0; jj < 4; ++jj) st[kb][4 * g + jj] += Fq - fk[jj];
                    }
                if (j >= 2 * qi) {
                    const int qabs = q0 + r;
#pragma unroll
                    for (int kb = 0; kb < 2; ++kb)
#pragma unroll
                        for (int g = 0; g < 4; ++g)
#pragma unroll
                            for (int jj = 0; jj < 4; ++jj) { const int key = 64 * j + kb * 32 + 8 * g + 4 * hf + jj; if (key > qabs) st[kb][4 * g + jj] = -INFINITY; }
                }
            }
            float mt = st[0][0];
#pragma unroll
            for (int i = 1; i < 16; ++i) mt = fmaxf(mt, st[0][i]);
#pragma unroll
            for (int i = 0; i < 16; ++i) mt = fmaxf(mt, st[1][i]);
            mt = fmaxf(mt, __shfl_xor(mt, 32));
            if (!(MODE == 1 && __all(mt < mrun - 40.0f))) {
            const float mn = fmaxf(mrun, mt);
            const float corr = ex2(mrun - mn);
            mrun = mn; lsum *= corr;
#pragma unroll
            for (int kb = 0; kb < 2; ++kb)
#pragma unroll
                for (int i = 0; i < 16; ++i) { const float pv = ex2(st[kb][i] - mn); st[kb][i] = pv; lsum += pv; }
#pragma unroll
            for (int eb = 0; eb < 4; ++eb) acc[eb] *= corr;
#pragma unroll
            for (int kb = 0; kb < 2; ++kb)
#pragma unroll
                for (int s2 = 0; s2 < 2; ++s2) {
                    const bf16x8 pf = pack8(st[kb][8 * s2], st[kb][8 * s2 + 1], st[kb][8 * s2 + 2], st[kb][8 * s2 + 3], st[kb][8 * s2 + 4], st[kb][8 * s2 + 5], st[kb][8 * s2 + 6], st[kb][8 * s2 + 7]);
#pragma unroll
                    for (int eb = 0; eb < 4; ++eb) {
                        const unsigned char* vp = B + KBYTES + ((eb * 32 + r) * VST + kb * 32 + 16 * s2 + 4 * hf) * 2;
                        const uint2 lo = *(const uint2*)vp, hi = *(const uint2*)(vp + 16);
                        typedef unsigned u32x4 __attribute__((ext_vector_type(4)));
                        u32x4 av; av[0] = lo.x; av[1] = lo.y; av[2] = hi.x; av[3] = hi.y;
                        acc[eb] = __builtin_amdgcn_mfma_f32_32x32x16_bf16(__builtin_bit_cast(bf16x8, av), pf, acc[eb], 0, 0, 0);
                    }
                }
            }
        }
        if (MODE == 1 && j <= wlast) {
            const float* Fl0 = (const float*)(smem + (it & 1) * BUFB + KBYTES + VBYTES);
            float mmin = mrun;
#pragma unroll
            for (int o = 16; o; o >>= 1) mmin = fminf(mmin, __shfl_xor(mmin, o));
            if (lane == 0 && qk_bound + (Fq0 - Fl0[0]) < mmin - 40.0f) donef[w] = 1u;
        }
        if (more) FL_SSTORE((it + 1) & 1);
        LDS_BARRIER();
        if (MODE == 1 && (donef[0] & donef[1] & donef[2] & donef[3])) break;
    }
#undef FL_GLOAD
#undef FL_SSTORE
#undef FL_K
#undef FL_V
#undef FL_KS
#undef FL_VS
    const float inv = 1.f / (lsum + __shfl_xor(lsum, 32));
    bf16_t* o = MODE == 0 ? p.oa + tq * 1024 + hh * 128 : p.yb + tq * 512 + hh * 128;
#pragma unroll
    for (int eb = 0; eb < 4; ++eb)
#pragma unroll
        for (int g = 0; g < 4; ++g) {
            f32x4 v = {acc[eb][4 * g] * inv, acc[eb][4 * g + 1] * inv, acc[eb][4 * g + 2] * inv, acc[eb][4 * g + 3] * inv};
            st4(o + eb * 32 + 8 * g + 4 * hf, v);
        }
}


DI void ret_state_item(const Params& p, int item) {
    const int n = item & 127, bh = item >> 7;
    const int tid = otid(), lane = tid & 63, w = tid >> 6, r = lane & 31, hf = lane >> 5;
    const bf16_t* kt = p.ckT + (size_t)bh * 128 * S + n * 64 + hf * 8;
    const bf16_t* vt = p.cv + ((size_t)bh * 256 + w * 64) * S + n * 64 + hf * 8;
    f32x16 acc[4][2];
#pragma unroll
    for (int a = 0; a < 4; ++a)
#pragma unroll
        for (int c = 0; c < 2; ++c)
#pragma unroll
            for (int i = 0; i < 16; ++i) acc[a][c][i] = 0.f;
#pragma unroll
    for (int s4 = 0; s4 < 4; ++s4) {
        bf16x8 af[4], bfr[2];
#pragma unroll
        for (int a = 0; a < 4; ++a) af[a] = *(const bf16x8*)(kt + (size_t)(a * 32 + r) * S + s4 * 16);
#pragma unroll
        for (int c = 0; c < 2; ++c) bfr[c] = *(const bf16x8*)(vt + (size_t)(c * 32 + r) * S + s4 * 16);
#pragma unroll
        for (int a = 0; a < 4; ++a)
#pragma unroll
            for (int c = 0; c < 2; ++c) acc[a][c] = __builtin_amdgcn_mfma_f32_32x32x16_bf16(af[a], bfr[c], acc[a][c], 0, 0, 0);
    }
    bf16_t* o = p.kv + ((size_t)(bh * 128 + n) * 256 + w * 64) * 128;
#pragma unroll
    for (int a = 0; a < 4; ++a)
#pragma unroll
        for (int c = 0; c < 2; ++c)
#pragma unroll
            for (int g = 0; g < 4; ++g) {
                f32x4 v = {acc[a][c][4 * g], acc[a][c][4 * g + 1], acc[a][c][4 * g + 2], acc[a][c][4 * g + 3]};
                st4_wt(o + (size_t)(c * 32 + r) * 128 + a * 32 + 8 * g + 4 * hf, v);
            }
}

DI void ret_scan(const Params& p) {
    const int gtid = obid() * 256 + otid(), gsz = gridDim.x * 256;
    for (int e = gtid; e < 8 * 8192; e += gsz) {
        const int bh = e >> 13, pi = e & 8191, hd = bh & 3;
        const float dec = ex2(64.0f * lg2gamma(hd));
        unsigned long long* ptr = (unsigned long long*)p.kv + (size_t)bh * 128 * 8192 + pi;
        float c0 = 0.f, c1 = 0.f, c2 = 0.f, c3 = 0.f;
        for (int n0 = 0; n0 < 128; n0 += 8) {
            unsigned long long v[8];
#pragma unroll
            for (int k = 0; k < 8; ++k) v[k] = ptr[(size_t)(n0 + k) * 8192];
            asm volatile("s_waitcnt vmcnt(0)" ::: "memory");
#pragma unroll
            for (int k = 0; k < 8; ++k) {
                const unsigned long long o = (unsigned long long)pack2(c0, c1) | ((unsigned long long)pack2(c2, c3) << 32);
                __hip_atomic_store(ptr + (size_t)(n0 + k) * 8192, o, __ATOMIC_RELAXED, __HIP_MEMORY_SCOPE_AGENT);
                const unsigned lo = (unsigned)v[k], hi = (unsigned)(v[k] >> 32);
                c0 = c0 * dec + bflo(lo); c1 = c1 * dec + bfhi(lo); c2 = c2 * dec + bflo(hi); c3 = c3 * dec + bfhi(hi);
            }
        }
    }
}

DI void ret_out_item(const Params& p, int l, int item, unsigned char* smem) {
    const int n = item & 127, bh = item >> 7, b = bh >> 2, hd = bh & 3;
    const int tid = otid(), lane = tid & 63, w = tid >> 6, r = lane & 31, hf = lane >> 5;
    const size_t t0 = (size_t)b * S + n * 64;
    f32x16 acc[2][2];
#pragma unroll
    for (int a = 0; a < 2; ++a)
#pragma unroll
        for (int c = 0; c < 2; ++c)
#pragma unroll
            for (int i = 0; i < 16; ++i) acc[a][c][i] = 0.f;
    bf16x8 pf[2][2][2];
    typedef unsigned u32x4 __attribute__((ext_vector_type(4)));
    bf16x8 qf[2][8], rf[2][8];
    uint2 vlo[2][2][2], vhi[2][2][2];
    {
        const bf16_t* rt = p.kv + ((size_t)(bh * 128 + n) * 256 + w * 64) * 128 + hf * 8;
#pragma unroll
        for (int qb = 0; qb < 2; ++qb)
#pragma unroll
            for (int ks = 0; ks < 8; ++ks) qf[qb][ks] = *(const bf16x8*)(p.cq + (t0 + qb * 32 + r) * 512 + hd * 128 + ks * 16 + hf * 8);
#pragma unroll
        for (int dvb = 0; dvb < 2; ++dvb)
#pragma unroll
            for (int ks = 0; ks < 8; ++ks) rf[dvb][ks] = *(const bf16x8*)(rt + (size_t)(dvb * 32 + r) * 128 + ks * 16);
    }
    __builtin_amdgcn_sched_barrier(0);
#pragma unroll
    for (int dvb = 0; dvb < 2; ++dvb)
#pragma unroll
        for (int ks = 0; ks < 8; ++ks)
#pragma unroll
            for (int qb = 0; qb < 2; ++qb) acc[dvb][qb] = __builtin_amdgcn_mfma_f32_32x32x16_bf16(rf[dvb][ks], qf[qb][ks], acc[dvb][qb], 0, 0, 0);
#pragma unroll
    for (int kb = 0; kb < 2; ++kb)
#pragma unroll
        for (int ks = 0; ks < 8; ++ks) rf[kb][ks] = *(const bf16x8*)(p.ck + (t0 + kb * 32 + r) * 512 + hd * 128 + ks * 16 + hf * 8);
    __builtin_amdgcn_sched_barrier(0);
#pragma unroll
    for (int kb = 0; kb < 2; ++kb) {
        f32x16 st[2];
#pragma unroll
        for (int qb = 0; qb < 2; ++qb)
#pragma unroll
            for (int i = 0; i < 16; ++i) st[qb][i] = 0.f;
#pragma unroll
        for (int ks = 0; ks < 8; ++ks)
#pragma unroll
            for (int qb = 0; qb < 2; ++qb) st[qb] = __builtin_amdgcn_mfma_f32_32x32x16_bf16(rf[kb][ks], qf[qb][ks], st[qb], 0, 0, 0);
#pragma unroll
        for (int qb = 0; qb < 2; ++qb) {
#pragma unroll
            for (int i = 0; i < 16; ++i) { const int key = kb * 32 + (i & 3) + 8 * (i >> 2) + 4 * hf; if (key > qb * 32 + r) st[qb][i] = 0.f; }
#pragma unroll
            for (int s2 = 0; s2 < 2; ++s2)
                pf[kb][s2][qb] = pack8(st[qb][8 * s2], st[qb][8 * s2 + 1], st[qb][8 * s2 + 2], st[qb][8 * s2 + 3], st[qb][8 * s2 + 4], st[qb][8 * s2 + 5], st[qb][8 * s2 + 6], st[qb][8 * s2 + 7]);
        }
    }
    {
        const bf16_t* vt = p.cv + ((size_t)bh * 256 + w * 64) * S + n * 64 + 4 * hf;
#pragma unroll
        for (int dvb = 0; dvb < 2; ++dvb)
#pragma unroll
            for (int kb = 0; kb < 2; ++kb)
#pragma unroll
                for (int s2 = 0; s2 < 2; ++s2) {
                    const bf16_t* vp = vt + (size_t)(dvb * 32 + r) * S + kb * 32 + 16 * s2;
                    vlo[dvb][kb][s2] = *(const uint2*)vp; vhi[dvb][kb][s2] = *(const uint2*)(vp + 8);
                }
    }
    __builtin_amdgcn_sched_barrier(0);
#pragma unroll
    for (int dvb = 0; dvb < 2; ++dvb)
#pragma unroll
        for (int kb = 0; kb < 2; ++kb)
#pragma unroll
            for (int s2 = 0; s2 < 2; ++s2) {
                u32x4 av; av[0] = vlo[dvb][kb][s2].x; av[1] = vlo[dvb][kb][s2].y; av[2] = vhi[dvb][kb][s2].x; av[3] = vhi[dvb][kb][s2].y;
                const bf16x8 a = __builtin_bit_cast(bf16x8, av);
#pragma unroll
                for (int qb = 0; qb < 2; ++qb) acc[dvb][qb] = __builtin_amdgcn_mfma_f32_32x32x16_bf16(a, pf[kb][s2][qb], acc[dvb][qb], 0, 0, 0);
            }
    float* red = (float*)smem;
    float mu[2], rstd[2];
    __syncthreads();
#pragma unroll
    for (int qb = 0; qb < 2; ++qb) {
        float s1 = 0.f, s2 = 0.f;
#pragma unroll
        for (int dvb = 0; dvb < 2; ++dvb)
#pragma unroll
            for (int i = 0; i < 16; ++i) { const float x = acc[dvb][qb][i]; s1 += x; s2 += x * x; }
        s1 += __shfl_xor(s1, 32); s2 += __shfl_xor(s2, 32);
        if (hf == 0) { red[(w * 64 + qb * 32 + r) * 2] = s1; red[(w * 64 + qb * 32 + r) * 2 + 1] = s2; }
    }
    __syncthreads();
#pragma unroll
    for (int qb = 0; qb < 2; ++qb) {
        float s1 = 0.f, s2 = 0.f;
#pragma unroll
        for (int ww = 0; ww < 4; ++ww) { s1 += red[(ww * 64 + qb * 32 + r) * 2]; s2 += red[(ww * 64 + qb * 32 + r) * 2 + 1]; }
        const float m_ = s1 * (1.f / 256.f);
        mu[qb] = m_; rstd[qb] = rsqrtf(fmaxf(s2 * (1.f / 256.f) - m_ * m_, 0.f) + LN_EPS);
    }
    const float* gr = p.g_ret + (size_t)l * 1024 + hd * 256 + w * 64;
#pragma unroll
    for (int dvb = 0; dvb < 2; ++dvb)
#pragma unroll
        for (int g = 0; g < 4; ++g) {
            const int dv = dvb * 32 + 8 * g + 4 * hf;
            const f32x4 gg = *(const f32x4*)(gr + dv);
#pragma unroll
            for (int qb = 0; qb < 2; ++qb) {
                const size_t off = (t0 + qb * 32 + r) * 1024 + hd * 256 + w * 64 + dv;
                const uint2 cgv = *(const uint2*)(p.cg + off);
                f32x4 y;
#pragma unroll
                for (int jj = 0; jj < 4; ++jj) y[jj] = (acc[dvb][qb][4 * g + jj] - mu[qb]) * rstd[qb] * gg[jj];
                y[0] *= bflo(cgv.x); y[1] *= bfhi(cgv.x); y[2] *= bflo(cgv.y); y[3] *= bfhi(cgv.y);
                st4(p.yc + off, y);
            }
        }
}

DI void phase_mixers(const Params& p, int l, unsigned char* smem) {
    const int nF = 64 * 24, nC = 2 * 4 * 128;
    int* sitem = (int*)(smem + SMEM_BYTES - 16);
    for (;;) {
        __syncthreads();
        if (otid() == 0) *sitem = (int)atomicAdd(p.ctr + l, 1u);
        __syncthreads();
        const int it = *sitem;
        if (it >= nF + nC) break;
        if (it < nF) {
            const int qi = 63 - it / 24, r = it % 24;
            if (r < 8) flash_item<1>(p, r >> 2, r & 3, qi, smem);
            else flash_item<0>(p, (r - 8) >> 3, (r - 8) & 7, qi, smem);
        } else ret_state_item(p, it - nF);
    }
}

DI void phase_mixers_naive(const Params& p) {
    const int nA = 2 * 8 * 128, nB = 2 * 4 * 128, nC = 2 * 4 * 128;
    for (int it = obid(); it < nA + nB + nC; it += gridDim.x) {
        if (it < nB) naive_attn<1>(p, it);
        else if (it < nB + nC) naive_attn<2>(p, it - nB);
        else naive_attn<0>(p, it - nB - nC);
    }
}

DI void phase_post(const Params& p, int l) {
    const int lane = otid() & 63, wv = otid() >> 6;
    const float lam = p.lamv[2 * l], li = p.lamv[2 * l + 1];
    const float* gd = p.g_diff + (size_t)l * 512; const float* gr = p.g_ret + (size_t)l * 1024;
    for (int row = obid() * 4 + wv; row < T; row += gridDim.x * 4) {
#pragma unroll
        for (int hh = 0; hh < 4; ++hh) {
            const unsigned o0 = *(const unsigned*)(p.oa + (size_t)row * 1024 + (2 * hh) * 128 + lane * 2);
            const unsigned o1 = *(const unsigned*)(p.oa + (size_t)row * 1024 + (2 * hh + 1) * 128 + lane * 2);
            const float d0 = bflo(o0) - lam * bflo(o1), d1 = bfhi(o0) - lam * bfhi(o1);
            float ss = d0 * d0 + d1 * d1;
            for (int o = 32; o; o >>= 1) ss += __shfl_xor(ss, o);
            const float r = rsqrtf(ss * (1.f / 128.f) + LN_EPS) * (1.f - li);
            const int c = hh * 128 + lane * 2;
            *(unsigned*)(p.ya + (size_t)row * 512 + c) = pack2(d0 * r * gd[c], d1 * r * gd[c + 1]);
        }
    }
}

DI void grid_bar(unsigned* bar, unsigned& epoch) {
    asm volatile("s_waitcnt vmcnt(0) lgkmcnt(0)" ::: "memory");
    __syncthreads();
    epoch += 1;
    const int tid = otid();
    unsigned* go = bar;
    unsigned* flags = bar + 32;
    if (tid == 0) {
        __builtin_amdgcn_fence(__ATOMIC_RELEASE, "agent");
        asm volatile("s_waitcnt vmcnt(0)" ::: "memory");
        __hip_atomic_store(flags + 32 * obid(), epoch, __ATOMIC_RELAXED, __HIP_MEMORY_SCOPE_AGENT);
    }
    if (obid() == 0 && tid < 64) {
        const int nb = gridDim.x;
        for (int base = 0; base < nb; base += 64) {
            const int idx = base + tid;
            if (idx < nb) while (__hip_atomic_load(flags + 32 * idx, __ATOMIC_RELAXED, __HIP_MEMORY_SCOPE_AGENT) < epoch) __builtin_amdgcn_s_sleep(1);
        }
        asm volatile("s_waitcnt vmcnt(0)" ::: "memory");
        if (tid == 0) __hip_atomic_store(go, epoch, __ATOMIC_RELAXED, __HIP_MEMORY_SCOPE_AGENT);
    }
    if (tid == 0) {
        while (__hip_atomic_load(go, __ATOMIC_RELAXED, __HIP_MEMORY_SCOPE_AGENT) < epoch) __builtin_amdgcn_s_sleep(1);
        __builtin_amdgcn_fence(__ATOMIC_ACQUIRE, "agent");
        asm volatile("s_waitcnt vmcnt(0)" ::: "memory");
    }
    __syncthreads();
}
#define GSYNC() grid_bar(p.bar, epoch)
__global__ void __launch_bounds__(256, 2) fwd_kernel(Params p) {
    __shared__ __attribute__((aligned(16))) unsigned char smem[SMEM_BYTES];
    cg::grid_group grid = cg::this_grid();
    bf16_t* sm = (bf16_t*)smem; float* smf = (float*)smem;

    unsigned epoch = 0;
    asm volatile("s_waitcnt vmcnt(0) lgkmcnt(0)" ::: "memory"); grid.sync();
    convert_layer(p, 0, smf);
    phase0_misc(p, smf);
    GSYNC();
    row_phase(p, p.x, false, nullptr, nullptr, nullptr, p.mod, 0, 1024, true, true);
    GSYNC();
    for (int l = 0; l < DEPTH; ++l) {
        const float* modl = p.mod + (size_t)l * 2 * 6144;
        const float* xcur = l == 0 ? p.x : p.xbuf;
        if (obid() >= gridDim.x - 8) scan_item(p, obid() - (gridDim.x - 8), smf);
        phase_inproj(p, sm);
        GSYNC();
        phase_mixers(p, l, smem);
        GSYNC();
        phase_post(p, l);
        ret_scan(p);
        GSYNC();
        for (int it = obid(); it < 1024; it += gridDim.x) ret_out_item(p, l, it, smem);
        GSYNC();
        phase_branch(p, sm);
        GSYNC();
        phase_gemm_res(p, p.h, 1024, p.WoutT, xcur, modl, 2048, sm);
        GSYNC();
        row_phase(p, p.vbuf, true, p.ln_g + (size_t)(l * 2) * Dm, p.ln_b + (size_t)(l * 2) * Dm, p.xbuf, modl, 3072, 4096, true, false);
        GSYNC();
        phase_up(p, sm);
        GSYNC();
        phase_conv(p, l);
        GSYNC();
        phase_gemm_res(p, p.act, DFF, p.WdownT, p.xbuf, modl, 5120, sm);
        GSYNC();
        if (l + 1 < DEPTH) {
            convert_layer(p, l + 1, smf);
            GSYNC();
            row_phase(p, p.vbuf, true, p.ln_g + (size_t)(l * 2 + 1) * Dm, p.ln_b + (size_t)(l * 2 + 1) * Dm, p.xbuf, modl + 2 * 6144, 0, 1024, true, true);
            GSYNC();
        } else {
            row_phase(p, p.vbuf, true, p.ln_g + (size_t)(l * 2 + 1) * Dm, p.ln_b + (size_t)(l * 2 + 1) * Dm, p.out, modl, 0, 1024, false, false);
        }
    }
}

extern "C" void kernel_launch(void* const* d_in, const int* in_sizes, int n_in, void* d_out, int out_size, void* d_ws, size_t ws_size, hipStream_t stream) {
    static int grid_blocks = 0;
    if (!grid_blocks) {
        int dev = 0, cus = 0, per_cu = 0;
        hipGetDevice(&dev);
        hipDeviceGetAttribute(&cus, hipDeviceAttributeMultiprocessorCount, dev);
        hipOccupancyMaxActiveBlocksPerMultiprocessor(&per_cu, fwd_kernel, 256, 0);
        if (per_cu > 2) per_cu = 2;
        if (per_cu < 1) per_cu = 1;
        grid_blocks = cus * per_cu;
    }
    Params p{};
    const float** ins = (const float**)&p.x;
    for (int i = 0; i < 22; ++i) ins[i] = (const float*)d_in[i];
    p.out = (float*)d_out;
    char* w = (char*)d_ws; size_t off = 0;
    auto take = [&](size_t bytes) { char* r = w + off; off += (bytes + 255) & ~(size_t)255; return r; };
    const size_t MB = 1u << 20;
    p.mod = (float*)take((size_t)DEPTH * 2 * 6144 * 4);
    p.lamv = (float*)take(256);
    p.ctr = (unsigned*)take(256);
    p.kn = (unsigned*)take(256);
    p.bar = (unsigned*)take((size_t)(1 + 1024) * 128);
    p.wf = (float*)take(4100 * 4);
    p.binp = (float*)take(NIN * 4);
    p.cstab = (float*)take((size_t)S * 64 * 2 * 4);
    p.logf = (float*)take((size_t)T * 4 * 4);
    p.F = (float*)take((size_t)T * 4 * 4);
    p.WinT = (bf16_t*)take((size_t)NIN * 1024 * 2);
    p.WpaT = (bf16_t*)take((size_t)1024 * 512 * 2);
    p.WpbT = (bf16_t*)take((size_t)1024 * 512 * 2);
    p.WpcT = (bf16_t*)take((size_t)1024 * 1024 * 2);
    p.WoutT = (bf16_t*)take((size_t)1024 * 1024 * 2);
    p.WupT = (bf16_t*)take((size_t)2 * DFF * 1024 * 2);
    p.WdownT = (bf16_t*)take((size_t)1024 * DFF * 2);
    p.xbuf = (float*)take((size_t)T * Dm * 4);
    p.h = (bf16_t*)take((size_t)T * Dm * 2);
    const size_t offA = off;
    p.qa = (bf16_t*)take((size_t)T * 512 * 2); p.ka = (bf16_t*)take((size_t)T * 512 * 2); p.vta = (bf16_t*)take((size_t)T * 512 * 2);
    p.qb = (bf16_t*)take((size_t)T * 512 * 2); p.kb = (bf16_t*)take((size_t)T * 512 * 2); p.vtb = (bf16_t*)take((size_t)T * 512 * 2);
    p.cq = (bf16_t*)take((size_t)T * 512 * 2); p.ck = (bf16_t*)take((size_t)T * 512 * 2);
    p.cv = (bf16_t*)take((size_t)T * 1024 * 2); p.cg = (bf16_t*)take((size_t)T * 1024 * 2);
    p.gates = (bf16_t*)take((size_t)T * 3072 * 2);
    const size_t endA = off;
    p.ug = (bf16_t*)(w + offA);
    p.act = (bf16_t*)(w + offA + (size_t)T * 2 * DFF * 2);
    const size_t offB = endA;
    off = offB;
    p.vbuf = (float*)(w + offB);
    p.oa = p.h;
    p.yb = (bf16_t*)take((size_t)T * 512 * 2);
    p.kv = (bf16_t*)take((size_t)8 * 128 * 256 * 128 * 2);
    p.ckT = (bf16_t*)take((size_t)T * 512 * 2);
    p.ya = (bf16_t*)take((size_t)T * 512 * 2);
    p.yc = (bf16_t*)take((size_t)T * 1024 * 2);
    if (off > ws_size || (size_t)T * 2 * DFF * 2 + (size_t)T * DFF * 2 > endA - offA) {
        fprintf(stderr, "kernel_launch: workspace too small: need %zu MB have %zu MB\n", off / MB, ws_size / MB);
        return;
    }
    (void)hipMemsetAsync(p.bar, 0, (size_t)(1 + 1024) * 128, stream);
    void* args[] = {&p};
    hipError_t e = hipLaunchCooperativeKernel((void*)fwd_kernel, dim3(grid_blocks), dim3(256), args, 0, stream);
    if (e != hipSuccess) fprintf(stderr, "cooperative launch failed: %s (grid %d)\n", hipGetErrorString(e), grid_blocks);
}
```

```cpp
#include <hip/hip_runtime.h>
#include <hip/hip_cooperative_groups.h>
#include <cstdio>
#include <cstdint>
namespace cg = cooperative_groups;

typedef unsigned short bf16_t;
typedef short bf16x8 __attribute__((ext_vector_type(8)));
typedef float f32x4 __attribute__((ext_vector_type(4)));

constexpr int Dm = 1024, NB = 2, S = 8192, T = NB * S, DEPTH = 4, DFF = 2816, DIN = 9220, NIN = 9216;
constexpr float LN_EPS = 1e-5f;
constexpr float LOG2E = 1.4426950408889634f;
#define ALPHA_F 1.681792830507429f

#define DI __device__ __forceinline__
DI int otid() { int t = threadIdx.x; asm volatile("" : "+v"(t)); return t; }
DI int obid() { int b = blockIdx.x; asm volatile("" : "+s"(b)); return b; }

typedef __bf16 hbf2 __attribute__((ext_vector_type(2)));
typedef float f32x2 __attribute__((ext_vector_type(2)));
DI bf16_t f2bf(float x) { return __builtin_bit_cast(unsigned short, (__bf16)x); }
DI float bf2f(bf16_t v) { return __uint_as_float(((unsigned)v) << 16); }
DI float bflo(unsigned w) { return __uint_as_float(w << 16); }
DI float bfhi(unsigned w) { return __uint_as_float(w & 0xffff0000u); }
DI unsigned pack2(float a, float b) { f32x2 v = {a, b}; return __builtin_bit_cast(unsigned, __builtin_convertvector(v, hbf2)); }

struct Params {
    const float *x, *c, *w_ada, *b_ada, *w_in, *b_in, *lq1, *lk1, *lq2, *lk2, *g_diff, *g_ret, *w_pa, *w_pb, *w_pc, *w_out, *ln_g, *ln_b, *w_up, *w_conv, *b_conv, *w_down;
    float* out;
    unsigned* ctr; unsigned* bar; unsigned* kn;
    float *mod, *lamv, *wf, *binp, *cstab, *xbuf, *vbuf, *logf, *F, *oc;
    bf16_t *WinT, *WpaT, *WpbT, *WpcT, *WoutT, *WupT, *WdownT;
    bf16_t *h, *qa, *ka, *vta, *qb, *kb, *vtb, *cq, *ck, *cv, *cg, *gates, *oa, *yb, *ya, *yc, *ug, *act, *ckT, *kv;
};

#define LDS_BARRIER() do { asm volatile("s_waitcnt lgkmcnt(0)" ::: "memory"); __builtin_amdgcn_s_barrier(); asm volatile("" ::: "memory"); } while (0)
constexpr int BM = 128, BN = 128, BK = 64, LDP = BK + 8;
constexpr int SMEM_BYTES = 2 * (BM + BN) * LDP * 2;

DI int win_map(int n) {
    if (n < 3072) return n;
    if (n < 4096) { int r = n - 3072; int seg = r >> 9; r &= 511; int head = r >> 7; int c = r & 127; return 3076 + seg * 512 + head * 128 + (c >> 1) + 64 * (c & 1); }
    return n + 4;
}

DI void convert_tile(const float* __restrict__ src, int ldsrc, bf16_t* __restrict__ dst, int K, int tiles_n, int tile, int kind, float* lds) {
    const int tn = tile % tiles_n, tk = tile / tiles_n;
    const int tx = otid() & 63, ty = otid() >> 6;
    const int n = tn * 64 + tx;
    const int sn = kind == 1 ? win_map(n) : n;
    __syncthreads();
#pragma unroll 4
    for (int r = 0; r < 16; ++r) {
        const int kk = ty * 16 + r;
        lds[kk * 65 + tx] = src[(size_t)(tk * 64 + kk) * ldsrc + sn];
    }
    __syncthreads();
#pragma unroll 4
    for (int r = 0; r < 16; ++r) {
        const int nn = ty * 16 + r;
        dst[(size_t)(tn * 64 + nn) * K + tk * 64 + tx] = f2bf(lds[tx * 65 + nn]);
    }
}

DI void convert_layer(const Params& p, int l, float* lds) {
    const int n_in = 16 * 144, n_pa = 8 * 16, n_pb = 8 * 16, n_pc = 16 * 16, n_out = 16 * 16, n_up = 16 * 88, n_dn = 44 * 16;
    const int total = n_in + n_pa + n_pb + n_pc + n_out + n_up + n_dn;
    for (int it = obid(); it < total; it += gridDim.x) {
        int t = it;
        if (t < n_in) { convert_tile(p.w_in + (size_t)l * Dm * DIN, DIN, p.WinT, 1024, 144, t, 1, lds); continue; } t -= n_in;
        if (t < n_pa) { convert_tile(p.w_pa + (size_t)l * 512 * Dm, Dm, p.WpaT, 512, 16, t, 0, lds); continue; } t -= n_pa;
        if (t < n_pb) { convert_tile(p.w_pb + (size_t)l * 512 * Dm, Dm, p.WpbT, 512, 16, t, 0, lds); continue; } t -= n_pb;
        if (t < n_pc) { convert_tile(p.w_pc + (size_t)l * 1024 * Dm, Dm, p.WpcT, 1024, 16, t, 0, lds); continue; } t -= n_pc;
        if (t < n_out) { convert_tile(p.w_out + (size_t)l * Dm * Dm, Dm, p.WoutT, 1024, 16, t, 0, lds); continue; } t -= n_out;
        if (t < n_up) { convert_tile(p.w_up + (size_t)l * Dm * 2 * DFF, 2 * DFF, p.WupT, 1024, 88, t, 0, lds); continue; } t -= n_up;
        convert_tile(p.w_down + (size_t)l * DFF * Dm, Dm, p.WdownT, DFF, 16, t, 0, lds);
    }
    const int gtid = obid() * blockDim.x + otid(), gsz = gridDim.x * blockDim.x;
    for (int i = gtid; i < NIN; i += gsz) p.binp[i] = p.b_in[(size_t)l * DIN + win_map(i)];
    for (int i = gtid; i < 4096; i += gsz) { const int k = i >> 2, hh = i & 3; p.wf[i] = p.w_in[(size_t)l * Dm * DIN + (size_t)k * DIN + 3072 + hh]; }
    for (int i = gtid; i < 4; i += gsz) p.wf[4096 + i] = p.b_in[(size_t)l * DIN + 3072 + i];
}

DI float ex2(float x) { return __builtin_amdgcn_exp2f(x); }
DI float lg2gamma(int hd) { return hd == 0 ? -0.04580368961312479f : hd == 1 ? -0.02272007650008353f : hd == 2 ? -0.011315313227834146f : -0.005646563141142063f; }
DI float silu_f(float v) { return v / (1.f + __expf(-v)); }
DI float sigmoid_f(float v) { return 1.f / (1.f + __expf(-v)); }

DI void phase0_misc(const Params& p, float* lds) {
    for (int it = obid(); it < DEPTH * 96; it += gridDim.x) {
        const int l = it / 96, jb = it % 96;
        const int tx = otid() & 63, ks = otid() >> 6;
        const int j = jb * 64 + tx;
        const float* w = p.w_ada + (size_t)l * Dm * 6144 + j;
        float a0 = 0.f, a1 = 0.f;
#pragma unroll 8
        for (int k = ks * 256; k < ks * 256 + 256; ++k) {
            const float wv = w[(size_t)k * 6144];
            a0 += silu_f(p.c[k]) * wv; a1 += silu_f(p.c[Dm + k]) * wv;
        }
        __syncthreads();
        lds[(ks * 64 + tx) * 2] = a0; lds[(ks * 64 + tx) * 2 + 1] = a1;
        __syncthreads();
        if (ks == 0) {
            float s0 = 0.f, s1 = 0.f;
            for (int q = 0; q < 4; ++q) { s0 += lds[(q * 64 + tx) * 2]; s1 += lds[(q * 64 + tx) * 2 + 1]; }
            const float bb = p.b_ada[(size_t)l * 6144 + j];
            p.mod[((size_t)l * 2 + 0) * 6144 + j] = s0 + bb;
            p.mod[((size_t)l * 2 + 1) * 6144 + j] = s1 + bb;
        }
    }
    const int gtid = obid() * blockDim.x + otid(), gsz = gridDim.x * blockDim.x;
    if (gtid < 64) p.ctr[gtid] = 0u;
    if (obid() == 0 && otid() < 64 * DEPTH) {
        const int l = otid() >> 6, ln = otid() & 63;
        float a = p.lq1[l * 64 + ln] * p.lk1[l * 64 + ln], b = p.lq2[l * 64 + ln] * p.lk2[l * 64 + ln];
        for (int o = 32; o; o >>= 1) { a += __shfl_xor(a, o); b += __shfl_xor(b, o); }
        if (ln == 0) { const float li = 0.8f - 0.6f * expf(-0.3f * (float)l); p.lamv[2 * l] = expf(a) - expf(b) + li; p.lamv[2 * l + 1] = li; }
    }
}

DI void row_phase(const Params& p, const float* __restrict__ src, bool do_ln, const float* __restrict__ lng, const float* __restrict__ lnb,
                  float* __restrict__ xdst, const float* __restrict__ modl  , int sh_off, int sc_off, bool want_h, bool want_logf) {
    const int lane = otid() & 63, wv = otid() >> 6;
    if (want_logf && obid() == 0 && otid() < 32) p.kn[otid()] = 0u;
    for (int row = obid() * 4 + wv; row < T; row += gridDim.x * 4) {
        const int b = row / S;
        const float* sp = src + (size_t)row * Dm;
        f32x4 v[4];
#pragma unroll
        for (int i = 0; i < 4; ++i) v[i] = *(const f32x4*)(sp + i * 256 + lane * 4);
        if (do_ln) {
            float s = 0.f;
#pragma unroll
            for (int i = 0; i < 4; ++i) s += (v[i][0] + v[i][1]) + (v[i][2] + v[i][3]);
            for (int o = 32; o; o >>= 1) s += __shfl_xor(s, o);
            const float mu = s * (1.f / 1024.f);
            float q = 0.f;
#pragma unroll
            for (int i = 0; i < 4; ++i) { f32x4 d = v[i] - mu; q += (d[0] * d[0] + d[1] * d[1]) + (d[2] * d[2] + d[3] * d[3]); }
            for (int o = 32; o; o >>= 1) q += __shfl_xor(q, o);
            const float rstd = rsqrtf(q * (1.f / 1024.f) + LN_EPS);
#pragma unroll
            for (int i = 0; i < 4; ++i) {
                const f32x4 g = *(const f32x4*)(lng + i * 256 + lane * 4), bb = *(const f32x4*)(lnb + i * 256 + lane * 4);
                v[i] = (v[i] - mu) * rstd * g + bb;
            }
        }
        if (xdst) {
#pragma unroll
            for (int i = 0; i < 4; ++i) *(f32x4*)(xdst + (size_t)row * Dm + i * 256 + lane * 4) = v[i];
        }
        if (want_h) {
            const float* mb = modl + (size_t)b * 6144;
            float d0 = 0.f, d1 = 0.f, d2 = 0.f, d3 = 0.f;
#pragma unroll
            for (int i = 0; i < 4; ++i) {
                const int c0 = i * 256 + lane * 4;
                const f32x4 sc = *(const f32x4*)(mb + sc_off + c0), sh = *(const f32x4*)(mb + sh_off + c0);
                const f32x4 hv = v[i] * (1.f + sc) + sh;
                uint2 w; w.x = pack2(hv[0], hv[1]); w.y = pack2(hv[2], hv[3]);
                *(uint2*)(p.h + (size_t)row * Dm + c0) = w;
                if (want_logf) {
#pragma unroll
                    for (int j = 0; j < 4; ++j) {
                        const f32x4 wf = *(const f32x4*)(p.wf + (c0 + j) * 4);
                        d0 += hv[j] * wf[0]; d1 += hv[j] * wf[1]; d2 += hv[j] * wf[2]; d3 += hv[j] * wf[3];
                    }
                }
            }
            if (want_logf) {
                for (int o = 32; o; o >>= 1) { d0 += __shfl_xor(d0, o); d1 += __shfl_xor(d1, o); d2 += __shfl_xor(d2, o); d3 += __shfl_xor(d3, o); }
                if (lane < 4) {
                    float z = (lane == 0 ? d0 : lane == 1 ? d1 : lane == 2 ? d2 : d3) + p.wf[4096 + lane];
                    const float ls = fminf(z, 0.f) - log1pf(__expf(-fabsf(z)));
                    p.logf[(size_t)row * 4 + lane] = ls * LOG2E;
                }
            }
        }
    }
}

DI void scan_item(const Params& p, int item, float* lds) {
    const int b = item >> 2, hh = item & 3, tid = otid();
    const float* lp = p.logf + (size_t)b * S * 4 + hh;
    float loc[32]; float s = 0.f;
#pragma unroll
    for (int i = 0; i < 32; ++i) { s += lp[(size_t)(tid * 32 + i) * 4]; loc[i] = s; }
    __syncthreads();
    lds[tid] = s;
    __syncthreads();
    float pre = 0.f;
    for (int i = 0; i < tid; ++i) pre += lds[i];
    float* fp = p.F + (size_t)(b * 4 + hh) * S + tid * 32;
#pragma unroll
    for (int i = 0; i < 32; ++i) fp[i] = pre + loc[i];
    __syncthreads();
}

DI void gemm_kloop(const bf16_t* __restrict__ Ag, int lda, const bf16_t* __restrict__ Bg, int ldb, int K, f32x4 (&acc)[4][4], bf16_t* sm) {
    const int tid = otid(), lane = tid & 63, wid = tid >> 6, wr = wid >> 1, wc = wid & 1;
    bf16_t* sa = sm; bf16_t* sb = sm + 2 * BM * LDP;
    const int lrow = tid >> 3, lcc = tid & 7;
    const bf16_t* ap = Ag + (size_t)lrow * lda + lcc * 8;
    const bf16_t* bp = Bg + (size_t)lrow * ldb + lcc * 8;
    const size_t sA = (size_t)32 * lda, sB = (size_t)32 * ldb;
    uint4 ra0, ra1, ra2, ra3, rb0, rb1, rb2, rb3;
#define G_LOAD(koff) do { ra0 = *(const uint4*)(ap + (koff)); ra1 = *(const uint4*)(ap + sA + (koff)); ra2 = *(const uint4*)(ap + 2 * sA + (koff)); ra3 = *(const uint4*)(ap + 3 * sA + (koff)); \
                          rb0 = *(const uint4*)(bp + (koff)); rb1 = *(const uint4*)(bp + sB + (koff)); rb2 = *(const uint4*)(bp + 2 * sB + (koff)); rb3 = *(const uint4*)(bp + 3 * sB + (koff)); } while (0)
#define G_STORE(buf) do { bf16_t* da_ = sa + (buf) * BM * LDP + lrow * LDP + lcc * 8; bf16_t* db_ = sb + (buf) * BN * LDP + lrow * LDP + lcc * 8; \
        *(uint4*)(da_) = ra0; *(uint4*)(da_ + 32 * LDP) = ra1; *(uint4*)(da_ + 64 * LDP) = ra2; *(uint4*)(da_ + 96 * LDP) = ra3; \
        *(uint4*)(db_) = rb0; *(uint4*)(db_ + 32 * LDP) = rb1; *(uint4*)(db_ + 64 * LDP) = rb2; *(uint4*)(db_ + 96 * LDP) = rb3; } while (0)
    G_LOAD(0);
    G_STORE(0);
    LDS_BARRIER();
    const int nk = K / BK;
    const int fr = lane & 15, fq = lane >> 4;
    for (int kt = 0; kt < nk; ++kt) {
        const int cur = kt & 1;
        const bool more = kt + 1 < nk;
        if (more) G_LOAD((kt + 1) * BK);
        const bf16_t* ca = sa + cur * BM * LDP + (wr * 64 + fr) * LDP + fq * 8;
        const bf16_t* cb = sb + cur * BN * LDP + (wc * 64 + fr) * LDP + fq * 8;
#pragma unroll
        for (int kk = 0; kk < 2; ++kk) {
            bf16x8 af[4], bfr[4];
#pragma unroll
            for (int m = 0; m < 4; ++m) af[m] = *(const bf16x8*)(ca + m * 16 * LDP + kk * 32);
#pragma unroll
            for (int n = 0; n < 4; ++n) bfr[n] = *(const bf16x8*)(cb + n * 16 * LDP + kk * 32);
#pragma unroll
            for (int m = 0; m < 4; ++m)
#pragma unroll
                for (int n = 0; n < 4; ++n) acc[m][n] = __builtin_amdgcn_mfma_f32_16x16x32_bf16(bfr[n], af[m], acc[m][n], 0, 0, 0);
        }
        if (more) G_STORE(cur ^ 1);
        LDS_BARRIER();
    }
#undef G_LOAD
#undef G_STORE
}

DI void gemm_kloop2(const bf16_t* __restrict__ Ag, int lda, const bf16_t* __restrict__ Bg, int ldb, int K, f32x4 (&acc)[4][4], bf16_t* sm) {
    const int tid = otid(), lane = tid & 63, wid = tid >> 6, wr = wid >> 1, wc = wid & 1;
    bf16_t* sa = sm; bf16_t* sb = sm + 2 * BM * LDP;
    const int lrow = tid >> 3, lcc = tid & 7;
    const bf16_t* ap = Ag + (size_t)lrow * lda + lcc * 8;
    const bf16_t* bp = Bg + (size_t)lrow * ldb + lcc * 8;
    const size_t sA = (size_t)32 * lda, sB = (size_t)32 * ldb;
    uint4 xa0, xa1, xa2, xa3, xb0, xb1, xb2, xb3;
    uint4 ya0, ya1, ya2, ya3, yb0, yb1, yb2, yb3;
#define G2_LOAD(P, koff) do { P##a0 = *(const uint4*)(ap + (koff)); P##a1 = *(const uint4*)(ap + sA + (koff)); P##a2 = *(const uint4*)(ap + 2 * sA + (koff)); P##a3 = *(const uint4*)(ap + 3 * sA + (koff)); \
                              P##b0 = *(const uint4*)(bp + (koff)); P##b1 = *(const uint4*)(bp + sB + (koff)); P##b2 = *(const uint4*)(bp + 2 * sB + (koff)); P##b3 = *(const uint4*)(bp + 3 * sB + (koff)); } while (0)
#define G2_STORE(P, buf) do { bf16_t* da_ = sa + (buf) * BM * LDP + lrow * LDP + lcc * 8; bf16_t* db_ = sb + (buf) * BN * LDP + lrow * LDP + lcc * 8; \
        *(uint4*)(da_) = P##a0; *(uint4*)(da_ + 32 * LDP) = P##a1; *(uint4*)(da_ + 64 * LDP) = P##a2; *(uint4*)(da_ + 96 * LDP) = P##a3; \
        *(uint4*)(db_) = P##b0; *(uint4*)(db_ + 32 * LDP) = P##b1; *(uint4*)(db_ + 64 * LDP) = P##b2; *(uint4*)(db_ + 96 * LDP) = P##b3; } while (0)
#define G2_COMPUTE(buf) do { \
        const bf16_t* ca = sa + (buf) * BM * LDP + (wr * 64 + fr) * LDP + fq * 8; \
        const bf16_t* cb = sb + (buf) * BN * LDP + (wc * 64 + fr) * LDP + fq * 8; \
        _Pragma("unroll") for (int kk = 0; kk < 2; ++kk) { \
            bf16x8 af[4], bfr[4]; \
            _Pragma("unroll") for (int m = 0; m < 4; ++m) af[m] = *(const bf16x8*)(ca + m * 16 * LDP + kk * 32); \
            _Pragma("unroll") for (int n = 0; n < 4; ++n) bfr[n] = *(const bf16x8*)(cb + n * 16 * LDP + kk * 32); \
            _Pragma("unroll") for (int m = 0; m < 4; ++m) _Pragma("unroll") for (int n = 0; n < 4; ++n) acc[m][n] = __builtin_amdgcn_mfma_f32_16x16x32_bf16(bfr[n], af[m], acc[m][n], 0, 0, 0); \
        } } while (0)
    const int nk = K / BK;
    const int fr = lane & 15, fq = lane >> 4;
    G2_LOAD(x, 0);
    G2_LOAD(y, BK);
    G2_STORE(x, 0);
    LDS_BARRIER();
    for (int kt = 0; kt < nk; kt += 2) {
        const int kx = kt + 2 < nk ? kt + 2 : nk - 2, ky = kt + 3 < nk ? kt + 3 : nk - 1;
        G2_LOAD(x, kx * BK);
        __builtin_amdgcn_sched_barrier(0);
        G2_COMPUTE(0);
        G2_STORE(y, 1);
        LDS_BARRIER();
        G2_LOAD(y, ky * BK);
        __builtin_amdgcn_sched_barrier(0);
        G2_COMPUTE(1);
        G2_STORE(x, 0);
        LDS_BARRIER();
    }
#undef G2_LOAD
#undef G2_STORE
#undef G2_COMPUTE
}

DI void tile_coords(int tile, int nM, int nN, int& mt, int& nt) {
    const int G = gridDim.x;
    if ((G & 7) == 0 && (nM & 63) == 0 && (nM * nN) % G == 0) {
        const int b = tile % G, k = tile / G, per = G >> 3;
        const int xcd = b & 7, slot = b >> 3;
        const int li = k * per + slot;
        const int mh = li / (8 * nN), rem = li % (8 * nN);
        nt = rem >> 3; mt = (mh * 8 + (rem & 7)) * 8 + xcd;
        return;
    }
    const int band = tile / (16 * nN), r = tile % (16 * nN);
    mt = band * 16 + (r & 15); nt = r >> 4;
}

DI void zero_acc(f32x4 (&acc)[4][4]) {
#pragma unroll
    for (int m = 0; m < 4; ++m)
#pragma unroll
        for (int n = 0; n < 4; ++n) acc[m][n] = (f32x4){0.f, 0.f, 0.f, 0.f};
}


constexpr int BM2 = 256, BK2 = 32, LDP2 = BK2 + 8;
typedef __attribute__((address_space(3))) unsigned lds_u32;
DI void gemm_kloop3(const bf16_t* __restrict__ Ag, int lda, const bf16_t* __restrict__ Bg, int ldb, int K, f32x4 (&acc)[8][4], bf16_t* sm) {
    const int tid = otid(), lane = tid & 63, wid = tid >> 6, wr = wid >> 1, wc = wid & 1;
    unsigned char* base = (unsigned char*)sm;
    const int fr = lane & 15, fq = lane >> 4;
    const int lr = lane >> 2, chunk = (lane & 3) ^ ((lane >> 4) & 3);
    const bf16_t* ga[4]; const bf16_t* gb[2];
#pragma unroll
    for (int i = 0; i < 4; ++i) ga[i] = Ag + (size_t)((wid * 4 + i) * 16 + lr) * lda + chunk * 8;
#pragma unroll
    for (int i = 0; i < 2; ++i) { const int rho = (wid * 2 + i) * 16 + lr; const int r64 = rho & 63; const int grow = (rho & 64) + ((r64 >> 2) & 3) * 16 + (r64 >> 4) * 4 + (r64 & 3); gb[i] = Bg + (size_t)grow * ldb + chunk * 8; }
#define G4_ISSUE(buf, koff) do { \
        _Pragma("unroll") for (int i_ = 0; i_ < 4; ++i_) __builtin_amdgcn_global_load_lds((const unsigned*)(ga[i_] + (koff)), (lds_u32*)(base + (buf) * 16384 + (wid * 4 + i_) * 1024), 16, 0, 0); \
        _Pragma("unroll") for (int i_ = 0; i_ < 2; ++i_) __builtin_amdgcn_global_load_lds((const unsigned*)(gb[i_] + (koff)), (lds_u32*)(base + 49152 + (buf) * 8192 + (wid * 2 + i_) * 1024), 16, 0, 0); } while (0)
    const int nk = K / BK2;
    const int slot16 = (fq ^ ((fr >> 2) & 3)) * 16;
    G4_ISSUE(0, 0);
    G4_ISSUE(1, BK2);
    asm volatile("s_waitcnt vmcnt(6)" ::: "memory");
    __builtin_amdgcn_s_barrier(); asm volatile("" ::: "memory");
    int cur = 0;
    for (int kt = 0; kt < nk; ++kt) {
        const bool more2 = kt + 2 < nk;
        const int nb = cur == 0 ? 2 : cur - 1;
        if (more2) G4_ISSUE(nb, (kt + 2) * BK2);
        const unsigned char* ca = base + cur * 16384 + (wr * 128 + fr) * 64 + slot16;
        const unsigned char* cb = base + 49152 + cur * 8192 + (wc * 64 + fr) * 64 + slot16;
        bf16x8 af[8], bfr[4];
#pragma unroll
        for (int m = 0; m < 8; ++m) af[m] = *(const bf16x8*)(ca + m * 16 * 64);
#pragma unroll
        for (int n = 0; n < 4; ++n) bfr[n] = *(const bf16x8*)(cb + n * 16 * 64);
        __builtin_amdgcn_s_setprio(1);
#pragma unroll
        for (int m = 0; m < 8; ++m)
#pragma unroll
            for (int n = 0; n < 4; ++n) acc[m][n] = __builtin_amdgcn_mfma_f32_16x16x32_bf16(bfr[n], af[m], acc[m][n], 0, 0, 0);
        __builtin_amdgcn_s_setprio(0);
        if (more2) asm volatile("s_waitcnt vmcnt(6) lgkmcnt(0)" ::: "memory"); else asm volatile("s_waitcnt vmcnt(0) lgkmcnt(0)" ::: "memory");
        __builtin_amdgcn_s_barrier(); asm volatile("" ::: "memory");
        cur = cur == 2 ? 0 : cur + 1;
    }
#undef G4_ISSUE
}
DI void zero_acc8(f32x4 (&acc)[8][4]) {
#pragma unroll
    for (int m = 0; m < 8; ++m)
#pragma unroll
        for (int n = 0; n < 4; ++n) acc[m][n] = (f32x4){0.f, 0.f, 0.f, 0.f};
}
DI void st4_wt(bf16_t* dst, f32x4 v) { const unsigned long long w = (unsigned long long)pack2(v[0], v[1]) | ((unsigned long long)pack2(v[2], v[3]) << 32); __hip_atomic_store((unsigned long long*)dst, w, __ATOMIC_RELAXED, __HIP_MEMORY_SCOPE_AGENT); }
DI void st4(bf16_t* dst, f32x4 v) { uint2 w; w.x = pack2(v[0], v[1]); w.y = pack2(v[2], v[3]); *(uint2*)dst = w; }

DI void st8(bf16_t* dst, f32x4 a, f32x4 b) { uint4 w; w.x = pack2(a[0], a[1]); w.y = pack2(a[2], a[3]); w.z = pack2(b[0], b[1]); w.w = pack2(b[2], b[3]); *(uint4*)dst = w; }
DI f32x4 rot4(f32x4 v, int s, int i0) {
    const float a0 = (float)s * ex2(-(float)i0 * 0.21091607f), a1 = (float)s * ex2(-(float)(i0 + 1) * 0.21091607f);
    float r0 = a0 * 0.15915494309189535f, r1 = a1 * 0.15915494309189535f;
    r0 -= floorf(r0); r1 -= floorf(r1);
    float c0_ = __builtin_amdgcn_cosf(r0), s0_ = __builtin_amdgcn_sinf(r0), c1_ = __builtin_amdgcn_cosf(r1), s1_ = __builtin_amdgcn_sinf(r1);
    asm volatile("s_nop 15\n\ts_nop 15" : "+v"(c0_), "+v"(s0_), "+v"(c1_), "+v"(s1_));
    f32x4 o; o[0] = v[0] * c0_ - v[1] * s0_; o[1] = v[0] * s0_ + v[1] * c0_; o[2] = v[2] * c1_ - v[3] * s1_; o[3] = v[2] * s1_ + v[3] * c1_;
    return o;
}
DI void epi_inproj(const Params& p, int row, int col, f32x4 v0, f32x4 v1) {
    v0 += *(const f32x4*)(p.binp + col); v1 += *(const f32x4*)(p.binp + col + 4);
    const int b = row / S, s = row % S;
    if (col < 512) { st8(p.qa + (size_t)row * 512 + col, v0 * (0.125f * LOG2E), v1 * (0.125f * LOG2E)); }
    else if (col < 1024) { st8(p.ka + (size_t)row * 512 + (col - 512), v0, v1); }
    else if (col < 1536) { const int c = col - 1024, hh = c >> 7, e = c & 127; bf16_t* d = p.vta + ((size_t)(b * 4 + hh) * 128 + e) * S + s;
#pragma unroll
        for (int j = 0; j < 4; ++j) { d[(size_t)j * S] = f2bf(v0[j]); d[(size_t)(j + 4) * S] = f2bf(v1[j]); } }
    else if (col < 2048) { st8(p.qb + (size_t)row * 512 + (col - 1536), v0 * (0.08838834764831845f * LOG2E), v1 * (0.08838834764831845f * LOG2E)); }
    else if (col < 2560) {
        st8(p.kb + (size_t)row * 512 + (col - 2048), v0, v1);
        float ss = 0.f;
#pragma unroll
        for (int j = 0; j < 4; ++j) { const float x0 = bf2f(f2bf(v0[j])), x1 = bf2f(f2bf(v1[j])); ss += x0 * x0 + x1 * x1; }
        ss += __shfl_xor(ss, 16); ss += __shfl_xor(ss, 32);
#pragma unroll
        for (int o = 8; o; o >>= 1) ss = fmaxf(ss, __shfl_xor(ss, o));
        const int c = col - 2048, grp = ((c >> 6) & 1) * 2 + ((c >> 3) & 1);
        if ((otid() & 63) == 0) atomicMax(p.kn + (b * 4 + (c >> 7)) * 4 + grp, __float_as_uint(ss));
    }
    else if (col < 3072) { const int c = col - 2560, hh = c >> 7, e = c & 127; bf16_t* d = p.vtb + ((size_t)(b * 4 + hh) * 128 + e) * S + s;
#pragma unroll
        for (int j = 0; j < 4; ++j) { d[(size_t)j * S] = f2bf(v0[j]); d[(size_t)(j + 4) * S] = f2bf(v1[j]); } }
    else if (col < 4096) {
        const int r = col - 3072, seg = r >> 9, c = r & 511, cc = c & 127, i0 = cc >> 1, hd = c >> 7;
        f32x4 o0 = rot4(v0, s, i0), o1 = rot4(v1, s, i0 + 2);
        const float lg = lg2gamma(hd);
        const int ic = s & 63;
        float e1_ = ex2(lg * (float)(ic + 1)), e2_ = ex2(-lg * (float)(ic + 1)), e3_ = ex2(lg * (float)(63 - ic));
        asm volatile("s_nop 15\n\ts_nop 15" : "+v"(e1_), "+v"(e2_), "+v"(e3_));
        if (seg == 0) st8(p.cq + (size_t)row * 512 + c, o0 * e1_, o1 * e1_);
        else {
            o0 = o0 * 0.08838834764831845f; o1 = o1 * 0.08838834764831845f;
            st8(p.ck + (size_t)row * 512 + c, o0 * e2_, o1 * e2_);
            const f32x4 d0 = o0 * e3_, d1 = o1 * e3_;
            bf16_t* d = p.ckT + ((size_t)(b * 4 + hd) * 128 + cc) * S + s;
#pragma unroll
            for (int j = 0; j < 4; ++j) { d[(size_t)j * S] = f2bf(d0[j]); d[(size_t)(j + 4) * S] = f2bf(d1[j]); }
        }
    }
    else if (col < 5120) { const int c = col - 4096; bf16_t* d = p.cv + ((size_t)b * 1024 + c) * S + s;
#pragma unroll
        for (int j = 0; j < 4; ++j) { d[(size_t)j * S] = f2bf(v0[j]); d[(size_t)(j + 4) * S] = f2bf(v1[j]); } }
    else if (col < 6144) { f32x4 o0, o1; for (int j = 0; j < 4; ++j) { o0[j] = silu_f(v0[j]); o1[j] = silu_f(v1[j]); } st8(p.cg + (size_t)row * 1024 + (col - 5120), o0, o1); }
    else { f32x4 o0, o1; for (int j = 0; j < 4; ++j) { o0[j] = sigmoid_f(v0[j]); o1[j] = sigmoid_f(v1[j]); } st8(p.gates + (size_t)row * 3072 + (col - 6144), o0, o1); }
}

DI void phase_inproj(const Params& p, bf16_t* sm) {
    const int nM = T / BM2, nN = NIN / BN;
    const int lane = otid() & 63, wid = otid() >> 6, wr = wid >> 1, wc = wid & 1;
    for (int tile = obid(); tile < nM * nN; tile += gridDim.x) {
        int mt, nt; tile_coords(tile, nM, nN, mt, nt);
        f32x4 acc[8][4]; zero_acc8(acc);
        gemm_kloop3(p.h + (size_t)mt * BM2 * Dm, Dm, p.WinT + (size_t)nt * BN * Dm, Dm, Dm, acc, sm);
#pragma unroll
        for (int m = 0; m < 8; ++m)
#pragma unroll
            for (int n2 = 0; n2 < 2; ++n2) epi_inproj(p, mt * BM2 + wr * 128 + m * 16 + (lane & 15), nt * BN + wc * 64 + (lane >> 4) * 16 + n2 * 8, acc[m][2 * n2], acc[m][2 * n2 + 1]);
    }
}

DI void phase_branch(const Params& p, bf16_t* sm) {
    const int nM = T / BM, nN = Dm / BN;
    const int lane = otid() & 63, wid = otid() >> 6, wr = wid >> 1, wc = wid & 1;
    for (int tile = obid(); tile < nM * nN; tile += gridDim.x) {
        int mt, nt; tile_coords(tile, nM, nN, mt, nt);
        f32x4 tot[4][4]; zero_acc(tot);
#pragma unroll 1
        for (int br = 0; br < 3; ++br) {
            const bf16_t* A = br == 0 ? p.ya : br == 1 ? p.yb : p.yc;
            const bf16_t* W = br == 0 ? p.WpaT : br == 1 ? p.WpbT : p.WpcT;
            const int K = br == 2 ? 1024 : 512;
            f32x4 acc[4][4]; zero_acc(acc);
            gemm_kloop(A + (size_t)mt * BM * K, K, W + (size_t)nt * BN * K, K, K, acc, sm);
#pragma unroll
            for (int m = 0; m < 4; ++m)
#pragma unroll
                for (int n = 0; n < 4; ++n) {
                    const int row = mt * BM + wr * 64 + m * 16 + (lane & 15), col = nt * BN + wc * 64 + n * 16 + (lane >> 4) * 4;
                    const uint2 g = *(const uint2*)(p.gates + (size_t)row * 3072 + br * 1024 + col);
                    tot[m][n][0] += bflo(g.x) * acc[m][n][0]; tot[m][n][1] += bfhi(g.x) * acc[m][n][1];
                    tot[m][n][2] += bflo(g.y) * acc[m][n][2]; tot[m][n][3] += bfhi(g.y) * acc[m][n][3];
                }
        }
#pragma unroll
        for (int m = 0; m < 4; ++m)
#pragma unroll
            for (int n = 0; n < 4; ++n) {
                const int row = mt * BM + wr * 64 + m * 16 + (lane & 15), col = nt * BN + wc * 64 + n * 16 + (lane >> 4) * 4;
                st4(p.h + (size_t)row * Dm + col, tot[m][n]);
            }
    }
}

DI void phase_gemm_res(const Params& p, const bf16_t* A, int K, const bf16_t* Wt, const float* xres, const float* modl, int gt_off, bf16_t* sm) {
    const int nM = T / BM2, nN = Dm / BN;
    const int lane = otid() & 63, wid = otid() >> 6, wr = wid >> 1, wc = wid & 1;
    for (int tile = obid(); tile < nM * nN; tile += gridDim.x) {
        int mt, nt; tile_coords(tile, nM, nN, mt, nt);
        f32x4 acc[8][4]; zero_acc8(acc);
        gemm_kloop3(A + (size_t)mt * BM2 * K, K, Wt + (size_t)nt * BN * K, K, K, acc, sm);
#pragma unroll
        for (int m = 0; m < 8; ++m)
#pragma unroll
            for (int n = 0; n < 4; ++n) {
                const int row = mt * BM2 + wr * 128 + m * 16 + (lane & 15), col = nt * BN + wc * 64 + (lane >> 4) * 16 + n * 4;
                const int b = row / S;
                const f32x4 xr = *(const f32x4*)(xres + (size_t)row * Dm + col);
                const f32x4 gt = *(const f32x4*)(modl + (size_t)b * 6144 + gt_off + col);
                *(f32x4*)(p.vbuf + (size_t)row * Dm + col) = xr * ALPHA_F + gt * acc[m][n];
            }
    }
}

DI void phase_up(const Params& p, bf16_t* sm) {
    const int nM = T / BM2, nN = 2 * DFF / BN;
    const int lane = otid() & 63, wid = otid() >> 6, wr = wid >> 1, wc = wid & 1;
    for (int tile = obid(); tile < nM * nN; tile += gridDim.x) {
        int mt, nt; tile_coords(tile, nM, nN, mt, nt);
        f32x4 acc[8][4]; zero_acc8(acc);
        gemm_kloop3(p.h + (size_t)mt * BM2 * Dm, Dm, p.WupT + (size_t)nt * BN * Dm, Dm, Dm, acc, sm);
#pragma unroll
        for (int m = 0; m < 8; ++m)
#pragma unroll
            for (int n2 = 0; n2 < 2; ++n2) {
                const int row = mt * BM2 + wr * 128 + m * 16 + (lane & 15), col = nt * BN + wc * 64 + (lane >> 4) * 16 + n2 * 8;
                st8(p.ug + (size_t)row * (2 * DFF) + col, acc[m][2 * n2], acc[m][2 * n2 + 1]);
            }
    }
}

DI void phase_conv(const Params& p, int l) {
    const int gtid = obid() * blockDim.x + otid(), gsz = gridDim.x * blockDim.x;
    const float* wc = p.w_conv + (size_t)l * 3 * DFF; const float* bc = p.b_conv + (size_t)l * DFF;
    for (int i = gtid; i < T * (DFF / 8); i += gsz) {
        const int row = i / (DFF / 8), c8 = (i % (DFF / 8)) * 8, s = row % S;
        const bf16_t* up = p.ug + (size_t)row * (2 * DFF) + c8;
        const uint4 u0 = *(const uint4*)up;
        uint4 u1 = make_uint4(0, 0, 0, 0), u2 = make_uint4(0, 0, 0, 0);
        if (s >= 1) u1 = *(const uint4*)(up - 2 * DFF);
        if (s >= 2) u2 = *(const uint4*)(up - 4 * DFF);
        const uint4 gg = *(const uint4*)(up + DFF);
        const unsigned a0[4] = {u0.x, u0.y, u0.z, u0.w}, a1[4] = {u1.x, u1.y, u1.z, u1.w}, a2[4] = {u2.x, u2.y, u2.z, u2.w}, ag[4] = {gg.x, gg.y, gg.z, gg.w};
        float cv[8], t[8], e[8];
#pragma unroll
        for (int h4 = 0; h4 < 2; ++h4) {
            const f32x4 w0 = *(const f32x4*)(wc + c8 + 4 * h4), w1 = *(const f32x4*)(wc + DFF + c8 + 4 * h4), w2 = *(const f32x4*)(wc + 2 * DFF + c8 + 4 * h4), bb = *(const f32x4*)(bc + c8 + 4 * h4);
#pragma unroll
            for (int k = 0; k < 4; ++k) {
                const int j = 2 * h4 + (k >> 1); const bool hi = k & 1;
                const float x0 = hi ? bfhi(a0[j]) : bflo(a0[j]), x1 = hi ? bfhi(a1[j]) : bflo(a1[j]), x2 = hi ? bfhi(a2[j]) : bflo(a2[j]);
                cv[4 * h4 + k] = bb[k] + w0[k] * x2 + w1[k] * x1 + w2[k] * x0;
            }
        }
#pragma unroll
        for (int k = 0; k < 8; ++k) { t[k] = __builtin_amdgcn_rcpf(fabsf(cv[k]) * 0.2316418882f + 1.0f); e[k] = ex2(cv[k] * cv[k] * (-0.72134752044f)); }
        asm volatile("s_nop 15\n\ts_nop 15" : "+v"(t[0]), "+v"(t[1]), "+v"(t[2]), "+v"(t[3]), "+v"(t[4]), "+v"(t[5]), "+v"(t[6]), "+v"(t[7]));
        asm volatile("s_nop 3" : "+v"(e[0]), "+v"(e[1]), "+v"(e[2]), "+v"(e[3]), "+v"(e[4]), "+v"(e[5]), "+v"(e[6]), "+v"(e[7]));
        unsigned o[4];
#pragma unroll
        for (int j = 0; j < 4; ++j) {
            float rr[2];
#pragma unroll
            for (int hl = 0; hl < 2; ++hl) {
                const int k = 2 * j + hl;
                float q = t[k] * 0.5307027145f + (-0.7265760135f); q = q * t[k] + 0.7107068705f; q = q * t[k] + (-0.142248368f); q = q * t[k] + 0.127414796f; q = q * t[k];
                const float m = cv[k] * (q * e[k]);
                const float gl = cv[k] < 0.f ? m : cv[k] - m;
                rr[hl] = gl * (hl ? bfhi(ag[j]) : bflo(ag[j]));
            }
            o[j] = pack2(rr[0], rr[1]);
        }
        *(uint4*)(p.act + (size_t)row * DFF + c8) = make_uint4(o[0], o[1], o[2], o[3]);
    }
}

template <int MODE>
DI void naive_attn(const Params& p, int item) {
    constexpr int D = MODE == 0 ? 64 : 128;
    constexpr int DV = MODE == 2 ? 256 : 128;
    constexpr int SW = DV / 4;
    constexpr int NH = MODE == 0 ? 8 : 4;
    const int tid = otid(), lane = tid & 63;
    const int sl = __builtin_amdgcn_readfirstlane(tid >> 6);
    const int qblk = 127 - (item % 128), hh = (item / 128) % NH, b = item / (128 * NH);
    const int q = qblk * 64 + lane; const size_t tq = (size_t)b * S + q;
    const bf16_t *Q, *Kp;
    if (MODE == 0) { Q = p.qa + tq * 512 + hh * 64; Kp = p.ka + (size_t)b * S * 512 + hh * 64; }
    else if (MODE == 1) { Q = p.qb + tq * 512 + hh * 128; Kp = p.kb + (size_t)b * S * 512 + hh * 128; }
    else { Q = p.cq + tq * 512 + hh * 128; Kp = p.ck + (size_t)b * S * 512 + hh * 128; }
    unsigned qp[D / 2];
#pragma unroll
    for (int i = 0; i < D / 8; ++i) { const uint4 t = ((const uint4*)Q)[i]; qp[4 * i] = t.x; qp[4 * i + 1] = t.y; qp[4 * i + 2] = t.z; qp[4 * i + 3] = t.w; }
    float acc[SW];
#pragma unroll
    for (int i = 0; i < SW; ++i) acc[i] = 0.f;
    float mx = -INFINITY, lsum = 0.f;
    const int send = (qblk + 1) * 64;
    float Fq = 0.f; const float* Fk = nullptr;
    if (MODE == 1) { Fk = p.F + (size_t)(b * 4 + hh) * S; Fq = Fk[q]; }
    float lg = 0.f;
    if (MODE == 2) lg = log2f(1.0f - exp2f(-5.0f - (float)hh));
    for (int s = 0; s < send; ++s) {
        const uint4* kr = (const uint4*)(Kp + (size_t)s * 512);
        float sc = 0.f;
#pragma unroll
        for (int i = 0; i < D / 8; ++i) {
            const uint4 kv = kr[i];
            sc += bflo(qp[4 * i]) * bflo(kv.x) + bfhi(qp[4 * i]) * bfhi(kv.x);
            sc += bflo(qp[4 * i + 1]) * bflo(kv.y) + bfhi(qp[4 * i + 1]) * bfhi(kv.y);
            sc += bflo(qp[4 * i + 2]) * bflo(kv.z) + bfhi(qp[4 * i + 2]) * bfhi(kv.z);
            sc += bflo(qp[4 * i + 3]) * bflo(kv.w) + bfhi(qp[4 * i + 3]) * bfhi(kv.w);
            if ((i & 3) == 3) asm volatile("" ::: "memory");
        }
        float w, corr = 1.f;
        if (MODE == 2) {
            w = (s <= q) ? sc * exp2f((float)(q - s) * lg) : 0.f;
        } else {
            if (MODE == 1) sc += Fq - Fk[s];
            const bool valid = (MODE == 0) || (s <= q);
            if (valid) {
                const float mn = fmaxf(mx, sc);
                corr = exp2f(mx - mn); w = exp2f(sc - mn); mx = mn;
                lsum = lsum * corr + w;
            } else { w = 0.f; }
        }
        if (MODE == 2) {
            const uint4* vr = (const uint4*)(p.cv + ((size_t)b * S + s) * 1024 + hh * 256 + sl * SW);
#pragma unroll
            for (int i = 0; i < SW / 8; ++i) {
                const uint4 vv = vr[i];
                acc[8 * i] += w * bflo(vv.x); acc[8 * i + 1] += w * bfhi(vv.x); acc[8 * i + 2] += w * bflo(vv.y); acc[8 * i + 3] += w * bfhi(vv.y);
                acc[8 * i + 4] += w * bflo(vv.z); acc[8 * i + 5] += w * bfhi(vv.z); acc[8 * i + 6] += w * bflo(vv.w); acc[8 * i + 7] += w * bfhi(vv.w);
            }
        } else {
            const bf16_t* vt = (MODE == 0 ? p.vta + ((size_t)(b * 4 + (hh >> 1)) * 128 + sl * SW) * S : p.vtb + ((size_t)(b * 4 + hh) * 128 + sl * SW) * S) + s;
#pragma unroll
            for (int i = 0; i < SW; ++i) { acc[i] = acc[i] * corr + w * bf2f(*vt); vt += S; asm volatile("" : "+v"(vt)); }
        }
    }
    if (MODE == 2) {
        float* o = p.oc + tq * 1024 + hh * 256 + sl * SW;
#pragma unroll
        for (int i = 0; i < SW / 4; ++i) *(f32x4*)(o + 4 * i) = (f32x4){acc[4 * i], acc[4 * i + 1], acc[4 * i + 2], acc[4 * i + 3]};
    } else {
        const float inv = 1.f / lsum;
        bf16_t* o = (MODE == 0 ? p.oa + tq * 1024 + hh * 128 : p.yb + tq * 512 + hh * 128) + sl * SW;
#pragma unroll
        for (int i = 0; i < SW / 8; ++i) {
            uint4 w4; w4.x = pack2(acc[8 * i] * inv, acc[8 * i + 1] * inv); w4.y = pack2(acc[8 * i + 2] * inv, acc[8 * i + 3] * inv);
            w4.z = pack2(acc[8 * i + 4] * inv, acc[8 * i + 5] * inv); w4.w = pack2(acc[8 * i + 6] * inv, acc[8 * i + 7] * inv);
            ((uint4*)o)[i] = w4;
        }
    }
}


typedef float f32x16 __attribute__((ext_vector_type(16)));
DI bf16x8 pack8(float a0, float a1, float a2, float a3, float a4, float a5, float a6, float a7) {
    typedef unsigned u32x4 __attribute__((ext_vector_type(4)));
    u32x4 w; w[0] = pack2(a0, a1); w[1] = pack2(a2, a3); w[2] = pack2(a4, a5); w[3] = pack2(a6, a7);
    return __builtin_bit_cast(bf16x8, w);
}

template <int MODE>
DI void flash_item(const Params& p, int b, int hh, int qi, unsigned char* smem) {
    constexpr int D = MODE == 0 ? 64 : 128, KST = D + 8, VST = 68, KS = D / 16;
    constexpr int KBYTES = 64 * KST * 2, VBYTES = 128 * VST * 2, BUFB = KBYTES + VBYTES + 256;
    constexpr int NKC = D / 32, CPR = D / 8;
    const int tid = otid(), lane = tid & 63, w = tid >> 6, r = lane & 31, hf = lane >> 5;
    const int q0 = qi * 128 + w * 32;
    const size_t tq = (size_t)b * S + q0 + r;
    bf16x8 qf[KS];
    {
        const bf16_t* qptr = (MODE == 0 ? p.qa + tq * 512 + hh * 64 : p.qb + tq * 512 + hh * 128) + hf * 8;
#pragma unroll
        for (int ks = 0; ks < KS; ++ks) qf[ks] = *(const bf16x8*)(qptr + ks * 16);
    }
    const float* fbase = p.F + (size_t)(b * 4 + (MODE == 1 ? hh : 0)) * S;
    float Fq = 0.f; if (MODE == 1) Fq = fbase[q0 + r];
    const bf16_t* kbase = MODE == 0 ? p.ka + (size_t)b * S * 512 + hh * 64 : p.kb + (size_t)b * S * 512 + hh * 128;
    const bf16_t* vbase = MODE == 0 ? p.vta + (size_t)(b * 4 + (hh >> 1)) * 128 * S : p.vtb + (size_t)(b * 4 + hh) * 128 * S;
    const int ntiles = 2 * qi + 2, wlast = 2 * qi + (w >> 1);
    uint4 kr0 = make_uint4(0, 0, 0, 0), kr1 = kr0, kr2 = kr0, kr3 = kr0, vr0 = kr0, vr1 = kr0, vr2 = kr0, vr3 = kr0; f32x4 frg = {0.f, 0.f, 0.f, 0.f};
#define FL_K(i_, jx) (*(const uint4*)(kbase + (size_t)(64 * (jx) + (tid + 256 * (i_)) / CPR) * 512 + ((tid + 256 * (i_)) % CPR) * 8))
#define FL_V(i_, jx) (*(const uint4*)(vbase + (size_t)((tid + 256 * (i_)) >> 3) * S + 64 * (jx) + ((tid + 256 * (i_)) & 7) * 8))
#define FL_GLOAD(jx) do { kr0 = FL_K(0, jx); kr1 = FL_K(1, jx); if (NKC == 4) { kr2 = FL_K(2, jx); kr3 = FL_K(3, jx); } \
        vr0 = FL_V(0, jx); vr1 = FL_V(1, jx); vr2 = FL_V(2, jx); vr3 = FL_V(3, jx); \
        if (MODE == 1 && tid < 16) frg = *(const f32x4*)(fbase + 64 * (jx) + tid * 4); } while (0)
#define FL_KS(i_, reg) (*(uint4*)(B_ + (((tid + 256 * (i_)) / CPR) * KST + ((tid + 256 * (i_)) % CPR) * 8) * 2) = (reg))
#define FL_VS(i_, reg) do { uint2* d_ = (uint2*)(B_ + KBYTES + (((tid + 256 * (i_)) >> 3) * VST + ((tid + 256 * (i_)) & 7) * 8) * 2); d_[0] = make_uint2((reg).x, (reg).y); d_[1] = make_uint2((reg).z, (reg).w); } while (0)
#define FL_SSTORE(buf) do { unsigned char* B_ = smem + (buf) * BUFB; FL_KS(0, kr0); FL_KS(1, kr1); if (NKC == 4) { FL_KS(2, kr2); FL_KS(3, kr3); } \
        FL_VS(0, vr0); FL_VS(1, vr1); FL_VS(2, vr2); FL_VS(3, vr3); \
        if (MODE == 1 && tid < 16) *(f32x4*)(B_ + KBYTES + VBYTES + tid * 16) = frg; } while (0)
    FL_GLOAD(MODE == 1 ? ntiles - 1 : 0);
    FL_SSTORE(0);
    LDS_BARRIER();
    f32x16 acc[4];
#pragma unroll
    for (int eb = 0; eb < 4; ++eb)
#pragma unroll
        for (int i = 0; i < 16; ++i) acc[eb][i] = 0.f;
    float mrun = -INFINITY, lsum = 0.f;
    unsigned* donef = (unsigned*)(smem + SMEM_BYTES - 64);
    float qk_bound = 0.f, Fq0 = 0.f;
    if (MODE == 1) {
        float qs = 0.f;
#pragma unroll
        for (int ks = 0; ks < KS; ++ks)
#pragma unroll
            for (int e = 0; e < 8; ++e) { const float x = bf2f((bf16_t)qf[ks][e]); qs += x * x; }
        qs += __shfl_xor(qs, 32);
#pragma unroll
        for (int o = 16; o; o >>= 1) qs = fmaxf(qs, __shfl_xor(qs, o));
        const unsigned* kn = p.kn + (b * 4 + hh) * 4;
        const float k2 = __uint_as_float(kn[0]) + __uint_as_float(kn[1]) + __uint_as_float(kn[2]) + __uint_as_float(kn[3]);
        qk_bound = sqrtf(qs) * sqrtf(k2) * 1.0001f + 1e-3f;
        Fq0 = __shfl(Fq, 0);
        if (lane == 0) donef[w] = 0u;
    }
    for (int it = 0; it < ntiles; ++it) {
        const int j = MODE == 1 ? ntiles - 1 - it : it;
        const bool more = it + 1 < ntiles;
        if (more) FL_GLOAD(MODE == 1 ? j - 1 : j + 1);
        if (j <= wlast) {
            const unsigned char* B = smem + (it & 1) * BUFB;
            f32x16 st[2];
#pragma unroll
            for (int kb = 0; kb < 2; ++kb) {
#pragma unroll
                for (int i = 0; i < 16; ++i) st[kb][i] = 0.f;
#pragma unroll
                for (int ks = 0; ks < KS; ++ks) {
                    const bf16x8 a = *(const bf16x8*)(B + ((kb * 32 + r) * KST + ks * 16 + hf * 8) * 2);
                    st[kb] = __builtin_amdgcn_mfma_f32_32x32x16_bf16(a, qf[ks], st[kb], 0, 0, 0);
                }
            }
            if (MODE == 1) {
                const float* Fl = (const float*)(B + KBYTES + VBYTES);
#pragma unroll
                for (int kb = 0; kb < 2; ++kb)
#pragma unroll
                    for (int g = 0; g < 4; ++g) {
                        const f32x4 fk = *(const f32x4*)(Fl + kb * 32 + 8 * g + 4 * hf);
#pragma unroll
                        for (int jj = 0; jj < 4; ++jj) st[kb][4 * g + jj] += Fq - fk[jj];
                    }
                if (j >= 2 * qi) {
                    const int qabs = q0 + r;
#pragma unroll
                    for (int kb = 0; kb < 2; ++kb)
#pragma unroll
                        for (int g = 0; g < 4; ++g)
#pragma unroll
                            for (int jj = 0; jj < 4; ++jj) { const int key = 64 * j + kb * 32 + 8 * g + 4 * hf + jj; if (key > qabs) st[kb][4 * g + jj] = -INFINITY; }
                }
            }
            float mt = st[0][0];
#pragma unroll
            for (int i = 1; i < 16; ++i) mt = fmaxf(mt, st[0][i]);
#pragma unroll
            for (int i = 0; i < 16; ++i) mt = fmaxf(mt, st[1][i]);
            mt = fmaxf(mt, __shfl_xor(mt, 32));
            if (!(MODE == 1 && __all(mt < mrun - 40.0f))) {
            const float mn = fmaxf(mrun, mt);
            const float corr = ex2(mrun - mn);
            mrun = mn; lsum *= corr;
#pragma unroll
            for (int kb = 0; kb < 2; ++kb)
#pragma unroll
                for (int i = 0; i < 16; ++i) { const float pv = ex2(st[kb][i] - mn); st[kb][i] = pv; lsum += pv; }
#pragma unroll
            for (int eb = 0; eb < 4; ++eb) acc[eb] *= corr;
#pragma unroll
            for (int kb = 0; kb < 2; ++kb)
#pragma unroll
                for (int s2 = 0; s2 < 2; ++s2) {
                    const bf16x8 pf = pack8(st[kb][8 * s2], st[kb][8 * s2 + 1], st[kb][8 * s2 + 2], st[kb][8 * s2 + 3], st[kb][8 * s2 + 4], st[kb][8 * s2 + 5], st[kb][8 * s2 + 6], st[kb][8 * s2 + 7]);
#pragma unroll
                    for (int eb = 0; eb < 4; ++eb) {
                        const unsigned char* vp = B + KBYTES + ((eb * 32 + r) * VST + kb * 32 + 16 * s2 + 4 * hf) * 2;
                        const uint2 lo = *(const uint2*)vp, hi = *(const uint2*)(vp + 16);
                        typedef unsigned u32x4 __attribute__((ext_vector_type(4)));
                        u32x4 av; av[0] = lo.x; av[1] = lo.y; av[2] = hi.x; av[3] = hi.y;
                        acc[eb] = __builtin_amdgcn_mfma_f32_32x32x16_bf16(__builtin_bit_cast(bf16x8, av), pf, acc[eb], 0, 0, 0);
                    }
                }
            }
        }
        if (MODE == 1 && j <= wlast) {
            const float* Fl0 = (const float*)(smem + (it & 1) * BUFB + KBYTES + VBYTES);
            float mmin = mrun;
#pragma unroll
            for (int o = 16; o; o >>= 1) mmin = fminf(mmin, __shfl_xor(mmin, o));
            if (lane == 0 && qk_bound + (Fq0 - Fl0[0]) < mmin - 40.0f) donef[w] = 1u;
        }
        if (more) FL_SSTORE((it + 1) & 1);
        LDS_BARRIER();
        if (MODE == 1 && (donef[0] & donef[1] & donef[2] & donef[3])) break;
    }
#undef FL_GLOAD
#undef FL_SSTORE
#undef FL_K
#undef FL_V
#undef FL_KS
#undef FL_VS
    const float inv = 1.f / (lsum + __shfl_xor(lsum, 32));
    bf16_t* o = MODE == 0 ? p.oa + tq * 1024 + hh * 128 : p.yb + tq * 512 + hh * 128;
#pragma unroll
    for (int eb = 0; eb < 4; ++eb)
#pragma unroll
        for (int g = 0; g < 4; ++g) {
            f32x4 v = {acc[eb][4 * g] * inv, acc[eb][4 * g + 1] * inv, acc[eb][4 * g + 2] * inv, acc[eb][4 * g + 3] * inv};
            st4(o + eb * 32 + 8 * g + 4 * hf, v);
        }
}


DI void ret_state_item(const Params& p, int item) {
    const int n = item & 127, bh = item >> 7;
    const int tid = otid(), lane = tid & 63, w = tid >> 6, r = lane & 31, hf = lane >> 5;
    const bf16_t* kt = p.ckT + (size_t)bh * 128 * S + n * 64 + hf * 8;
    const bf16_t* vt = p.cv + ((size_t)bh * 256 + w * 64) * S + n * 64 + hf * 8;
    f32x16 acc[4][2];
#pragma unroll
    for (int a = 0; a < 4; ++a)
#pragma unroll
        for (int c = 0; c < 2; ++c)
#pragma unroll
            for (int i = 0; i < 16; ++i) acc[a][c][i] = 0.f;
#pragma unroll
    for (int s4 = 0; s4 < 4; ++s4) {
        bf16x8 af[4], bfr[2];
#pragma unroll
        for (int a = 0; a < 4; ++a) af[a] = *(const bf16x8*)(kt + (size_t)(a * 32 + r) * S + s4 * 16);
#pragma unroll
        for (int c = 0; c < 2; ++c) bfr[c] = *(const bf16x8*)(vt + (size_t)(c * 32 + r) * S + s4 * 16);
#pragma unroll
        for (int a = 0; a < 4; ++a)
#pragma unroll
            for (int c = 0; c < 2; ++c) acc[a][c] = __builtin_amdgcn_mfma_f32_32x32x16_bf16(af[a], bfr[c], acc[a][c], 0, 0, 0);
    }
    bf16_t* o = p.kv + ((size_t)(bh * 128 + n) * 256 + w * 64) * 128;
#pragma unroll
    for (int a = 0; a < 4; ++a)
#pragma unroll
        for (int c = 0; c < 2; ++c)
#pragma unroll
            for (int g = 0; g < 4; ++g) {
                f32x4 v = {acc[a][c][4 * g], acc[a][c][4 * g + 1], acc[a][c][4 * g + 2], acc[a][c][4 * g + 3]};
                st4_wt(o + (size_t)(c * 32 + r) * 128 + a * 32 + 8 * g + 4 * hf, v);
            }
}

DI void ret_scan(const Params& p) {
    const int gtid = obid() * 256 + otid(), gsz = gridDim.x * 256;
    for (int e = gtid; e < 8 * 8192; e += gsz) {
        const int bh = e >> 13, pi = e & 8191, hd = bh & 3;
        const float dec = ex2(64.0f * lg2gamma(hd));
        unsigned long long* ptr = (unsigned long long*)p.kv + (size_t)bh * 128 * 8192 + pi;
        float c0 = 0.f, c1 = 0.f, c2 = 0.f, c3 = 0.f;
        for (int n0 = 0; n0 < 128; n0 += 8) {
            unsigned long long v[8];
#pragma unroll
            for (int k = 0; k < 8; ++k) v[k] = ptr[(size_t)(n0 + k) * 8192];
            asm volatile("s_waitcnt vmcnt(0)" ::: "memory");
#pragma unroll
            for (int k = 0; k < 8; ++k) {
                const unsigned long long o = (unsigned long long)pack2(c0, c1) | ((unsigned long long)pack2(c2, c3) << 32);
                __hip_atomic_store(ptr + (size_t)(n0 + k) * 8192, o, __ATOMIC_RELAXED, __HIP_MEMORY_SCOPE_AGENT);
                const unsigned lo = (unsigned)v[k], hi = (unsigned)(v[k] >> 32);
                c0 = c0 * dec + bflo(lo); c1 = c1 * dec + bfhi(lo); c2 = c2 * dec + bflo(hi); c3 = c3 * dec + bfhi(hi);
            }
        }
    }
}

DI void ret_out_item(const Params& p, int l, int item, unsigned char* smem) {
    const int n = item & 127, bh = item >> 7, b = bh >> 2, hd = bh & 3;
    const int tid = otid(), lane = tid & 63, w = tid >> 6, r = lane & 31, hf = lane >> 5;
    const size_t t0 = (size_t)b * S + n * 64;
    f32x16 acc[2][2];
#pragma unroll
    for (int a = 0; a < 2; ++a)
#pragma unroll
        for (int c = 0; c < 2; ++c)
#pragma unroll
            for (int i = 0; i < 16; ++i) acc[a][c][i] = 0.f;
    bf16x8 pf[2][2][2];
    typedef unsigned u32x4 __attribute__((ext_vector_type(4)));
    bf16x8 qf[2][8], rf[2][8];
    uint2 vlo[2][2][2], vhi[2][2][2];
    {
        const bf16_t* rt = p.kv + ((size_t)(bh * 128 + n) * 256 + w * 64) * 128 + hf * 8;
#pragma unroll
        for (int qb = 0; qb < 2; ++qb)
#pragma unroll
            for (int ks = 0; ks < 8; ++ks) qf[qb][ks] = *(const bf16x8*)(p.cq + (t0 + qb * 32 + r) * 512 + hd * 128 + ks * 16 + hf * 8);
#pragma unroll
        for (int dvb = 0; dvb < 2; ++dvb)
#pragma unroll
            for (int ks = 0; ks < 8; ++ks) rf[dvb][ks] = *(const bf16x8*)(rt + (size_t)(dvb * 32 + r) * 128 + ks * 16);
    }
    __builtin_amdgcn_sched_barrier(0);
#pragma unroll
    for (int dvb = 0; dvb < 2; ++dvb)
#pragma unroll
        for (int ks = 0; ks < 8; ++ks)
#pragma unroll
            for (int qb = 0; qb < 2; ++qb) acc[dvb][qb] = __builtin_amdgcn_mfma_f32_32x32x16_bf16(rf[dvb][ks], qf[qb][ks], acc[dvb][qb], 0, 0, 0);
#pragma unroll
    for (int kb = 0; kb < 2; ++kb)
#pragma unroll
        for (int ks = 0; ks < 8; ++ks) rf[kb][ks] = *(const bf16x8*)(p.ck + (t0 + kb * 32 + r) * 512 + hd * 128 + ks * 16 + hf * 8);
    __builtin_amdgcn_sched_barrier(0);
#pragma unroll
    for (int kb = 0; kb < 2; ++kb) {
        f32x16 st[2];
#pragma unroll
        for (int qb = 0; qb < 2; ++qb)
#pragma unroll
            for (int i = 0; i < 16; ++i) st[qb][i] = 0.f;
#pragma unroll
        for (int ks = 0; ks < 8; ++ks)
#pragma unroll
            for (int qb = 0; qb < 2; ++qb) st[qb] = __builtin_amdgcn_mfma_f32_32x32x16_bf16(rf[kb][ks], qf[qb][ks], st[qb], 0, 0, 0);
#pragma unroll
        for (int qb = 0; qb < 2; ++qb) {
#pragma unroll
            for (int i = 0; i < 16; ++i) { const int key = kb * 32 + (i & 3) + 8 * (i >> 2) + 4 * hf; if (key > qb * 32 + r) st[qb][i] = 0.f; }
#pragma unroll
            for (int s2 = 0; s2 < 2; ++s2)
                pf[kb][s2][qb] = pack8(st[qb][8 * s2], st[qb][8 * s2 + 1], st[qb][8 * s2 + 2], st[qb][8 * s2 + 3], st[qb][8 * s2 + 4], st[qb][8 * s2 + 5], st[qb][8 * s2 + 6], st[qb][8 * s2 + 7]);
        }
    }
    {
        const bf16_t* vt = p.cv + ((size_t)bh * 256 + w * 64) * S + n * 64 + 4 * hf;
#pragma unroll
        for (int dvb = 0; dvb < 2; ++dvb)
#pragma unroll
            for (int kb = 0; kb < 2; ++kb)
#pragma unroll
                for (int s2 = 0; s2 < 2; ++s2) {
                    const bf16_t* vp = vt + (size_t)(dvb * 32 + r) * S + kb * 32 + 16 * s2;
                    vlo[dvb][kb][s2] = *(const uint2*)vp; vhi[dvb][kb][s2] = *(const uint2*)(vp + 8);
                }
    }
    __builtin_amdgcn_sched_barrier(0);
#pragma unroll
    for (int dvb = 0; dvb < 2; ++dvb)
#pragma unroll
        for (int kb = 0; kb < 2; ++kb)
#pragma unroll
            for (int s2 = 0; s2 < 2; ++s2) {
                u32x4 av; av[0] = vlo[dvb][kb][s2].x; av[1] = vlo[dvb][kb][s2].y; av[2] = vhi[dvb][kb][s2].x; av[3] = vhi[dvb][kb][s2].y;
                const bf16x8 a = __builtin_bit_cast(bf16x8, av);
#pragma unroll
                for (int qb = 0; qb < 2; ++qb) acc[dvb][qb] = __builtin_amdgcn_mfma_f32_32x32x16_bf16(a, pf[kb][s2][qb], acc[dvb][qb], 0, 0, 0);
            }
    float* red = (float*)smem;
    float mu[2], rstd[2];
    __syncthreads();
#pragma unroll
    for (int qb = 0; qb < 2; ++qb) {
        float s1 = 0.f, s2 = 0.f;
#pragma unroll
        for (int dvb = 0; dvb < 2; ++dvb)
#pragma unroll
            for (int i = 0; i < 16; ++i) { const float x = acc[dvb][qb][i]; s1 += x; s2 += x * x; }
        s1 += __shfl_xor(s1, 32); s2 += __shfl_xor(s2, 32);
        if (hf == 0) { red[(w * 64 + qb * 32 + r) * 2] = s1; red[(w * 64 + qb * 32 + r) * 2 + 1] = s2; }
    }
    __syncthreads();
#pragma unroll
    for (int qb = 0; qb < 2; ++qb) {
        float s1 = 0.f, s2 = 0.f;
#pragma unroll
        for (int ww = 0; ww < 4; ++ww) { s1 += red[(ww * 64 + qb * 32 + r) * 2]; s2 += red[(ww * 64 + qb * 32 + r) * 2 + 1]; }
        const float m_ = s1 * (1.f / 256.f);
        mu[qb] = m_; rstd[qb] = rsqrtf(fmaxf(s2 * (1.f / 256.f) - m_ * m_, 0.f) + LN_EPS);
    }
    const float* gr = p.g_ret + (size_t)l * 1024 + hd * 256 + w * 64;
#pragma unroll
    for (int dvb = 0; dvb < 2; ++dvb)
#pragma unroll
        for (int g = 0; g < 4; ++g) {
            const int dv = dvb * 32 + 8 * g + 4 * hf;
            const f32x4 gg = *(const f32x4*)(gr + dv);
#pragma unroll
            for (int qb = 0; qb < 2; ++qb) {
                const size_t off = (t0 + qb * 32 + r) * 1024 + hd * 256 + w * 64 + dv;
                const uint2 cgv = *(const uint2*)(p.cg + off);
                f32x4 y;
#pragma unroll
                for (int jj = 0; jj < 4; ++jj) y[jj] = (acc[dvb][qb][4 * g + jj] - mu[qb]) * rstd[qb] * gg[jj];
                y[0] *= bflo(cgv.x); y[1] *= bfhi(cgv.x); y[2] *= bflo(cgv.y); y[3] *= bfhi(cgv.y);
                st4(p.yc + off, y);
            }
        }
}

DI void phase_mixers(const Params& p, int l, unsigned char* smem) {
    const int nF = 64 * 24, nC = 2 * 4 * 128;
    int* sitem = (int*)(smem + SMEM_BYTES - 16);
    for (;;) {
        __syncthreads();
        if (otid() == 0) *sitem = (int)atomicAdd(p.ctr + l, 1u);
        __syncthreads();
        const int it = *sitem;
        if (it >= nF + nC) break;
        if (it < nF) {
            const int qi = 63 - it / 24, r = it % 24;
            if (r < 8) flash_item<1>(p, r >> 2, r & 3, qi, smem);
            else flash_item<0>(p, (r - 8) >> 3, (r - 8) & 7, qi, smem);
        } else ret_state_item(p, it - nF);
    }
}

DI void phase_mixers_naive(const Params& p) {
    const int nA = 2 * 8 * 128, nB = 2 * 4 * 128, nC = 2 * 4 * 128;
    for (int it = obid(); it < nA + nB + nC; it += gridDim.x) {
        if (it < nB) naive_attn<1>(p, it);
        else if (it < nB + nC) naive_attn<2>(p, it - nB);
        else naive_attn<0>(p, it - nB - nC);
    }
}

DI void phase_post(const Params& p, int l) {
    const int lane = otid() & 63, wv = otid() >> 6;
    const float lam = p.lamv[2 * l], li = p.lamv[2 * l + 1];
    const float* gd = p.g_diff + (size_t)l * 512; const float* gr = p.g_ret + (size_t)l * 1024;
    for (int row = obid() * 4 + wv; row < T; row += gridDim.x * 4) {
#pragma unroll
        for (int hh = 0; hh < 4; ++hh) {
            const unsigned o0 = *(const unsigned*)(p.oa + (size_t)row * 1024 + (2 * hh) * 128 + lane * 2);
            const unsigned o1 = *(const unsigned*)(p.oa + (size_t)row * 1024 + (2 * hh + 1) * 128 + lane * 2);
            const float d0 = bflo(o0) - lam * bflo(o1), d1 = bfhi(o0) - lam * bfhi(o1);
            float ss = d0 * d0 + d1 * d1;
            for (int o = 32; o; o >>= 1) ss += __shfl_xor(ss, o);
            const float r = rsqrtf(ss * (1.f / 128.f) + LN_EPS) * (1.f - li);
            const int c = hh * 128 + lane * 2;
            *(unsigned*)(p.ya + (size_t)row * 512 + c) = pack2(d0 * r * gd[c], d1 * r * gd[c + 1]);
        }
    }
}

DI void grid_bar(unsigned* bar, unsigned& epoch) {
    asm volatile("s_waitcnt vmcnt(0) lgkmcnt(0)" ::: "memory");
    __syncthreads();
    epoch += 1;
    const int tid = otid();
    unsigned* go = bar;
    unsigned* flags = bar + 32;
    if (tid == 0) {
        __builtin_amdgcn_fence(__ATOMIC_RELEASE, "agent");
        asm volatile("s_waitcnt vmcnt(0)" ::: "memory");
        __hip_atomic_store(flags + 32 * obid(), epoch, __ATOMIC_RELAXED, __HIP_MEMORY_SCOPE_AGENT);
    }
    if (obid() == 0 && tid < 64) {
        const int nb = gridDim.x;
        for (int base = 0; base < nb; base += 64) {
            const int idx = base + tid;
            if (idx < nb) while (__hip_atomic_load(flags + 32 * idx, __ATOMIC_RELAXED, __HIP_MEMORY_SCOPE_AGENT) < epoch) __builtin_amdgcn_s_sleep(1);
        }
        asm volatile("s_waitcnt vmcnt(0)" ::: "memory");
        if (tid == 0) __hip_atomic_store(go, epoch, __ATOMIC_RELAXED, __HIP_MEMORY_SCOPE_AGENT);
    }
    if (tid == 0) {
        while (__hip_atomic_load(go, __ATOMIC_RELAXED, __HIP_MEMORY_SCOPE_AGENT) < epoch) __builtin_amdgcn_s_sleep(1);
        __builtin_amdgcn_fence(__ATOMIC_ACQUIRE, "agent");
        asm volatile("s_waitcnt vmcnt(0)" ::: "memory");
    }
    __syncthreads();
}
#define GSYNC() grid_bar(p.bar, epoch)
__global__ void __launch_bounds__(256, 2) fwd_kernel(Params p) {
    __shared__ __attribute__((aligned(16))) unsigned char smem[SMEM_BYTES];
    cg::grid_group grid = cg::this_grid();
    bf16_t* sm = (bf16_t*)smem; float* smf = (float*)smem;

    unsigned epoch = 0;
    asm volatile("s_waitcnt vmcnt(0) lgkmcnt(0)" ::: "memory"); grid.sync();
    convert_layer(p, 0, smf);
    phase0_misc(p, smf);
    GSYNC();
    row_phase(p, p.x, false, nullptr, nullptr, nullptr, p.mod, 0, 1024, true, true);
    GSYNC();
    for (int l = 0; l < DEPTH; ++l) {
        const float* modl = p.mod + (size_t)l * 2 * 6144;
        const float* xcur = l == 0 ? p.x : p.xbuf;
        if (obid() >= gridDim.x - 8) scan_item(p, obid() - (gridDim.x - 8), smf);
        phase_inproj(p, sm);
        GSYNC();
        phase_mixers(p, l, smem);
        GSYNC();
        phase_post(p, l);
        ret_scan(p);
        GSYNC();
        for (int it = obid(); it < 1024; it += gridDim.x) ret_out_item(p, l, it, smem);
        GSYNC();
        phase_branch(p, sm);
        GSYNC();
        phase_gemm_res(p, p.h, 1024, p.WoutT, xcur, modl, 2048, sm);
        GSYNC();
        row_phase(p, p.vbuf, true, p.ln_g + (size_t)(l * 2) * Dm, p.ln_b + (size_t)(l * 2) * Dm, p.xbuf, modl, 3072, 4096, true, false);
        GSYNC();
        phase_up(p, sm);
        GSYNC();
        phase_conv(p, l);
        GSYNC();
        phase_gemm_res(p, p.act, DFF, p.WdownT, p.xbuf, modl, 5120, sm);
        GSYNC();
        if (l + 1 < DEPTH) {
            convert_layer(p, l + 1, smf);
            GSYNC();
            row_phase(p, p.vbuf, true, p.ln_g + (size_t)(l * 2 + 1) * Dm, p.ln_b + (size_t)(l * 2 + 1) * Dm, p.xbuf, modl + 2 * 6144, 0, 1024, true, true);
            GSYNC();
        } else {
            row_phase(p, p.vbuf, true, p.ln_g + (size_t)(l * 2 + 1) * Dm, p.ln_b + (size_t)(l * 2 + 1) * Dm, p.out, modl, 0, 1024, false, false);
        }
    }
}

extern "C" void kernel_launch(void* const* d_in, const int* in_sizes, int n_in, void* d_out, int out_size, void* d_ws, size_t ws_size, hipStream_t stream) {
    static int grid_blocks = 0;
    if (!grid_blocks) {
        int dev = 0, cus = 0, per_cu = 0;
        hipGetDevice(&dev);
        hipDeviceGetAttribute(&cus, hipDeviceAttributeMultiprocessorCount, dev);
        hipOccupancyMaxActiveBlocksPerMultiprocessor(&per_cu, fwd_kernel, 256, 0);
        if (per_cu > 2) per_cu = 2;
        if (per_cu < 1) per_cu = 1;
        grid_blocks = cus * per_cu;
    }
    Params p{};
    const float** ins = (const float**)&p.x;
    for (int i = 0; i < 22; ++i) ins[i] = (const float*)d_in[i];
    p.out = (float*)d_out;
    char* w = (char*)d_ws; size_t off = 0;
    auto take = [&](size_t bytes) { char* r = w + off; off += (bytes + 255) & ~(size_t)255; return r; };
    const size_t MB = 1u << 20;
    p.mod = (float*)take((size_t)DEPTH * 2 * 6144 * 4);
    p.lamv = (float*)take(256);
    p.ctr = (unsigned*)take(256);
    p.kn = (unsigned*)take(256);
    p.bar = (unsigned*)take((size_t)(1 + 1024) * 128);
    p.wf = (float*)take(4100 * 4);
    p.binp = (float*)take(NIN * 4);
    p.cstab = (float*)take((size_t)S * 64 * 2 * 4);
    p.logf = (float*)take((size_t)T * 4 * 4);
    p.F = (float*)take((size_t)T * 4 * 4);
    p.WinT = (bf16_t*)take((size_t)NIN * 1024 * 2);
    p.WpaT = (bf16_t*)take((size_t)1024 * 512 * 2);
    p.WpbT = (bf16_t*)take((size_t)1024 * 512 * 2);
    p.WpcT = (bf16_t*)take((size_t)1024 * 1024 * 2);
    p.WoutT = (bf16_t*)take((size_t)1024 * 1024 * 2);
    p.WupT = (bf16_t*)take((size_t)2 * DFF * 1024 * 2);
    p.WdownT = (bf16_t*)take((size_t)1024 * DFF * 2);
    p.xbuf = (float*)take((size_t)T * Dm * 4);
    p.h = (bf16_t*)take((size_t)T * Dm * 2);
    const size_t offA = off;
    p.qa = (bf16_t*)take((size_t)T * 512 * 2); p.ka = (bf16_t*)take((size_t)T * 512 * 2); p.vta = (bf16_t*)take((size_t)T * 512 * 2);
    p.qb = (bf16_t*)take((size_t)T * 512 * 2); p.kb = (bf16_t*)take((size_t)T * 512 * 2); p.vtb = (bf16_t*)take((size_t)T * 512 * 2);
    p.cq = (bf16_t*)take((size_t)T * 512 * 2); p.ck = (bf16_t*)take((size_t)T * 512 * 2);
    p.cv = (bf16_t*)take((size_t)T * 1024 * 2); p.cg = (bf16_t*)take((size_t)T * 1024 * 2);
    p.gates = (bf16_t*)take((size_t)T * 3072 * 2);
    const size_t endA = off;
    p.ug = (bf16_t*)(w + offA);
    p.act = (bf16_t*)(w + offA + (size_t)T * 2 * DFF * 2);
    const size_t offB = endA;
    off = offB;
    p.vbuf = (float*)(w + offB);
    p.oa = p.h;
    p.yb = (bf16_t*)take((size_t)T * 512 * 2);
    p.kv = (bf16_t*)take((size_t)8 * 128 * 256 * 128 * 2);
    p.ckT = (bf16_t*)take((size_t)T * 512 * 2);
    p.ya = (bf16_t*)take((size_t)T * 512 * 2);
    p.yc = (bf16_t*)take((size_t)T * 1024 * 2);
    if (off > ws_size || (size_t)T * 2 * DFF * 2 + (size_t)T * DFF * 2 > endA - offA) {
        fprintf(stderr, "kernel_launch: workspace too small: need %zu MB have %zu MB\n", off / MB, ws_size / MB);
        return;
    }
    (void)hipMemsetAsync(p.bar, 0, (size_t)(1 + 1024) * 128, stream);
    void* args[] = {&p};
    hipError_t e = hipLaunchCooperativeKernel((void*)fwd_kernel, dim3(grid_blocks), dim3(256), args, 0, stream);
    if (e != hipSuccess) fprintf(stderr, "cooperative launch failed: %s (grid %d)\n", hipGetErrorString(e), grid_blocks);
}
```

```cpp
#include <hip/hip_runtime.h>
#include <hip/hip_cooperative_groups.h>
#include <cstdio>
#include <cstdint>
namespace cg = cooperative_groups;

typedef unsigned short bf16_t;
typedef short bf16x8 __attribute__((ext_vector_type(8)));
typedef float f32x4 __attribute__((ext_vector_type(4)));

constexpr int Dm = 1024, NB = 2, S = 8192, T = NB * S, DEPTH = 4, DFF = 2816, DIN = 9220, NIN = 9216;
constexpr float LN_EPS = 1e-5f;
constexpr float LOG2E = 1.4426950408889634f;
#define ALPHA_F 1.681792830507429f

#define DI __device__ __forceinline__
DI int otid() { int t = threadIdx.x; asm volatile("" : "+v"(t)); return t; }
DI int obid() { int b = blockIdx.x; asm volatile("" : "+s"(b)); return b; }

typedef __bf16 hbf2 __attribute__((ext_vector_type(2)));
typedef float f32x2 __attribute__((ext_vector_type(2)));
DI bf16_t f2bf(float x) { return __builtin_bit_cast(unsigned short, (__bf16)x); }
DI float bf2f(bf16_t v) { return __uint_as_float(((unsigned)v) << 16); }
DI float bflo(unsigned w) { return __uint_as_float(w << 16); }
DI float bfhi(unsigned w) { return __uint_as_float(w & 0xffff0000u); }
DI unsigned pack2(float a, float b) { f32x2 v = {a, b}; return __builtin_bit_cast(unsigned, __builtin_convertvector(v, hbf2)); }

struct Params {
    const float *x, *c, *w_ada, *b_ada, *w_in, *b_in, *lq1, *lk1, *lq2, *lk2, *g_diff, *g_ret, *w_pa, *w_pb, *w_pc, *w_out, *ln_g, *ln_b, *w_up, *w_conv, *b_conv, *w_down;
    float* out;
    unsigned* ctr; unsigned* bar; unsigned* kn;
    float *mod, *lamv, *wf, *binp, *cstab, *xbuf, *vbuf, *logf, *F, *oc;
    bf16_t *WinT, *WpaT, *WpbT, *WpcT, *WoutT, *WupT, *WdownT;
    bf16_t *h, *qa, *ka, *vta, *qb, *kb, *vtb, *cq, *ck, *cv, *cg, *gates, *oa, *yb, *ya, *yc, *ug, *act, *ckT, *kv;
};

#define LDS_BARRIER() do { asm volatile("s_waitcnt lgkmcnt(0)" ::: "memory"); __builtin_amdgcn_s_barrier(); asm volatile("" ::: "memory"); } while (0)
constexpr int BM = 128, BN = 128, BK = 64, LDP = BK + 8;
constexpr int SMEM_BYTES = 2 * (BM + BN) * LDP * 2;

DI int win_map(int n) {
    if (n < 3072) return n;
    if (n < 4096) { int r = n - 3072; int seg = r >> 9; r &= 511; int head = r >> 7; int c = r & 127; return 3076 + seg * 512 + head * 128 + (c >> 1) + 64 * (c & 1); }
    return n + 4;
}

DI void convert_tile(const float* __restrict__ src, int ldsrc, bf16_t* __restrict__ dst, int K, int tiles_n, int tile, int kind, float* lds) {
    const int tn = tile % tiles_n, tk = tile / tiles_n;
    const int tx = otid() & 63, ty = otid() >> 6;
    const int n = tn * 64 + tx;
    const int sn = kind == 1 ? win_map(n) : n;
    __syncthreads();
#pragma unroll 4
    for (int r = 0; r < 16; ++r) {
        const int kk = ty * 16 + r;
        lds[kk * 65 + tx] = src[(size_t)(tk * 64 + kk) * ldsrc + sn];
    }
    __syncthreads();
#pragma unroll 4
    for (int r = 0; r < 16; ++r) {
        const int nn = ty * 16 + r;
        dst[(size_t)(tn * 64 + nn) * K + tk * 64 + tx] = f2bf(lds[tx * 65 + nn]);
    }
}

DI void convert_layer(const Params& p, int l, float* lds) {
    const int n_in = 16 * 144, n_pa = 8 * 16, n_pb = 8 * 16, n_pc = 16 * 16, n_out = 16 * 16, n_up = 16 * 88, n_dn = 44 * 16;
    const int total = n_in + n_pa + n_pb + n_pc + n_out + n_up + n_dn;
    for (int it = obid(); it < total; it += gridDim.x) {
        int t = it;
        if (t < n_in) { convert_tile(p.w_in + (size_t)l * Dm * DIN, DIN, p.WinT, 1024, 144, t, 1, lds); continue; } t -= n_in;
        if (t < n_pa) { convert_tile(p.w_pa + (size_t)l * 512 * Dm, Dm, p.WpaT, 512, 16, t, 0, lds); continue; } t -= n_pa;
        if (t < n_pb) { convert_tile(p.w_pb + (size_t)l * 512 * Dm, Dm, p.WpbT, 512, 16, t, 0, lds); continue; } t -= n_pb;
        if (t < n_pc) { convert_tile(p.w_pc + (size_t)l * 1024 * Dm, Dm, p.WpcT, 1024, 16, t, 0, lds); continue; } t -= n_pc;
        if (t < n_out) { convert_tile(p.w_out + (size_t)l * Dm * Dm, Dm, p.WoutT, 1024, 16, t, 0, lds); continue; } t -= n_out;
        if (t < n_up) { convert_tile(p.w_up + (size_t)l * Dm * 2 * DFF, 2 * DFF, p.WupT, 1024, 88, t, 0, lds); continue; } t -= n_up;
        convert_tile(p.w_down + (size_t)l * DFF * Dm, Dm, p.WdownT, DFF, 16, t, 0, lds);
    }
    const int gtid = obid() * blockDim.x + otid(), gsz = gridDim.x * blockDim.x;
    for (int i = gtid; i < NIN; i += gsz) p.binp[i] = p.b_in[(size_t)l * DIN + win_map(i)];
    for (int i = gtid; i < 4096; i += gsz) { const int k = i >> 2, hh = i & 3; p.wf[i] = p.w_in[(size_t)l * Dm * DIN + (size_t)k * DIN + 3072 + hh]; }
    for (int i = gtid; i < 4; i += gsz) p.wf[4096 + i] = p.b_in[(size_t)l * DIN + 3072 + i];
}

DI float ex2(float x) { return __builtin_amdgcn_exp2f(x); }
DI float lg2gamma(int hd) { return hd == 0 ? -0.04580368961312479f : hd == 1 ? -0.02272007650008353f : hd == 2 ? -0.011315313227834146f : -0.005646563141142063f; }
DI float silu_f(float v) { return v / (1.f + __expf(-v)); }
DI float sigmoid_f(float v) { return 1.f / (1.f + __expf(-v)); }

DI void phase0_misc(const Params& p, float* lds) {
    for (int it = obid(); it < DEPTH * 96; it += gridDim.x) {
        const int l = it / 96, jb = it % 96;
        const int tx = otid() & 63, ks = otid() >> 6;
        const int j = jb * 64 + tx;
        const float* w = p.w_ada + (size_t)l * Dm * 6144 + j;
        float a0 = 0.f, a1 = 0.f;
#pragma unroll 8
        for (int k = ks * 256; k < ks * 256 + 256; ++k) {
            const float wv = w[(size_t)k * 6144];
            a0 += silu_f(p.c[k]) * wv; a1 += silu_f(p.c[Dm + k]) * wv;
        }
        __syncthreads();
        lds[(ks * 64 + tx) * 2] = a0; lds[(ks * 64 + tx) * 2 + 1] = a1;
        __syncthreads();
        if (ks == 0) {
            float s0 = 0.f, s1 = 0.f;
            for (int q = 0; q < 4; ++q) { s0 += lds[(q * 64 + tx) * 2]; s1 += lds[(q * 64 + tx) * 2 + 1]; }
            const float bb = p.b_ada[(size_t)l * 6144 + j];
            p.mod[((size_t)l * 2 + 0) * 6144 + j] = s0 + bb;
            p.mod[((size_t)l * 2 + 1) * 6144 + j] = s1 + bb;
        }
    }
    const int gtid = obid() * blockDim.x + otid(), gsz = gridDim.x * blockDim.x;
    if (gtid < 64) p.ctr[gtid] = 0u;
    if (obid() == 0 && otid() < 64 * DEPTH) {
        const int l = otid() >> 6, ln = otid() & 63;
        float a = p.lq1[l * 64 + ln] * p.lk1[l * 64 + ln], b = p.lq2[l * 64 + ln] * p.lk2[l * 64 + ln];
        for (int o = 32; o; o >>= 1) { a += __shfl_xor(a, o); b += __shfl_xor(b, o); }
        if (ln == 0) { const float li = 0.8f - 0.6f * expf(-0.3f * (float)l); p.lamv[2 * l] = expf(a) - expf(b) + li; p.lamv[2 * l + 1] = li; }
    }
}

DI void row_phase(const Params& p, const float* __restrict__ src, bool do_ln, const float* __restrict__ lng, const float* __restrict__ lnb,
                  float* __restrict__ xdst, const float* __restrict__ modl  , int sh_off, int sc_off, bool want_h, bool want_logf) {
    const int lane = otid() & 63, wv = otid() >> 6;
    if (want_logf && obid() == 0 && otid() < 32) p.kn[otid()] = 0u;
    for (int row = obid() * 4 + wv; row < T; row += gridDim.x * 4) {
        const int b = row / S;
        const float* sp = src + (size_t)row * Dm;
        f32x4 v[4];
#pragma unroll
        for (int i = 0; i < 4; ++i) v[i] = *(const f32x4*)(sp + i * 256 + lane * 4);
        if (do_ln) {
            float s = 0.f;
#pragma unroll
            for (int i = 0; i < 4; ++i) s += (v[i][0] + v[i][1]) + (v[i][2] + v[i][3]);
            for (int o = 32; o; o >>= 1) s += __shfl_xor(s, o);
            const float mu = s * (1.f / 1024.f);
            float q = 0.f;
#pragma unroll
            for (int i = 0; i < 4; ++i) { f32x4 d = v[i] - mu; q += (d[0] * d[0] + d[1] * d[1]) + (d[2] * d[2] + d[3] * d[3]); }
            for (int o = 32; o; o >>= 1) q += __shfl_xor(q, o);
            const float rstd = rsqrtf(q * (1.f / 1024.f) + LN_EPS);
#pragma unroll
            for (int i = 0; i < 4; ++i) {
                const f32x4 g = *(const f32x4*)(lng + i * 256 + lane * 4), bb = *(const f32x4*)(lnb + i * 256 + lane * 4);
                v[i] = (v[i] - mu) * rstd * g + bb;
            }
        }
        if (xdst) {
#pragma unroll
            for (int i = 0; i < 4; ++i) *(f32x4*)(xdst + (size_t)row * Dm + i * 256 + lane * 4) = v[i];
        }
        if (want_h) {
            const float* mb = modl + (size_t)b * 6144;
            float d0 = 0.f, d1 = 0.f, d2 = 0.f, d3 = 0.f;
#pragma unroll
            for (int i = 0; i < 4; ++i) {
                const int c0 = i * 256 + lane * 4;
                const f32x4 sc = *(const f32x4*)(mb + sc_off + c0), sh = *(const f32x4*)(mb + sh_off + c0);
                const f32x4 hv = v[i] * (1.f + sc) + sh;
                uint2 w; w.x = pack2(hv[0], hv[1]); w.y = pack2(hv[2], hv[3]);
                *(uint2*)(p.h + (size_t)row * Dm + c0) = w;
                if (want_logf) {
#pragma unroll
                    for (int j = 0; j < 4; ++j) {
                        const f32x4 wf = *(const f32x4*)(p.wf + (c0 + j) * 4);
                        d0 += hv[j] * wf[0]; d1 += hv[j] * wf[1]; d2 += hv[j] * wf[2]; d3 += hv[j] * wf[3];
                    }
                }
            }
            if (want_logf) {
                for (int o = 32; o; o >>= 1) { d0 += __shfl_xor(d0, o); d1 += __shfl_xor(d1, o); d2 += __shfl_xor(d2, o); d3 += __shfl_xor(d3, o); }
                if (lane < 4) {
                    float z = (lane == 0 ? d0 : lane == 1 ? d1 : lane == 2 ? d2 : d3) + p.wf[4096 + lane];
                    const float ls = fminf(z, 0.f) - log1pf(__expf(-fabsf(z)));
                    p.logf[(size_t)row * 4 + lane] = ls * LOG2E;
                }
            }
        }
    }
}

DI void scan_item(const Params& p, int item, float* lds) {
    const int b = item >> 2, hh = item & 3, tid = otid();
    const float* lp = p.logf + (size_t)b * S * 4 + hh;
    float loc[32]; float s = 0.f;
#pragma unroll
    for (int i = 0; i < 32; ++i) { s += lp[(size_t)(tid * 32 + i) * 4]; loc[i] = s; }
    __syncthreads();
    lds[tid] = s;
    __syncthreads();
    float pre = 0.f;
    for (int i = 0; i < tid; ++i) pre += lds[i];
    float* fp = p.F + (size_t)(b * 4 + hh) * S + tid * 32;
#pragma unroll
    for (int i = 0; i < 32; ++i) fp[i] = pre + loc[i];
    __syncthreads();
}

DI void gemm_kloop(const bf16_t* __restrict__ Ag, int lda, const bf16_t* __restrict__ Bg, int ldb, int K, f32x4 (&acc)[4][4], bf16_t* sm) {
    const int tid = otid(), lane = tid & 63, wid = tid >> 6, wr = wid >> 1, wc = wid & 1;
    bf16_t* sa = sm; bf16_t* sb = sm + 2 * BM * LDP;
    const int lrow = tid >> 3, lcc = tid & 7;
    const bf16_t* ap = Ag + (size_t)lrow * lda + lcc * 8;
    const bf16_t* bp = Bg + (size_t)lrow * ldb + lcc * 8;
    const size_t sA = (size_t)32 * lda, sB = (size_t)32 * ldb;
    uint4 ra0, ra1, ra2, ra3, rb0, rb1, rb2, rb3;
#define G_LOAD(koff) do { ra0 = *(const uint4*)(ap + (koff)); ra1 = *(const uint4*)(ap + sA + (koff)); ra2 = *(const uint4*)(ap + 2 * sA + (koff)); ra3 = *(const uint4*)(ap + 3 * sA + (koff)); \
                          rb0 = *(const uint4*)(bp + (koff)); rb1 = *(const uint4*)(bp + sB + (koff)); rb2 = *(const uint4*)(bp + 2 * sB + (koff)); rb3 = *(const uint4*)(bp + 3 * sB + (koff)); } while (0)
#define G_STORE(buf) do { bf16_t* da_ = sa + (buf) * BM * LDP + lrow * LDP + lcc * 8; bf16_t* db_ = sb + (buf) * BN * LDP + lrow * LDP + lcc * 8; \
        *(uint4*)(da_) = ra0; *(uint4*)(da_ + 32 * LDP) = ra1; *(uint4*)(da_ + 64 * LDP) = ra2; *(uint4*)(da_ + 96 * LDP) = ra3; \
        *(uint4*)(db_) = rb0; *(uint4*)(db_ + 32 * LDP) = rb1; *(uint4*)(db_ + 64 * LDP) = rb2; *(uint4*)(db_ + 96 * LDP) = rb3; } while (0)
    G_LOAD(0);
    G_STORE(0);
    LDS_BARRIER();
    const int nk = K / BK;
    const int fr = lane & 15, fq = lane >> 4;
    for (int kt = 0; kt < nk; ++kt) {
        const int cur = kt & 1;
        const bool more = kt + 1 < nk;
        if (more) G_LOAD((kt + 1) * BK);
        const bf16_t* ca = sa + cur * BM * LDP + (wr * 64 + fr) * LDP + fq * 8;
        const bf16_t* cb = sb + cur * BN * LDP + (wc * 64 + fr) * LDP + fq * 8;
#pragma unroll
        for (int kk = 0; kk < 2; ++kk) {
            bf16x8 af[4], bfr[4];
#pragma unroll
            for (int m = 0; m < 4; ++m) af[m] = *(const bf16x8*)(ca + m * 16 * LDP + kk * 32);
#pragma unroll
            for (int n = 0; n < 4; ++n) bfr[n] = *(const bf16x8*)(cb + n * 16 * LDP + kk * 32);
#pragma unroll
            for (int m = 0; m < 4; ++m)
#pragma unroll
                for (int n = 0; n < 4; ++n) acc[m][n] = __builtin_amdgcn_mfma_f32_16x16x32_bf16(bfr[n], af[m], acc[m][n], 0, 0, 0);
        }
        if (more) G_STORE(cur ^ 1);
        LDS_BARRIER();
    }
#undef G_LOAD
#undef G_STORE
}

DI void gemm_kloop2(const bf16_t* __restrict__ Ag, int lda, const bf16_t* __restrict__ Bg, int ldb, int K, f32x4 (&acc)[4][4], bf16_t* sm) {
    const int tid = otid(), lane = tid & 63, wid = tid >> 6, wr = wid >> 1, wc = wid & 1;
    bf16_t* sa = sm; bf16_t* sb = sm + 2 * BM * LDP;
    const int lrow = tid >> 3, lcc = tid & 7;
    const bf16_t* ap = Ag + (size_t)lrow * lda + lcc * 8;
    const bf16_t* bp = Bg + (size_t)lrow * ldb + lcc * 8;
    const size_t sA = (size_t)32 * lda, sB = (size_t)32 * ldb;
    uint4 xa0, xa1, xa2, xa3, xb0, xb1, xb2, xb3;
    uint4 ya0, ya1, ya2, ya3, yb0, yb1, yb2, yb3;
#define G2_LOAD(P, koff) do { P##a0 = *(const uint4*)(ap + (koff)); P##a1 = *(const uint4*)(ap + sA + (koff)); P##a2 = *(const uint4*)(ap + 2 * sA + (koff)); P##a3 = *(const uint4*)(ap + 3 * sA + (koff)); \
                              P##b0 = *(const uint4*)(bp + (koff)); P##b1 = *(const uint4*)(bp + sB + (koff)); P##b2 = *(const uint4*)(bp + 2 * sB + (koff)); P##b3 = *(const uint4*)(bp + 3 * sB + (koff)); } while (0)
#define G2_STORE(P, buf) do { bf16_t* da_ = sa + (buf) * BM * LDP + lrow * LDP + lcc * 8; bf16_t* db_ = sb + (buf) * BN * LDP + lrow * LDP + lcc * 8; \
        *(uint4*)(da_) = P##a0; *(uint4*)(da_ + 32 * LDP) = P##a1; *(uint4*)(da_ + 64 * LDP) = P##a2; *(uint4*)(da_ + 96 * LDP) = P##a3; \
        *(uint4*)(db_) = P##b0; *(uint4*)(db_ + 32 * LDP) = P##b1; *(uint4*)(db_ + 64 * LDP) = P##b2; *(uint4*)(db_ + 96 * LDP) = P##b3; } while (0)
#define G2_COMPUTE(buf) do { \
        const bf16_t* ca = sa + (buf) * BM * LDP + (wr * 64 + fr) * LDP + fq * 8; \
        const bf16_t* cb = sb + (buf) * BN * LDP + (wc * 64 + fr) * LDP + fq * 8; \
        _Pragma("unroll") for (int kk = 0; kk < 2; ++kk) { \
            bf16x8 af[4], bfr[4]; \
            _Pragma("unroll") for (int m = 0; m < 4; ++m) af[m] = *(const bf16x8*)(ca + m * 16 * LDP + kk * 32); \
            _Pragma("unroll") for (int n = 0; n < 4; ++n) bfr[n] = *(const bf16x8*)(cb + n * 16 * LDP + kk * 32); \
            _Pragma("unroll") for (int m = 0; m < 4; ++m) _Pragma("unroll") for (int n = 0; n < 4; ++n) acc[m][n] = __builtin_amdgcn_mfma_f32_16x16x32_bf16(bfr[n], af[m], acc[m][n], 0, 0, 0); \
        } } while (0)
    const int nk = K / BK;
    const int fr = lane & 15, fq = lane >> 4;
    G2_LOAD(x, 0);
    G2_LOAD(y, BK);
    G2_STORE(x, 0);
    LDS_BARRIER();
    for (int kt = 0; kt < nk; kt += 2) {
        const int kx = kt + 2 < nk ? kt + 2 : nk - 2, ky = kt + 3 < nk ? kt + 3 : nk - 1;
        G2_LOAD(x, kx * BK);
        __builtin_amdgcn_sched_barrier(0);
        G2_COMPUTE(0);
        G2_STORE(y, 1);
        LDS_BARRIER();
        G2_LOAD(y, ky * BK);
        __builtin_amdgcn_sched_barrier(0);
        G2_COMPUTE(1);
        G2_STORE(x, 0);
        LDS_BARRIER();
    }
#undef G2_LOAD
#undef G2_STORE
#undef G2_COMPUTE
}

DI void tile_coords(int tile, int nM, int nN, int& mt, int& nt) {
    const int G = gridDim.x;
    if ((G & 7) == 0 && (nM & 63) == 0 && (nM * nN) % G == 0) {
        const int b = tile % G, k = tile / G, per = G >> 3;
        const int xcd = b & 7, slot = b >> 3;
        const int li = k * per + slot;
        const int mh = li / (8 * nN), rem = li % (8 * nN);
        nt = rem >> 3; mt = (mh * 8 + (rem & 7)) * 8 + xcd;
        return;
    }
    const int band = tile / (16 * nN), r = tile % (16 * nN);
    mt = band * 16 + (r & 15); nt = r >> 4;
}

DI void zero_acc(f32x4 (&acc)[4][4]) {
#pragma unroll
    for (int m = 0; m < 4; ++m)
#pragma unroll
        for (int n = 0; n < 4; ++n) acc[m][n] = (f32x4){0.f, 0.f, 0.f, 0.f};
}


constexpr int BM2 = 256, BK2 = 32, LDP2 = BK2 + 8;
typedef __attribute__((address_space(3))) unsigned lds_u32;
DI void gemm_kloop3(const bf16_t* __restrict__ Ag, int lda, const bf16_t* __restrict__ Bg, int ldb, int K, f32x4 (&acc)[8][4], bf16_t* sm) {
    const int tid = otid(), lane = tid & 63, wid = tid >> 6, wr = wid >> 1, wc = wid & 1;
    unsigned char* base = (unsigned char*)sm;
    const int fr = lane & 15, fq = lane >> 4;
    const int lr = lane >> 2, chunk = (lane & 3) ^ ((lane >> 4) & 3);
    const bf16_t* ga[4]; const bf16_t* gb[2];
#pragma unroll
    for (int i = 0; i < 4; ++i) ga[i] = Ag + (size_t)((wid * 4 + i) * 16 + lr) * lda + chunk * 8;
#pragma unroll
    for (int i = 0; i < 2; ++i) { const int rho = (wid * 2 + i) * 16 + lr; const int r64 = rho & 63; const int grow = (rho & 64) + ((r64 >> 2) & 3) * 16 + (r64 >> 4) * 4 + (r64 & 3); gb[i] = Bg + (size_t)grow * ldb + chunk * 8; }
#define G4_ISSUE(buf, koff) do { \
        _Pragma("unroll") for (int i_ = 0; i_ < 4; ++i_) __builtin_amdgcn_global_load_lds((const unsigned*)(ga[i_] + (koff)), (lds_u32*)(base + (buf) * 16384 + (wid * 4 + i_) * 1024), 16, 0, 0); \
        _Pragma("unroll") for (int i_ = 0; i_ < 2; ++i_) __builtin_amdgcn_global_load_lds((const unsigned*)(gb[i_] + (koff)), (lds_u32*)(base + 49152 + (buf) * 8192 + (wid * 2 + i_) * 1024), 16, 0, 0); } while (0)
    const int nk = K / BK2;
    const int slot16 = (fq ^ ((fr >> 2) & 3)) * 16;
    G4_ISSUE(0, 0);
    G4_ISSUE(1, BK2);
    asm volatile("s_waitcnt vmcnt(6)" ::: "memory");
    __builtin_amdgcn_s_barrier(); asm volatile("" ::: "memory");
    int cur = 0;
    for (int kt = 0; kt < nk; ++kt) {
        const bool more2 = kt + 2 < nk;
        const int nb = cur == 0 ? 2 : cur - 1;
        const unsigned char* ca = base + cur * 16384 + (wr * 128 + fr) * 64 + slot16;
        const unsigned char* cb = base + 49152 + cur * 8192 + (wc * 64 + fr) * 64 + slot16;
        bf16x8 af[8], bfr[4];
#pragma unroll
        for (int m = 0; m < 8; ++m) af[m] = *(const bf16x8*)(ca + m * 16 * 64);
#pragma unroll
        for (int n = 0; n < 4; ++n) bfr[n] = *(const bf16x8*)(cb + n * 16 * 64);
        __builtin_amdgcn_sched_barrier(0);
        if (more2) G4_ISSUE(nb, (kt + 2) * BK2);
        __builtin_amdgcn_s_setprio(1);
#pragma unroll
        for (int m = 0; m < 8; ++m)
#pragma unroll
            for (int n = 0; n < 4; ++n) acc[m][n] = __builtin_amdgcn_mfma_f32_16x16x32_bf16(bfr[n], af[m], acc[m][n], 0, 0, 0);
        __builtin_amdgcn_s_setprio(0);
        if (more2) asm volatile("s_waitcnt vmcnt(6) lgkmcnt(0)" ::: "memory"); else asm volatile("s_waitcnt vmcnt(0) lgkmcnt(0)" ::: "memory");
        __builtin_amdgcn_s_barrier(); asm volatile("" ::: "memory");
        cur = cur == 2 ? 0 : cur + 1;
    }
#undef G4_ISSUE
}
DI void zero_acc8(f32x4 (&acc)[8][4]) {
#pragma unroll
    for (int m = 0; m < 8; ++m)
#pragma unroll
        for (int n = 0; n < 4; ++n) acc[m][n] = (f32x4){0.f, 0.f, 0.f, 0.f};
}
DI void st4_wt(bf16_t* dst, f32x4 v) { const unsigned long long w = (unsigned long long)pack2(v[0], v[1]) | ((unsigned long long)pack2(v[2], v[3]) << 32); __hip_atomic_store((unsigned long long*)dst, w, __ATOMIC_RELAXED, __HIP_MEMORY_SCOPE_AGENT); }
DI void st4(bf16_t* dst, f32x4 v) { uint2 w; w.x = pack2(v[0], v[1]); w.y = pack2(v[2], v[3]); *(uint2*)dst = w; }

DI void st8(bf16_t* dst, f32x4 a, f32x4 b) { uint4 w; w.x = pack2(a[0], a[1]); w.y = pack2(a[2], a[3]); w.z = pack2(b[0], b[1]); w.w = pack2(b[2], b[3]); *(uint4*)dst = w; }
DI f32x4 rot4(f32x4 v, int s, int i0) {
    const float a0 = (float)s * ex2(-(float)i0 * 0.21091607f), a1 = (float)s * ex2(-(float)(i0 + 1) * 0.21091607f);
    float r0 = a0 * 0.15915494309189535f, r1 = a1 * 0.15915494309189535f;
    r0 -= floorf(r0); r1 -= floorf(r1);
    float c0_ = __builtin_amdgcn_cosf(r0), s0_ = __builtin_amdgcn_sinf(r0), c1_ = __builtin_amdgcn_cosf(r1), s1_ = __builtin_amdgcn_sinf(r1);
    asm volatile("s_nop 15\n\ts_nop 15" : "+v"(c0_), "+v"(s0_), "+v"(c1_), "+v"(s1_));
    f32x4 o; o[0] = v[0] * c0_ - v[1] * s0_; o[1] = v[0] * s0_ + v[1] * c0_; o[2] = v[2] * c1_ - v[3] * s1_; o[3] = v[2] * s1_ + v[3] * c1_;
    return o;
}
DI void epi_inproj(const Params& p, int row, int col, f32x4 v0, f32x4 v1) {
    v0 += *(const f32x4*)(p.binp + col); v1 += *(const f32x4*)(p.binp + col + 4);
    const int b = row / S, s = row % S;
    if (col < 512) { st8(p.qa + (size_t)row * 512 + col, v0 * (0.125f * LOG2E), v1 * (0.125f * LOG2E)); }
    else if (col < 1024) { st8(p.ka + (size_t)row * 512 + (col - 512), v0, v1); }
    else if (col < 1536) { const int c = col - 1024, hh = c >> 7, e = c & 127; bf16_t* d = p.vta + ((size_t)(b * 4 + hh) * 128 + e) * S + s;
#pragma unroll
        for (int j = 0; j < 4; ++j) { d[(size_t)j * S] = f2bf(v0[j]); d[(size_t)(j + 4) * S] = f2bf(v1[j]); } }
    else if (col < 2048) { st8(p.qb + (size_t)row * 512 + (col - 1536), v0 * (0.08838834764831845f * LOG2E), v1 * (0.08838834764831845f * LOG2E)); }
    else if (col < 2560) {
        st8(p.kb + (size_t)row * 512 + (col - 2048), v0, v1);
        float ss = 0.f;
#pragma unroll
        for (int j = 0; j < 4; ++j) { const float x0 = bf2f(f2bf(v0[j])), x1 = bf2f(f2bf(v1[j])); ss += x0 * x0 + x1 * x1; }
        ss += __shfl_xor(ss, 16); ss += __shfl_xor(ss, 32);
#pragma unroll
        for (int o = 8; o; o >>= 1) ss = fmaxf(ss, __shfl_xor(ss, o));
        const int c = col - 2048, grp = ((c >> 6) & 1) * 2 + ((c >> 3) & 1);
        if ((otid() & 63) == 0) atomicMax(p.kn + (b * 4 + (c >> 7)) * 4 + grp, __float_as_uint(ss));
    }
    else if (col < 3072) { const int c = col - 2560, hh = c >> 7, e = c & 127; bf16_t* d = p.vtb + ((size_t)(b * 4 + hh) * 128 + e) * S + s;
#pragma unroll
        for (int j = 0; j < 4; ++j) { d[(size_t)j * S] = f2bf(v0[j]); d[(size_t)(j + 4) * S] = f2bf(v1[j]); } }
    else if (col < 4096) {
        const int r = col - 3072, seg = r >> 9, c = r & 511, cc = c & 127, i0 = cc >> 1, hd = c >> 7;
        f32x4 o0 = rot4(v0, s, i0), o1 = rot4(v1, s, i0 + 2);
        const float lg = lg2gamma(hd);
        const int ic = s & 63;
        float e1_ = ex2(lg * (float)(ic + 1)), e2_ = ex2(-lg * (float)(ic + 1)), e3_ = ex2(lg * (float)(63 - ic));
        asm volatile("s_nop 15\n\ts_nop 15" : "+v"(e1_), "+v"(e2_), "+v"(e3_));
        if (seg == 0) st8(p.cq + (size_t)row * 512 + c, o0 * e1_, o1 * e1_);
        else {
            o0 = o0 * 0.08838834764831845f; o1 = o1 * 0.08838834764831845f;
            st8(p.ck + (size_t)row * 512 + c, o0 * e2_, o1 * e2_);
            const f32x4 d0 = o0 * e3_, d1 = o1 * e3_;
            bf16_t* d = p.ckT + ((size_t)(b * 4 + hd) * 128 + cc) * S + s;
#pragma unroll
            for (int j = 0; j < 4; ++j) { d[(size_t)j * S] = f2bf(d0[j]); d[(size_t)(j + 4) * S] = f2bf(d1[j]); }
        }
    }
    else if (col < 5120) { const int c = col - 4096; bf16_t* d = p.cv + ((size_t)b * 1024 + c) * S + s;
#pragma unroll
        for (int j = 0; j < 4; ++j) { d[(size_t)j * S] = f2bf(v0[j]); d[(size_t)(j + 4) * S] = f2bf(v1[j]); } }
    else if (col < 6144) { f32x4 o0, o1; for (int j = 0; j < 4; ++j) { o0[j] = silu_f(v0[j]); o1[j] = silu_f(v1[j]); } st8(p.cg + (size_t)row * 1024 + (col - 5120), o0, o1); }
    else { f32x4 o0, o1; for (int j = 0; j < 4; ++j) { o0[j] = sigmoid_f(v0[j]); o1[j] = sigmoid_f(v1[j]); } st8(p.gates + (size_t)row * 3072 + (col - 6144), o0, o1); }
}

DI void phase_inproj(const Params& p, bf16_t* sm) {
    const int nM = T / BM2, nN = NIN / BN;
    const int lane = otid() & 63, wid = otid() >> 6, wr = wid >> 1, wc = wid & 1;
    for (int tile = obid(); tile < nM * nN; tile += gridDim.x) {
        int mt, nt; tile_coords(tile, nM, nN, mt, nt);
        f32x4 acc[8][4]; zero_acc8(acc);
        gemm_kloop3(p.h + (size_t)mt * BM2 * Dm, Dm, p.WinT + (size_t)nt * BN * Dm, Dm, Dm, acc, sm);
#pragma unroll
        for (int m = 0; m < 8; ++m)
#pragma unroll
            for (int n2 = 0; n2 < 2; ++n2) epi_inproj(p, mt * BM2 + wr * 128 + m * 16 + (lane & 15), nt * BN + wc * 64 + (lane >> 4) * 16 + n2 * 8, acc[m][2 * n2], acc[m][2 * n2 + 1]);
    }
}

DI void phase_branch(const Params& p, bf16_t* sm) {
    const int nM = T / BM, nN = Dm / BN;
    const int lane = otid() & 63, wid = otid() >> 6, wr = wid >> 1, wc = wid & 1;
    for (int tile = obid(); tile < nM * nN; tile += gridDim.x) {
        int mt, nt; tile_coords(tile, nM, nN, mt, nt);
        f32x4 tot[4][4]; zero_acc(tot);
#pragma unroll 1
        for (int br = 0; br < 3; ++br) {
            const bf16_t* A = br == 0 ? p.ya : br == 1 ? p.yb : p.yc;
            const bf16_t* W = br == 0 ? p.WpaT : br == 1 ? p.WpbT : p.WpcT;
            const int K = br == 2 ? 1024 : 512;
            f32x4 acc[4][4]; zero_acc(acc);
            gemm_kloop(A + (size_t)mt * BM * K, K, W + (size_t)nt * BN * K, K, K, acc, sm);
#pragma unroll
            for (int m = 0; m < 4; ++m)
#pragma unroll
                for (int n = 0; n < 4; ++n) {
                    const int row = mt * BM + wr * 64 + m * 16 + (lane & 15), col = nt * BN + wc * 64 + n * 16 + (lane >> 4) * 4;
                    const uint2 g = *(const uint2*)(p.gates + (size_t)row * 3072 + br * 1024 + col);
                    tot[m][n][0] += bflo(g.x) * acc[m][n][0]; tot[m][n][1] += bfhi(g.x) * acc[m][n][1];
                    tot[m][n][2] += bflo(g.y) * acc[m][n][2]; tot[m][n][3] += bfhi(g.y) * acc[m][n][3];
                }
        }
#pragma unroll
        for (int m = 0; m < 4; ++m)
#pragma unroll
            for (int n = 0; n < 4; ++n) {
                const int row = mt * BM + wr * 64 + m * 16 + (lane & 15), col = nt * BN + wc * 64 + n * 16 + (lane >> 4) * 4;
                st4(p.h + (size_t)row * Dm + col, tot[m][n]);
            }
    }
}

DI void phase_gemm_res(const Params& p, const bf16_t* A, int K, const bf16_t* Wt, const float* xres, const float* modl, int gt_off, bf16_t* sm) {
    const int nM = T / BM2, nN = Dm / BN;
    const int lane = otid() & 63, wid = otid() >> 6, wr = wid >> 1, wc = wid & 1;
    for (int tile = obid(); tile < nM * nN; tile += gridDim.x) {
        int mt, nt; tile_coords(tile, nM, nN, mt, nt);
        f32x4 acc[8][4]; zero_acc8(acc);
        gemm_kloop3(A + (size_t)mt * BM2 * K, K, Wt + (size_t)nt * BN * K, K, K, acc, sm);
#pragma unroll
        for (int m = 0; m < 8; ++m)
#pragma unroll
            for (int n = 0; n < 4; ++n) {
                const int row = mt * BM2 + wr * 128 + m * 16 + (lane & 15), col = nt * BN + wc * 64 + (lane >> 4) * 16 + n * 4;
                const int b = row / S;
                const f32x4 xr = *(const f32x4*)(xres + (size_t)row * Dm + col);
                const f32x4 gt = *(const f32x4*)(modl + (size_t)b * 6144 + gt_off + col);
                *(f32x4*)(p.vbuf + (size_t)row * Dm + col) = xr * ALPHA_F + gt * acc[m][n];
            }
    }
}

DI void phase_up(const Params& p, bf16_t* sm) {
    const int nM = T / BM2, nN = 2 * DFF / BN;
    const int lane = otid() & 63, wid = otid() >> 6, wr = wid >> 1, wc = wid & 1;
    for (int tile = obid(); tile < nM * nN; tile += gridDim.x) {
        int mt, nt; tile_coords(tile, nM, nN, mt, nt);
        f32x4 acc[8][4]; zero_acc8(acc);
        gemm_kloop3(p.h + (size_t)mt * BM2 * Dm, Dm, p.WupT + (size_t)nt * BN * Dm, Dm, Dm, acc, sm);
#pragma unroll
        for (int m = 0; m < 8; ++m)
#pragma unroll
            for (int n2 = 0; n2 < 2; ++n2) {
                const int row = mt * BM2 + wr * 128 + m * 16 + (lane & 15), col = nt * BN + wc * 64 + (lane >> 4) * 16 + n2 * 8;
                st8(p.ug + (size_t)row * (2 * DFF) + col, acc[m][2 * n2], acc[m][2 * n2 + 1]);
            }
    }
}

DI void phase_conv(const Params& p, int l) {
    const int gtid = obid() * blockDim.x + otid(), gsz = gridDim.x * blockDim.x;
    const float* wc = p.w_conv + (size_t)l * 3 * DFF; const float* bc = p.b_conv + (size_t)l * DFF;
    for (int i = gtid; i < T * (DFF / 8); i += gsz) {
        const int row = i / (DFF / 8), c8 = (i % (DFF / 8)) * 8, s = row % S;
        const bf16_t* up = p.ug + (size_t)row * (2 * DFF) + c8;
        const uint4 u0 = *(const uint4*)up;
        uint4 u1 = make_uint4(0, 0, 0, 0), u2 = make_uint4(0, 0, 0, 0);
        if (s >= 1) u1 = *(const uint4*)(up - 2 * DFF);
        if (s >= 2) u2 = *(const uint4*)(up - 4 * DFF);
        const uint4 gg = *(const uint4*)(up + DFF);
        const unsigned a0[4] = {u0.x, u0.y, u0.z, u0.w}, a1[4] = {u1.x, u1.y, u1.z, u1.w}, a2[4] = {u2.x, u2.y, u2.z, u2.w}, ag[4] = {gg.x, gg.y, gg.z, gg.w};
        float cv[8], t[8], e[8];
#pragma unroll
        for (int h4 = 0; h4 < 2; ++h4) {
            const f32x4 w0 = *(const f32x4*)(wc + c8 + 4 * h4), w1 = *(const f32x4*)(wc + DFF + c8 + 4 * h4), w2 = *(const f32x4*)(wc + 2 * DFF + c8 + 4 * h4), bb = *(const f32x4*)(bc + c8 + 4 * h4);
#pragma unroll
            for (int k = 0; k < 4; ++k) {
                const int j = 2 * h4 + (k >> 1); const bool hi = k & 1;
                const float x0 = hi ? bfhi(a0[j]) : bflo(a0[j]), x1 = hi ? bfhi(a1[j]) : bflo(a1[j]), x2 = hi ? bfhi(a2[j]) : bflo(a2[j]);
                cv[4 * h4 + k] = bb[k] + w0[k] * x2 + w1[k] * x1 + w2[k] * x0;
            }
        }
#pragma unroll
        for (int k = 0; k < 8; ++k) { t[k] = __builtin_amdgcn_rcpf(fabsf(cv[k]) * 0.2316418882f + 1.0f); e[k] = ex2(cv[k] * cv[k] * (-0.72134752044f)); }
        asm volatile("s_nop 15\n\ts_nop 15" : "+v"(t[0]), "+v"(t[1]), "+v"(t[2]), "+v"(t[3]), "+v"(t[4]), "+v"(t[5]), "+v"(t[6]), "+v"(t[7]));
        asm volatile("s_nop 3" : "+v"(e[0]), "+v"(e[1]), "+v"(e[2]), "+v"(e[3]), "+v"(e[4]), "+v"(e[5]), "+v"(e[6]), "+v"(e[7]));
        unsigned o[4];
#pragma unroll
        for (int j = 0; j < 4; ++j) {
            float rr[2];
#pragma unroll
            for (int hl = 0; hl < 2; ++hl) {
                const int k = 2 * j + hl;
                float q = t[k] * 0.5307027145f + (-0.7265760135f); q = q * t[k] + 0.7107068705f; q = q * t[k] + (-0.142248368f); q = q * t[k] + 0.127414796f; q = q * t[k];
                const float m = cv[k] * (q * e[k]);
                const float gl = cv[k] < 0.f ? m : cv[k] - m;
                rr[hl] = gl * (hl ? bfhi(ag[j]) : bflo(ag[j]));
            }
            o[j] = pack2(rr[0], rr[1]);
        }
        *(uint4*)(p.act + (size_t)row * DFF + c8) = make_uint4(o[0], o[1], o[2], o[3]);
    }
}

template <int MODE>
DI void naive_attn(const Params& p, int item) {
    constexpr int D = MODE == 0 ? 64 : 128;
    constexpr int DV = MODE == 2 ? 256 : 128;
    constexpr int SW = DV / 4;
    constexpr int NH = MODE == 0 ? 8 : 4;
    const int tid = otid(), lane = tid & 63;
    const int sl = __builtin_amdgcn_readfirstlane(tid >> 6);
    const int qblk = 127 - (item % 128), hh = (item / 128) % NH, b = item / (128 * NH);
    const int q = qblk * 64 + lane; const size_t tq = (size_t)b * S + q;
    const bf16_t *Q, *Kp;
    if (MODE == 0) { Q = p.qa + tq * 512 + hh * 64; Kp = p.ka + (size_t)b * S * 512 + hh * 64; }
    else if (MODE == 1) { Q = p.qb + tq * 512 + hh * 128; Kp = p.kb + (size_t)b * S * 512 + hh * 128; }
    else { Q = p.cq + tq * 512 + hh * 128; Kp = p.ck + (size_t)b * S * 512 + hh * 128; }
    unsigned qp[D / 2];
#pragma unroll
    for (int i = 0; i < D / 8; ++i) { const uint4 t = ((const uint4*)Q)[i]; qp[4 * i] = t.x; qp[4 * i + 1] = t.y; qp[4 * i + 2] = t.z; qp[4 * i + 3] = t.w; }
    float acc[SW];
#pragma unroll
    for (int i = 0; i < SW; ++i) acc[i] = 0.f;
    float mx = -INFINITY, lsum = 0.f;
    const int send = (qblk + 1) * 64;
    float Fq = 0.f; const float* Fk = nullptr;
    if (MODE == 1) { Fk = p.F + (size_t)(b * 4 + hh) * S; Fq = Fk[q]; }
    float lg = 0.f;
    if (MODE == 2) lg = log2f(1.0f - exp2f(-5.0f - (float)hh));
    for (int s = 0; s < send; ++s) {
        const uint4* kr = (const uint4*)(Kp + (size_t)s * 512);
        float sc = 0.f;
#pragma unroll
        for (int i = 0; i < D / 8; ++i) {
            const uint4 kv = kr[i];
            sc += bflo(qp[4 * i]) * bflo(kv.x) + bfhi(qp[4 * i]) * bfhi(kv.x);
            sc += bflo(qp[4 * i + 1]) * bflo(kv.y) + bfhi(qp[4 * i + 1]) * bfhi(kv.y);
            sc += bflo(qp[4 * i + 2]) * bflo(kv.z) + bfhi(qp[4 * i + 2]) * bfhi(kv.z);
            sc += bflo(qp[4 * i + 3]) * bflo(kv.w) + bfhi(qp[4 * i + 3]) * bfhi(kv.w);
            if ((i & 3) == 3) asm volatile("" ::: "memory");
        }
        float w, corr = 1.f;
        if (MODE == 2) {
            w = (s <= q) ? sc * exp2f((float)(q - s) * lg) : 0.f;
        } else {
            if (MODE == 1) sc += Fq - Fk[s];
            const bool valid = (MODE == 0) || (s <= q);
            if (valid) {
                const float mn = fmaxf(mx, sc);
                corr = exp2f(mx - mn); w = exp2f(sc - mn); mx = mn;
                lsum = lsum * corr + w;
            } else { w = 0.f; }
        }
        if (MODE == 2) {
            const uint4* vr = (const uint4*)(p.cv + ((size_t)b * S + s) * 1024 + hh * 256 + sl * SW);
#pragma unroll
            for (int i = 0; i < SW / 8; ++i) {
                const uint4 vv = vr[i];
                acc[8 * i] += w * bflo(vv.x); acc[8 * i + 1] += w * bfhi(vv.x); acc[8 * i + 2] += w * bflo(vv.y); acc[8 * i + 3] += w * bfhi(vv.y);
                acc[8 * i + 4] += w * bflo(vv.z); acc[8 * i + 5] += w * bfhi(vv.z); acc[8 * i + 6] += w * bflo(vv.w); acc[8 * i + 7] += w * bfhi(vv.w);
            }
        } else {
            const bf16_t* vt = (MODE == 0 ? p.vta + ((size_t)(b * 4 + (hh >> 1)) * 128 + sl * SW) * S : p.vtb + ((size_t)(b * 4 + hh) * 128 + sl * SW) * S) + s;
#pragma unroll
            for (int i = 0; i < SW; ++i) { acc[i] = acc[i] * corr + w * bf2f(*vt); vt += S; asm volatile("" : "+v"(vt)); }
        }
    }
    if (MODE == 2) {
        float* o = p.oc + tq * 1024 + hh * 256 + sl * SW;
#pragma unroll
        for (int i = 0; i < SW / 4; ++i) *(f32x4*)(o + 4 * i) = (f32x4){acc[4 * i], acc[4 * i + 1], acc[4 * i + 2], acc[4 * i + 3]};
    } else {
        const float inv = 1.f / lsum;
        bf16_t* o = (MODE == 0 ? p.oa + tq * 1024 + hh * 128 : p.yb + tq * 512 + hh * 128) + sl * SW;
#pragma unroll
        for (int i = 0; i < SW / 8; ++i) {
            uint4 w4; w4.x = pack2(acc[8 * i] * inv, acc[8 * i + 1] * inv); w4.y = pack2(acc[8 * i + 2] * inv, acc[8 * i + 3] * inv);
            w4.z = pack2(acc[8 * i + 4] * inv, acc[8 * i + 5] * inv); w4.w = pack2(acc[8 * i + 6] * inv, acc[8 * i + 7] * inv);
            ((uint4*)o)[i] = w4;
        }
    }
}


typedef float f32x16 __attribute__((ext_vector_type(16)));
DI bf16x8 pack8(float a0, float a1, float a2, float a3, float a4, float a5, float a6, float a7) {
    typedef unsigned u32x4 __attribute__((ext_vector_type(4)));
    u32x4 w; w[0] = pack2(a0, a1); w[1] = pack2(a2, a3); w[2] = pack2(a4, a5); w[3] = pack2(a6, a7);
    return __builtin_bit_cast(bf16x8, w);
}

template <int MODE>
DI void flash_item(const Params& p, int b, int hh, int qi, unsigned char* smem) {
    constexpr int D = MODE == 0 ? 64 : 128, KST = D + 8, VST = 68, KS = D / 16;
    constexpr int KBYTES = 64 * KST * 2, VBYTES = 128 * VST * 2, BUFB = KBYTES + VBYTES + 256;
    constexpr int NKC = D / 32, CPR = D / 8;
    const int tid = otid(), lane = tid & 63, w = tid >> 6, r = lane & 31, hf = lane >> 5;
    const int q0 = qi * 128 + w * 32;
    const size_t tq = (size_t)b * S + q0 + r;
    bf16x8 qf[KS];
    {
        const bf16_t* qptr = (MODE == 0 ? p.qa + tq * 512 + hh * 64 : p.qb + tq * 512 + hh * 128) + hf * 8;
#pragma unroll
        for (int ks = 0; ks < KS; ++ks) qf[ks] = *(const bf16x8*)(qptr + ks * 16);
    }
    const float* fbase = p.F + (size_t)(b * 4 + (MODE == 1 ? hh : 0)) * S;
    float Fq = 0.f; if (MODE == 1) Fq = fbase[q0 + r];
    const bf16_t* kbase = MODE == 0 ? p.ka + (size_t)b * S * 512 + hh * 64 : p.kb + (size_t)b * S * 512 + hh * 128;
    const bf16_t* vbase = MODE == 0 ? p.vta + (size_t)(b * 4 + (hh >> 1)) * 128 * S : p.vtb + (size_t)(b * 4 + hh) * 128 * S;
    const int ntiles = 2 * qi + 2, wlast = 2 * qi + (w >> 1);
    uint4 kr0 = make_uint4(0, 0, 0, 0), kr1 = kr0, kr2 = kr0, kr3 = kr0, vr0 = kr0, vr1 = kr0, vr2 = kr0, vr3 = kr0; f32x4 frg = {0.f, 0.f, 0.f, 0.f};
#define FL_K(i_, jx) (*(const uint4*)(kbase + (size_t)(64 * (jx) + (tid + 256 * (i_)) / CPR) * 512 + ((tid + 256 * (i_)) % CPR) * 8))
#define FL_V(i_, jx) (*(const uint4*)(vbase + (size_t)((tid + 256 * (i_)) >> 3) * S + 64 * (jx) + ((tid + 256 * (i_)) & 7) * 8))
#define FL_GLOAD(jx) do { kr0 = FL_K(0, jx); kr1 = FL_K(1, jx); if (NKC == 4) { kr2 = FL_K(2, jx); kr3 = FL_K(3, jx); } \
        vr0 = FL_V(0, jx); vr1 = FL_V(1, jx); vr2 = FL_V(2, jx); vr3 = FL_V(3, jx); \
        if (MODE == 1 && tid < 16) frg = *(const f32x4*)(fbase + 64 * (jx) + tid * 4); } while (0)
#define FL_KS(i_, reg) (*(uint4*)(B_ + (((tid + 256 * (i_)) / CPR) * KST + ((tid + 256 * (i_)) % CPR) * 8) * 2) = (reg))
#define FL_VS(i_, reg) do { uint2* d_ = (uint2*)(B_ + KBYTES + (((tid + 256 * (i_)) >> 3) * VST + ((tid + 256 * (i_)) & 7) * 8) * 2); d_[0] = make_uint2((reg).x, (reg).y); d_[1] = make_uint2((reg).z, (reg).w); } while (0)
#define FL_SSTORE(buf) do { unsigned char* B_ = smem + (buf) * BUFB; FL_KS(0, kr0); FL_KS(1, kr1); if (NKC == 4) { FL_KS(2, kr2); FL_KS(3, kr3); } \
        FL_VS(0, vr0); FL_VS(1, vr1); FL_VS(2, vr2); FL_VS(3, vr3); \
        if (MODE == 1 && tid < 16) *(f32x4*)(B_ + KBYTES + VBYTES + tid * 16) = frg; } while (0)
    FL_GLOAD(MODE == 1 ? ntiles - 1 : 0);
    FL_SSTORE(0);
    LDS_BARRIER();
    f32x16 acc[4];
#pragma unroll
    for (int eb = 0; eb < 4; ++eb)
#pragma unroll
        for (int i = 0; i < 16; ++i) acc[eb][i] = 0.f;
    float mrun = -INFINITY, lsum = 0.f;
    unsigned* donef = (unsigned*)(smem + SMEM_BYTES - 64);
    float qk_bound = 0.f, Fq0 = 0.f;
    if (MODE == 1) {
        float qs = 0.f;
#pragma unroll
        for (int ks = 0; ks < KS; ++ks)
#pragma unroll
            for (int e = 0; e < 8; ++e) { const float x = bf2f((bf16_t)qf[ks][e]); qs += x * x; }
        qs += __shfl_xor(qs, 32);
#pragma unroll
        for (int o = 16; o; o >>= 1) qs = fmaxf(qs, __shfl_xor(qs, o));
        const unsigned* kn = p.kn + (b * 4 + hh) * 4;
        const float k2 = __uint_as_float(kn[0]) + __uint_as_float(kn[1]) + __uint_as_float(kn[2]) + __uint_as_float(kn[3]);
        qk_bound = sqrtf(qs) * sqrtf(k2) * 1.0001f + 1e-3f;
        Fq0 = __shfl(Fq, 0);
        if (lane == 0) donef[w] = 0u;
    }
    for (int it = 0; it < ntiles; ++it) {
        const int j = MODE == 1 ? ntiles - 1 - it : it;
        const bool more = it + 1 < ntiles;
        if (more) FL_GLOAD(MODE == 1 ? j - 1 : j + 1);
        if (j <= wlast) {
            const unsigned char* B = smem + (it & 1) * BUFB;
            f32x16 st[2];
#pragma unroll
            for (int kb = 0; kb < 2; ++kb) {
#pragma unroll
                for (int i = 0; i < 16; ++i) st[kb][i] = 0.f;
#pragma unroll
                for (int ks = 0; ks < KS; ++ks) {
                    const bf16x8 a = *(const bf16x8*)(B + ((kb * 32 + r) * KST + ks * 16 + hf * 8) * 2);
                    st[kb] = __builtin_amdgcn_mfma_f32_32x32x16_bf16(a, qf[ks], st[kb], 0, 0, 0);
                }
            }
            if (MODE == 1) {
                const float* Fl = (const float*)(B + KBYTES + VBYTES);
#pragma unroll
                for (int kb = 0; kb < 2; ++kb)
#pragma unroll
                    for (int g = 0; g < 4; ++g) {
                        const f32x4 fk = *(const f32x4*)(Fl + kb * 32 + 8 * g + 4 * hf);
#pragma unroll
                        for (int jj = 0; jj < 4; ++jj) st[kb][4 * g + jj] += Fq - fk[jj];
                    }
                if (j >= 2 * qi) {
                    const int qabs = q0 + r;
#pragma unroll
                    for (int kb = 0; kb < 2; ++kb)
#pragma unroll
                        for (int g = 0; g < 4; ++g)
#pragma unroll
                            for (int jj = 0; jj < 4; ++jj) { const int key = 64 * j + kb * 32 + 8 * g + 4 * hf + jj; if (key > qabs) st[kb][4 * g + jj] = -INFINITY; }
                }
            }
            float mt = st[0][0];
#pragma unroll
            for (int i = 1; i < 16; ++i) mt = fmaxf(mt, st[0][i]);
#pragma unroll
            for (int i = 0; i < 16; ++i) mt = fmaxf(mt, st[1][i]);
            mt = fmaxf(mt, __shfl_xor(mt, 32));
            if (!(MODE == 1 && __all(mt < mrun - 40.0f))) {
            const float mn = fmaxf(mrun, mt);
            const float corr = ex2(mrun - mn);
            mrun = mn; lsum *= corr;
#pragma unroll
            for (int kb = 0; kb < 2; ++kb)
#pragma unroll
                for (int i = 0; i < 16; ++i) { const float pv = ex2(st[kb][i] - mn); st[kb][i] = pv; lsum += pv; }
#pragma unroll
            for (int eb = 0; eb < 4; ++eb) acc[eb] *= corr;
#pragma unroll
            for (int kb = 0; kb < 2; ++kb)
#pragma unroll
                for (int s2 = 0; s2 < 2; ++s2) {
                    const bf16x8 pf = pack8(st[kb][8 * s2], st[kb][8 * s2 + 1], st[kb][8 * s2 + 2], st[kb][8 * s2 + 3], st[kb][8 * s2 + 4], st[kb][8 * s2 + 5], st[kb][8 * s2 + 6], st[kb][8 * s2 + 7]);
#pragma unroll
                    for (int eb = 0; eb < 4; ++eb) {
                        const unsigned char* vp = B + KBYTES + ((eb * 32 + r) * VST + kb * 32 + 16 * s2 + 4 * hf) * 2;
                        const uint2 lo = *(const uint2*)vp, hi = *(const uint2*)(vp + 16);
                        typedef unsigned u32x4 __attribute__((ext_vector_type(4)));
                        u32x4 av; av[0] = lo.x; av[1] = lo.y; av[2] = hi.x; av[3] = hi.y;
                        acc[eb] = __builtin_amdgcn_mfma_f32_32x32x16_bf16(__builtin_bit_cast(bf16x8, av), pf, acc[eb], 0, 0, 0);
                    }
                }
            }
        }
        if (MODE == 1 && j <= wlast) {
            const float* Fl0 = (const float*)(smem + (it & 1) * BUFB + KBYTES + VBYTES);
            float mmin = mrun;
#pragma unroll
            for (int o = 16; o; o >>= 1) mmin = fminf(mmin, __shfl_xor(mmin, o));
            if (lane == 0 && qk_bound + (Fq0 - Fl0[0]) < mmin - 40.0f) donef[w] = 1u;
        }
        if (more) FL_SSTORE((it + 1) & 1);
        LDS_BARRIER();
        if (MODE == 1 && (donef[0] & donef[1] & donef[2] & donef[3])) break;
    }
#undef FL_GLOAD
#undef FL_SSTORE
#undef FL_K
#undef FL_V
#undef FL_KS
#undef FL_VS
    const float inv = 1.f / (lsum + __shfl_xor(lsum, 32));
    bf16_t* o = MODE == 0 ? p.oa + tq * 1024 + hh * 128 : p.yb + tq * 512 + hh * 128;
#pragma unroll
    for (int eb = 0; eb < 4; ++eb)
#pragma unroll
        for (int g = 0; g < 4; ++g) {
            f32x4 v = {acc[eb][4 * g] * inv, acc[eb][4 * g + 1] * inv, acc[eb][4 * g + 2] * inv, acc[eb][4 * g + 3] * inv};
            st4(o + eb * 32 + 8 * g + 4 * hf, v);
        }
}


DI void ret_state_item(const Params& p, int item) {
    const int n = item & 127, bh = item >> 7;
    const int tid = otid(), lane = tid & 63, w = tid >> 6, r = lane & 31, hf = lane >> 5;
    const bf16_t* kt = p.ckT + (size_t)bh * 128 * S + n * 64 + hf * 8;
    const bf16_t* vt = p.cv + ((size_t)bh * 256 + w * 64) * S + n * 64 + hf * 8;
    f32x16 acc[4][2];
#pragma unroll
    for (int a = 0; a < 4; ++a)
#pragma unroll
        for (int c = 0; c < 2; ++c)
#pragma unroll
            for (int i = 0; i < 16; ++i) acc[a][c][i] = 0.f;
#pragma unroll
    for (int s4 = 0; s4 < 4; ++s4) {
        bf16x8 af[4], bfr[2];
#pragma unroll
        for (int a = 0; a < 4; ++a) af[a] = *(const bf16x8*)(kt + (size_t)(a * 32 + r) * S + s4 * 16);
#pragma unroll
        for (int c = 0; c < 2; ++c) bfr[c] = *(const bf16x8*)(vt + (size_t)(c * 32 + r) * S + s4 * 16);
#pragma unroll
        for (int a = 0; a < 4; ++a)
#pragma unroll
            for (int c = 0; c < 2; ++c) acc[a][c] = __builtin_amdgcn_mfma_f32_32x32x16_bf16(af[a], bfr[c], acc[a][c], 0, 0, 0);
    }
    bf16_t* o = p.kv + ((size_t)(bh * 128 + n) * 256 + w * 64) * 128;
#pragma unroll
    for (int a = 0; a < 4; ++a)
#pragma unroll
        for (int c = 0; c < 2; ++c)
#pragma unroll
            for (int g = 0; g < 4; ++g) {
                f32x4 v = {acc[a][c][4 * g], acc[a][c][4 * g + 1], acc[a][c][4 * g + 2], acc[a][c][4 * g + 3]};
                st4_wt(o + (size_t)(c * 32 + r) * 128 + a * 32 + 8 * g + 4 * hf, v);
            }
}

DI void ret_scan(const Params& p) {
    const int gtid = obid() * 256 + otid(), gsz = gridDim.x * 256;
    for (int e = gtid; e < 8 * 8192; e += gsz) {
        const int bh = e >> 13, pi = e & 8191, hd = bh & 3;
        const float dec = ex2(64.0f * lg2gamma(hd));
        unsigned long long* ptr = (unsigned long long*)p.kv + (size_t)bh * 128 * 8192 + pi;
        float c0 = 0.f, c1 = 0.f, c2 = 0.f, c3 = 0.f;
        for (int n0 = 0; n0 < 128; n0 += 8) {
            unsigned long long v[8];
#pragma unroll
            for (int k = 0; k < 8; ++k) v[k] = ptr[(size_t)(n0 + k) * 8192];
            asm volatile("s_waitcnt vmcnt(0)" ::: "memory");
#pragma unroll
            for (int k = 0; k < 8; ++k) {
                const unsigned long long o = (unsigned long long)pack2(c0, c1) | ((unsigned long long)pack2(c2, c3) << 32);
                __hip_atomic_store(ptr + (size_t)(n0 + k) * 8192, o, __ATOMIC_RELAXED, __HIP_MEMORY_SCOPE_AGENT);
                const unsigned lo = (unsigned)v[k], hi = (unsigned)(v[k] >> 32);
                c0 = c0 * dec + bflo(lo); c1 = c1 * dec + bfhi(lo); c2 = c2 * dec + bflo(hi); c3 = c3 * dec + bfhi(hi);
            }
        }
    }
}

DI void ret_out_item(const Params& p, int l, int item, unsigned char* smem) {
    const int n = item & 127, bh = item >> 7, b = bh >> 2, hd = bh & 3;
    const int tid = otid(), lane = tid & 63, w = tid >> 6, r = lane & 31, hf = lane >> 5;
    const size_t t0 = (size_t)b * S + n * 64;
    f32x16 acc[2][2];
#pragma unroll
    for (int a = 0; a < 2; ++a)
#pragma unroll
        for (int c = 0; c < 2; ++c)
#pragma unroll
            for (int i = 0; i < 16; ++i) acc[a][c][i] = 0.f;
    bf16x8 pf[2][2][2];
    typedef unsigned u32x4 __attribute__((ext_vector_type(4)));
    bf16x8 qf[2][8], rf[2][8];
    uint2 vlo[2][2][2], vhi[2][2][2];
    {
        const bf16_t* rt = p.kv + ((size_t)(bh * 128 + n) * 256 + w * 64) * 128 + hf * 8;
#pragma unroll
        for (int qb = 0; qb < 2; ++qb)
#pragma unroll
            for (int ks = 0; ks < 8; ++ks) qf[qb][ks] = *(const bf16x8*)(p.cq + (t0 + qb * 32 + r) * 512 + hd * 128 + ks * 16 + hf * 8);
#pragma unroll
        for (int dvb = 0; dvb < 2; ++dvb)
#pragma unroll
            for (int ks = 0; ks < 8; ++ks) rf[dvb][ks] = *(const bf16x8*)(rt + (size_t)(dvb * 32 + r) * 128 + ks * 16);
    }
    __builtin_amdgcn_sched_barrier(0);
#pragma unroll
    for (int dvb = 0; dvb < 2; ++dvb)
#pragma unroll
        for (int ks = 0; ks < 8; ++ks)
#pragma unroll
            for (int qb = 0; qb < 2; ++qb) acc[dvb][qb] = __builtin_amdgcn_mfma_f32_32x32x16_bf16(rf[dvb][ks], qf[qb][ks], acc[dvb][qb], 0, 0, 0);
#pragma unroll
    for (int kb = 0; kb < 2; ++kb)
#pragma unroll
        for (int ks = 0; ks < 8; ++ks) rf[kb][ks] = *(const bf16x8*)(p.ck + (t0 + kb * 32 + r) * 512 + hd * 128 + ks * 16 + hf * 8);
    __builtin_amdgcn_sched_barrier(0);
#pragma unroll
    for (int kb = 0; kb < 2; ++kb) {
        f32x16 st[2];
#pragma unroll
        for (int qb = 0; qb < 2; ++qb)
#pragma unroll
            for (int i = 0; i < 16; ++i) st[qb][i] = 0.f;
#pragma unroll
        for (int ks = 0; ks < 8; ++ks)
#pragma unroll
            for (int qb = 0; qb < 2; ++qb) st[qb] = __builtin_amdgcn_mfma_f32_32x32x16_bf16(rf[kb][ks], qf[qb][ks], st[qb], 0, 0, 0);
#pragma unroll
        for (int qb = 0; qb < 2; ++qb) {
#pragma unroll
            for (int i = 0; i < 16; ++i) { const int key = kb * 32 + (i & 3) + 8 * (i >> 2) + 4 * hf; if (key > qb * 32 + r) st[qb][i] = 0.f; }
#pragma unroll
            for (int s2 = 0; s2 < 2; ++s2)
                pf[kb][s2][qb] = pack8(st[qb][8 * s2], st[qb][8 * s2 + 1], st[qb][8 * s2 + 2], st[qb][8 * s2 + 3], st[qb][8 * s2 + 4], st[qb][8 * s2 + 5], st[qb][8 * s2 + 6], st[qb][8 * s2 + 7]);
        }
    }
    {
        const bf16_t* vt = p.cv + ((size_t)bh * 256 + w * 64) * S + n * 64 + 4 * hf;
#pragma unroll
        for (int dvb = 0; dvb < 2; ++dvb)
#pragma unroll
            for (int kb = 0; kb < 2; ++kb)
#pragma unroll
                for (int s2 = 0; s2 < 2; ++s2) {
                    const bf16_t* vp = vt + (size_t)(dvb * 32 + r) * S + kb * 32 + 16 * s2;
                    vlo[dvb][kb][s2] = *(const uint2*)vp; vhi[dvb][kb][s2] = *(const uint2*)(vp + 8);
                }
    }
    __builtin_amdgcn_sched_barrier(0);
#pragma unroll
    for (int dvb = 0; dvb < 2; ++dvb)
#pragma unroll
        for (int kb = 0; kb < 2; ++kb)
#pragma unroll
            for (int s2 = 0; s2 < 2; ++s2) {
                u32x4 av; av[0] = vlo[dvb][kb][s2].x; av[1] = vlo[dvb][kb][s2].y; av[2] = vhi[dvb][kb][s2].x; av[3] = vhi[dvb][kb][s2].y;
                const bf16x8 a = __builtin_bit_cast(bf16x8, av);
#pragma unroll
                for (int qb = 0; qb < 2; ++qb) acc[dvb][qb] = __builtin_amdgcn_mfma_f32_32x32x16_bf16(a, pf[kb][s2][qb], acc[dvb][qb], 0, 0, 0);
            }
    float* red = (float*)smem;
    float mu[2], rstd[2];
    __syncthreads();
#pragma unroll
    for (int qb = 0; qb < 2; ++qb) {
        float s1 = 0.f, s2 = 0.f;
#pragma unroll
        for (int dvb = 0; dvb < 2; ++dvb)
#pragma unroll
            for (int i = 0; i < 16; ++i) { const float x = acc[dvb][qb][i]; s1 += x; s2 += x * x; }
        s1 += __shfl_xor(s1, 32); s2 += __shfl_xor(s2, 32);
        if (hf == 0) { red[(w * 64 + qb * 32 + r) * 2] = s1; red[(w * 64 + qb * 32 + r) * 2 + 1] = s2; }
    }
    __syncthreads();
#pragma unroll
    for (int qb = 0; qb < 2; ++qb) {
        float s1 = 0.f, s2 = 0.f;
#pragma unroll
        for (int ww = 0; ww < 4; ++ww) { s1 += red[(ww * 64 + qb * 32 + r) * 2]; s2 += red[(ww * 64 + qb * 32 + r) * 2 + 1]; }
        const float m_ = s1 * (1.f / 256.f);
        mu[qb] = m_; rstd[qb] = rsqrtf(fmaxf(s2 * (1.f / 256.f) - m_ * m_, 0.f) + LN_EPS);
    }
    const float* gr = p.g_ret + (size_t)l * 1024 + hd * 256 + w * 64;
#pragma unroll
    for (int dvb = 0; dvb < 2; ++dvb)
#pragma unroll
        for (int g = 0; g < 4; ++g) {
            const int dv = dvb * 32 + 8 * g + 4 * hf;
            const f32x4 gg = *(const f32x4*)(gr + dv);
#pragma unroll
            for (int qb = 0; qb < 2; ++qb) {
                const size_t off = (t0 + qb * 32 + r) * 1024 + hd * 256 + w * 64 + dv;
                const uint2 cgv = *(const uint2*)(p.cg + off);
                f32x4 y;
#pragma unroll
                for (int jj = 0; jj < 4; ++jj) y[jj] = (acc[dvb][qb][4 * g + jj] - mu[qb]) * rstd[qb] * gg[jj];
                y[0] *= bflo(cgv.x); y[1] *= bfhi(cgv.x); y[2] *= bflo(cgv.y); y[3] *= bfhi(cgv.y);
                st4(p.yc + off, y);
            }
        }
}

DI void phase_mixers(const Params& p, int l, unsigned char* smem) {
    const int nF = 64 * 24, nC = 2 * 4 * 128;
    int* sitem = (int*)(smem + SMEM_BYTES - 16);
    for (;;) {
        __syncthreads();
        if (otid() == 0) *sitem = (int)atomicAdd(p.ctr + l, 1u);
        __syncthreads();
        const int it = *sitem;
        if (it >= nF + nC) break;
        if (it < nF) {
            const int qi = 63 - it / 24, r = it % 24;
            if (r < 8) flash_item<1>(p, r >> 2, r & 3, qi, smem);
            else flash_item<0>(p, (r - 8) >> 3, (r - 8) & 7, qi, smem);
        } else ret_state_item(p, it - nF);
    }
}

DI void phase_mixers_naive(const Params& p) {
    const int nA = 2 * 8 * 128, nB = 2 * 4 * 128, nC = 2 * 4 * 128;
    for (int it = obid(); it < nA + nB + nC; it += gridDim.x) {
        if (it < nB) naive_attn<1>(p, it);
        else if (it < nB + nC) naive_attn<2>(p, it - nB);
        else naive_attn<0>(p, it - nB - nC);
    }
}

DI void phase_post(const Params& p, int l) {
    const int lane = otid() & 63, wv = otid() >> 6;
    const float lam = p.lamv[2 * l], li = p.lamv[2 * l + 1];
    const float* gd = p.g_diff + (size_t)l * 512; const float* gr = p.g_ret + (size_t)l * 1024;
    for (int row = obid() * 4 + wv; row < T; row += gridDim.x * 4) {
#pragma unroll
        for (int hh = 0; hh < 4; ++hh) {
            const unsigned o0 = *(const unsigned*)(p.oa + (size_t)row * 1024 + (2 * hh) * 128 + lane * 2);
            const unsigned o1 = *(const unsigned*)(p.oa + (size_t)row * 1024 + (2 * hh + 1) * 128 + lane * 2);
            const float d0 = bflo(o0) - lam * bflo(o1), d1 = bfhi(o0) - lam * bfhi(o1);
            float ss = d0 * d0 + d1 * d1;
            for (int o = 32; o; o >>= 1) ss += __shfl_xor(ss, o);
            const float r = rsqrtf(ss * (1.f / 128.f) + LN_EPS) * (1.f - li);
            const int c = hh * 128 + lane * 2;
            *(unsigned*)(p.ya + (size_t)row * 512 + c) = pack2(d0 * r * gd[c], d1 * r * gd[c + 1]);
        }
    }
}

DI void grid_bar(unsigned* bar, unsigned& epoch) {
    asm volatile("s_waitcnt vmcnt(0) lgkmcnt(0)" ::: "memory");
    __syncthreads();
    epoch += 1;
    const int tid = otid();
    unsigned* go = bar;
    unsigned* flags = bar + 32;
    if (tid == 0) {
        __builtin_amdgcn_fence(__ATOMIC_RELEASE, "agent");
        asm volatile("s_waitcnt vmcnt(0)" ::: "memory");
        __hip_atomic_store(flags + 32 * obid(), epoch, __ATOMIC_RELAXED, __HIP_MEMORY_SCOPE_AGENT);
    }
    if (obid() == 0 && tid < 64) {
        const int nb = gridDim.x;
        for (int base = 0; base < nb; base += 64) {
            const int idx = base + tid;
            if (idx < nb) while (__hip_atomic_load(flags + 32 * idx, __ATOMIC_RELAXED, __HIP_MEMORY_SCOPE_AGENT) < epoch) __builtin_amdgcn_s_sleep(1);
        }
        asm volatile("s_waitcnt vmcnt(0)" ::: "memory");
        if (tid == 0) __hip_atomic_store(go, epoch, __ATOMIC_RELAXED, __HIP_MEMORY_SCOPE_AGENT);
    }
    if (tid == 0) {
        while (__hip_atomic_load(go, __ATOMIC_RELAXED, __HIP_MEMORY_SCOPE_AGENT) < epoch) __builtin_amdgcn_s_sleep(1);
        __builtin_amdgcn_fence(__ATOMIC_ACQUIRE, "agent");
        asm volatile("s_waitcnt vmcnt(0)" ::: "memory");
    }
    __syncthreads();
}
#define GSYNC() grid_bar(p.bar, epoch)
__global__ void __launch_bounds__(256, 2) fwd_kernel(Params p) {
    __shared__ __attribute__((aligned(16))) unsigned char smem[SMEM_BYTES];
    cg::grid_group grid = cg::this_grid();
    bf16_t* sm = (bf16_t*)smem; float* smf = (float*)smem;

    unsigned epoch = 0;
    asm volatile("s_waitcnt vmcnt(0) lgkmcnt(0)" ::: "memory"); grid.sync();
    convert_layer(p, 0, smf);
    phase0_misc(p, smf);
    GSYNC();
    row_phase(p, p.x, false, nullptr, nullptr, nullptr, p.mod, 0, 1024, true, true);
    GSYNC();
    for (int l = 0; l < DEPTH; ++l) {
        const float* modl = p.mod + (size_t)l * 2 * 6144;
        const float* xcur = l == 0 ? p.x : p.xbuf;
        if (obid() >= gridDim.x - 8) scan_item(p, obid() - (gridDim.x - 8), smf);
        phase_inproj(p, sm);
        GSYNC();
        phase_mixers(p, l, smem);
        GSYNC();
        phase_post(p, l);
        ret_scan(p);
        GSYNC();
        for (int it = obid(); it < 1024; it += gridDim.x) ret_out_item(p, l, it, smem);
        GSYNC();
        phase_branch(p, sm);
        GSYNC();
        phase_gemm_res(p, p.h, 1024, p.WoutT, xcur, modl, 2048, sm);
        GSYNC();
        row_phase(p, p.vbuf, true, p.ln_g + (size_t)(l * 2) * Dm, p.ln_b + (size_t)(l * 2) * Dm, p.xbuf, modl, 3072, 4096, true, false);
        GSYNC();
        phase_up(p, sm);
        GSYNC();
        phase_conv(p, l);
        GSYNC();
        phase_gemm_res(p, p.act, DFF, p.WdownT, p.xbuf, modl, 5120, sm);
        GSYNC();
        if (l + 1 < DEPTH) {
            convert_layer(p, l + 1, smf);
            GSYNC();
            row_phase(p, p.vbuf, true, p.ln_g + (size_t)(l * 2 + 1) * Dm, p.ln_b + (size_t)(l * 2 + 1) * Dm, p.xbuf, modl + 2 * 6144, 0, 1024, true, true);
            GSYNC();
        } else {
            row_phase(p, p.vbuf, true, p.ln_g + (size_t)(l * 2 + 1) * Dm, p.ln_b + (size_t)(l * 2 + 1) * Dm, p.out, modl, 0, 1024, false, false);
        }
    }
}

extern "C" void kernel_launch(void* const* d_in, const int* in_sizes, int n_in, void* d_out, int out_size, void* d_ws, size_t ws_size, hipStream_t stream) {
    static int grid_blocks = 0;
    if (!grid_blocks) {
        int dev = 0, cus = 0, per_cu = 0;
        hipGetDevice(&dev);
        hipDeviceGetAttribute(&cus, hipDeviceAttributeMultiprocessorCount, dev);
        hipOccupancyMaxActiveBlocksPerMultiprocessor(&per_cu, fwd_kernel, 256, 0);
        if (per_cu > 2) per_cu = 2;
        if (per_cu < 1) per_cu = 1;
        grid_blocks = cus * per_cu;
    }
    Params p{};
    const float** ins = (const float**)&p.x;
    for (int i = 0; i < 22; ++i) ins[i] = (const float*)d_in[i];
    p.out = (float*)d_out;
    char* w = (char*)d_ws; size_t off = 0;
    auto take = [&](size_t bytes) { char* r = w + off; off += (bytes + 255) & ~(size_t)255; return r; };
    const size_t MB = 1u << 20;
    p.mod = (float*)take((size_t)DEPTH * 2 * 6144 * 4);
    p.lamv = (float*)take(256);
    p.ctr = (unsigned*)take(256);
    p.kn = (unsigned*)take(256);
    p.bar = (unsigned*)take((size_t)(1 + 1024) * 128);
    p.wf = (float*)take(4100 * 4);
    p.binp = (float*)take(NIN * 4);
    p.cstab = (float*)take((size_t)S * 64 * 2 * 4);
    p.logf = (float*)take((size_t)T * 4 * 4);
    p.F = (float*)take((size_t)T * 4 * 4);
    p.WinT = (bf16_t*)take((size_t)NIN * 1024 * 2);
    p.WpaT = (bf16_t*)take((size_t)1024 * 512 * 2);
    p.WpbT = (bf16_t*)take((size_t)1024 * 512 * 2);
    p.WpcT = (bf16_t*)take((size_t)1024 * 1024 * 2);
    p.WoutT = (bf16_t*)take((size_t)1024 * 1024 * 2);
    p.WupT = (bf16_t*)take((size_t)2 * DFF * 1024 * 2);
    p.WdownT = (bf16_t*)take((size_t)1024 * DFF * 2);
    p.xbuf = (float*)take((size_t)T * Dm * 4);
    p.h = (bf16_t*)take((size_t)T * Dm * 2);
    const size_t offA = off;
    p.qa = (bf16_t*)take((size_t)T * 512 * 2); p.ka = (bf16_t*)take((size_t)T * 512 * 2); p.vta = (bf16_t*)take((size_t)T * 512 * 2);
    p.qb = (bf16_t*)take((size_t)T * 512 * 2); p.kb = (bf16_t*)take((size_t)T * 512 * 2); p.vtb = (bf16_t*)take((size_t)T * 512 * 2);
    p.cq = (bf16_t*)take((size_t)T * 512 * 2); p.ck = (bf16_t*)take((size_t)T * 512 * 2);
    p.cv = (bf16_t*)take((size_t)T * 1024 * 2); p.cg = (bf16_t*)take((size_t)T * 1024 * 2);
    p.gates = (bf16_t*)take((size_t)T * 3072 * 2);
    const size_t endA = off;
    p.ug = (bf16_t*)(w + offA);
    p.act = (bf16_t*)(w + offA + (size_t)T * 2 * DFF * 2);
    const size_t offB = endA;
    off = offB;
    p.vbuf = (float*)(w + offB);
    p.oa = p.h;
    p.yb = (bf16_t*)take((size_t)T * 512 * 2);
    p.kv = (bf16_t*)take((size_t)8 * 128 * 256 * 128 * 2);
    p.ckT = (bf16_t*)take((size_t)T * 512 * 2);
    p.ya = (bf16_t*)take((size_t)T * 512 * 2);
    p.yc = (bf16_t*)take((size_t)T * 1024 * 2);
    if (off > ws_size || (size_t)T * 2 * DFF * 2 + (size_t)T * DFF * 2 > endA - offA) {
        fprintf(stderr, "kernel_launch: workspace too small: need %zu MB have %zu MB\n", off / MB, ws_size / MB);
        return;
    }
    (void)hipMemsetAsync(p.bar, 0, (size_t)(1 + 1024) * 128, stream);
    void* args[] = {&p};
    hipError_t e = hipLaunchCooperativeKernel((void*)fwd_kernel, dim3(grid_blocks), dim3(256), args, 0, stream);
    if (e != hipSuccess) fprintf(stderr, "cooperative launch failed: %s (grid %d)\n", hipGetErrorString(e), grid_blocks);
}
```
